# Optimizing an MI355X kernel written in HIP

```python
import jax
import jax.numpy as jnp
from jax import lax
import numpy as np


D_MODEL = 1024
BATCH = 1
SEQ = 16384
DEPTH = 2

CHUNK = 64
D_MIX = D_MODEL
EPS = 1e-6
NEG_INF = -1e30

SGU_WIDTH = D_MIX // 4
SGU_HEADS = 4
SGU_HEAD_DIM = SGU_WIDTH // SGU_HEADS
SGU_BLOCK = 128

POOL_WIDTH = D_MIX // 4
POOL_WINDOWS = (2, 4, 8, 16)
POOL_GROUPS = len(POOL_WINDOWS)
POOL_GROUP_DIM = POOL_WIDTH // POOL_GROUPS

MLA_WIDTH = D_MIX // 2
MLA_HEADS = 4
V_HEAD_DIM = MLA_WIDTH // MLA_HEADS
QK_NOPE_DIM = 128
QK_ROPE_DIM = 64
QK_HEAD_DIM = QK_NOPE_DIM + QK_ROPE_DIM
Q_LORA_RANK = 384
KV_LORA_RANK = 256
ROPE_BASE = 10000.0
Q_BLOCK = 128

IN_SPLITS = (SGU_WIDTH, SGU_WIDTH, SGU_WIDTH, POOL_WIDTH, POOL_WIDTH, Q_LORA_RANK, KV_LORA_RANK, QK_ROPE_DIM, MLA_WIDTH)
D_IN = sum(IN_SPLITS)

kernel_name = "hybrid_sgu_pool_mla_block"


def rms_norm(x, g):
    xf = x.astype(jnp.float32)
    y = xf * lax.rsqrt(jnp.mean(xf * xf, axis=-1, keepdims=True) + EPS)
    return (y * g.astype(jnp.float32)).astype(x.dtype)


def layer_norm(x, g, b):
    xf = x.astype(jnp.float32)
    mu = jnp.mean(xf, axis=-1, keepdims=True)
    var = jnp.mean(jnp.square(xf - mu), axis=-1, keepdims=True)
    y = (xf - mu) * lax.rsqrt(var + EPS)
    return (y * g.astype(jnp.float32) + b.astype(jnp.float32)).astype(x.dtype)


def rope_tables(positions):
    inv_freq = ROPE_BASE ** (-jnp.arange(0, QK_ROPE_DIM, 2, dtype=jnp.float32) / QK_ROPE_DIM)
    ang = positions.astype(jnp.float32)[..., None] * inv_freq
    return jnp.cos(ang)[:, :, None, :], jnp.sin(ang)[:, :, None, :]


def apply_rope(x, cos, sin):
    xf = x.astype(jnp.float32)
    x1, x2 = jnp.split(xf, 2, axis=-1)
    return jnp.concatenate([x1 * cos - x2 * sin, x2 * cos + x1 * sin], axis=-1).astype(x.dtype)


def sgu_mixer(u, v, w_s, b_s, ln_g, ln_b):
    bsz, seq, _ = v.shape
    v = layer_norm(v, ln_g, ln_b)
    vb = v.reshape(bsz, seq // SGU_BLOCK, SGU_BLOCK, SGU_HEADS, SGU_HEAD_DIM)
    pos_chunk = jnp.arange(SGU_BLOCK) // CHUNK
    mask = (pos_chunk[None, :] <= pos_chunk[:, None]).astype(w_s.dtype)
    mixed = jnp.einsum("hij,bnjhd->bnihd", w_s * mask, vb) + b_s.T[None, None, :, :, None]
    return u * mixed.reshape(bsz, seq, SGU_WIDTH)


def pool_mixer(p, w_g, scale):
    bsz, seq, _ = p.shape
    pf = p.astype(jnp.float32)
    cs = jnp.concatenate([jnp.zeros((bsz, 1, POOL_WIDTH), jnp.float32), jnp.cumsum(pf, axis=1)], axis=1)
    t = jnp.arange(seq)
    outs = []
    for g, w in enumerate(POOL_WINDOWS):
        lo, hi = g * POOL_GROUP_DIM, (g + 1) * POOL_GROUP_DIM
        csg = cs[:, :, lo:hi]
        upper = csg[:, 1:]
        lower = jnp.concatenate([jnp.zeros((bsz, w - 1, POOL_GROUP_DIM), jnp.float32), csg[:, :seq + 1 - w]], axis=1)
        count = jnp.minimum(t + 1, w).astype(jnp.float32)[None, :, None]
        outs.append((upper - lower) / count - pf[:, :, lo:hi])
    pooled = jnp.stack(outs, axis=2).astype(p.dtype)
    mixed = jnp.einsum("bsgc,gcd->bsgd", pooled, w_g).reshape(bsz, seq, POOL_WIDTH)
    return mixed * scale


def mla_mixer(c_q, c_kv, k_rope, q_norm_g, w_uq, kv_norm_g, w_ukv, cos, sin):
    bsz, seq, _ = c_q.shape
    q = (rms_norm(c_q, q_norm_g) @ w_uq).reshape(bsz, seq, MLA_HEADS, QK_HEAD_DIM)
    q = jnp.concatenate([q[..., :QK_NOPE_DIM], apply_rope(q[..., QK_NOPE_DIM:], cos, sin)], axis=-1)
    kv = (rms_norm(c_kv, kv_norm_g) @ w_ukv).reshape(bsz, seq, MLA_HEADS, QK_NOPE_DIM + V_HEAD_DIM)
    k_nope, v = kv[..., :QK_NOPE_DIM], kv[..., QK_NOPE_DIM:]
    k_pe = apply_rope(k_rope[:, :, None, :], cos, sin)
    k = jnp.concatenate([k_nope, jnp.broadcast_to(k_pe, (bsz, seq, MLA_HEADS, QK_ROPE_DIM))], axis=-1)
    scale = QK_HEAD_DIM ** -0.5
    n_blk = seq // Q_BLOCK
    q_blocks = q.reshape(bsz, n_blk, Q_BLOCK, MLA_HEADS, QK_HEAD_DIM).transpose(1, 0, 2, 3, 4)
    key_chunk = jnp.arange(seq) // CHUNK

    def attend(args):
        q_blk, blk = args
        s = jnp.einsum("bqhd,bkhd->bhqk", q_blk, k).astype(jnp.float32) * scale
        q_chunk = (blk * Q_BLOCK + jnp.arange(Q_BLOCK)) // CHUNK
        allowed = key_chunk[None, :] <= q_chunk[:, None]
        s = jnp.where(allowed, s, NEG_INF)
        p = jax.nn.softmax(s, axis=-1).astype(v.dtype)
        return jnp.einsum("bhqk,bkhd->bqhd", p, v)

    o = lax.map(attend, (q_blocks, jnp.arange(n_blk)))
    return o.transpose(1, 0, 2, 3, 4).reshape(bsz, seq, MLA_WIDTH)


def hybrid_layer(x, pre_g, post_g, w_in, sgu_w, sgu_b, sgu_ln_g, sgu_ln_b, pool_w, pool_scale, q_norm_g, w_uq, kv_norm_g, w_ukv, w_out, cos, sin):
    h = rms_norm(x, pre_g)
    z = h @ w_in
    offs = [int(o) for o in np.cumsum(IN_SPLITS)[:-1]]
    sgu_u, sgu_v, sgu_gate, pool_in, pool_gate, c_q, c_kv, k_rope, mla_gate = jnp.split(z, offs, axis=-1)
    ya = sgu_mixer(sgu_u, sgu_v, sgu_w, sgu_b, sgu_ln_g, sgu_ln_b) * jax.nn.silu(sgu_gate)
    yb = pool_mixer(pool_in, pool_w, pool_scale) * jax.nn.silu(pool_gate)
    yc = mla_mixer(c_q, c_kv, k_rope, q_norm_g, w_uq, kv_norm_g, w_ukv, cos, sin) * jax.nn.silu(mla_gate)
    y = jnp.concatenate([ya, yb, yc], axis=-1) @ w_out
    return x + rms_norm(y, post_g)


def setup_inputs(seed: int = 0) -> dict:
    key = jax.random.key(seed)
    ks = jax.random.split(key, 16)

    def nrm(k, shape, s):
        return jax.random.normal(k, shape, jnp.float32) * s

    x = jax.random.normal(ks[0], (BATCH, SEQ, D_MODEL), jnp.float32)
    positions = jnp.broadcast_to(jnp.arange(SEQ, dtype=jnp.int32)[None, :], (BATCH, SEQ))
    pre_norm_g = 1.0 + nrm(ks[1], (DEPTH, D_MODEL), 0.02)
    post_norm_g = 1.0 + nrm(ks[2], (DEPTH, D_MODEL), 0.02)
    w_in = nrm(ks[3], (DEPTH, D_MODEL, D_IN), D_MODEL ** -0.5)
    sgu_w = nrm(ks[4], (DEPTH, SGU_HEADS, SGU_BLOCK, SGU_BLOCK), SGU_BLOCK ** -0.5)
    sgu_b = 1.0 + nrm(ks[5], (DEPTH, SGU_HEADS, SGU_BLOCK), 0.02)
    sgu_ln_g = 1.0 + nrm(ks[6], (DEPTH, SGU_WIDTH), 0.02)
    sgu_ln_b = nrm(ks[7], (DEPTH, SGU_WIDTH), 0.02)
    pool_w = nrm(ks[8], (DEPTH, POOL_GROUPS, POOL_GROUP_DIM, POOL_GROUP_DIM), POOL_GROUP_DIM ** -0.5)
    pool_scale = 1.0 + nrm(ks[9], (DEPTH, POOL_WIDTH), 0.02)
    q_norm_g = 1.0 + nrm(ks[10], (DEPTH, Q_LORA_RANK), 0.02)
    w_uq = nrm(ks[11], (DEPTH, Q_LORA_RANK, MLA_HEADS * QK_HEAD_DIM), Q_LORA_RANK ** -0.5)
    kv_norm_g = 1.0 + nrm(ks[12], (DEPTH, KV_LORA_RANK), 0.02)
    w_ukv = nrm(ks[13], (DEPTH, KV_LORA_RANK, MLA_HEADS * (QK_NOPE_DIM + V_HEAD_DIM)), KV_LORA_RANK ** -0.5)
    w_out = nrm(ks[14], (DEPTH, D_MIX, D_MODEL), D_MIX ** -0.5)
    return {"x": x, "positions": positions, "pre_norm_g": pre_norm_g, "post_norm_g": post_norm_g, "w_in": w_in, "sgu_w": sgu_w, "sgu_b": sgu_b, "sgu_ln_g": sgu_ln_g, "sgu_ln_b": sgu_ln_b, "pool_w": pool_w, "pool_scale": pool_scale, "q_norm_g": q_norm_g, "w_uq": w_uq, "kv_norm_g": kv_norm_g, "w_ukv": w_ukv, "w_out": w_out}


def reference(x, positions, pre_norm_g, post_norm_g, w_in, sgu_w, sgu_b, sgu_ln_g, sgu_ln_b, pool_w, pool_scale, q_norm_g, w_uq, kv_norm_g, w_ukv, w_out):
    cos, sin = rope_tables(positions)
    for l in range(DEPTH):
        x = hybrid_layer(x, pre_norm_g[l], post_norm_g[l], w_in[l], sgu_w[l], sgu_b[l], sgu_ln_g[l], sgu_ln_b[l], pool_w[l], pool_scale[l], q_norm_g[l], w_uq[l], kv_norm_g[l], w_ukv[l], w_out[l], cos, sin)
    return x
```

```cpp
#include <hip/hip_runtime.h>
#include <hip/hip_cooperative_groups.h>
#include <cstdio>
#include <cmath>
namespace cg = cooperative_groups;

#define DI __device__ __forceinline__
typedef unsigned short u16;
using bf16x8 = __attribute__((ext_vector_type(8))) short;
using f32x16 = __attribute__((ext_vector_type(16))) float;
using f32x4  = __attribute__((ext_vector_type(4))) float;
using f32x2  = __attribute__((ext_vector_type(2))) float;
using u32x4  = __attribute__((ext_vector_type(4))) unsigned;
using u32x2  = __attribute__((ext_vector_type(2))) unsigned;
typedef __bf16 bf2_t __attribute__((ext_vector_type(2)));
#define MFMA(a, b, c) __builtin_amdgcn_mfma_f32_32x32x16_bf16((a), (b), (c), 0, 0, 0)

#ifndef COOP
#define COOP 1
#endif

constexpr int S = 16384, DM = 1024, DIN = 2496, ZLD = 2560, NT = 512, DEPTH = 2;
constexpr float EPS = 1e-6f;
constexpr float QSCALE = 0.07216878364870322f * 1.4426950408889634f;
constexpr int Z_U = 0, Z_V = 256, Z_SG = 512, Z_PI = 768, Z_PG = 1024, Z_CQ = 1280, Z_CKV = 1664, Z_KR = 1920, Z_MG = 1984;

constexpr size_t WS_HY   = 0;
constexpr size_t WS_Z    = WS_HY + (size_t)S * 1024 * 2;
constexpr size_t WS_Q    = WS_Z + (size_t)S * ZLD * 2;
constexpr size_t WS_K    = WS_Q + (size_t)4 * S * 192 * 2;
constexpr size_t WS_VT   = WS_K + (size_t)4 * S * 192 * 2;
constexpr size_t WS_WIN  = WS_VT + (size_t)4 * S * 128 * 2;
constexpr size_t WS_WUQ  = WS_WIN + (size_t)2 * 2560 * 1024 * 2;
constexpr size_t WS_WUKV = WS_WUQ + (size_t)2 * 768 * 384 * 2;
constexpr size_t WS_WOUT = WS_WUKV + (size_t)2 * 1024 * 256 * 2;
constexpr size_t WS_SGUW = WS_WOUT + (size_t)2 * 1024 * 1024 * 2;
constexpr size_t WS_PWT  = WS_SGUW + (size_t)2 * 4 * 128 * 128 * 2;
constexpr size_t WS_COS  = WS_PWT + (size_t)2 * 4 * 64 * 64 * 2;
constexpr size_t WS_SIN  = WS_COS + (size_t)S * 32 * 4;
constexpr size_t WS_END  = WS_SIN + (size_t)S * 32 * 4;

constexpr int GEMM_STAGE = 256 * 144 + 128 * 144;
constexpr int RS_OFF = 2 * GEMM_STAGE;
constexpr int LDS_BYTES = RS_OFF + 512;
constexpr int ATT_STAGE = 64 * 400 + 128 * 144;

struct P {
  const float* x; const int* pos; const float* pre_g; const float* post_g; const float* w_in; const float* sgu_w; const float* sgu_b;
  const float* sgu_ln_g; const float* sgu_ln_b; const float* pool_w; const float* pool_scale; const float* q_norm_g; const float* w_uq;
  const float* kv_norm_g; const float* w_ukv; const float* w_out;
  float* out; unsigned char* ws;
  float invfreq[32];
  int ph_lo, ph_hi;
};

DI int otid() { int t = threadIdx.x; asm volatile("" : "+v"(t)); return t; }
DI int wave_of(int tid) { return __builtin_amdgcn_readfirstlane(tid >> 6); }
DI unsigned pack2(float a, float b) { f32x2 v = {a, b}; return __builtin_bit_cast(unsigned, __builtin_convertvector(v, bf2_t)); }
DI u16 tobf(float a) { return (u16)(pack2(a, 0.f) & 0xffffu); }
DI float bflo(unsigned u) { return __uint_as_float(u << 16); }
DI float bfhi(unsigned u) { return __uint_as_float(u & 0xffff0000u); }
DI float silu(float x) { return x / (1.f + __expf(-x)); }
DI float ex2(float x) { return __builtin_amdgcn_exp2f(x); }
DI f32x16 zero16() { f32x16 z; for (int i = 0; i < 16; ++i) z[i] = 0.f; return z; }

template <class Epi>
DI void gemm_tile(unsigned char* lds, const u16* __restrict__ A, const u16* __restrict__ X, int ldx, int K, int m0, int n0, Epi& epi) {
  const int tid = otid(), lane = tid & 63, wave = wave_of(tid);
  const int wm = wave & 3, wn = wave >> 2, l32 = lane & 31, h = lane >> 5;
  f32x16 acc[2][2];
  acc[0][0] = zero16(); acc[0][1] = zero16(); acc[1][0] = zero16(); acc[1][1] = zero16();
  const int nk = K >> 6;
  const int lrow = tid >> 3, lcol = tid & 7;
  const u16* ga = A + (size_t)lrow * K + lcol * 8;
  const u16* gx = X + (size_t)lrow * ldx + lcol * 8;
  u32x4 ra[4], rb[2];
#pragma unroll
  for (int i = 0; i < 4; ++i) ra[i] = *(const u32x4*)(ga + (size_t)i * 64 * K);
#pragma unroll
  for (int i = 0; i < 2; ++i) rb[i] = *(const u32x4*)(gx + (size_t)i * 64 * ldx);
  {
    unsigned char* as = lds; unsigned char* bs = lds + 256 * 144;
#pragma unroll
    for (int i = 0; i < 4; ++i) *(u32x4*)(as + (lrow + i * 64) * 144 + lcol * 16) = ra[i];
#pragma unroll
    for (int i = 0; i < 2; ++i) *(u32x4*)(bs + (lrow + i * 64) * 144 + lcol * 16) = rb[i];
  }
  __syncthreads();
#pragma unroll 1
  for (int ks = 0; ks < nk; ++ks) {
    const bool more = ks + 1 < nk;
    if (more) {
#pragma unroll
      for (int i = 0; i < 4; ++i) ra[i] = *(const u32x4*)(ga + (size_t)i * 64 * K + (ks + 1) * 64);
#pragma unroll
      for (int i = 0; i < 2; ++i) rb[i] = *(const u32x4*)(gx + (size_t)i * 64 * ldx + (ks + 1) * 64);
    }
    const unsigned char* as = lds + (ks & 1) * GEMM_STAGE; const unsigned char* bs = as + 256 * 144;
#pragma unroll
    for (int kk = 0; kk < 4; ++kk) {
      bf16x8 a0 = *(const bf16x8*)(as + (wm * 64 + l32) * 144 + kk * 32 + h * 16);
      bf16x8 a1 = *(const bf16x8*)(as + (wm * 64 + 32 + l32) * 144 + kk * 32 + h * 16);
      bf16x8 b0 = *(const bf16x8*)(bs + (wn * 64 + l32) * 144 + kk * 32 + h * 16);
      bf16x8 b1 = *(const bf16x8*)(bs + (wn * 64 + 32 + l32) * 144 + kk * 32 + h * 16);
      acc[0][0] = MFMA(a0, b0, acc[0][0]); acc[0][1] = MFMA(a0, b1, acc[0][1]);
      acc[1][0] = MFMA(a1, b0, acc[1][0]); acc[1][1] = MFMA(a1, b1, acc[1][1]);
    }
    if (more) {
      unsigned char* as2 = lds + ((ks + 1) & 1) * GEMM_STAGE; unsigned char* bs2 = as2 + 256 * 144;
#pragma unroll
      for (int i = 0; i < 4; ++i) *(u32x4*)(as2 + (lrow + i * 64) * 144 + lcol * 16) = ra[i];
#pragma unroll
      for (int i = 0; i < 2; ++i) *(u32x4*)(bs2 + (lrow + i * 64) * 144 + lcol * 16) = rb[i];
    }
    __syncthreads();
  }
  epi(acc, m0 + wm * 64, n0 + wn * 64, l32, h);
}

struct EpiZ {
  u16* z;
  DI void operator()(f32x16 (&acc)[2][2], int chb, int tokb, int l32, int h) {
#pragma unroll
    for (int nt = 0; nt < 2; ++nt) { const int t = tokb + nt * 32 + l32;
#pragma unroll
      for (int mt = 0; mt < 2; ++mt)
#pragma unroll
        for (int q = 0; q < 4; ++q) {
          u32x2 v = {pack2(acc[mt][nt][q * 4], acc[mt][nt][q * 4 + 1]), pack2(acc[mt][nt][q * 4 + 2], acc[mt][nt][q * 4 + 3])};
          *(u32x2*)(z + (size_t)t * ZLD + chb + mt * 32 + q * 8 + h * 4) = v;
        }
    }
  }
};
struct EpiOut {
  float* y;
  DI void operator()(f32x16 (&acc)[2][2], int chb, int tokb, int l32, int h) {
#pragma unroll
    for (int nt = 0; nt < 2; ++nt) { const int t = tokb + nt * 32 + l32;
#pragma unroll
      for (int mt = 0; mt < 2; ++mt)
#pragma unroll
        for (int q = 0; q < 4; ++q) {
          f32x4 v = {acc[mt][nt][q * 4], acc[mt][nt][q * 4 + 1], acc[mt][nt][q * 4 + 2], acc[mt][nt][q * 4 + 3]};
          *(f32x4*)(y + (size_t)t * DM + chb + mt * 32 + q * 8 + h * 4) = v;
        }
    }
  }
};
struct EpiQ {
  u16* Q; const float* cosT; const float* sinT; const float* rs; int n0;
  DI void operator()(f32x16 (&acc)[2][2], int chb, int tokb, int l32, int h) {
    const int seg = chb >> 6, head = seg / 3, part = seg - head * 3;
#pragma unroll
    for (int nt = 0; nt < 2; ++nt) {
      const int t = tokb + nt * 32 + l32; const float r = rs[tokb - n0 + nt * 32 + l32] * QSCALE;
      u16* dst = Q + ((size_t)head * S + t) * 192;
      if (part < 2) {
#pragma unroll
        for (int mt = 0; mt < 2; ++mt)
#pragma unroll
          for (int q = 0; q < 4; ++q) {
            u32x2 v = {pack2(acc[mt][nt][q * 4] * r, acc[mt][nt][q * 4 + 1] * r), pack2(acc[mt][nt][q * 4 + 2] * r, acc[mt][nt][q * 4 + 3] * r)};
            *(u32x2*)(dst + part * 64 + mt * 32 + q * 8 + h * 4) = v;
          }
      } else {
#pragma unroll
        for (int q = 0; q < 4; ++q) {
          const int d = q * 8 + h * 4;
          const f32x4 c = *(const f32x4*)(cosT + (size_t)t * 32 + d), s = *(const f32x4*)(sinT + (size_t)t * 32 + d);
          float o1[4], o2[4];
#pragma unroll
          for (int j = 0; j < 4; ++j) { const float x1 = acc[0][nt][q * 4 + j], x2 = acc[1][nt][q * 4 + j]; o1[j] = (x1 * c[j] - x2 * s[j]) * r; o2[j] = (x2 * c[j] + x1 * s[j]) * r; }
          u32x2 v1 = {pack2(o1[0], o1[1]), pack2(o1[2], o1[3])}, v2 = {pack2(o2[0], o2[1]), pack2(o2[2], o2[3])};
          *(u32x2*)(dst + 128 + d) = v1; *(u32x2*)(dst + 160 + d) = v2;
        }
      }
    }
  }
};
DI int permpos(int k64) { const int kk = k64 & 15; return (k64 & 48) | (((kk >> 2) & 1) * 8 + (kk >> 3) * 4 + (kk & 3)); }
struct EpiKV {
  u16* K; u16* Vt; const float* rs; int n0;
  DI void operator()(f32x16 (&acc)[2][2], int chb, int tokb, int l32, int h) {
    const int seg = chb >> 6, head = seg >> 2, part = seg & 3;
#pragma unroll
    for (int nt = 0; nt < 2; ++nt) {
      const int t = tokb + nt * 32 + l32; const float r = rs[tokb - n0 + nt * 32 + l32];
      if (part < 2) {
        u16* dst = K + ((size_t)head * S + t) * 192 + part * 64;
#pragma unroll
        for (int mt = 0; mt < 2; ++mt)
#pragma unroll
          for (int q = 0; q < 4; ++q) {
            u32x2 v = {pack2(acc[mt][nt][q * 4] * r, acc[mt][nt][q * 4 + 1] * r), pack2(acc[mt][nt][q * 4 + 2] * r, acc[mt][nt][q * 4 + 3] * r)};
            *(u32x2*)(dst + mt * 32 + q * 8 + h * 4) = v;
          }
      } else {
        u16* dst = Vt + (((size_t)head * (S / 64) + (t >> 6)) * 128 + (part - 2) * 64) * 64 + permpos(t & 63);
#pragma unroll
        for (int mt = 0; mt < 2; ++mt)
#pragma unroll
          for (int i = 0; i < 16; ++i) { const int dv = mt * 32 + (i & 3) + 8 * (i >> 2) + 4 * h; dst[dv * 64] = tobf(acc[mt][nt][i] * r); }
      }
    }
  }
};

DI void row_rstd(float* rs, const u16* X, int ldx, int K) {
  const int tid = otid(), tl = tid >> 2, sub = tid & 3;
  const u16* src = X + (size_t)tl * ldx; float ss = 0.f;
  for (int c = sub; c < (K >> 3); c += 4) {
    u32x4 v = *(const u32x4*)(src + c * 8);
#pragma unroll
    for (int j = 0; j < 4; ++j) { const float a = bflo(v[j]), b = bfhi(v[j]); ss += a * a + b * b; }
  }
  ss += __shfl_xor(ss, 1); ss += __shfl_xor(ss, 2);
  if (sub == 0) rs[tl] = rsqrtf(ss / (float)K + EPS);
}

DI void krope_tile(const P& p, int n0) {
  const int tid = otid(), t = n0 + (tid >> 2), i0 = (tid & 3) * 8;
  const u16* z = (const u16*)(p.ws + WS_Z) + (size_t)t * ZLD + Z_KR;
  const float* cosT = (const float*)(p.ws + WS_COS) + (size_t)t * 32 + i0; const float* sinT = (const float*)(p.ws + WS_SIN) + (size_t)t * 32 + i0;
  u32x4 a = *(const u32x4*)(z + i0), b = *(const u32x4*)(z + 32 + i0);
  f32x4 c0 = *(const f32x4*)cosT, c1 = *(const f32x4*)(cosT + 4), s0 = *(const f32x4*)sinT, s1 = *(const f32x4*)(sinT + 4);
  float x1[8], x2[8], c[8], s[8];
#pragma unroll
  for (int j = 0; j < 4; ++j) { x1[2 * j] = bflo(a[j]); x1[2 * j + 1] = bfhi(a[j]); x2[2 * j] = bflo(b[j]); x2[2 * j + 1] = bfhi(b[j]); c[j] = c0[j]; c[4 + j] = c1[j]; s[j] = s0[j]; s[4 + j] = s1[j]; }
  u32x4 o1, o2;
#pragma unroll
  for (int j = 0; j < 4; ++j) {
    o1[j] = pack2(x1[2 * j] * c[2 * j] - x2[2 * j] * s[2 * j], x1[2 * j + 1] * c[2 * j + 1] - x2[2 * j + 1] * s[2 * j + 1]);
    o2[j] = pack2(x2[2 * j] * c[2 * j] + x1[2 * j] * s[2 * j], x2[2 * j + 1] * c[2 * j + 1] + x1[2 * j + 1] * s[2 * j + 1]);
  }
  u16* K = (u16*)(p.ws + WS_K);
#pragma unroll
  for (int hd = 0; hd < 4; ++hd) { u16* dst = K + ((size_t)hd * S + t) * 192 + 128 + i0; *(u32x4*)dst = o1; *(u32x4*)(dst + 32) = o2; }
}

DI void sgu_job(unsigned char* lds, const P& p, int layer, int nb) {
  const int tid = otid(), lane = tid & 63, wave = wave_of(tid);
  const int n0 = nb * 128;
  const u16* z = (const u16*)(p.ws + WS_Z);
  u16* vT = (u16*)lds;
  {
    const int j = tid >> 2, sub = tid & 3; const u16* src = z + (size_t)(n0 + j) * ZLD + Z_V + sub * 64;
    float v[64]; float s = 0.f;
#pragma unroll
    for (int c = 0; c < 8; ++c) { u32x4 u = *(const u32x4*)(src + c * 8);
#pragma unroll
      for (int k = 0; k < 4; ++k) { v[c * 8 + 2 * k] = bflo(u[k]); v[c * 8 + 2 * k + 1] = bfhi(u[k]); s += v[c * 8 + 2 * k] + v[c * 8 + 2 * k + 1]; } }
    s += __shfl_xor(s, 1); s += __shfl_xor(s, 2);
    const float mu = s * (1.f / 256.f); float q = 0.f;
#pragma unroll
    for (int c = 0; c < 64; ++c) { const float d = v[c] - mu; q += d * d; }
    q += __shfl_xor(q, 1); q += __shfl_xor(q, 2);
    const float rstd = rsqrtf(q * (1.f / 256.f) + EPS);
    const float* g = p.sgu_ln_g + layer * 256 + sub * 64; const float* b = p.sgu_ln_b + layer * 256 + sub * 64;
#pragma unroll
    for (int c = 0; c < 64; ++c) vT[(sub * 64 + c) * 136 + j] = tobf((v[c] - mu) * rstd * g[c] + b[c]);
  }
  __syncthreads();
  const int wm = wave & 3, wn = wave >> 2, l32 = lane & 31, h = lane >> 5;
  f32x16 acc[2][2]; acc[0][0] = zero16(); acc[0][1] = zero16(); acc[1][0] = zero16(); acc[1][1] = zero16();
  const u16* W = (const u16*)(p.ws + WS_SGUW) + (size_t)(layer * 4 + wm) * 128 * 128;
  const int kmax = wn ? 8 : 4;
#pragma unroll 1
  for (int kk = 0; kk < kmax; ++kk) {
    bf16x8 a0 = *(const bf16x8*)(vT + (wm * 64 + l32) * 136 + kk * 16 + h * 8);
    bf16x8 a1 = *(const bf16x8*)(vT + (wm * 64 + 32 + l32) * 136 + kk * 16 + h * 8);
    bf16x8 b0 = *(const bf16x8*)(W + (wn * 64 + l32) * 128 + kk * 16 + h * 8);
    bf16x8 b1 = *(const bf16x8*)(W + (wn * 64 + 32 + l32) * 128 + kk * 16 + h * 8);
    acc[0][0] = MFMA(a0, b0, acc[0][0]); acc[0][1] = MFMA(a0, b1, acc[0][1]);
    acc[1][0] = MFMA(a1, b0, acc[1][0]); acc[1][1] = MFMA(a1, b1, acc[1][1]);
  }
  u16* Y = (u16*)(p.ws + WS_HY);
#pragma unroll
  for (int nt = 0; nt < 2; ++nt) {
    const int i = wn * 64 + nt * 32 + l32, t = n0 + i; const float bias = p.sgu_b[(layer * 4 + wm) * 128 + i];
#pragma unroll
    for (int mt = 0; mt < 2; ++mt)
#pragma unroll
      for (int q = 0; q < 4; ++q) {
        const int c = wm * 64 + mt * 32 + q * 8 + h * 4;
        const u32x2 u = *(const u32x2*)(z + (size_t)t * ZLD + Z_U + c), g = *(const u32x2*)(z + (size_t)t * ZLD + Z_SG + c);
        const float o0 = bflo(u[0]) * (acc[mt][nt][q * 4] + bias) * silu(bflo(g[0])), o1 = bfhi(u[0]) * (acc[mt][nt][q * 4 + 1] + bias) * silu(bfhi(g[0]));
        const float o2 = bflo(u[1]) * (acc[mt][nt][q * 4 + 2] + bias) * silu(bflo(g[1])), o3 = bfhi(u[1]) * (acc[mt][nt][q * 4 + 3] + bias) * silu(bfhi(g[1]));
        u32x2 v = {pack2(o0, o1), pack2(o2, o3)};
        *(u32x2*)(Y + (size_t)t * DM + c) = v;
      }
  }
}

DI void pool_job(unsigned char* lds, const P& p, int layer, int nb) {
  const int tid = otid(), lane = tid & 63, wave = wave_of(tid);
  const int n0 = nb * 128;
  const u16* z = (const u16*)(p.ws + WS_Z);
  u16* pl = (u16*)lds;
  {
    const int cp = tid & 127, tq = tid >> 7, c = cp * 2, w = 2 << (cp >> 5);
    const u16* zp = z + Z_PI + c; const int t0 = n0 + tq * 32;
    float s0 = 0.f, s1 = 0.f;
    for (int s = max(t0 - w, 0); s < t0; ++s) { const unsigned u = *(const unsigned*)(zp + (size_t)s * ZLD); s0 += bflo(u); s1 += bfhi(u); }
#pragma unroll 4
    for (int tt = 0; tt < 32; ++tt) {
      const int t = t0 + tt; const unsigned u = *(const unsigned*)(zp + (size_t)t * ZLD);
      const float p0 = bflo(u), p1 = bfhi(u); s0 += p0; s1 += p1;
      if (t - w >= 0) { const unsigned u2 = *(const unsigned*)(zp + (size_t)(t - w) * ZLD); s0 -= bflo(u2); s1 -= bfhi(u2); }
      const float inv = 1.f / (float)min(t + 1, w);
      *(unsigned*)(pl + (tq * 32 + tt) * 264 + c) = pack2(s0 * inv - p0, s1 * inv - p1);
    }
  }
  __syncthreads();
  const int wm = wave & 3, wn = wave >> 2, l32 = lane & 31, h = lane >> 5;
  f32x16 acc[2][2]; acc[0][0] = zero16(); acc[0][1] = zero16(); acc[1][0] = zero16(); acc[1][1] = zero16();
  const u16* W = (const u16*)(p.ws + WS_PWT) + (size_t)(layer * 4 + wm) * 64 * 64;
#pragma unroll
  for (int kk = 0; kk < 4; ++kk) {
    bf16x8 a0 = *(const bf16x8*)(W + (l32) * 64 + kk * 16 + h * 8);
    bf16x8 a1 = *(const bf16x8*)(W + (32 + l32) * 64 + kk * 16 + h * 8);
    bf16x8 b0 = *(const bf16x8*)(pl + (wn * 64 + l32) * 264 + wm * 64 + kk * 16 + h * 8);
    bf16x8 b1 = *(const bf16x8*)(pl + (wn * 64 + 32 + l32) * 264 + wm * 64 + kk * 16 + h * 8);
    acc[0][0] = MFMA(a0, b0, acc[0][0]); acc[0][1] = MFMA(a0, b1, acc[0][1]);
    acc[1][0] = MFMA(a1, b0, acc[1][0]); acc[1][1] = MFMA(a1, b1, acc[1][1]);
  }
  u16* Y = (u16*)(p.ws + WS_HY);
#pragma unroll
  for (int nt = 0; nt < 2; ++nt) {
    const int t = n0 + wn * 64 + nt * 32 + l32;
#pragma unroll
    for (int mt = 0; mt < 2; ++mt)
#pragma unroll
      for (int q = 0; q < 4; ++q) {
        const int c = wm * 64 + mt * 32 + q * 8 + h * 4;
        const f32x4 sc = *(const f32x4*)(p.pool_scale + layer * 256 + c);
        const u32x2 g = *(const u32x2*)(z + (size_t)t * ZLD + Z_PG + c);
        const float o0 = acc[mt][nt][q * 4] * sc[0] * silu(bflo(g[0])), o1 = acc[mt][nt][q * 4 + 1] * sc[1] * silu(bfhi(g[0]));
        const float o2 = acc[mt][nt][q * 4 + 2] * sc[2] * silu(bflo(g[1])), o3 = acc[mt][nt][q * 4 + 3] * sc[3] * silu(bfhi(g[1]));
        u32x2 v = {pack2(o0, o1), pack2(o2, o3)};
        *(u32x2*)(Y + (size_t)t * DM + 256 + c) = v;
      }
  }
}

DI void attn_item(unsigned char* lds, const P& p, int hd, int qb) {
  const int tid = otid(), lane = tid & 63, wave = wave_of(tid);
  const int wq = wave & 3, wk = wave >> 2, l32 = lane & 31, h = lane >> 5;
  const u16* Qg = (const u16*)(p.ws + WS_Q) + ((size_t)hd * S + qb * 128 + wq * 32 + l32) * 192 + h * 8;
  bf16x8 qf[12];
#pragma unroll
  for (int ks = 0; ks < 12; ++ks) qf[ks] = *(const bf16x8*)(Qg + ks * 16);
  const int ntile = 2 * qb + 2, mychunk = 2 * qb + (wq >> 1);
  const u16* Kg = (const u16*)(p.ws + WS_K) + (size_t)hd * S * 192 + tid * 8;
  const u16* Vg = (const u16*)(p.ws + WS_VT) + (size_t)hd * S * 128 + tid * 8;
  int kdst[3], vdst[2];
#pragma unroll
  for (int i = 0; i < 3; ++i) { const int c = tid + i * NT; kdst[i] = (c / 24) * 400 + (c % 24) * 16; }
#pragma unroll
  for (int i = 0; i < 2; ++i) { const int c = tid + i * NT; vdst[i] = 64 * 400 + (c >> 3) * 144 + (c & 7) * 16; }
  f32x16 O[4]; O[0] = zero16(); O[1] = zero16(); O[2] = zero16(); O[3] = zero16();
  float m = -1e30f, l = 0.f;
  u32x4 rk[3], rv[2];
#pragma unroll
  for (int i = 0; i < 3; ++i) rk[i] = *(const u32x4*)(Kg + i * NT * 8);
#pragma unroll
  for (int i = 0; i < 2; ++i) rv[i] = *(const u32x4*)(Vg + i * NT * 8);
#pragma unroll
  for (int i = 0; i < 3; ++i) *(u32x4*)(lds + kdst[i]) = rk[i];
#pragma unroll
  for (int i = 0; i < 2; ++i) *(u32x4*)(lds + vdst[i]) = rv[i];
  __syncthreads();
#pragma unroll 1
  for (int kt = 0; kt < ntile; ++kt) {
    const bool more = kt + 1 < ntile;
    if (more) {
#pragma unroll
      for (int i = 0; i < 3; ++i) rk[i] = *(const u32x4*)(Kg + (size_t)(kt + 1) * 64 * 192 + i * NT * 8);
#pragma unroll
      for (int i = 0; i < 2; ++i) rv[i] = *(const u32x4*)(Vg + (size_t)(kt + 1) * 128 * 64 + i * NT * 8);
    }
    if (kt <= mychunk) {
      const unsigned char* ks_ = lds + (kt & 1) * ATT_STAGE; const unsigned char* vs_ = ks_ + 64 * 400;
      f32x16 s = zero16();
#pragma unroll
      for (int ks = 0; ks < 12; ++ks) { bf16x8 kf = *(const bf16x8*)(ks_ + (wk * 32 + l32) * 400 + ks * 32 + h * 16); s = MFMA(kf, qf[ks], s); }
      float mx = s[0];
#pragma unroll
      for (int i = 1; i < 16; ++i) mx = fmaxf(mx, s[i]);
      mx = fmaxf(mx, __shfl_xor(mx, 32));
      const float mn = fmaxf(m, mx), alpha = ex2(m - mn); m = mn;
      float ps = 0.f;
#pragma unroll
      for (int i = 0; i < 16; ++i) { s[i] = ex2(s[i] - mn); ps += s[i]; }
      l = l * alpha + ps;
#pragma unroll
      for (int mt = 0; mt < 4; ++mt)
#pragma unroll
        for (int i = 0; i < 16; ++i) O[mt][i] *= alpha;
      u32x4 p0 = {pack2(s[0], s[1]), pack2(s[2], s[3]), pack2(s[4], s[5]), pack2(s[6], s[7])};
      u32x4 p1 = {pack2(s[8], s[9]), pack2(s[10], s[11]), pack2(s[12], s[13]), pack2(s[14], s[15])};
      const bf16x8 pf0 = __builtin_bit_cast(bf16x8, p0), pf1 = __builtin_bit_cast(bf16x8, p1);
#pragma unroll
      for (int mt = 0; mt < 4; ++mt) {
        bf16x8 v0 = *(const bf16x8*)(vs_ + (mt * 32 + l32) * 144 + (wk * 32 + h * 8) * 2);
        bf16x8 v1 = *(const bf16x8*)(vs_ + (mt * 32 + l32) * 144 + (wk * 32 + 16 + h * 8) * 2);
        O[mt] = MFMA(v0, pf0, O[mt]); O[mt] = MFMA(v1, pf1, O[mt]);
      }
    }
    if (more) {
      unsigned char* st = lds + ((kt + 1) & 1) * ATT_STAGE;
#pragma unroll
      for (int i = 0; i < 3; ++i) *(u32x4*)(st + kdst[i]) = rk[i];
#pragma unroll
      for (int i = 0; i < 2; ++i) *(u32x4*)(st + vdst[i]) = rv[i];
    }
    __syncthreads();
  }
  const float lt = l + __shfl_xor(l, 32);
  float* cO = (float*)lds; float* cm = (float*)(lds + 65536);
  if (wk == 1) {
#pragma unroll
    for (int mt = 0; mt < 4; ++mt)
#pragma unroll
      for (int i = 0; i < 16; ++i) cO[(wq * 64 + mt * 16 + i) * 64 + lane] = O[mt][i];
    cm[wq * 64 + lane] = m; cm[256 + wq * 64 + lane] = lt;
  }
  __syncthreads();
  if (wk == 0) {
    const float m1 = cm[wq * 64 + lane], l1 = cm[256 + wq * 64 + lane];
    const float mm = fmaxf(m, m1); float a0 = ex2(m - mm), a1 = ex2(m1 - mm);
    const float inv = 1.f / (lt * a0 + l1 * a1); a0 *= inv; a1 *= inv;
    const int t = qb * 128 + wq * 32 + l32;
    const u16* zg = (const u16*)(p.ws + WS_Z) + (size_t)t * ZLD + Z_MG + hd * 128;
    u16* Y = (u16*)(p.ws + WS_HY) + (size_t)t * DM + 512 + hd * 128;
#pragma unroll
    for (int mt = 0; mt < 4; ++mt)
#pragma unroll
      for (int q = 0; q < 4; ++q) {
        const int dv = mt * 32 + q * 8 + h * 4;
        const u32x2 g = *(const u32x2*)(zg + dv);
        float o[4];
#pragma unroll
        for (int j = 0; j < 4; ++j) o[j] = O[mt][q * 4 + j] * a0 + cO[(wq * 64 + mt * 16 + q * 4 + j) * 64 + lane] * a1;
        u32x2 v = {pack2(o[0] * silu(bflo(g[0])), o[1] * silu(bfhi(g[0]))), pack2(o[2] * silu(bflo(g[1])), o[3] * silu(bfhi(g[1])))};
        *(u32x2*)(Y + dv) = v;
      }
  }
  __syncthreads();
}

DI void transpose_tile(unsigned char* lds, const float* __restrict__ src, int ldsrc, u16* __restrict__ dst, int ldd, int k0, int n0, int nvalid, const float* gain) {
  float* tile = (float*)lds;
  const int tid = otid();
#pragma unroll
  for (int i = 0; i < 8; ++i) { const int idx = tid + i * NT, r = idx >> 6, cc = idx & 63, n = n0 + cc;
    float v = (n < nvalid) ? src[(size_t)(k0 + r) * ldsrc + n] : 0.f; if (gain) v *= gain[k0 + r]; tile[r * 65 + cc] = v; }
  __syncthreads();
#pragma unroll
  for (int i = 0; i < 8; ++i) { const int idx = tid + i * NT, r = idx >> 6, cc = idx & 63; dst[(size_t)(n0 + r) * ldd + k0 + cc] = tobf(tile[cc * 65 + r]); }
  __syncthreads();
}
DI float wave_sum(float v) { v += __shfl_xor(v, 32); v += __shfl_xor(v, 16); v += __shfl_xor(v, 8); v += __shfl_xor(v, 4); v += __shfl_xor(v, 2); v += __shfl_xor(v, 1); return v; }
DI void prenorm_row(const f32x4 (&v)[4], const float* g, u16* hrow, int lane) {
  float ss = 0.f;
#pragma unroll
  for (int i = 0; i < 4; ++i) ss += v[i][0] * v[i][0] + v[i][1] * v[i][1] + v[i][2] * v[i][2] + v[i][3] * v[i][3];
  ss = wave_sum(ss);
  const float r = rsqrtf(ss * (1.f / 1024.f) + EPS);
#pragma unroll
  for (int i = 0; i < 4; ++i) { const f32x4 gg = *(const f32x4*)(g + (lane + 64 * i) * 4);
    u32x2 o = {pack2(v[i][0] * r * gg[0], v[i][1] * r * gg[1]), pack2(v[i][2] * r * gg[2], v[i][3] * r * gg[3])};
    *(u32x2*)(hrow + (lane + 64 * i) * 4) = o; }
}

DI void phase_prep(unsigned char* lds, const P& p) {
  const int nb = gridDim.x, bid = blockIdx.x, tid = otid();
  u16* win = (u16*)(p.ws + WS_WIN); u16* wuq = (u16*)(p.ws + WS_WUQ); u16* wukv = (u16*)(p.ws + WS_WUKV); u16* wout = (u16*)(p.ws + WS_WOUT);
  for (int job = bid; job < 2 * 1032; job += nb) {
    const int layer = job / 1032; int r = job - layer * 1032;
    if (r < 640) { const int kt = r / 40, nt = r - kt * 40; transpose_tile(lds, p.w_in + (size_t)layer * 1024 * DIN, DIN, win + (size_t)layer * 2560 * 1024, 1024, kt * 64, nt * 64, DIN, nullptr); }
    else if (r < 712) { r -= 640; const int kt = r / 12, nt = r - kt * 12; transpose_tile(lds, p.w_uq + (size_t)layer * 384 * 768, 768, wuq + (size_t)layer * 768 * 384, 384, kt * 64, nt * 64, 768, p.q_norm_g + layer * 384); }
    else if (r < 776) { r -= 712; const int kt = r / 16, nt = r - kt * 16; transpose_tile(lds, p.w_ukv + (size_t)layer * 256 * 1024, 1024, wukv + (size_t)layer * 1024 * 256, 256, kt * 64, nt * 64, 1024, p.kv_norm_g + layer * 256); }
    else { r -= 776; const int kt = r / 16, nt = r - kt * 16; transpose_tile(lds, p.w_out + (size_t)layer * 1024 * 1024, 1024, wout + (size_t)layer * 1024 * 1024, 1024, kt * 64, nt * 64, 1024, nullptr); }
  }
  const int gtid = bid * NT + tid, gn = nb * NT;
  u16* sguw = (u16*)(p.ws + WS_SGUW);
  for (int idx = gtid; idx < 2 * 4 * 128 * 128; idx += gn) { const int i = (idx >> 7) & 127, j = idx & 127; sguw[idx] = ((j >> 6) <= (i >> 6)) ? tobf(p.sgu_w[idx]) : (u16)0; }
  u16* pwt = (u16*)(p.ws + WS_PWT);
  for (int idx = gtid; idx < 2 * 4 * 64 * 64; idx += gn) { const int lg = idx >> 12, d = (idx >> 6) & 63, c = idx & 63; pwt[idx] = tobf(p.pool_w[(lg * 64 + c) * 64 + d]); }
  float* cosT = (float*)(p.ws + WS_COS); float* sinT = (float*)(p.ws + WS_SIN);
  for (int idx = gtid; idx < S * 32; idx += gn) {
    const int t = idx >> 5, i = idx & 31; const float angf = (float)p.pos[t] * p.invfreq[i];
    const double a = (double)angf; const double k = rint(a * 0.15915494309189535); const double r = a - k * 6.283185307179586; const double r2 = r * r;
    double ts = r, ss = r, tc = 1.0, sc = 1.0;
#pragma unroll
    for (int n = 1; n <= 13; ++n) { ts *= -r2 * (1.0 / (double)((2 * n) * (2 * n + 1))); ss += ts; tc *= -r2 * (1.0 / (double)((2 * n - 1) * (2 * n))); sc += tc; }
    cosT[idx] = (float)sc; sinT[idx] = (float)ss;
  }
  u16* hb = (u16*)(p.ws + WS_HY);
  const int lane = tid & 63, wave = wave_of(tid);
  for (int row = bid * 8 + wave; row < S; row += nb * 8) {
    f32x4 v[4];
#pragma unroll
    for (int i = 0; i < 4; ++i) v[i] = *(const f32x4*)(p.x + (size_t)row * DM + (lane + 64 * i) * 4);
    prenorm_row(v, p.pre_g, hb + (size_t)row * DM, lane);
  }
}

DI void phase_post(const P& p, int layer) {
  const int nb = gridDim.x, bid = blockIdx.x, tid = otid(), lane = tid & 63, wave = wave_of(tid);
  const float* yout = (const float*)(p.ws + WS_Z); const float* xold = layer == 0 ? p.x : p.out;
  u16* hb = (u16*)(p.ws + WS_HY);
  for (int row = bid * 8 + wave; row < S; row += nb * 8) {
    f32x4 y[4]; float ss = 0.f;
#pragma unroll
    for (int i = 0; i < 4; ++i) { y[i] = *(const f32x4*)(yout + (size_t)row * DM + (lane + 64 * i) * 4); ss += y[i][0] * y[i][0] + y[i][1] * y[i][1] + y[i][2] * y[i][2] + y[i][3] * y[i][3]; }
    ss = wave_sum(ss);
    const float r = rsqrtf(ss * (1.f / 1024.f) + EPS);
#pragma unroll
    for (int i = 0; i < 4; ++i) {
      const f32x4 g = *(const f32x4*)(p.post_g + layer * DM + (lane + 64 * i) * 4); const f32x4 xo = *(const f32x4*)(xold + (size_t)row * DM + (lane + 64 * i) * 4);
      y[i] = xo + y[i] * r * g;
      *(f32x4*)(p.out + (size_t)row * DM + (lane + 64 * i) * 4) = y[i];
    }
    if (layer + 1 < DEPTH) prenorm_row(y, p.pre_g + (layer + 1) * DM, hb + (size_t)row * DM, lane);
  }
}

__global__ void __launch_bounds__(NT) mega(P p) {
  extern __shared__ __attribute__((aligned(16))) unsigned char lds[];
  cg::grid_group grid = cg::this_grid();
  const int nb = gridDim.x, bid = blockIdx.x;
  int ph = 0;
#define RUN(ph_) ((ph_) >= p.ph_lo && (ph_) < p.ph_hi)
#define SEAM(ph_) do { if (RUN(ph_) && RUN((ph_) + 1)) grid.sync(); } while (0)
  if (RUN(ph)) phase_prep(lds, p);
  SEAM(ph); ++ph;
#pragma unroll 1
  for (int layer = 0; layer < DEPTH; ++layer) {
    u16* hy = (u16*)(p.ws + WS_HY); u16* z = (u16*)(p.ws + WS_Z);
    float* rs = (float*)(lds + RS_OFF);
    if (RUN(ph)) {
      const u16* W = (const u16*)(p.ws + WS_WIN) + (size_t)layer * 2560 * 1024;
      EpiZ e{z};
      for (int job = bid; job < 1280; job += nb) { const int nt = job / 10, mt = job - nt * 10;
        gemm_tile(lds, W + (size_t)mt * 256 * 1024, hy + (size_t)nt * 128 * 1024, 1024, 1024, mt * 256, nt * 128, e); }
    }
    SEAM(ph); ++ph;
    if (RUN(ph)) {
      const float* cosT = (const float*)(p.ws + WS_COS); const float* sinT = (const float*)(p.ws + WS_SIN);
      for (int job = bid; job < 1152; job += nb) {
        __syncthreads();
        if (job < 384) { const int nt = job / 3, mt = job - nt * 3, n0 = nt * 128;
          const u16* X = z + (size_t)n0 * ZLD + Z_CQ; row_rstd(rs, X, ZLD, 384);
          EpiQ e{(u16*)(p.ws + WS_Q), cosT, sinT, rs, n0};
          gemm_tile(lds, (const u16*)(p.ws + WS_WUQ) + (size_t)layer * 768 * 384 + (size_t)mt * 256 * 384, X, ZLD, 384, mt * 256, n0, e);
        } else if (job < 896) { const int j2 = job - 384, nt = j2 >> 2, mt = j2 & 3, n0 = nt * 128;
          const u16* X = z + (size_t)n0 * ZLD + Z_CKV; row_rstd(rs, X, ZLD, 256);
          EpiKV e{(u16*)(p.ws + WS_K), (u16*)(p.ws + WS_VT), rs, n0};
          gemm_tile(lds, (const u16*)(p.ws + WS_WUKV) + (size_t)layer * 1024 * 256 + (size_t)mt * 256 * 256, X, ZLD, 256, mt * 256, n0, e);
          if (mt == 0) krope_tile(p, n0);
        } else if (job < 1024) sgu_job(lds, p, layer, job - 896);
        else pool_job(lds, p, layer, job - 1024);
      }
    }
    SEAM(ph); ++ph;
    if (RUN(ph)) {
      for (int it = bid; it < 256; it += nb) {
        const int hd = (it & 7) >> 1, pr = (it >> 3) * 2 + (it & 1);
        attn_item(lds, p, hd, 127 - pr);
        attn_item(lds, p, hd, pr);
      }
    }
    SEAM(ph); ++ph;
    if (RUN(ph)) {
      const u16* W = (const u16*)(p.ws + WS_WOUT) + (size_t)layer * 1024 * 1024;
      EpiOut e{(float*)(p.ws + WS_Z)};
      for (int job = bid; job < 512; job += nb) { const int nt = job >> 2, mt = job & 3;
        gemm_tile(lds, W + (size_t)mt * 256 * 1024, hy + (size_t)nt * 128 * 1024, 1024, 1024, mt * 256, nt * 128, e); }
    }
    SEAM(ph); ++ph;
    if (RUN(ph)) phase_post(p, layer);
    SEAM(ph); ++ph;
  }
}
constexpr int NPHASE = 1 + 5 * DEPTH;

extern "C" void kernel_launch(void* const* d_in, const int* in_sizes, int n_in, void* d_out, int out_size, void* d_ws, size_t ws_size, hipStream_t stream) {
  static int grid_blocks = 0;
  if (!grid_blocks) {
    int dev = 0, cus = 0, per_cu = 0;
    hipGetDevice(&dev);
    hipDeviceGetAttribute(&cus, hipDeviceAttributeMultiprocessorCount, dev);
    hipFuncSetAttribute((const void*)mega, hipFuncAttributeMaxDynamicSharedMemorySize, LDS_BYTES);
    hipOccupancyMaxActiveBlocksPerMultiprocessor(&per_cu, (const void*)mega, NT, LDS_BYTES);
    if (per_cu < 1) { fprintf(stderr, "occupancy query returned %d\n", per_cu); per_cu = 1; }
    if (per_cu > 1) per_cu = 1;
    grid_blocks = cus * per_cu;
    if (ws_size < WS_END) fprintf(stderr, "workspace too small: %zu < %zu\n", ws_size, (size_t)WS_END);
  }
  P p{};
  p.x = (const float*)d_in[0]; p.pos = (const int*)d_in[1]; p.pre_g = (const float*)d_in[2]; p.post_g = (const float*)d_in[3];
  p.w_in = (const float*)d_in[4]; p.sgu_w = (const float*)d_in[5]; p.sgu_b = (const float*)d_in[6]; p.sgu_ln_g = (const float*)d_in[7];
  p.sgu_ln_b = (const float*)d_in[8]; p.pool_w = (const float*)d_in[9]; p.pool_scale = (const float*)d_in[10]; p.q_norm_g = (const float*)d_in[11];
  p.w_uq = (const float*)d_in[12]; p.kv_norm_g = (const float*)d_in[13]; p.w_ukv = (const float*)d_in[14]; p.w_out = (const float*)d_in[15];
  p.out = (float*)d_out; p.ws = (unsigned char*)d_ws;
  for (int i = 0; i < 32; ++i) p.invfreq[i] = powf(10000.0f, -(float)(2 * i) / 64.0f);
#if COOP
  p.ph_lo = 0; p.ph_hi = NPHASE;
  void* args[] = {&p};
  hipError_t e = hipLaunchCooperativeKernel((void*)mega, dim3(grid_blocks), dim3(NT), args, LDS_BYTES, stream);
  if (e != hipSuccess) fprintf(stderr, "cooperative launch failed: %s (grid %d)\n", hipGetErrorString(e), grid_blocks);
#else
  for (int ph = 0; ph < NPHASE; ++ph) { p.ph_lo = ph; p.ph_hi = ph + 1; hipLaunchKernelGGL(mega, dim3(grid_blocks), dim3(NT), LDS_BYTES, stream, p); }
#endif
}
```

```cpp
#include <hip/hip_runtime.h>
#include <hip/hip_cooperative_groups.h>
#include <cstdio>
#include <cmath>
namespace cg = cooperative_groups;

#define DI __device__ __forceinline__
typedef unsigned short u16;
using bf16x8 = __attribute__((ext_vector_type(8))) short;
using f32x16 = __attribute__((ext_vector_type(16))) float;
using f32x4  = __attribute__((ext_vector_type(4))) float;
using f32x2  = __attribute__((ext_vector_type(2))) float;
using u32x4  = __attribute__((ext_vector_type(4))) unsigned;
using u32x2  = __attribute__((ext_vector_type(2))) unsigned;
typedef __bf16 bf2_t __attribute__((ext_vector_type(2)));
#define MFMA(a, b, c) __builtin_amdgcn_mfma_f32_32x32x16_bf16((a), (b), (c), 0, 0, 0)

#ifndef COOP
#define COOP 1
#endif
#ifndef DUP
#define DUP 7
#endif

constexpr int S = 16384, DM = 1024, DIN = 2496, ZLD = 2560, NT = 512, DEPTH = 2;
constexpr float EPS = 1e-6f;
constexpr float QSCALE = 0.07216878364870322f * 1.4426950408889634f;
constexpr int Z_U = 0, Z_V = 256, Z_SG = 512, Z_PI = 768, Z_PG = 1024, Z_CQ = 1280, Z_CKV = 1664, Z_KR = 1920, Z_MG = 1984;

constexpr size_t WS_HY   = 0;
constexpr size_t WS_Z    = WS_HY + (size_t)S * 1024 * 2;
constexpr size_t WS_Q    = WS_Z + (size_t)S * ZLD * 2;
constexpr size_t WS_K    = WS_Q + (size_t)4 * S * 192 * 2;
constexpr size_t WS_VT   = WS_K + (size_t)4 * S * 192 * 2;
constexpr size_t WS_WIN  = WS_VT + (size_t)4 * S * 128 * 2;
constexpr size_t WS_WUQ  = WS_WIN + (size_t)2 * 2560 * 1024 * 2;
constexpr size_t WS_WUKV = WS_WUQ + (size_t)2 * 768 * 384 * 2;
constexpr size_t WS_WOUT = WS_WUKV + (size_t)2 * 1024 * 256 * 2;
constexpr size_t WS_SGUW = WS_WOUT + (size_t)2 * 1024 * 1024 * 2;
constexpr size_t WS_PWT  = WS_SGUW + (size_t)2 * 4 * 128 * 128 * 2;
constexpr size_t WS_COS  = WS_PWT + (size_t)2 * 4 * 64 * 64 * 2;
constexpr size_t WS_SIN  = WS_COS + (size_t)S * 32 * 4;
constexpr size_t WS_BAR  = WS_SIN + (size_t)S * 32 * 4;
constexpr size_t WS_END  = WS_BAR + 16384;

constexpr int GEMM_STAGE = 256 * 144 + 128 * 144;
constexpr int RS_OFF = 2 * GEMM_STAGE;
constexpr int XB_LDS_OFF = RS_OFF + 512;
constexpr int LDS_BYTES = XB_LDS_OFF + 16;
constexpr int ATT_STAGE = 64 * 400 + 128 * 144;

struct P {
  const float* x; const int* pos; const float* pre_g; const float* post_g; const float* w_in; const float* sgu_w; const float* sgu_b;
  const float* sgu_ln_g; const float* sgu_ln_b; const float* pool_w; const float* pool_scale; const float* q_norm_g; const float* w_uq;
  const float* kv_norm_g; const float* w_ukv; const float* w_out;
  float* out; unsigned char* ws;
  float invfreq[32];
  int ph_lo, ph_hi;
};

DI int otid() { int t = threadIdx.x; asm volatile("" : "+v"(t)); return t; }
DI int wave_of(int tid) { return __builtin_amdgcn_readfirstlane(tid >> 6); }
DI unsigned pack2(float a, float b) { f32x2 v = {a, b}; return __builtin_bit_cast(unsigned, __builtin_convertvector(v, bf2_t)); }
DI u16 tobf(float a) { return (u16)(pack2(a, 0.f) & 0xffffu); }
DI float bflo(unsigned u) { return __uint_as_float(u << 16); }
DI float bfhi(unsigned u) { return __uint_as_float(u & 0xffff0000u); }
DI float silu(float x) { return x / (1.f + __expf(-x)); }
DI float ex2(float x) { return __builtin_amdgcn_exp2f(x); }
DI f32x16 zero16() { f32x16 z; for (int i = 0; i < 16; ++i) z[i] = 0.f; return z; }

#define XB_TMO      128
#define XB_XCNT(j)  (256  + 64 * (j))
#define XB_XSUB(j)  (1280 + 64 * (j))
#define XB_XGEN(j)  (2304 + 64 * (j))
#define XB_TOP      3328
#define XB_TOPGEN   3392
#define XCD_BAR_WORDS 3456
#define XB_SPIN_CAP (1u << 18)
#define LAS __attribute__((address_space(3)))

__device__ __forceinline__ unsigned xb_ld(unsigned* p)              { return __hip_atomic_load(p, __ATOMIC_RELAXED, __HIP_MEMORY_SCOPE_AGENT); }
__device__ __forceinline__ unsigned xb_add(unsigned* p, unsigned v) { return __hip_atomic_fetch_add(p, v, __ATOMIC_RELAXED, __HIP_MEMORY_SCOPE_AGENT); }
__device__ __forceinline__ unsigned xb_xcc_id() { return (unsigned)__builtin_amdgcn_s_getreg((3 << 11) | 20) & 0xFu; }
#define XB_SPIN(cond, bar) do { unsigned _sp = 0; while (cond) { __builtin_amdgcn_s_sleep(1); \
    if ((++_sp & 255u) == 0u) { if (xb_ld(&(bar)[XB_TMO])) break; if (_sp > XB_SPIN_CAP) { atomicAdd(&(bar)[XB_TMO], 1u); break; } } } } while (0)

struct XcdBarrier {
    unsigned* bar; unsigned x;
    volatile LAS unsigned* st;
};

__device__ __forceinline__ XcdBarrier xcd_barrier_post(unsigned* bar, volatile LAS unsigned* st) {
    XcdBarrier b; b.bar = bar; b.x = xb_xcc_id(); b.st = st;
    if (threadIdx.x == 0) (void)xb_add(&bar[XB_XCNT(b.x)], 1u);
    return b;
}
__device__ __forceinline__ void xcd_barrier_complete(unsigned* bar, unsigned x, unsigned& nloc, unsigned& nx) {
    const unsigned G = gridDim.x * gridDim.y * gridDim.z;
    unsigned sum, cnt, mine, sp = 0u;
    for (;;) {
        sum = 0u; cnt = 0u; mine = 0u;
#pragma unroll
        for (unsigned j = 0; j < 16; ++j) { const unsigned c = xb_ld(&bar[XB_XCNT(j)]); sum += c; cnt += (c > 0u) ? 1u : 0u; mine = (j == x) ? c : mine; }
        if (sum == G) break;
        __builtin_amdgcn_s_sleep(1);
        if ((++sp & 255u) == 0u) { if (xb_ld(&bar[XB_TMO])) break; if (sp > XB_SPIN_CAP) { atomicAdd(&bar[XB_TMO], 1u); break; } }
    }
    nloc = mine > 0u ? mine : 1u; nx = cnt > 0u ? cnt : 1u;
}

__device__ __forceinline__ void xcd_barrier(const XcdBarrier& b) {
    asm volatile("s_waitcnt vmcnt(0)" ::: "memory");
    __syncthreads();
    if (threadIdx.x == 0) {
        unsigned* bar = b.bar;
        __builtin_amdgcn_s_waitcnt(0);
        unsigned nloc = b.st[0], nx = b.st[1];
        if (nloc == 0u) { xcd_barrier_complete(bar, b.x, nloc, nx); b.st[0] = nloc; b.st[1] = nx; }
        const unsigned old = xb_add(&bar[XB_XSUB(b.x)], 1u);
        const unsigned gen = old / nloc;
        if (old + 1u == (gen + 1u) * nloc) {
            __builtin_amdgcn_fence(__ATOMIC_RELEASE, "agent");
            asm volatile("s_waitcnt vmcnt(0)" ::: "memory");
            const unsigned og = xb_add(&bar[XB_TOP], 1u);
            const unsigned tg = og / nx;
            if (og + 1u == (tg + 1u) * nx) xb_add(&bar[XB_TOPGEN], 1u);
            else XB_SPIN(xb_ld(&bar[XB_TOPGEN]) == tg, bar);
            __builtin_amdgcn_fence(__ATOMIC_ACQUIRE, "agent");
            xb_add(&bar[XB_XGEN(b.x)], 1u);
            asm volatile("s_waitcnt vmcnt(0)" ::: "memory");
        } else {
            XB_SPIN(xb_ld(&bar[XB_XGEN(b.x)]) == gen, bar);
            __builtin_amdgcn_fence(__ATOMIC_ACQUIRE, "agent");
            asm volatile("s_waitcnt vmcnt(0)" ::: "memory");
        }
    }
    __syncthreads();
}


template <class Epi>
DI void gemm_tile(unsigned char* lds, const u16* __restrict__ A, const u16* __restrict__ X, int ldx, int K, int m0, int n0, Epi& epi) {
  const int tid = otid(), lane = tid & 63, wave = wave_of(tid);
  const int wm = wave & 3, wn = wave >> 2, l32 = lane & 31, h = lane >> 5;
  f32x16 acc[2][2];
  acc[0][0] = zero16(); acc[0][1] = zero16(); acc[1][0] = zero16(); acc[1][1] = zero16();
  const int nk = K >> 6;
  const int lrow = tid >> 3, lcol = tid & 7;
  const u16* ga = A + (size_t)lrow * K + lcol * 8;
  const u16* gx = X + (size_t)lrow * ldx + lcol * 8;
  u32x4 ra[4], rb[2];
#pragma unroll
  for (int i = 0; i < 4; ++i) ra[i] = *(const u32x4*)(ga + (size_t)i * 64 * K);
#pragma unroll
  for (int i = 0; i < 2; ++i) rb[i] = *(const u32x4*)(gx + (size_t)i * 64 * ldx);
  {
    unsigned char* as = lds; unsigned char* bs = lds + 256 * 144;
#pragma unroll
    for (int i = 0; i < 4; ++i) *(u32x4*)(as + (lrow + i * 64) * 144 + lcol * 16) = ra[i];
#pragma unroll
    for (int i = 0; i < 2; ++i) *(u32x4*)(bs + (lrow + i * 64) * 144 + lcol * 16) = rb[i];
  }
  __syncthreads();
#pragma unroll 1
  for (int ks = 0; ks < nk; ++ks) {
    const bool more = ks + 1 < nk;
    if (more) {
#pragma unroll
      for (int i = 0; i < 4; ++i) ra[i] = *(const u32x4*)(ga + (size_t)i * 64 * K + (ks + 1) * 64);
#pragma unroll
      for (int i = 0; i < 2; ++i) rb[i] = *(const u32x4*)(gx + (size_t)i * 64 * ldx + (ks + 1) * 64);
    }
    const unsigned char* as = lds + (ks & 1) * GEMM_STAGE; const unsigned char* bs = as + 256 * 144;
#pragma unroll
    for (int kk = 0; kk < 4; ++kk) {
      bf16x8 a0 = *(const bf16x8*)(as + (wm * 64 + l32) * 144 + kk * 32 + h * 16);
      bf16x8 a1 = *(const bf16x8*)(as + (wm * 64 + 32 + l32) * 144 + kk * 32 + h * 16);
      bf16x8 b0 = *(const bf16x8*)(bs + (wn * 64 + l32) * 144 + kk * 32 + h * 16);
      bf16x8 b1 = *(const bf16x8*)(bs + (wn * 64 + 32 + l32) * 144 + kk * 32 + h * 16);
      acc[0][0] = MFMA(a0, b0, acc[0][0]); acc[0][1] = MFMA(a0, b1, acc[0][1]);
      acc[1][0] = MFMA(a1, b0, acc[1][0]); acc[1][1] = MFMA(a1, b1, acc[1][1]);
    }
    if (more) {
      unsigned char* as2 = lds + ((ks + 1) & 1) * GEMM_STAGE; unsigned char* bs2 = as2 + 256 * 144;
#pragma unroll
      for (int i = 0; i < 4; ++i) *(u32x4*)(as2 + (lrow + i * 64) * 144 + lcol * 16) = ra[i];
#pragma unroll
      for (int i = 0; i < 2; ++i) *(u32x4*)(bs2 + (lrow + i * 64) * 144 + lcol * 16) = rb[i];
    }
    __syncthreads();
  }
  epi(acc, m0 + wm * 64, n0 + wn * 64, l32, h);
}

struct EpiZ {
  u16* z;
  DI void operator()(f32x16 (&acc)[2][2], int chb, int tokb, int l32, int h) {
#pragma unroll
    for (int nt = 0; nt < 2; ++nt) { const int t = tokb + nt * 32 + l32;
#pragma unroll
      for (int mt = 0; mt < 2; ++mt)
#pragma unroll
        for (int q = 0; q < 4; ++q) {
          u32x2 v = {pack2(acc[mt][nt][q * 4], acc[mt][nt][q * 4 + 1]), pack2(acc[mt][nt][q * 4 + 2], acc[mt][nt][q * 4 + 3])};
          *(u32x2*)(z + (size_t)t * ZLD + chb + mt * 32 + q * 8 + h * 4) = v;
        }
    }
  }
};
struct EpiOut {
  float* y;
  DI void operator()(f32x16 (&acc)[2][2], int chb, int tokb, int l32, int h) {
#pragma unroll
    for (int nt = 0; nt < 2; ++nt) { const int t = tokb + nt * 32 + l32;
#pragma unroll
      for (int mt = 0; mt < 2; ++mt)
#pragma unroll
        for (int q = 0; q < 4; ++q) {
          f32x4 v = {acc[mt][nt][q * 4], acc[mt][nt][q * 4 + 1], acc[mt][nt][q * 4 + 2], acc[mt][nt][q * 4 + 3]};
          *(f32x4*)(y + (size_t)t * DM + chb + mt * 32 + q * 8 + h * 4) = v;
        }
    }
  }
};
struct EpiQ {
  u16* Q; const float* cosT; const float* sinT; const float* rs; int n0;
  DI void operator()(f32x16 (&acc)[2][2], int chb, int tokb, int l32, int h) {
    const int seg = chb >> 6, head = seg / 3, part = seg - head * 3;
#pragma unroll
    for (int nt = 0; nt < 2; ++nt) {
      const int t = tokb + nt * 32 + l32; const float r = rs[tokb - n0 + nt * 32 + l32] * QSCALE;
      u16* dst = Q + ((size_t)head * S + t) * 192;
      if (part < 2) {
#pragma unroll
        for (int mt = 0; mt < 2; ++mt)
#pragma unroll
          for (int q = 0; q < 4; ++q) {
            u32x2 v = {pack2(acc[mt][nt][q * 4] * r, acc[mt][nt][q * 4 + 1] * r), pack2(acc[mt][nt][q * 4 + 2] * r, acc[mt][nt][q * 4 + 3] * r)};
            *(u32x2*)(dst + part * 64 + mt * 32 + q * 8 + h * 4) = v;
          }
      } else {
#pragma unroll
        for (int q = 0; q < 4; ++q) {
          const int d = q * 8 + h * 4;
          const f32x4 c = *(const f32x4*)(cosT + (size_t)t * 32 + d), s = *(const f32x4*)(sinT + (size_t)t * 32 + d);
          float o1[4], o2[4];
#pragma unroll
          for (int j = 0; j < 4; ++j) { const float x1 = acc[0][nt][q * 4 + j], x2 = acc[1][nt][q * 4 + j]; o1[j] = (x1 * c[j] - x2 * s[j]) * r; o2[j] = (x2 * c[j] + x1 * s[j]) * r; }
          u32x2 v1 = {pack2(o1[0], o1[1]), pack2(o1[2], o1[3])}, v2 = {pack2(o2[0], o2[1]), pack2(o2[2], o2[3])};
          *(u32x2*)(dst + 128 + d) = v1; *(u32x2*)(dst + 160 + d) = v2;
        }
      }
    }
  }
};
DI int permpos(int k64) { const int kk = k64 & 15; return (k64 & 48) | (((kk >> 2) & 1) * 8 + (kk >> 3) * 4 + (kk & 3)); }
struct EpiKV {
  u16* K; u16* Vt; const float* rs; int n0;
  DI void operator()(f32x16 (&acc)[2][2], int chb, int tokb, int l32, int h) {
    const int seg = chb >> 6, head = seg >> 2, part = seg & 3;
#pragma unroll
    for (int nt = 0; nt < 2; ++nt) {
      const int t = tokb + nt * 32 + l32; const float r = rs[tokb - n0 + nt * 32 + l32];
      if (part < 2) {
        u16* dst = K + ((size_t)head * S + t) * 192 + part * 64;
#pragma unroll
        for (int mt = 0; mt < 2; ++mt)
#pragma unroll
          for (int q = 0; q < 4; ++q) {
            u32x2 v = {pack2(acc[mt][nt][q * 4] * r, acc[mt][nt][q * 4 + 1] * r), pack2(acc[mt][nt][q * 4 + 2] * r, acc[mt][nt][q * 4 + 3] * r)};
            *(u32x2*)(dst + mt * 32 + q * 8 + h * 4) = v;
          }
      } else {
        u16* dst = Vt + (((size_t)head * (S / 64) + (t >> 6)) * 128 + (part - 2) * 64) * 64 + permpos(t & 63);
#pragma unroll
        for (int mt = 0; mt < 2; ++mt)
#pragma unroll
          for (int i = 0; i < 16; ++i) { const int dv = mt * 32 + (i & 3) + 8 * (i >> 2) + 4 * h; dst[dv * 64] = tobf(acc[mt][nt][i] * r); }
      }
    }
  }
};

DI void row_rstd(float* rs, const u16* X, int ldx, int K) {
  const int tid = otid(), tl = tid >> 2, sub = tid & 3;
  const u16* src = X + (size_t)tl * ldx; float ss = 0.f;
  for (int c = sub; c < (K >> 3); c += 4) {
    u32x4 v = *(const u32x4*)(src + c * 8);
#pragma unroll
    for (int j = 0; j < 4; ++j) { const float a = bflo(v[j]), b = bfhi(v[j]); ss += a * a + b * b; }
  }
  ss += __shfl_xor(ss, 1); ss += __shfl_xor(ss, 2);
  if (sub == 0) rs[tl] = rsqrtf(ss / (float)K + EPS);
}

DI void krope_tile(const P& p, int n0) {
  const int tid = otid(), t = n0 + (tid >> 2), i0 = (tid & 3) * 8;
  const u16* z = (const u16*)(p.ws + WS_Z) + (size_t)t * ZLD + Z_KR;
  const float* cosT = (const float*)(p.ws + WS_COS) + (size_t)t * 32 + i0; const float* sinT = (const float*)(p.ws + WS_SIN) + (size_t)t * 32 + i0;
  u32x4 a = *(const u32x4*)(z + i0), b = *(const u32x4*)(z + 32 + i0);
  f32x4 c0 = *(const f32x4*)cosT, c1 = *(const f32x4*)(cosT + 4), s0 = *(const f32x4*)sinT, s1 = *(const f32x4*)(sinT + 4);
  float x1[8], x2[8], c[8], s[8];
#pragma unroll
  for (int j = 0; j < 4; ++j) { x1[2 * j] = bflo(a[j]); x1[2 * j + 1] = bfhi(a[j]); x2[2 * j] = bflo(b[j]); x2[2 * j + 1] = bfhi(b[j]); c[j] = c0[j]; c[4 + j] = c1[j]; s[j] = s0[j]; s[4 + j] = s1[j]; }
  u32x4 o1, o2;
#pragma unroll
  for (int j = 0; j < 4; ++j) {
    o1[j] = pack2(x1[2 * j] * c[2 * j] - x2[2 * j] * s[2 * j], x1[2 * j + 1] * c[2 * j + 1] - x2[2 * j + 1] * s[2 * j + 1]);
    o2[j] = pack2(x2[2 * j] * c[2 * j] + x1[2 * j] * s[2 * j], x2[2 * j + 1] * c[2 * j + 1] + x1[2 * j + 1] * s[2 * j + 1]);
  }
  u16* K = (u16*)(p.ws + WS_K);
#pragma unroll
  for (int hd = 0; hd < 4; ++hd) { u16* dst = K + ((size_t)hd * S + t) * 192 + 128 + i0; *(u32x4*)dst = o1; *(u32x4*)(dst + 32) = o2; }
}

DI void sgu_job(unsigned char* lds, const P& p, int layer, int nb) {
  const int tid = otid(), lane = tid & 63, wave = wave_of(tid);
  const int n0 = nb * 128;
  const u16* z = (const u16*)(p.ws + WS_Z);
  u16* vT = (u16*)lds;
  {
    const int j = tid >> 2, sub = tid & 3; const u16* src = z + (size_t)(n0 + j) * ZLD + Z_V + sub * 64;
    float v[64]; float s = 0.f;
#pragma unroll
    for (int c = 0; c < 8; ++c) { u32x4 u = *(const u32x4*)(src + c * 8);
#pragma unroll
      for (int k = 0; k < 4; ++k) { v[c * 8 + 2 * k] = bflo(u[k]); v[c * 8 + 2 * k + 1] = bfhi(u[k]); s += v[c * 8 + 2 * k] + v[c * 8 + 2 * k + 1]; } }
    s += __shfl_xor(s, 1); s += __shfl_xor(s, 2);
    const float mu = s * (1.f / 256.f); float q = 0.f;
#pragma unroll
    for (int c = 0; c < 64; ++c) { const float d = v[c] - mu; q += d * d; }
    q += __shfl_xor(q, 1); q += __shfl_xor(q, 2);
    const float rstd = rsqrtf(q * (1.f / 256.f) + EPS);
    const float* g = p.sgu_ln_g + layer * 256 + sub * 64; const float* b = p.sgu_ln_b + layer * 256 + sub * 64;
#pragma unroll
    for (int c = 0; c < 64; ++c) vT[(sub * 64 + c) * 136 + j] = tobf((v[c] - mu) * rstd * g[c] + b[c]);
  }
  __syncthreads();
  const int wm = wave & 3, wn = wave >> 2, l32 = lane & 31, h = lane >> 5;
  f32x16 acc[2][2]; acc[0][0] = zero16(); acc[0][1] = zero16(); acc[1][0] = zero16(); acc[1][1] = zero16();
  const u16* W = (const u16*)(p.ws + WS_SGUW) + (size_t)(layer * 4 + wm) * 128 * 128;
  const int kmax = wn ? 8 : 4;
#pragma unroll 1
  for (int kk = 0; kk < kmax; ++kk) {
    bf16x8 a0 = *(const bf16x8*)(vT + (wm * 64 + l32) * 136 + kk * 16 + h * 8);
    bf16x8 a1 = *(const bf16x8*)(vT + (wm * 64 + 32 + l32) * 136 + kk * 16 + h * 8);
    bf16x8 b0 = *(const bf16x8*)(W + (wn * 64 + l32) * 128 + kk * 16 + h * 8);
    bf16x8 b1 = *(const bf16x8*)(W + (wn * 64 + 32 + l32) * 128 + kk * 16 + h * 8);
    acc[0][0] = MFMA(a0, b0, acc[0][0]); acc[0][1] = MFMA(a0, b1, acc[0][1]);
    acc[1][0] = MFMA(a1, b0, acc[1][0]); acc[1][1] = MFMA(a1, b1, acc[1][1]);
  }
  u16* Y = (u16*)(p.ws + WS_HY);
#pragma unroll
  for (int nt = 0; nt < 2; ++nt) {
    const int i = wn * 64 + nt * 32 + l32, t = n0 + i; const float bias = p.sgu_b[(layer * 4 + wm) * 128 + i];
#pragma unroll
    for (int mt = 0; mt < 2; ++mt)
#pragma unroll
      for (int q = 0; q < 4; ++q) {
        const int c = wm * 64 + mt * 32 + q * 8 + h * 4;
        const u32x2 u = *(const u32x2*)(z + (size_t)t * ZLD + Z_U + c), g = *(const u32x2*)(z + (size_t)t * ZLD + Z_SG + c);
        const float o0 = bflo(u[0]) * (acc[mt][nt][q * 4] + bias) * silu(bflo(g[0])), o1 = bfhi(u[0]) * (acc[mt][nt][q * 4 + 1] + bias) * silu(bfhi(g[0]));
        const float o2 = bflo(u[1]) * (acc[mt][nt][q * 4 + 2] + bias) * silu(bflo(g[1])), o3 = bfhi(u[1]) * (acc[mt][nt][q * 4 + 3] + bias) * silu(bfhi(g[1]));
        u32x2 v = {pack2(o0, o1), pack2(o2, o3)};
        *(u32x2*)(Y + (size_t)t * DM + c) = v;
      }
  }
}

DI void pool_job(unsigned char* lds, const P& p, int layer, int nb) {
  const int tid = otid(), lane = tid & 63, wave = wave_of(tid);
  const int n0 = nb * 128;
  const u16* z = (const u16*)(p.ws + WS_Z);
  u16* pl = (u16*)lds;
  {
    const int cp = tid & 127, tq = tid >> 7, c = cp * 2, w = 2 << (cp >> 5);
    const u16* zp = z + Z_PI + c; const int t0 = n0 + tq * 32;
    float s0 = 0.f, s1 = 0.f;
    for (int s = max(t0 - w, 0); s < t0; ++s) { const unsigned u = *(const unsigned*)(zp + (size_t)s * ZLD); s0 += bflo(u); s1 += bfhi(u); }
#pragma unroll 4
    for (int tt = 0; tt < 32; ++tt) {
      const int t = t0 + tt; const unsigned u = *(const unsigned*)(zp + (size_t)t * ZLD);
      const float p0 = bflo(u), p1 = bfhi(u); s0 += p0; s1 += p1;
      if (t - w >= 0) { const unsigned u2 = *(const unsigned*)(zp + (size_t)(t - w) * ZLD); s0 -= bflo(u2); s1 -= bfhi(u2); }
      const float inv = 1.f / (float)min(t + 1, w);
      *(unsigned*)(pl + (tq * 32 + tt) * 264 + c) = pack2(s0 * inv - p0, s1 * inv - p1);
    }
  }
  __syncthreads();
  const int wm = wave & 3, wn = wave >> 2, l32 = lane & 31, h = lane >> 5;
  f32x16 acc[2][2]; acc[0][0] = zero16(); acc[0][1] = zero16(); acc[1][0] = zero16(); acc[1][1] = zero16();
  const u16* W = (const u16*)(p.ws + WS_PWT) + (size_t)(layer * 4 + wm) * 64 * 64;
#pragma unroll
  for (int kk = 0; kk < 4; ++kk) {
    bf16x8 a0 = *(const bf16x8*)(W + (l32) * 64 + kk * 16 + h * 8);
    bf16x8 a1 = *(const bf16x8*)(W + (32 + l32) * 64 + kk * 16 + h * 8);
    bf16x8 b0 = *(const bf16x8*)(pl + (wn * 64 + l32) * 264 + wm * 64 + kk * 16 + h * 8);
    bf16x8 b1 = *(const bf16x8*)(pl + (wn * 64 + 32 + l32) * 264 + wm * 64 + kk * 16 + h * 8);
    acc[0][0] = MFMA(a0, b0, acc[0][0]); acc[0][1] = MFMA(a0, b1, acc[0][1]);
    acc[1][0] = MFMA(a1, b0, acc[1][0]); acc[1][1] = MFMA(a1, b1, acc[1][1]);
  }
  u16* Y = (u16*)(p.ws + WS_HY);
#pragma unroll
  for (int nt = 0; nt < 2; ++nt) {
    const int t = n0 + wn * 64 + nt * 32 + l32;
#pragma unroll
    for (int mt = 0; mt < 2; ++mt)
#pragma unroll
      for (int q = 0; q < 4; ++q) {
        const int c = wm * 64 + mt * 32 + q * 8 + h * 4;
        const f32x4 sc = *(const f32x4*)(p.pool_scale + layer * 256 + c);
        const u32x2 g = *(const u32x2*)(z + (size_t)t * ZLD + Z_PG + c);
        const float o0 = acc[mt][nt][q * 4] * sc[0] * silu(bflo(g[0])), o1 = acc[mt][nt][q * 4 + 1] * sc[1] * silu(bfhi(g[0]));
        const float o2 = acc[mt][nt][q * 4 + 2] * sc[2] * silu(bflo(g[1])), o3 = acc[mt][nt][q * 4 + 3] * sc[3] * silu(bfhi(g[1]));
        u32x2 v = {pack2(o0, o1), pack2(o2, o3)};
        *(u32x2*)(Y + (size_t)t * DM + 256 + c) = v;
      }
  }
}

DI void attn_item(unsigned char* lds, const P& p, int hd, int qb) {
  const int tid = otid(), lane = tid & 63, wave = wave_of(tid);
  const int wq = wave & 3, wk = wave >> 2, l32 = lane & 31, h = lane >> 5;
  const u16* Qg = (const u16*)(p.ws + WS_Q) + ((size_t)hd * S + qb * 128 + wq * 32 + l32) * 192 + h * 8;
  bf16x8 qf[12];
#pragma unroll
  for (int ks = 0; ks < 12; ++ks) qf[ks] = *(const bf16x8*)(Qg + ks * 16);
  const int ntile = 2 * qb + 2, mychunk = 2 * qb + (wq >> 1);
  const u16* Kg = (const u16*)(p.ws + WS_K) + (size_t)hd * S * 192 + tid * 8;
  const u16* Vg = (const u16*)(p.ws + WS_VT) + (size_t)hd * S * 128 + tid * 8;
  int kdst[3], vdst[2];
#pragma unroll
  for (int i = 0; i < 3; ++i) { const int c = tid + i * NT; kdst[i] = (c / 24) * 400 + (c % 24) * 16; }
#pragma unroll
  for (int i = 0; i < 2; ++i) { const int c = tid + i * NT; vdst[i] = 64 * 400 + (c >> 3) * 144 + (c & 7) * 16; }
  f32x16 O[4]; O[0] = zero16(); O[1] = zero16(); O[2] = zero16(); O[3] = zero16();
  float m = -1e30f, l = 0.f;
  u32x4 rk[3], rv[2];
#pragma unroll
  for (int i = 0; i < 3; ++i) rk[i] = *(const u32x4*)(Kg + i * NT * 8);
#pragma unroll
  for (int i = 0; i < 2; ++i) rv[i] = *(const u32x4*)(Vg + i * NT * 8);
#pragma unroll
  for (int i = 0; i < 3; ++i) *(u32x4*)(lds + kdst[i]) = rk[i];
#pragma unroll
  for (int i = 0; i < 2; ++i) *(u32x4*)(lds + vdst[i]) = rv[i];
  __syncthreads();
#pragma unroll 1
  for (int kt = 0; kt < ntile; ++kt) {
    const bool more = kt + 1 < ntile;
    if (more) {
#pragma unroll
      for (int i = 0; i < 3; ++i) rk[i] = *(const u32x4*)(Kg + (size_t)(kt + 1) * 64 * 192 + i * NT * 8);
#pragma unroll
      for (int i = 0; i < 2; ++i) rv[i] = *(const u32x4*)(Vg + (size_t)(kt + 1) * 128 * 64 + i * NT * 8);
    }
    if (kt <= mychunk) {
      const unsigned char* ks_ = lds + (kt & 1) * ATT_STAGE; const unsigned char* vs_ = ks_ + 64 * 400;
      f32x16 s = zero16();
#pragma unroll
      for (int ks = 0; ks < 12; ++ks) { bf16x8 kf = *(const bf16x8*)(ks_ + (wk * 32 + l32) * 400 + ks * 32 + h * 16); s = MFMA(kf, qf[ks], s); }
      float mx = s[0];
#pragma unroll
      for (int i = 1; i < 16; ++i) mx = fmaxf(mx, s[i]);
      mx = fmaxf(mx, __shfl_xor(mx, 32));
      const float mn = fmaxf(m, mx), alpha = ex2(m - mn); m = mn;
      float ps = 0.f;
#pragma unroll
      for (int i = 0; i < 16; ++i) { s[i] = ex2(s[i] - mn); ps += s[i]; }
      l = l * alpha + ps;
#pragma unroll
      for (int mt = 0; mt < 4; ++mt)
#pragma unroll
        for (int i = 0; i < 16; ++i) O[mt][i] *= alpha;
      u32x4 p0 = {pack2(s[0], s[1]), pack2(s[2], s[3]), pack2(s[4], s[5]), pack2(s[6], s[7])};
      u32x4 p1 = {pack2(s[8], s[9]), pack2(s[10], s[11]), pack2(s[12], s[13]), pack2(s[14], s[15])};
      const bf16x8 pf0 = __builtin_bit_cast(bf16x8, p0), pf1 = __builtin_bit_cast(bf16x8, p1);
#pragma unroll
      for (int mt = 0; mt < 4; ++mt) {
        bf16x8 v0 = *(const bf16x8*)(vs_ + (mt * 32 + l32) * 144 + (wk * 32 + h * 8) * 2);
        bf16x8 v1 = *(const bf16x8*)(vs_ + (mt * 32 + l32) * 144 + (wk * 32 + 16 + h * 8) * 2);
        O[mt] = MFMA(v0, pf0, O[mt]); O[mt] = MFMA(v1, pf1, O[mt]);
      }
    }
    if (more) {
      unsigned char* st = lds + ((kt + 1) & 1) * ATT_STAGE;
#pragma unroll
      for (int i = 0; i < 3; ++i) *(u32x4*)(st + kdst[i]) = rk[i];
#pragma unroll
      for (int i = 0; i < 2; ++i) *(u32x4*)(st + vdst[i]) = rv[i];
    }
    __syncthreads();
  }
  const float lt = l + __shfl_xor(l, 32);
  float* cO = (float*)lds; float* cm = (float*)(lds + 65536);
  if (wk == 1) {
#pragma unroll
    for (int mt = 0; mt < 4; ++mt)
#pragma unroll
      for (int i = 0; i < 16; ++i) cO[(wq * 64 + mt * 16 + i) * 64 + lane] = O[mt][i];
    cm[wq * 64 + lane] = m; cm[256 + wq * 64 + lane] = lt;
  }
  __syncthreads();
  if (wk == 0) {
    const float m1 = cm[wq * 64 + lane], l1 = cm[256 + wq * 64 + lane];
    const float mm = fmaxf(m, m1); float a0 = ex2(m - mm), a1 = ex2(m1 - mm);
    const float inv = 1.f / (lt * a0 + l1 * a1); a0 *= inv; a1 *= inv;
    const int t = qb * 128 + wq * 32 + l32;
    const u16* zg = (const u16*)(p.ws + WS_Z) + (size_t)t * ZLD + Z_MG + hd * 128;
    u16* Y = (u16*)(p.ws + WS_HY) + (size_t)t * DM + 512 + hd * 128;
#pragma unroll
    for (int mt = 0; mt < 4; ++mt)
#pragma unroll
      for (int q = 0; q < 4; ++q) {
        const int dv = mt * 32 + q * 8 + h * 4;
        const u32x2 g = *(const u32x2*)(zg + dv);
        float o[4];
#pragma unroll
        for (int j = 0; j < 4; ++j) o[j] = O[mt][q * 4 + j] * a0 + cO[(wq * 64 + mt * 16 + q * 4 + j) * 64 + lane] * a1;
        u32x2 v = {pack2(o[0] * silu(bflo(g[0])), o[1] * silu(bfhi(g[0]))), pack2(o[2] * silu(bflo(g[1])), o[3] * silu(bfhi(g[1])))};
        *(u32x2*)(Y + dv) = v;
      }
  }
  __syncthreads();
}

DI void transpose_tile(unsigned char* lds, const float* __restrict__ src, int ldsrc, u16* __restrict__ dst, int ldd, int k0, int n0, int nvalid, const float* gain) {
  float* tile = (float*)lds;
  const int tid = otid();
#pragma unroll
  for (int i = 0; i < 8; ++i) { const int idx = tid + i * NT, r = idx >> 6, cc = idx & 63, n = n0 + cc;
    float v = (n < nvalid) ? src[(size_t)(k0 + r) * ldsrc + n] : 0.f; if (gain) v *= gain[k0 + r]; tile[r * 65 + cc] = v; }
  __syncthreads();
#pragma unroll
  for (int i = 0; i < 8; ++i) { const int idx = tid + i * NT, r = idx >> 6, cc = idx & 63; dst[(size_t)(n0 + r) * ldd + k0 + cc] = tobf(tile[cc * 65 + r]); }
  __syncthreads();
}
DI float wave_sum(float v) { v += __shfl_xor(v, 32); v += __shfl_xor(v, 16); v += __shfl_xor(v, 8); v += __shfl_xor(v, 4); v += __shfl_xor(v, 2); v += __shfl_xor(v, 1); return v; }
DI void prenorm_row(const f32x4 (&v)[4], const float* g, u16* hrow, int lane) {
  float ss = 0.f;
#pragma unroll
  for (int i = 0; i < 4; ++i) ss += v[i][0] * v[i][0] + v[i][1] * v[i][1] + v[i][2] * v[i][2] + v[i][3] * v[i][3];
  ss = wave_sum(ss);
  const float r = rsqrtf(ss * (1.f / 1024.f) + EPS);
#pragma unroll
  for (int i = 0; i < 4; ++i) { const f32x4 gg = *(const f32x4*)(g + (lane + 64 * i) * 4);
    u32x2 o = {pack2(v[i][0] * r * gg[0], v[i][1] * r * gg[1]), pack2(v[i][2] * r * gg[2], v[i][3] * r * gg[3])};
    *(u32x2*)(hrow + (lane + 64 * i) * 4) = o; }
}

DI void phase_prep(unsigned char* lds, const P& p) {
  const int nb = gridDim.x, bid = blockIdx.x, tid = otid();
  u16* win = (u16*)(p.ws + WS_WIN); u16* wuq = (u16*)(p.ws + WS_WUQ); u16* wukv = (u16*)(p.ws + WS_WUKV); u16* wout = (u16*)(p.ws + WS_WOUT);
  for (int job = bid; job < 2 * 1032; job += nb) {
    const int layer = job / 1032; int r = job - layer * 1032;
    if (r < 640) { const int kt = r / 40, nt = r - kt * 40; transpose_tile(lds, p.w_in + (size_t)layer * 1024 * DIN, DIN, win + (size_t)layer * 2560 * 1024, 1024, kt * 64, nt * 64, DIN, nullptr); }
    else if (r < 712) { r -= 640; const int kt = r / 12, nt = r - kt * 12; transpose_tile(lds, p.w_uq + (size_t)layer * 384 * 768, 768, wuq + (size_t)layer * 768 * 384, 384, kt * 64, nt * 64, 768, p.q_norm_g + layer * 384); }
    else if (r < 776) { r -= 712; const int kt = r / 16, nt = r - kt * 16; transpose_tile(lds, p.w_ukv + (size_t)layer * 256 * 1024, 1024, wukv + (size_t)layer * 1024 * 256, 256, kt * 64, nt * 64, 1024, p.kv_norm_g + layer * 256); }
    else { r -= 776; const int kt = r / 16, nt = r - kt * 16; transpose_tile(lds, p.w_out + (size_t)layer * 1024 * 1024, 1024, wout + (size_t)layer * 1024 * 1024, 1024, kt * 64, nt * 64, 1024, nullptr); }
  }
  const int gtid = bid * NT + tid, gn = nb * NT;
  u16* sguw = (u16*)(p.ws + WS_SGUW);
  for (int idx = gtid; idx < 2 * 4 * 128 * 128; idx += gn) { const int i = (idx >> 7) & 127, j = idx & 127; sguw[idx] = ((j >> 6) <= (i >> 6)) ? tobf(p.sgu_w[idx]) : (u16)0; }
  u16* pwt = (u16*)(p.ws + WS_PWT);
  for (int idx = gtid; idx < 2 * 4 * 64 * 64; idx += gn) { const int lg = idx >> 12, d = (idx >> 6) & 63, c = idx & 63; pwt[idx] = tobf(p.pool_w[(lg * 64 + c) * 64 + d]); }
  float* cosT = (float*)(p.ws + WS_COS); float* sinT = (float*)(p.ws + WS_SIN);
  for (int idx = gtid; idx < S * 32; idx += gn) {
    const int t = idx >> 5, i = idx & 31; const float angf = (float)p.pos[t] * p.invfreq[i];
    const double a = (double)angf; const double k = rint(a * 0.15915494309189535); const double r = a - k * 6.283185307179586; const double r2 = r * r;
    double ts = r, ss = r, tc = 1.0, sc = 1.0;
#pragma unroll
    for (int n = 1; n <= 13; ++n) { ts *= -r2 * (1.0 / (double)((2 * n) * (2 * n + 1))); ss += ts; tc *= -r2 * (1.0 / (double)((2 * n - 1) * (2 * n))); sc += tc; }
    cosT[idx] = (float)sc; sinT[idx] = (float)ss;
  }
  u16* hb = (u16*)(p.ws + WS_HY);
  const int lane = tid & 63, wave = wave_of(tid);
  for (int row = bid * 8 + wave; row < S; row += nb * 8) {
    f32x4 v[4];
#pragma unroll
    for (int i = 0; i < 4; ++i) v[i] = *(const f32x4*)(p.x + (size_t)row * DM + (lane + 64 * i) * 4);
    prenorm_row(v, p.pre_g, hb + (size_t)row * DM, lane);
  }
}

DI void phase_post(const P& p, int layer) {
  const int nb = gridDim.x, bid = blockIdx.x, tid = otid(), lane = tid & 63, wave = wave_of(tid);
  const float* yout = (const float*)(p.ws + WS_Z); const float* xold = layer == 0 ? p.x : p.out;
  u16* hb = (u16*)(p.ws + WS_HY);
  for (int row = bid * 8 + wave; row < S; row += nb * 8) {
    f32x4 y[4]; float ss = 0.f;
#pragma unroll
    for (int i = 0; i < 4; ++i) { y[i] = *(const f32x4*)(yout + (size_t)row * DM + (lane + 64 * i) * 4); ss += y[i][0] * y[i][0] + y[i][1] * y[i][1] + y[i][2] * y[i][2] + y[i][3] * y[i][3]; }
    ss = wave_sum(ss);
    const float r = rsqrtf(ss * (1.f / 1024.f) + EPS);
#pragma unroll
    for (int i = 0; i < 4; ++i) {
      const f32x4 g = *(const f32x4*)(p.post_g + layer * DM + (lane + 64 * i) * 4); const f32x4 xo = *(const f32x4*)(xold + (size_t)row * DM + (lane + 64 * i) * 4);
      y[i] = xo + y[i] * r * g;
      *(f32x4*)(p.out + (size_t)row * DM + (lane + 64 * i) * 4) = y[i];
    }
    if (layer + 1 < DEPTH) prenorm_row(y, p.pre_g + (layer + 1) * DM, hb + (size_t)row * DM, lane);
  }
}

__global__ void __launch_bounds__(NT) mega(P p) {
  extern __shared__ __attribute__((aligned(16))) unsigned char lds[];
  cg::grid_group grid = cg::this_grid();
  const int nb = gridDim.x, bid = blockIdx.x;
  if (threadIdx.x < 4) ((unsigned*)(lds + XB_LDS_OFF))[threadIdx.x] = 0u;
  __syncthreads();
  XcdBarrier xbar = xcd_barrier_post((unsigned*)(p.ws + WS_BAR), (volatile LAS unsigned*)(lds + XB_LDS_OFF));
  int ph = 0;
#define RUN(ph_) ((ph_) >= p.ph_lo && (ph_) < p.ph_hi)
#define SEAM(ph_) do { if (RUN(ph_) && RUN((ph_) + 1)) { if ((ph_) == 0) grid.sync(); else xcd_barrier(xbar); } } while (0)
  for (int rep = 0; rep < (DUP == 5 ? 2 : 1); ++rep)
  if (RUN(ph)) phase_prep(lds, p);
  if (DUP == 7) for (int rep = 0; rep < 10; ++rep) grid.sync();
  SEAM(ph); ++ph;
#pragma unroll 1
  for (int layer = 0; layer < DEPTH; ++layer) {
    u16* hy = (u16*)(p.ws + WS_HY); u16* z = (u16*)(p.ws + WS_Z);
    float* rs = (float*)(lds + RS_OFF);
    for (int rep = 0; rep < (DUP == 1 ? 2 : 1); ++rep)
    if (RUN(ph)) {
      const u16* W = (const u16*)(p.ws + WS_WIN) + (size_t)layer * 2560 * 1024;
      EpiZ e{z};
      for (int job = bid; job < 1280; job += nb) { const int nt = job / 10, mt = job - nt * 10;
        gemm_tile(lds, W + (size_t)mt * 256 * 1024, hy + (size_t)nt * 128 * 1024, 1024, 1024, mt * 256, nt * 128, e); }
    }
    SEAM(ph); ++ph;
    for (int rep = 0; rep < (DUP == 2 ? 2 : 1); ++rep)
    if (RUN(ph)) {
      const float* cosT = (const float*)(p.ws + WS_COS); const float* sinT = (const float*)(p.ws + WS_SIN);
      for (int job = bid; job < 1152; job += nb) {
        __syncthreads();
        if (job < 384) { const int nt = job / 3, mt = job - nt * 3, n0 = nt * 128;
          const u16* X = z + (size_t)n0 * ZLD + Z_CQ; row_rstd(rs, X, ZLD, 384);
          EpiQ e{(u16*)(p.ws + WS_Q), cosT, sinT, rs, n0};
          gemm_tile(lds, (const u16*)(p.ws + WS_WUQ) + (size_t)layer * 768 * 384 + (size_t)mt * 256 * 384, X, ZLD, 384, mt * 256, n0, e);
        } else if (job < 896) { const int j2 = job - 384, nt = j2 >> 2, mt = j2 & 3, n0 = nt * 128;
          const u16* X = z + (size_t)n0 * ZLD + Z_CKV; row_rstd(rs, X, ZLD, 256);
          EpiKV e{(u16*)(p.ws + WS_K), (u16*)(p.ws + WS_VT), rs, n0};
          gemm_tile(lds, (const u16*)(p.ws + WS_WUKV) + (size_t)layer * 1024 * 256 + (size_t)mt * 256 * 256, X, ZLD, 256, mt * 256, n0, e);
          if (mt == 0) krope_tile(p, n0);
        } else if (job < 1024) sgu_job(lds, p, layer, job - 896);
        else pool_job(lds, p, layer, job - 1024);
      }
    }
    SEAM(ph); ++ph;
    for (int rep = 0; rep < (DUP == 3 ? 2 : 1); ++rep)
    if (RUN(ph)) {
      for (int it = bid; it < 256; it += nb) {
        const int hd = (it & 7) >> 1, pr = (it >> 3) * 2 + (it & 1);
        attn_item(lds, p, hd, 127 - pr);
        attn_item(lds, p, hd, pr);
      }
    }
    SEAM(ph); ++ph;
    for (int rep = 0; rep < (DUP == 4 ? 2 : 1); ++rep)
    if (RUN(ph)) {
      const u16* W = (const u16*)(p.ws + WS_WOUT) + (size_t)layer * 1024 * 1024;
      EpiOut e{(float*)(p.ws + WS_Z)};
      for (int job = bid; job < 512; job += nb) { const int nt = job >> 2, mt = job & 3;
        gemm_tile(lds, W + (size_t)mt * 256 * 1024, hy + (size_t)nt * 128 * 1024, 1024, 1024, mt * 256, nt * 128, e); }
    }
    SEAM(ph); ++ph;
    for (int rep = 0; rep < ((DUP == 6 && layer == 0) ? 2 : 1); ++rep)
    if (RUN(ph)) phase_post(p, layer);
    SEAM(ph); ++ph;
  }
}
constexpr int NPHASE = 1 + 5 * DEPTH;

extern "C" void kernel_launch(void* const* d_in, const int* in_sizes, int n_in, void* d_out, int out_size, void* d_ws, size_t ws_size, hipStream_t stream) {
  static int grid_blocks = 0;
  if (!grid_blocks) {
    int dev = 0, cus = 0, per_cu = 0;
    hipGetDevice(&dev);
    hipDeviceGetAttribute(&cus, hipDeviceAttributeMultiprocessorCount, dev);
    hipFuncSetAttribute((const void*)mega, hipFuncAttributeMaxDynamicSharedMemorySize, LDS_BYTES);
    hipOccupancyMaxActiveBlocksPerMultiprocessor(&per_cu, (const void*)mega, NT, LDS_BYTES);
    if (per_cu < 1) { fprintf(stderr, "occupancy query returned %d\n", per_cu); per_cu = 1; }
    if (per_cu > 1) per_cu = 1;
    grid_blocks = cus * per_cu;
    if (ws_size < WS_END) fprintf(stderr, "workspace too small: %zu < %zu\n", ws_size, (size_t)WS_END);
  }
  P p{};
  p.x = (const float*)d_in[0]; p.pos = (const int*)d_in[1]; p.pre_g = (const float*)d_in[2]; p.post_g = (const float*)d_in[3];
  p.w_in = (const float*)d_in[4]; p.sgu_w = (const float*)d_in[5]; p.sgu_b = (const float*)d_in[6]; p.sgu_ln_g = (const float*)d_in[7];
  p.sgu_ln_b = (const float*)d_in[8]; p.pool_w = (const float*)d_in[9]; p.pool_scale = (const float*)d_in[10]; p.q_norm_g = (const float*)d_in[11];
  p.w_uq = (const float*)d_in[12]; p.kv_norm_g = (const float*)d_in[13]; p.w_ukv = (const float*)d_in[14]; p.w_out = (const float*)d_in[15];
  p.out = (float*)d_out; p.ws = (unsigned char*)d_ws;
  for (int i = 0; i < 32; ++i) p.invfreq[i] = powf(10000.0f, -(float)(2 * i) / 64.0f);
  hipMemsetAsync((char*)d_ws + WS_BAR, 0, 16384, stream);
#if COOP
  p.ph_lo = 0; p.ph_hi = NPHASE;
  void* args[] = {&p};
  hipError_t e = hipLaunchCooperativeKernel((void*)mega, dim3(grid_blocks), dim3(NT), args, LDS_BYTES, stream);
  if (e != hipSuccess) fprintf(stderr, "cooperative launch failed: %s (grid %d)\n", hipGetErrorString(e), grid_blocks);
#else
  for (int ph = 0; ph < NPHASE; ++ph) { p.ph_lo = ph; p.ph_hi = ph + 1; hipLaunchKernelGGL(mega, dim3(grid_blocks), dim3(NT), LDS_BYTES, stream, p); }
#endif
}
```

```cpp
#include <hip/hip_runtime.h>
#include <hip/hip_cooperative_groups.h>
#include <cstdio>
#include <cmath>
namespace cg = cooperative_groups;

#define DI __device__ __forceinline__
typedef unsigned short u16;
using bf16x8 = __attribute__((ext_vector_type(8))) short;
using f32x16 = __attribute__((ext_vector_type(16))) float;
using f32x4  = __attribute__((ext_vector_type(4))) float;
using f32x2  = __attribute__((ext_vector_type(2))) float;
using u32x4  = __attribute__((ext_vector_type(4))) unsigned;
using u32x2  = __attribute__((ext_vector_type(2))) unsigned;
typedef __bf16 bf2_t __attribute__((ext_vector_type(2)));
#define MFMA(a, b, c) __builtin_amdgcn_mfma_f32_32x32x16_bf16((a), (b), (c), 0, 0, 0)

#ifndef COOP
#define COOP 1
#endif
#ifndef DUP
#define DUP 7
#endif

constexpr int S = 16384, DM = 1024, DIN = 2496, ZLD = 2560, NT = 512, DEPTH = 2;
constexpr float EPS = 1e-6f;
constexpr float QSCALE = 0.07216878364870322f * 1.4426950408889634f;
constexpr int Z_U = 0, Z_V = 256, Z_SG = 512, Z_PI = 768, Z_PG = 1024, Z_CQ = 1280, Z_CKV = 1664, Z_KR = 1920, Z_MG = 1984;

constexpr size_t WS_HY   = 0;
constexpr size_t WS_Z    = WS_HY + (size_t)S * 1024 * 2;
constexpr size_t WS_Q    = WS_Z + (size_t)S * ZLD * 2;
constexpr size_t WS_K    = WS_Q + (size_t)4 * S * 192 * 2;
constexpr size_t WS_VT   = WS_K + (size_t)4 * S * 192 * 2;
constexpr size_t WS_WIN  = WS_VT + (size_t)4 * S * 128 * 2;
constexpr size_t WS_WUQ  = WS_WIN + (size_t)2 * 2560 * 1024 * 2;
constexpr size_t WS_WUKV = WS_WUQ + (size_t)2 * 768 * 384 * 2;
constexpr size_t WS_WOUT = WS_WUKV + (size_t)2 * 1024 * 256 * 2;
constexpr size_t WS_SGUW = WS_WOUT + (size_t)2 * 1024 * 1024 * 2;
constexpr size_t WS_PWT  = WS_SGUW + (size_t)2 * 4 * 128 * 128 * 2;
constexpr size_t WS_COS  = WS_PWT + (size_t)2 * 4 * 64 * 64 * 2;
constexpr size_t WS_SIN  = WS_COS + (size_t)S * 32 * 4;
constexpr size_t WS_BAR  = WS_SIN + (size_t)S * 32 * 4;
constexpr size_t WS_END  = WS_BAR + 16384;

constexpr int GEMM_STAGE = 256 * 144 + 128 * 144;
constexpr int RS_OFF = 2 * GEMM_STAGE;
constexpr int XB_LDS_OFF = RS_OFF + 512;
constexpr int LDS_BYTES = XB_LDS_OFF + 16;
constexpr int ATT_STAGE = 64 * 400 + 128 * 144;

struct P {
  const float* x; const int* pos; const float* pre_g; const float* post_g; const float* w_in; const float* sgu_w; const float* sgu_b;
  const float* sgu_ln_g; const float* sgu_ln_b; const float* pool_w; const float* pool_scale; const float* q_norm_g; const float* w_uq;
  const float* kv_norm_g; const float* w_ukv; const float* w_out;
  float* out; unsigned char* ws;
  float invfreq[32];
  int ph_lo, ph_hi;
};

DI int otid() { int t = threadIdx.x; asm volatile("" : "+v"(t)); return t; }
DI int wave_of(int tid) { return __builtin_amdgcn_readfirstlane(tid >> 6); }
DI unsigned pack2(float a, float b) { f32x2 v = {a, b}; return __builtin_bit_cast(unsigned, __builtin_convertvector(v, bf2_t)); }
DI u16 tobf(float a) { return (u16)(pack2(a, 0.f) & 0xffffu); }
DI float bflo(unsigned u) { return __uint_as_float(u << 16); }
DI float bfhi(unsigned u) { return __uint_as_float(u & 0xffff0000u); }
DI float silu(float x) { return x / (1.f + __expf(-x)); }
DI float ex2(float x) { return __builtin_amdgcn_exp2f(x); }
DI f32x16 zero16() { f32x16 z; for (int i = 0; i < 16; ++i) z[i] = 0.f; return z; }

#define XB_TMO      128
#define XB_XCNT(j)  (256  + 64 * (j))
#define XB_XSUB(j)  (1280 + 64 * (j))
#define XB_XGEN(j)  (2304 + 64 * (j))
#define XB_TOP      3328
#define XB_TOPGEN   3392
#define XCD_BAR_WORDS 3456
#define XB_SPIN_CAP (1u << 18)
#define LAS __attribute__((address_space(3)))

__device__ __forceinline__ unsigned xb_ld(unsigned* p)              { return __hip_atomic_load(p, __ATOMIC_RELAXED, __HIP_MEMORY_SCOPE_AGENT); }
__device__ __forceinline__ unsigned xb_add(unsigned* p, unsigned v) { return __hip_atomic_fetch_add(p, v, __ATOMIC_RELAXED, __HIP_MEMORY_SCOPE_AGENT); }
__device__ __forceinline__ unsigned xb_xcc_id() { return (unsigned)__builtin_amdgcn_s_getreg((3 << 11) | 20) & 0xFu; }
#define XB_SPIN(cond, bar) do { unsigned _sp = 0; while (cond) { __builtin_amdgcn_s_sleep(1); \
    if ((++_sp & 255u) == 0u) { if (xb_ld(&(bar)[XB_TMO])) break; if (_sp > XB_SPIN_CAP) { atomicAdd(&(bar)[XB_TMO], 1u); break; } } } } while (0)

struct XcdBarrier {
    unsigned* bar; unsigned x;
    volatile LAS unsigned* st;
};

__device__ __forceinline__ XcdBarrier xcd_barrier_post(unsigned* bar, volatile LAS unsigned* st) {
    XcdBarrier b; b.bar = bar; b.x = xb_xcc_id(); b.st = st;
    if (threadIdx.x == 0) (void)xb_add(&bar[XB_XCNT(b.x)], 1u);
    return b;
}
__device__ __forceinline__ void xcd_barrier_complete(unsigned* bar, unsigned x, unsigned& nloc, unsigned& nx) {
    const unsigned G = gridDim.x * gridDim.y * gridDim.z;
    unsigned sum, cnt, mine, sp = 0u;
    for (;;) {
        sum = 0u; cnt = 0u; mine = 0u;
#pragma unroll
        for (unsigned j = 0; j < 16; ++j) { const unsigned c = xb_ld(&bar[XB_XCNT(j)]); sum += c; cnt += (c > 0u) ? 1u : 0u; mine = (j == x) ? c : mine; }
        if (sum == G) break;
        __builtin_amdgcn_s_sleep(1);
        if ((++sp & 255u) == 0u) { if (xb_ld(&bar[XB_TMO])) break; if (sp > XB_SPIN_CAP) { atomicAdd(&bar[XB_TMO], 1u); break; } }
    }
    nloc = mine > 0u ? mine : 1u; nx = cnt > 0u ? cnt : 1u;
}

__device__ __forceinline__ void xcd_barrier(const XcdBarrier& b) {
    asm volatile("s_waitcnt vmcnt(0)" ::: "memory");
    __syncthreads();
    if (threadIdx.x == 0) {
        unsigned* bar = b.bar;
        __builtin_amdgcn_s_waitcnt(0);
        unsigned nloc = b.st[0], nx = b.st[1];
        if (nloc == 0u) { xcd_barrier_complete(bar, b.x, nloc, nx); b.st[0] = nloc; b.st[1] = nx; }
        const unsigned old = xb_add(&bar[XB_XSUB(b.x)], 1u);
        const unsigned gen = old / nloc;
        if (old + 1u == (gen + 1u) * nloc) {
            __builtin_amdgcn_fence(__ATOMIC_RELEASE, "agent");
            asm volatile("s_waitcnt vmcnt(0)" ::: "memory");
            const unsigned og = xb_add(&bar[XB_TOP], 1u);
            const unsigned tg = og / nx;
            if (og + 1u == (tg + 1u) * nx) xb_add(&bar[XB_TOPGEN], 1u);
            else XB_SPIN(xb_ld(&bar[XB_TOPGEN]) == tg, bar);
            __builtin_amdgcn_fence(__ATOMIC_ACQUIRE, "agent");
            xb_add(&bar[XB_XGEN(b.x)], 1u);
            asm volatile("s_waitcnt vmcnt(0)" ::: "memory");
        } else {
            XB_SPIN(xb_ld(&bar[XB_XGEN(b.x)]) == gen, bar);
            __builtin_amdgcn_fence(__ATOMIC_ACQUIRE, "agent");
            asm volatile("s_waitcnt vmcnt(0)" ::: "memory");
        }
    }
    __syncthreads();
}


template <class Epi>
DI void gemm_tile(unsigned char* lds, const u16* __restrict__ A, const u16* __restrict__ X, int ldx, int K, int m0, int n0, Epi& epi) {
  const int tid = otid(), lane = tid & 63, wave = wave_of(tid);
  const int wm = wave & 3, wn = wave >> 2, l32 = lane & 31, h = lane >> 5;
  f32x16 acc[2][2];
  acc[0][0] = zero16(); acc[0][1] = zero16(); acc[1][0] = zero16(); acc[1][1] = zero16();
  const int nk = K >> 6;
  const int lrow = tid >> 3, lcol = tid & 7;
  const u16* ga = A + (size_t)lrow * K + lcol * 8;
  const u16* gx = X + (size_t)lrow * ldx + lcol * 8;
  u32x4 ra[4], rb[2];
#pragma unroll
  for (int i = 0; i < 4; ++i) ra[i] = *(const u32x4*)(ga + (size_t)i * 64 * K);
#pragma unroll
  for (int i = 0; i < 2; ++i) rb[i] = *(const u32x4*)(gx + (size_t)i * 64 * ldx);
  {
    unsigned char* as = lds; unsigned char* bs = lds + 256 * 144;
#pragma unroll
    for (int i = 0; i < 4; ++i) *(u32x4*)(as + (lrow + i * 64) * 144 + lcol * 16) = ra[i];
#pragma unroll
    for (int i = 0; i < 2; ++i) *(u32x4*)(bs + (lrow + i * 64) * 144 + lcol * 16) = rb[i];
  }
  __syncthreads();
#pragma unroll 1
  for (int ks = 0; ks < nk; ++ks) {
    const bool more = ks + 1 < nk;
    if (more) {
#pragma unroll
      for (int i = 0; i < 4; ++i) ra[i] = *(const u32x4*)(ga + (size_t)i * 64 * K + (ks + 1) * 64);
#pragma unroll
      for (int i = 0; i < 2; ++i) rb[i] = *(const u32x4*)(gx + (size_t)i * 64 * ldx + (ks + 1) * 64);
    }
    const unsigned char* as = lds + (ks & 1) * GEMM_STAGE; const unsigned char* bs = as + 256 * 144;
#pragma unroll
    for (int kk = 0; kk < 4; ++kk) {
      bf16x8 a0 = *(const bf16x8*)(as + (wm * 64 + l32) * 144 + kk * 32 + h * 16);
      bf16x8 a1 = *(const bf16x8*)(as + (wm * 64 + 32 + l32) * 144 + kk * 32 + h * 16);
      bf16x8 b0 = *(const bf16x8*)(bs + (wn * 64 + l32) * 144 + kk * 32 + h * 16);
      bf16x8 b1 = *(const bf16x8*)(bs + (wn * 64 + 32 + l32) * 144 + kk * 32 + h * 16);
      acc[0][0] = MFMA(a0, b0, acc[0][0]); acc[0][1] = MFMA(a0, b1, acc[0][1]);
      acc[1][0] = MFMA(a1, b0, acc[1][0]); acc[1][1] = MFMA(a1, b1, acc[1][1]);
    }
    if (more) {
      unsigned char* as2 = lds + ((ks + 1) & 1) * GEMM_STAGE; unsigned char* bs2 = as2 + 256 * 144;
#pragma unroll
      for (int i = 0; i < 4; ++i) *(u32x4*)(as2 + (lrow + i * 64) * 144 + lcol * 16) = ra[i];
#pragma unroll
      for (int i = 0; i < 2; ++i) *(u32x4*)(bs2 + (lrow + i * 64) * 144 + lcol * 16) = rb[i];
    }
    __syncthreads();
  }
  epi(acc, m0 + wm * 64, n0 + wn * 64, l32, h);
}

struct EpiZ {
  u16* z;
  DI void operator()(f32x16 (&acc)[2][2], int chb, int tokb, int l32, int h) {
#pragma unroll
    for (int nt = 0; nt < 2; ++nt) { const int t = tokb + nt * 32 + l32;
#pragma unroll
      for (int mt = 0; mt < 2; ++mt)
#pragma unroll
        for (int q = 0; q < 4; ++q) {
          u32x2 v = {pack2(acc[mt][nt][q * 4], acc[mt][nt][q * 4 + 1]), pack2(acc[mt][nt][q * 4 + 2], acc[mt][nt][q * 4 + 3])};
          *(u32x2*)(z + (size_t)t * ZLD + chb + mt * 32 + q * 8 + h * 4) = v;
        }
    }
  }
};
struct EpiOut {
  float* y;
  DI void operator()(f32x16 (&acc)[2][2], int chb, int tokb, int l32, int h) {
#pragma unroll
    for (int nt = 0; nt < 2; ++nt) { const int t = tokb + nt * 32 + l32;
#pragma unroll
      for (int mt = 0; mt < 2; ++mt)
#pragma unroll
        for (int q = 0; q < 4; ++q) {
          f32x4 v = {acc[mt][nt][q * 4], acc[mt][nt][q * 4 + 1], acc[mt][nt][q * 4 + 2], acc[mt][nt][q * 4 + 3]};
          *(f32x4*)(y + (size_t)t * DM + chb + mt * 32 + q * 8 + h * 4) = v;
        }
    }
  }
};
struct EpiQ {
  u16* Q; const float* cosT; const float* sinT; const float* rs; int n0;
  DI void operator()(f32x16 (&acc)[2][2], int chb, int tokb, int l32, int h) {
    const int seg = chb >> 6, head = seg / 3, part = seg - head * 3;
#pragma unroll
    for (int nt = 0; nt < 2; ++nt) {
      const int t = tokb + nt * 32 + l32; const float r = rs[tokb - n0 + nt * 32 + l32] * QSCALE;
      u16* dst = Q + ((size_t)head * S + t) * 192;
      if (part < 2) {
#pragma unroll
        for (int mt = 0; mt < 2; ++mt)
#pragma unroll
          for (int q = 0; q < 4; ++q) {
            u32x2 v = {pack2(acc[mt][nt][q * 4] * r, acc[mt][nt][q * 4 + 1] * r), pack2(acc[mt][nt][q * 4 + 2] * r, acc[mt][nt][q * 4 + 3] * r)};
            *(u32x2*)(dst + part * 64 + mt * 32 + q * 8 + h * 4) = v;
          }
      } else {
#pragma unroll
        for (int q = 0; q < 4; ++q) {
          const int d = q * 8 + h * 4;
          const f32x4 c = *(const f32x4*)(cosT + (size_t)t * 32 + d), s = *(const f32x4*)(sinT + (size_t)t * 32 + d);
          float o1[4], o2[4];
#pragma unroll
          for (int j = 0; j < 4; ++j) { const float x1 = acc[0][nt][q * 4 + j], x2 = acc[1][nt][q * 4 + j]; o1[j] = (x1 * c[j] - x2 * s[j]) * r; o2[j] = (x2 * c[j] + x1 * s[j]) * r; }
          u32x2 v1 = {pack2(o1[0], o1[1]), pack2(o1[2], o1[3])}, v2 = {pack2(o2[0], o2[1]), pack2(o2[2], o2[3])};
          *(u32x2*)(dst + 128 + d) = v1; *(u32x2*)(dst + 160 + d) = v2;
        }
      }
    }
  }
};
DI int permpos(int k64) { const int kk = k64 & 15; return (k64 & 48) | (((kk >> 2) & 1) * 8 + (kk >> 3) * 4 + (kk & 3)); }
struct EpiKV {
  u16* K; u16* Vt; const float* rs; int n0;
  DI void operator()(f32x16 (&acc)[2][2], int chb, int tokb, int l32, int h) {
    const int seg = chb >> 6, head = seg >> 2, part = seg & 3;
#pragma unroll
    for (int nt = 0; nt < 2; ++nt) {
      const int t = tokb + nt * 32 + l32; const float r = rs[tokb - n0 + nt * 32 + l32];
      if (part < 2) {
        u16* dst = K + ((size_t)head * S + t) * 192 + part * 64;
#pragma unroll
        for (int mt = 0; mt < 2; ++mt)
#pragma unroll
          for (int q = 0; q < 4; ++q) {
            u32x2 v = {pack2(acc[mt][nt][q * 4] * r, acc[mt][nt][q * 4 + 1] * r), pack2(acc[mt][nt][q * 4 + 2] * r, acc[mt][nt][q * 4 + 3] * r)};
            *(u32x2*)(dst + mt * 32 + q * 8 + h * 4) = v;
          }
      } else {
        u16* dst = Vt + (((size_t)head * (S / 64) + (t >> 6)) * 128 + (part - 2) * 64) * 64 + permpos(t & 63);
#pragma unroll
        for (int mt = 0; mt < 2; ++mt)
#pragma unroll
          for (int i = 0; i < 16; ++i) { const int dv = mt * 32 + (i & 3) + 8 * (i >> 2) + 4 * h; dst[dv * 64] = tobf(acc[mt][nt][i] * r); }
      }
    }
  }
};

DI void row_rstd(float* rs, const u16* X, int ldx, int K) {
  const int tid = otid(), tl = tid >> 2, sub = tid & 3;
  const u16* src = X + (size_t)tl * ldx; float ss = 0.f;
  for (int c = sub; c < (K >> 3); c += 4) {
    u32x4 v = *(const u32x4*)(src + c * 8);
#pragma unroll
    for (int j = 0; j < 4; ++j) { const float a = bflo(v[j]), b = bfhi(v[j]); ss += a * a + b * b; }
  }
  ss += __shfl_xor(ss, 1); ss += __shfl_xor(ss, 2);
  if (sub == 0) rs[tl] = rsqrtf(ss / (float)K + EPS);
}

DI void krope_tile(const P& p, int n0) {
  const int tid = otid(), t = n0 + (tid >> 2), i0 = (tid & 3) * 8;
  const u16* z = (const u16*)(p.ws + WS_Z) + (size_t)t * ZLD + Z_KR;
  const float* cosT = (const float*)(p.ws + WS_COS) + (size_t)t * 32 + i0; const float* sinT = (const float*)(p.ws + WS_SIN) + (size_t)t * 32 + i0;
  u32x4 a = *(const u32x4*)(z + i0), b = *(const u32x4*)(z + 32 + i0);
  f32x4 c0 = *(const f32x4*)cosT, c1 = *(const f32x4*)(cosT + 4), s0 = *(const f32x4*)sinT, s1 = *(const f32x4*)(sinT + 4);
  float x1[8], x2[8], c[8], s[8];
#pragma unroll
  for (int j = 0; j < 4; ++j) { x1[2 * j] = bflo(a[j]); x1[2 * j + 1] = bfhi(a[j]); x2[2 * j] = bflo(b[j]); x2[2 * j + 1] = bfhi(b[j]); c[j] = c0[j]; c[4 + j] = c1[j]; s[j] = s0[j]; s[4 + j] = s1[j]; }
  u32x4 o1, o2;
#pragma unroll
  for (int j = 0; j < 4; ++j) {
    o1[j] = pack2(x1[2 * j] * c[2 * j] - x2[2 * j] * s[2 * j], x1[2 * j + 1] * c[2 * j + 1] - x2[2 * j + 1] * s[2 * j + 1]);
    o2[j] = pack2(x2[2 * j] * c[2 * j] + x1[2 * j] * s[2 * j], x2[2 * j + 1] * c[2 * j + 1] + x1[2 * j + 1] * s[2 * j + 1]);
  }
  u16* K = (u16*)(p.ws + WS_K);
#pragma unroll
  for (int hd = 0; hd < 4; ++hd) { u16* dst = K + ((size_t)hd * S + t) * 192 + 128 + i0; *(u32x4*)dst = o1; *(u32x4*)(dst + 32) = o2; }
}

DI void sgu_job(unsigned char* lds, const P& p, int layer, int nb) {
  const int tid = otid(), lane = tid & 63, wave = wave_of(tid);
  const int n0 = nb * 128;
  const u16* z = (const u16*)(p.ws + WS_Z);
  u16* vT = (u16*)lds;
  {
    const int j = tid >> 2, sub = tid & 3; const u16* src = z + (size_t)(n0 + j) * ZLD + Z_V + sub * 64;
    float v[64]; float s = 0.f;
#pragma unroll
    for (int c = 0; c < 8; ++c) { u32x4 u = *(const u32x4*)(src + c * 8);
#pragma unroll
      for (int k = 0; k < 4; ++k) { v[c * 8 + 2 * k] = bflo(u[k]); v[c * 8 + 2 * k + 1] = bfhi(u[k]); s += v[c * 8 + 2 * k] + v[c * 8 + 2 * k + 1]; } }
    s += __shfl_xor(s, 1); s += __shfl_xor(s, 2);
    const float mu = s * (1.f / 256.f); float q = 0.f;
#pragma unroll
    for (int c = 0; c < 64; ++c) { const float d = v[c] - mu; q += d * d; }
    q += __shfl_xor(q, 1); q += __shfl_xor(q, 2);
    const float rstd = rsqrtf(q * (1.f / 256.f) + EPS);
    const float* g = p.sgu_ln_g + layer * 256 + sub * 64; const float* b = p.sgu_ln_b + layer * 256 + sub * 64;
#pragma unroll
    for (int c = 0; c < 64; ++c) vT[(sub * 64 + c) * 136 + j] = tobf((v[c] - mu) * rstd * g[c] + b[c]);
  }
  __syncthreads();
  const int wm = wave & 3, wn = wave >> 2, l32 = lane & 31, h = lane >> 5;
  f32x16 acc[2][2]; acc[0][0] = zero16(); acc[0][1] = zero16(); acc[1][0] = zero16(); acc[1][1] = zero16();
  const u16* W = (const u16*)(p.ws + WS_SGUW) + (size_t)(layer * 4 + wm) * 128 * 128;
  const int kmax = wn ? 8 : 4;
#pragma unroll 1
  for (int kk = 0; kk < kmax; ++kk) {
    bf16x8 a0 = *(const bf16x8*)(vT + (wm * 64 + l32) * 136 + kk * 16 + h * 8);
    bf16x8 a1 = *(const bf16x8*)(vT + (wm * 64 + 32 + l32) * 136 + kk * 16 + h * 8);
    bf16x8 b0 = *(const bf16x8*)(W + (wn * 64 + l32) * 128 + kk * 16 + h * 8);
    bf16x8 b1 = *(const bf16x8*)(W + (wn * 64 + 32 + l32) * 128 + kk * 16 + h * 8);
    acc[0][0] = MFMA(a0, b0, acc[0][0]); acc[0][1] = MFMA(a0, b1, acc[0][1]);
    acc[1][0] = MFMA(a1, b0, acc[1][0]); acc[1][1] = MFMA(a1, b1, acc[1][1]);
  }
  u16* Y = (u16*)(p.ws + WS_HY);
#pragma unroll
  for (int nt = 0; nt < 2; ++nt) {
    const int i = wn * 64 + nt * 32 + l32, t = n0 + i; const float bias = p.sgu_b[(layer * 4 + wm) * 128 + i];
#pragma unroll
    for (int mt = 0; mt < 2; ++mt)
#pragma unroll
      for (int q = 0; q < 4; ++q) {
        const int c = wm * 64 + mt * 32 + q * 8 + h * 4;
        const u32x2 u = *(const u32x2*)(z + (size_t)t * ZLD + Z_U + c), g = *(const u32x2*)(z + (size_t)t * ZLD + Z_SG + c);
        const float o0 = bflo(u[0]) * (acc[mt][nt][q * 4] + bias) * silu(bflo(g[0])), o1 = bfhi(u[0]) * (acc[mt][nt][q * 4 + 1] + bias) * silu(bfhi(g[0]));
        const float o2 = bflo(u[1]) * (acc[mt][nt][q * 4 + 2] + bias) * silu(bflo(g[1])), o3 = bfhi(u[1]) * (acc[mt][nt][q * 4 + 3] + bias) * silu(bfhi(g[1]));
        u32x2 v = {pack2(o0, o1), pack2(o2, o3)};
        *(u32x2*)(Y + (size_t)t * DM + c) = v;
      }
  }
}

DI void pool_job(unsigned char* lds, const P& p, int layer, int nb) {
  const int tid = otid(), lane = tid & 63, wave = wave_of(tid);
  const int n0 = nb * 128;
  const u16* z = (const u16*)(p.ws + WS_Z);
  u16* pl = (u16*)lds;
  {
    const int cp = tid & 127, tq = tid >> 7, c = cp * 2, w = 2 << (cp >> 5);
    const u16* zp = z + Z_PI + c; const int t0 = n0 + tq * 32;
    float s0 = 0.f, s1 = 0.f;
    for (int s = max(t0 - w, 0); s < t0; ++s) { const unsigned u = *(const unsigned*)(zp + (size_t)s * ZLD); s0 += bflo(u); s1 += bfhi(u); }
#pragma unroll 4
    for (int tt = 0; tt < 32; ++tt) {
      const int t = t0 + tt; const unsigned u = *(const unsigned*)(zp + (size_t)t * ZLD);
      const float p0 = bflo(u), p1 = bfhi(u); s0 += p0; s1 += p1;
      if (t - w >= 0) { const unsigned u2 = *(const unsigned*)(zp + (size_t)(t - w) * ZLD); s0 -= bflo(u2); s1 -= bfhi(u2); }
      const float inv = 1.f / (float)min(t + 1, w);
      *(unsigned*)(pl + (tq * 32 + tt) * 264 + c) = pack2(s0 * inv - p0, s1 * inv - p1);
    }
  }
  __syncthreads();
  const int wm = wave & 3, wn = wave >> 2, l32 = lane & 31, h = lane >> 5;
  f32x16 acc[2][2]; acc[0][0] = zero16(); acc[0][1] = zero16(); acc[1][0] = zero16(); acc[1][1] = zero16();
  const u16* W = (const u16*)(p.ws + WS_PWT) + (size_t)(layer * 4 + wm) * 64 * 64;
#pragma unroll
  for (int kk = 0; kk < 4; ++kk) {
    bf16x8 a0 = *(const bf16x8*)(W + (l32) * 64 + kk * 16 + h * 8);
    bf16x8 a1 = *(const bf16x8*)(W + (32 + l32) * 64 + kk * 16 + h * 8);
    bf16x8 b0 = *(const bf16x8*)(pl + (wn * 64 + l32) * 264 + wm * 64 + kk * 16 + h * 8);
    bf16x8 b1 = *(const bf16x8*)(pl + (wn * 64 + 32 + l32) * 264 + wm * 64 + kk * 16 + h * 8);
    acc[0][0] = MFMA(a0, b0, acc[0][0]); acc[0][1] = MFMA(a0, b1, acc[0][1]);
    acc[1][0] = MFMA(a1, b0, acc[1][0]); acc[1][1] = MFMA(a1, b1, acc[1][1]);
  }
  u16* Y = (u16*)(p.ws + WS_HY);
#pragma unroll
  for (int nt = 0; nt < 2; ++nt) {
    const int t = n0 + wn * 64 + nt * 32 + l32;
#pragma unroll
    for (int mt = 0; mt < 2; ++mt)
#pragma unroll
      for (int q = 0; q < 4; ++q) {
        const int c = wm * 64 + mt * 32 + q * 8 + h * 4;
        const f32x4 sc = *(const f32x4*)(p.pool_scale + layer * 256 + c);
        const u32x2 g = *(const u32x2*)(z + (size_t)t * ZLD + Z_PG + c);
        const float o0 = acc[mt][nt][q * 4] * sc[0] * silu(bflo(g[0])), o1 = acc[mt][nt][q * 4 + 1] * sc[1] * silu(bfhi(g[0]));
        const float o2 = acc[mt][nt][q * 4 + 2] * sc[2] * silu(bflo(g[1])), o3 = acc[mt][nt][q * 4 + 3] * sc[3] * silu(bfhi(g[1]));
        u32x2 v = {pack2(o0, o1), pack2(o2, o3)};
        *(u32x2*)(Y + (size_t)t * DM + 256 + c) = v;
      }
  }
}

DI void attn_item(unsigned char* lds, const P& p, int hd, int qb) {
  const int tid = otid(), lane = tid & 63, wave = wave_of(tid);
  const int wq = wave & 3, wk = wave >> 2, l32 = lane & 31, h = lane >> 5;
  const u16* Qg = (const u16*)(p.ws + WS_Q) + ((size_t)hd * S + qb * 128 + wq * 32 + l32) * 192 + h * 8;
  bf16x8 qf[12];
#pragma unroll
  for (int ks = 0; ks < 12; ++ks) qf[ks] = *(const bf16x8*)(Qg + ks * 16);
  const int ntile = 2 * qb + 2, mychunk = 2 * qb + (wq >> 1);
  const u16* Kg = (const u16*)(p.ws + WS_K) + (size_t)hd * S * 192 + tid * 8;
  const u16* Vg = (const u16*)(p.ws + WS_VT) + (size_t)hd * S * 128 + tid * 8;
  int kdst[3], vdst[2];
#pragma unroll
  for (int i = 0; i < 3; ++i) { const int c = tid + i * NT; kdst[i] = (c / 24) * 400 + (c % 24) * 16; }
#pragma unroll
  for (int i = 0; i < 2; ++i) { const int c = tid + i * NT; vdst[i] = 64 * 400 + (c >> 3) * 144 + (c & 7) * 16; }
  f32x16 O[4]; O[0] = zero16(); O[1] = zero16(); O[2] = zero16(); O[3] = zero16();
  float m = -1e30f, l = 0.f;
  u32x4 rk[3], rv[2];
#pragma unroll
  for (int i = 0; i < 3; ++i) rk[i] = *(const u32x4*)(Kg + i * NT * 8);
#pragma unroll
  for (int i = 0; i < 2; ++i) rv[i] = *(const u32x4*)(Vg + i * NT * 8);
#pragma unroll
  for (int i = 0; i < 3; ++i) *(u32x4*)(lds + kdst[i]) = rk[i];
#pragma unroll
  for (int i = 0; i < 2; ++i) *(u32x4*)(lds + vdst[i]) = rv[i];
  __syncthreads();
#pragma unroll 1
  for (int kt = 0; kt < ntile; ++kt) {
    const bool more = kt + 1 < ntile;
    if (more) {
#pragma unroll
      for (int i = 0; i < 3; ++i) rk[i] = *(const u32x4*)(Kg + (size_t)(kt + 1) * 64 * 192 + i * NT * 8);
#pragma unroll
      for (int i = 0; i < 2; ++i) rv[i] = *(const u32x4*)(Vg + (size_t)(kt + 1) * 128 * 64 + i * NT * 8);
    }
    if (kt <= mychunk) {
      const unsigned char* ks_ = lds + (kt & 1) * ATT_STAGE; const unsigned char* vs_ = ks_ + 64 * 400;
      f32x16 s = zero16();
#pragma unroll
      for (int ks = 0; ks < 12; ++ks) { bf16x8 kf = *(const bf16x8*)(ks_ + (wk * 32 + l32) * 400 + ks * 32 + h * 16); s = MFMA(kf, qf[ks], s); }
      float mx = s[0];
#pragma unroll
      for (int i = 1; i < 16; ++i) mx = fmaxf(mx, s[i]);
      mx = fmaxf(mx, __shfl_xor(mx, 32));
      const float mn = fmaxf(m, mx), alpha = ex2(m - mn); m = mn;
      float ps = 0.f;
#pragma unroll
      for (int i = 0; i < 16; ++i) { s[i] = ex2(s[i] - mn); ps += s[i]; }
      l = l * alpha + ps;
#pragma unroll
      for (int mt = 0; mt < 4; ++mt)
#pragma unroll
        for (int i = 0; i < 16; ++i) O[mt][i] *= alpha;
      u32x4 p0 = {pack2(s[0], s[1]), pack2(s[2], s[3]), pack2(s[4], s[5]), pack2(s[6], s[7])};
      u32x4 p1 = {pack2(s[8], s[9]), pack2(s[10], s[11]), pack2(s[12], s[13]), pack2(s[14], s[15])};
      const bf16x8 pf0 = __builtin_bit_cast(bf16x8, p0), pf1 = __builtin_bit_cast(bf16x8, p1);
#pragma unroll
      for (int mt = 0; mt < 4; ++mt) {
        bf16x8 v0 = *(const bf16x8*)(vs_ + (mt * 32 + l32) * 144 + (wk * 32 + h * 8) * 2);
        bf16x8 v1 = *(const bf16x8*)(vs_ + (mt * 32 + l32) * 144 + (wk * 32 + 16 + h * 8) * 2);
        O[mt] = MFMA(v0, pf0, O[mt]); O[mt] = MFMA(v1, pf1, O[mt]);
      }
    }
    if (more) {
      unsigned char* st = lds + ((kt + 1) & 1) * ATT_STAGE;
#pragma unroll
      for (int i = 0; i < 3; ++i) *(u32x4*)(st + kdst[i]) = rk[i];
#pragma unroll
      for (int i = 0; i < 2; ++i) *(u32x4*)(st + vdst[i]) = rv[i];
    }
    __syncthreads();
  }
  const float lt = l + __shfl_xor(l, 32);
  float* cO = (float*)lds; float* cm = (float*)(lds + 65536);
  if (wk == 1) {
#pragma unroll
    for (int mt = 0; mt < 4; ++mt)
#pragma unroll
      for (int i = 0; i < 16; ++i) cO[(wq * 64 + mt * 16 + i) * 64 + lane] = O[mt][i];
    cm[wq * 64 + lane] = m; cm[256 + wq * 64 + lane] = lt;
  }
  __syncthreads();
  if (wk == 0) {
    const float m1 = cm[wq * 64 + lane], l1 = cm[256 + wq * 64 + lane];
    const float mm = fmaxf(m, m1); float a0 = ex2(m - mm), a1 = ex2(m1 - mm);
    const float inv = 1.f / (lt * a0 + l1 * a1); a0 *= inv; a1 *= inv;
    const int t = qb * 128 + wq * 32 + l32;
    const u16* zg = (const u16*)(p.ws + WS_Z) + (size_t)t * ZLD + Z_MG + hd * 128;
    u16* Y = (u16*)(p.ws + WS_HY) + (size_t)t * DM + 512 + hd * 128;
#pragma unroll
    for (int mt = 0; mt < 4; ++mt)
#pragma unroll
      for (int q = 0; q < 4; ++q) {
        const int dv = mt * 32 + q * 8 + h * 4;
        const u32x2 g = *(const u32x2*)(zg + dv);
        float o[4];
#pragma unroll
        for (int j = 0; j < 4; ++j) o[j] = O[mt][q * 4 + j] * a0 + cO[(wq * 64 + mt * 16 + q * 4 + j) * 64 + lane] * a1;
        u32x2 v = {pack2(o[0] * silu(bflo(g[0])), o[1] * silu(bfhi(g[0]))), pack2(o[2] * silu(bflo(g[1])), o[3] * silu(bfhi(g[1])))};
        *(u32x2*)(Y + dv) = v;
      }
  }
  __syncthreads();
}

DI void transpose_tile(unsigned char* lds, const float* __restrict__ src, int ldsrc, u16* __restrict__ dst, int ldd, int k0, int n0, int nvalid, const float* gain) {
  float* tile = (float*)lds;
  const int tid = otid();
#pragma unroll
  for (int i = 0; i < 8; ++i) { const int idx = tid + i * NT, r = idx >> 6, cc = idx & 63, n = n0 + cc;
    float v = (n < nvalid) ? src[(size_t)(k0 + r) * ldsrc + n] : 0.f; if (gain) v *= gain[k0 + r]; tile[r * 65 + cc] = v; }
  __syncthreads();
#pragma unroll
  for (int i = 0; i < 8; ++i) { const int idx = tid + i * NT, r = idx >> 6, cc = idx & 63; dst[(size_t)(n0 + r) * ldd + k0 + cc] = tobf(tile[cc * 65 + r]); }
  __syncthreads();
}
DI float wave_sum(float v) { v += __shfl_xor(v, 32); v += __shfl_xor(v, 16); v += __shfl_xor(v, 8); v += __shfl_xor(v, 4); v += __shfl_xor(v, 2); v += __shfl_xor(v, 1); return v; }
DI void prenorm_row(const f32x4 (&v)[4], const float* g, u16* hrow, int lane) {
  float ss = 0.f;
#pragma unroll
  for (int i = 0; i < 4; ++i) ss += v[i][0] * v[i][0] + v[i][1] * v[i][1] + v[i][2] * v[i][2] + v[i][3] * v[i][3];
  ss = wave_sum(ss);
  const float r = rsqrtf(ss * (1.f / 1024.f) + EPS);
#pragma unroll
  for (int i = 0; i < 4; ++i) { const f32x4 gg = *(const f32x4*)(g + (lane + 64 * i) * 4);
    u32x2 o = {pack2(v[i][0] * r * gg[0], v[i][1] * r * gg[1]), pack2(v[i][2] * r * gg[2], v[i][3] * r * gg[3])};
    *(u32x2*)(hrow + (lane + 64 * i) * 4) = o; }
}

DI void phase_prep(unsigned char* lds, const P& p) {
  const int nb = gridDim.x, bid = blockIdx.x, tid = otid();
  u16* win = (u16*)(p.ws + WS_WIN); u16* wuq = (u16*)(p.ws + WS_WUQ); u16* wukv = (u16*)(p.ws + WS_WUKV); u16* wout = (u16*)(p.ws + WS_WOUT);
  for (int job = bid; job < 2 * 1032; job += nb) {
    const int layer = job / 1032; int r = job - layer * 1032;
    if (r < 640) { const int kt = r / 40, nt = r - kt * 40; transpose_tile(lds, p.w_in + (size_t)layer * 1024 * DIN, DIN, win + (size_t)layer * 2560 * 1024, 1024, kt * 64, nt * 64, DIN, nullptr); }
    else if (r < 712) { r -= 640; const int kt = r / 12, nt = r - kt * 12; transpose_tile(lds, p.w_uq + (size_t)layer * 384 * 768, 768, wuq + (size_t)layer * 768 * 384, 384, kt * 64, nt * 64, 768, p.q_norm_g + layer * 384); }
    else if (r < 776) { r -= 712; const int kt = r / 16, nt = r - kt * 16; transpose_tile(lds, p.w_ukv + (size_t)layer * 256 * 1024, 1024, wukv + (size_t)layer * 1024 * 256, 256, kt * 64, nt * 64, 1024, p.kv_norm_g + layer * 256); }
    else { r -= 776; const int kt = r / 16, nt = r - kt * 16; transpose_tile(lds, p.w_out + (size_t)layer * 1024 * 1024, 1024, wout + (size_t)layer * 1024 * 1024, 1024, kt * 64, nt * 64, 1024, nullptr); }
  }
  const int gtid = bid * NT + tid, gn = nb * NT;
  u16* sguw = (u16*)(p.ws + WS_SGUW);
  for (int idx = gtid; idx < 2 * 4 * 128 * 128; idx += gn) { const int i = (idx >> 7) & 127, j = idx & 127; sguw[idx] = ((j >> 6) <= (i >> 6)) ? tobf(p.sgu_w[idx]) : (u16)0; }
  u16* pwt = (u16*)(p.ws + WS_PWT);
  for (int idx = gtid; idx < 2 * 4 * 64 * 64; idx += gn) { const int lg = idx >> 12, d = (idx >> 6) & 63, c = idx & 63; pwt[idx] = tobf(p.pool_w[(lg * 64 + c) * 64 + d]); }
  float* cosT = (float*)(p.ws + WS_COS); float* sinT = (float*)(p.ws + WS_SIN);
  for (int idx = gtid; idx < S * 32; idx += gn) {
    const int t = idx >> 5, i = idx & 31; const float angf = (float)p.pos[t] * p.invfreq[i];
    const double a = (double)angf; const double k = rint(a * 0.15915494309189535); const double r = a - k * 6.283185307179586; const double r2 = r * r;
    double ts = r, ss = r, tc = 1.0, sc = 1.0;
#pragma unroll
    for (int n = 1; n <= 13; ++n) { ts *= -r2 * (1.0 / (double)((2 * n) * (2 * n + 1))); ss += ts; tc *= -r2 * (1.0 / (double)((2 * n - 1) * (2 * n))); sc += tc; }
    cosT[idx] = (float)sc; sinT[idx] = (float)ss;
  }
  u16* hb = (u16*)(p.ws + WS_HY);
  const int lane = tid & 63, wave = wave_of(tid);
  for (int row = bid * 8 + wave; row < S; row += nb * 8) {
    f32x4 v[4];
#pragma unroll
    for (int i = 0; i < 4; ++i) v[i] = *(const f32x4*)(p.x + (size_t)row * DM + (lane + 64 * i) * 4);
    prenorm_row(v, p.pre_g, hb + (size_t)row * DM, lane);
  }
}

DI void phase_post(const P& p, int layer) {
  const int nb = gridDim.x, bid = blockIdx.x, tid = otid(), lane = tid & 63, wave = wave_of(tid);
  const float* yout = (const float*)(p.ws + WS_Z); const float* xold = layer == 0 ? p.x : p.out;
  u16* hb = (u16*)(p.ws + WS_HY);
  for (int row = bid * 8 + wave; row < S; row += nb * 8) {
    f32x4 y[4]; float ss = 0.f;
#pragma unroll
    for (int i = 0; i < 4; ++i) { y[i] = *(const f32x4*)(yout + (size_t)row * DM + (lane + 64 * i) * 4); ss += y[i][0] * y[i][0] + y[i][1] * y[i][1] + y[i][2] * y[i][2] + y[i][3] * y[i][3]; }
    ss = wave_sum(ss);
    const float r = rsqrtf(ss * (1.f / 1024.f) + EPS);
#pragma unroll
    for (int i = 0; i < 4; ++i) {
      const f32x4 g = *(const f32x4*)(p.post_g + layer * DM + (lane + 64 * i) * 4); const f32x4 xo = *(const f32x4*)(xold + (size_t)row * DM + (lane + 64 * i) * 4);
      y[i] = xo + y[i] * r * g;
      *(f32x4*)(p.out + (size_t)row * DM + (lane + 64 * i) * 4) = y[i];
    }
    if (layer + 1 < DEPTH) prenorm_row(y, p.pre_g + (layer + 1) * DM, hb + (size_t)row * DM, lane);
  }
}

__global__ void __launch_bounds__(NT) mega(P p) {
  extern __shared__ __attribute__((aligned(16))) unsigned char lds[];
  cg::grid_group grid = cg::this_grid();
  const int nb = gridDim.x, bid = blockIdx.x;
  if (threadIdx.x < 4) ((unsigned*)(lds + XB_LDS_OFF))[threadIdx.x] = 0u;
  __syncthreads();
  XcdBarrier xbar = xcd_barrier_post((unsigned*)(p.ws + WS_BAR), (volatile LAS unsigned*)(lds + XB_LDS_OFF));
  int ph = 0;
#define RUN(ph_) ((ph_) >= p.ph_lo && (ph_) < p.ph_hi)
#define SEAM(ph_) do { if (RUN(ph_) && RUN((ph_) + 1)) { if (p.ph_hi < 0) grid.sync(); else xcd_barrier(xbar); } } while (0)
  for (int rep = 0; rep < (DUP == 5 ? 2 : 1); ++rep)
  if (RUN(ph)) phase_prep(lds, p);
  SEAM(ph); ++ph;
#pragma unroll 1
  for (int layer = 0; layer < DEPTH; ++layer) {
    u16* hy = (u16*)(p.ws + WS_HY); u16* z = (u16*)(p.ws + WS_Z);
    float* rs = (float*)(lds + RS_OFF);
    for (int rep = 0; rep < (DUP == 1 ? 2 : 1); ++rep)
    if (RUN(ph)) {
      const u16* W = (const u16*)(p.ws + WS_WIN) + (size_t)layer * 2560 * 1024;
      EpiZ e{z};
      for (int job = bid; job < 1280; job += nb) { const int nt = job / 10, mt = job - nt * 10;
        gemm_tile(lds, W + (size_t)mt * 256 * 1024, hy + (size_t)nt * 128 * 1024, 1024, 1024, mt * 256, nt * 128, e); }
    }
    SEAM(ph); ++ph;
    for (int rep = 0; rep < (DUP == 2 ? 2 : 1); ++rep)
    if (RUN(ph)) {
      const float* cosT = (const float*)(p.ws + WS_COS); const float* sinT = (const float*)(p.ws + WS_SIN);
      for (int job = bid; job < 1152; job += nb) {
        __syncthreads();
        if (job < 384) { const int nt = job / 3, mt = job - nt * 3, n0 = nt * 128;
          const u16* X = z + (size_t)n0 * ZLD + Z_CQ; row_rstd(rs, X, ZLD, 384);
          EpiQ e{(u16*)(p.ws + WS_Q), cosT, sinT, rs, n0};
          gemm_tile(lds, (const u16*)(p.ws + WS_WUQ) + (size_t)layer * 768 * 384 + (size_t)mt * 256 * 384, X, ZLD, 384, mt * 256, n0, e);
        } else if (job < 896) { const int j2 = job - 384, nt = j2 >> 2, mt = j2 & 3, n0 = nt * 128;
          const u16* X = z + (size_t)n0 * ZLD + Z_CKV; row_rstd(rs, X, ZLD, 256);
          EpiKV e{(u16*)(p.ws + WS_K), (u16*)(p.ws + WS_VT), rs, n0};
          gemm_tile(lds, (const u16*)(p.ws + WS_WUKV) + (size_t)layer * 1024 * 256 + (size_t)mt * 256 * 256, X, ZLD, 256, mt * 256, n0, e);
          if (mt == 0) krope_tile(p, n0);
        } else if (job < 1024) sgu_job(lds, p, layer, job - 896);
        else pool_job(lds, p, layer, job - 1024);
      }
    }
    SEAM(ph); ++ph;
    for (int rep = 0; rep < (DUP == 3 ? 2 : 1); ++rep)
    if (RUN(ph)) {
      for (int it = bid; it < 256; it += nb) {
        const int hd = (it & 7) >> 1, pr = (it >> 3) * 2 + (it & 1);
        attn_item(lds, p, hd, 127 - pr);
        attn_item(lds, p, hd, pr);
      }
    }
    SEAM(ph); ++ph;
    for (int rep = 0; rep < (DUP == 4 ? 2 : 1); ++rep)
    if (RUN(ph)) {
      const u16* W = (const u16*)(p.ws + WS_WOUT) + (size_t)layer * 1024 * 1024;
      EpiOut e{(float*)(p.ws + WS_Z)};
      for (int job = bid; job < 512; job += nb) { const int nt = job >> 2, mt = job & 3;
        gemm_tile(lds, W + (size_t)mt * 256 * 1024, hy + (size_t)nt * 128 * 1024, 1024, 1024, mt * 256, nt * 128, e); }
    }
    SEAM(ph); ++ph;
    for (int rep = 0; rep < ((DUP == 6 && layer == 0) ? 2 : 1); ++rep)
    if (RUN(ph)) phase_post(p, layer);
    SEAM(ph); ++ph;
  }
  if (p.ph_hi - p.ph_lo > 1) xcd_barrier(xbar);
}
constexpr int NPHASE = 1 + 5 * DEPTH;

extern "C" void kernel_launch(void* const* d_in, const int* in_sizes, int n_in, void* d_out, int out_size, void* d_ws, size_t ws_size, hipStream_t stream) {
  static int grid_blocks = 0;
  if (!grid_blocks) {
    int dev = 0, cus = 0, per_cu = 0;
    hipGetDevice(&dev);
    hipDeviceGetAttribute(&cus, hipDeviceAttributeMultiprocessorCount, dev);
    hipFuncSetAttribute((const void*)mega, hipFuncAttributeMaxDynamicSharedMemorySize, LDS_BYTES);
    hipOccupancyMaxActiveBlocksPerMultiprocessor(&per_cu, (const void*)mega, NT, LDS_BYTES);
    if (per_cu < 1) { fprintf(stderr, "occupancy query returned %d\n", per_cu); per_cu = 1; }
    if (per_cu > 1) per_cu = 1;
    grid_blocks = cus * per_cu;
    if (ws_size < WS_END) fprintf(stderr, "workspace too small: %zu < %zu\n", ws_size, (size_t)WS_END);
  }
  P p{};
  p.x = (const float*)d_in[0]; p.pos = (const int*)d_in[1]; p.pre_g = (const float*)d_in[2]; p.post_g = (const float*)d_in[3];
  p.w_in = (const float*)d_in[4]; p.sgu_w = (const float*)d_in[5]; p.sgu_b = (const float*)d_in[6]; p.sgu_ln_g = (const float*)d_in[7];
  p.sgu_ln_b = (const float*)d_in[8]; p.pool_w = (const float*)d_in[9]; p.pool_scale = (const float*)d_in[10]; p.q_norm_g = (const float*)d_in[11];
  p.w_uq = (const float*)d_in[12]; p.kv_norm_g = (const float*)d_in[13]; p.w_ukv = (const float*)d_in[14]; p.w_out = (const float*)d_in[15];
  p.out = (float*)d_out; p.ws = (unsigned char*)d_ws;
  for (int i = 0; i < 32; ++i) p.invfreq[i] = powf(10000.0f, -(float)(2 * i) / 64.0f);
  hipMemsetAsync((char*)d_ws + WS_BAR, 0, 16384, stream);
#if COOP
  p.ph_lo = 0; p.ph_hi = NPHASE;
  void* args[] = {&p};
  hipError_t e = hipLaunchCooperativeKernel((void*)mega, dim3(grid_blocks), dim3(NT), args, LDS_BYTES, stream);
  if (e != hipSuccess) fprintf(stderr, "cooperative launch failed: %s (grid %d)\n", hipGetErrorString(e), grid_blocks);
#else
  for (int ph = 0; ph < NPHASE; ++ph) { p.ph_lo = ph; p.ph_hi = ph + 1; hipLaunchKernelGGL(mega, dim3(grid_blocks), dim3(NT), LDS_BYTES, stream, p); }
#endif
}
```

```cpp
#include <hip/hip_runtime.h>
#include <hip/hip_cooperative_groups.h>
#include <cstdio>
#include <cmath>
namespace cg = cooperative_groups;

#define DI __device__ __forceinline__
typedef unsigned short u16;
using bf16x8 = __attribute__((ext_vector_type(8))) short;
using f32x16 = __attribute__((ext_vector_type(16))) float;
using f32x4  = __attribute__((ext_vector_type(4))) float;
using f32x2  = __attribute__((ext_vector_type(2))) float;
using u32x4  = __attribute__((ext_vector_type(4))) unsigned;
using u32x2  = __attribute__((ext_vector_type(2))) unsigned;
typedef __bf16 bf2_t __attribute__((ext_vector_type(2)));
#define MFMA(a, b, c) __builtin_amdgcn_mfma_f32_32x32x16_bf16((a), (b), (c), 0, 0, 0)

#ifndef COOP
#define COOP 1
#endif
#ifndef DUP
#define DUP 7
#endif

constexpr int S = 16384, DM = 1024, DIN = 2496, ZLD = 2560, NT = 512, DEPTH = 2;
constexpr float EPS = 1e-6f;
constexpr float QSCALE = 0.07216878364870322f * 1.4426950408889634f;
constexpr int Z_U = 0, Z_V = 256, Z_SG = 512, Z_PI = 768, Z_PG = 1024, Z_CQ = 1280, Z_CKV = 1664, Z_KR = 1920, Z_MG = 1984;

constexpr size_t WS_HY   = 0;
constexpr size_t WS_Z    = WS_HY + (size_t)S * 1024 * 2;
constexpr size_t WS_Q    = WS_Z + (size_t)S * ZLD * 2;
constexpr size_t WS_K    = WS_Q + (size_t)4 * S * 192 * 2;
constexpr size_t WS_VT   = WS_K + (size_t)4 * S * 192 * 2;
constexpr size_t WS_WIN  = WS_VT + (size_t)4 * S * 128 * 2;
constexpr size_t WS_WUQ  = WS_WIN + (size_t)2 * 2560 * 1024 * 2;
constexpr size_t WS_WUKV = WS_WUQ + (size_t)2 * 768 * 384 * 2;
constexpr size_t WS_WOUT = WS_WUKV + (size_t)2 * 1024 * 256 * 2;
constexpr size_t WS_SGUW = WS_WOUT + (size_t)2 * 1024 * 1024 * 2;
constexpr size_t WS_PWT  = WS_SGUW + (size_t)2 * 4 * 128 * 128 * 2;
constexpr size_t WS_COS  = WS_PWT + (size_t)2 * 4 * 64 * 64 * 2;
constexpr size_t WS_SIN  = WS_COS + (size_t)S * 32 * 4;
constexpr size_t WS_BAR  = WS_SIN + (size_t)S * 32 * 4;
constexpr size_t WS_END  = WS_BAR + 16384;

constexpr int GEMM_STAGE = 256 * 144 + 128 * 144;
constexpr int RS_OFF = 3 * (64 * 400 + 128 * 144);
constexpr int XB_LDS_OFF = RS_OFF + 512;
constexpr int LDS_BYTES = XB_LDS_OFF + 16;
constexpr int ATT_STAGE = 64 * 400 + 128 * 144;

struct P {
  const float* x; const int* pos; const float* pre_g; const float* post_g; const float* w_in; const float* sgu_w; const float* sgu_b;
  const float* sgu_ln_g; const float* sgu_ln_b; const float* pool_w; const float* pool_scale; const float* q_norm_g; const float* w_uq;
  const float* kv_norm_g; const float* w_ukv; const float* w_out;
  float* out; unsigned char* ws;
  float invfreq[32];
  int ph_lo, ph_hi;
};

DI int otid() { int t = threadIdx.x; asm volatile("" : "+v"(t)); return t; }
DI int wave_of(int tid) { return __builtin_amdgcn_readfirstlane(tid >> 6); }
DI void lds_barrier() { asm volatile("s_waitcnt lgkmcnt(0)" ::: "memory"); __builtin_amdgcn_s_barrier(); asm volatile("" ::: "memory"); }
DI unsigned pack2(float a, float b) { f32x2 v = {a, b}; return __builtin_bit_cast(unsigned, __builtin_convertvector(v, bf2_t)); }
DI u16 tobf(float a) { return (u16)(pack2(a, 0.f) & 0xffffu); }
DI float bflo(unsigned u) { return __uint_as_float(u << 16); }
DI float bfhi(unsigned u) { return __uint_as_float(u & 0xffff0000u); }
DI float silu(float x) { return x / (1.f + __expf(-x)); }
DI float ex2(float x) { return __builtin_amdgcn_exp2f(x); }
DI f32x16 zero16() { f32x16 z; for (int i = 0; i < 16; ++i) z[i] = 0.f; return z; }

#define XB_TMO      128
#define XB_XCNT(j)  (256  + 64 * (j))
#define XB_XSUB(j)  (1280 + 64 * (j))
#define XB_XGEN(j)  (2304 + 64 * (j))
#define XB_TOP      3328
#define XB_TOPGEN   3392
#define XCD_BAR_WORDS 3456
#define XB_SPIN_CAP (1u << 18)
#define LAS __attribute__((address_space(3)))

__device__ __forceinline__ unsigned xb_ld(unsigned* p)              { return __hip_atomic_load(p, __ATOMIC_RELAXED, __HIP_MEMORY_SCOPE_AGENT); }
__device__ __forceinline__ unsigned xb_add(unsigned* p, unsigned v) { return __hip_atomic_fetch_add(p, v, __ATOMIC_RELAXED, __HIP_MEMORY_SCOPE_AGENT); }
__device__ __forceinline__ unsigned xb_xcc_id() { return (unsigned)__builtin_amdgcn_s_getreg((3 << 11) | 20) & 0xFu; }
#define XB_SPIN(cond, bar) do { unsigned _sp = 0; while (cond) { __builtin_amdgcn_s_sleep(1); \
    if ((++_sp & 255u) == 0u) { if (xb_ld(&(bar)[XB_TMO])) break; if (_sp > XB_SPIN_CAP) { atomicAdd(&(bar)[XB_TMO], 1u); break; } } } } while (0)

struct XcdBarrier {
    unsigned* bar; unsigned x;
    volatile LAS unsigned* st;
};

__device__ __forceinline__ XcdBarrier xcd_barrier_post(unsigned* bar, volatile LAS unsigned* st) {
    XcdBarrier b; b.bar = bar; b.x = xb_xcc_id(); b.st = st;
    if (threadIdx.x == 0) (void)xb_add(&bar[XB_XCNT(b.x)], 1u);
    return b;
}
__device__ __forceinline__ void xcd_barrier_complete(unsigned* bar, unsigned x, unsigned& nloc, unsigned& nx) {
    const unsigned G = gridDim.x * gridDim.y * gridDim.z;
    unsigned sum, cnt, mine, sp = 0u;
    for (;;) {
        sum = 0u; cnt = 0u; mine = 0u;
#pragma unroll
        for (unsigned j = 0; j < 16; ++j) { const unsigned c = xb_ld(&bar[XB_XCNT(j)]); sum += c; cnt += (c > 0u) ? 1u : 0u; mine = (j == x) ? c : mine; }
        if (sum == G) break;
        __builtin_amdgcn_s_sleep(1);
        if ((++sp & 255u) == 0u) { if (xb_ld(&bar[XB_TMO])) break; if (sp > XB_SPIN_CAP) { atomicAdd(&bar[XB_TMO], 1u); break; } }
    }
    nloc = mine > 0u ? mine : 1u; nx = cnt > 0u ? cnt : 1u;
}

__device__ __forceinline__ void xcd_barrier(const XcdBarrier& b) {
    asm volatile("s_waitcnt vmcnt(0)" ::: "memory");
    __syncthreads();
    if (threadIdx.x == 0) {
        unsigned* bar = b.bar;
        __builtin_amdgcn_s_waitcnt(0);
        unsigned nloc = b.st[0], nx = b.st[1];
        if (nloc == 0u) { xcd_barrier_complete(bar, b.x, nloc, nx); b.st[0] = nloc; b.st[1] = nx; }
        const unsigned old = xb_add(&bar[XB_XSUB(b.x)], 1u);
        const unsigned gen = old / nloc;
        if (old + 1u == (gen + 1u) * nloc) {
            __builtin_amdgcn_fence(__ATOMIC_RELEASE, "agent");
            asm volatile("s_waitcnt vmcnt(0)" ::: "memory");
            const unsigned og = xb_add(&bar[XB_TOP], 1u);
            const unsigned tg = og / nx;
            if (og + 1u == (tg + 1u) * nx) xb_add(&bar[XB_TOPGEN], 1u);
            else XB_SPIN(xb_ld(&bar[XB_TOPGEN]) == tg, bar);
            __builtin_amdgcn_fence(__ATOMIC_ACQUIRE, "agent");
            xb_add(&bar[XB_XGEN(b.x)], 1u);
            asm volatile("s_waitcnt vmcnt(0)" ::: "memory");
        } else {
            XB_SPIN(xb_ld(&bar[XB_XGEN(b.x)]) == gen, bar);
            __builtin_amdgcn_fence(__ATOMIC_ACQUIRE, "agent");
            asm volatile("s_waitcnt vmcnt(0)" ::: "memory");
        }
    }
    __syncthreads();
}


template <class Epi>
DI void gemm_tile(unsigned char* lds, const u16* __restrict__ A, const u16* __restrict__ X, int ldx, int K, int m0, int n0, Epi& epi) {
  const int tid = otid(), lane = tid & 63, wave = wave_of(tid);
  const int wm = wave & 3, wn = wave >> 2, l32 = lane & 31, h = lane >> 5;
  f32x16 acc[2][2];
  acc[0][0] = zero16(); acc[0][1] = zero16(); acc[1][0] = zero16(); acc[1][1] = zero16();
  const int nk = K >> 6;
  const int lrow = tid >> 3, lcol = tid & 7;
  const u16* ga = A + (size_t)lrow * K + lcol * 8;
  const u16* gx = X + (size_t)lrow * ldx + lcol * 8;
  u32x4 raA[4], rbA[2], raB[4], rbB[2];
#define G_GLOAD(RA, RB, KS) do { _Pragma("unroll") for (int i = 0; i < 4; ++i) RA[i] = *(const u32x4*)(ga + (size_t)i * 64 * K + (KS) * 64); \
                                 _Pragma("unroll") for (int i = 0; i < 2; ++i) RB[i] = *(const u32x4*)(gx + (size_t)i * 64 * ldx + (KS) * 64); } while (0)
#define G_LSTORE(RA, RB, ST) do { unsigned char* as_ = lds + (ST) * GEMM_STAGE; unsigned char* bs_ = as_ + 256 * 144; \
    _Pragma("unroll") for (int i = 0; i < 4; ++i) *(u32x4*)(as_ + (lrow + i * 64) * 144 + lcol * 16) = RA[i]; \
    _Pragma("unroll") for (int i = 0; i < 2; ++i) *(u32x4*)(bs_ + (lrow + i * 64) * 144 + lcol * 16) = RB[i]; } while (0)
#define G_STEP(KS, RLA, RLB, RSA, RSB) do { \
    if ((KS) + 2 < nk) G_GLOAD(RLA, RLB, (KS) + 2); \
    { const unsigned char* as = lds + ((KS) & 1) * GEMM_STAGE; const unsigned char* bs = as + 256 * 144; \
      _Pragma("unroll") for (int kk = 0; kk < 4; ++kk) { \
        bf16x8 a0 = *(const bf16x8*)(as + (wm * 64 + l32) * 144 + kk * 32 + h * 16); \
        bf16x8 a1 = *(const bf16x8*)(as + (wm * 64 + 32 + l32) * 144 + kk * 32 + h * 16); \
        bf16x8 b0 = *(const bf16x8*)(bs + (wn * 64 + l32) * 144 + kk * 32 + h * 16); \
        bf16x8 b1 = *(const bf16x8*)(bs + (wn * 64 + 32 + l32) * 144 + kk * 32 + h * 16); \
        acc[0][0] = MFMA(a0, b0, acc[0][0]); acc[0][1] = MFMA(a0, b1, acc[0][1]); \
        acc[1][0] = MFMA(a1, b0, acc[1][0]); acc[1][1] = MFMA(a1, b1, acc[1][1]); } } \
    if ((KS) + 1 < nk) G_LSTORE(RSA, RSB, ((KS) + 1) & 1); \
    __syncthreads(); } while (0)
  G_GLOAD(raA, rbA, 0);
  G_GLOAD(raB, rbB, 1);
  G_LSTORE(raA, rbA, 0);
  __syncthreads();
#pragma unroll 1
  for (int ks = 0; ks < nk; ks += 2) {
    G_STEP(ks, raA, rbA, raB, rbB);
    G_STEP(ks + 1, raB, rbB, raA, rbA);
  }
  epi(acc, m0 + wm * 64, n0 + wn * 64, l32, h);
}

struct EpiZ {
  u16* z;
  DI void operator()(f32x16 (&acc)[2][2], int chb, int tokb, int l32, int h) {
#pragma unroll
    for (int nt = 0; nt < 2; ++nt) { const int t = tokb + nt * 32 + l32;
#pragma unroll
      for (int mt = 0; mt < 2; ++mt)
#pragma unroll
        for (int q = 0; q < 4; ++q) {
          u32x2 v = {pack2(acc[mt][nt][q * 4], acc[mt][nt][q * 4 + 1]), pack2(acc[mt][nt][q * 4 + 2], acc[mt][nt][q * 4 + 3])};
          *(u32x2*)(z + (size_t)t * ZLD + chb + mt * 32 + q * 8 + h * 4) = v;
        }
    }
  }
};
struct EpiOut {
  u16* y;
  DI void operator()(f32x16 (&acc)[2][2], int chb, int tokb, int l32, int h) {
#pragma unroll
    for (int nt = 0; nt < 2; ++nt) { const int t = tokb + nt * 32 + l32;
#pragma unroll
      for (int mt = 0; mt < 2; ++mt)
#pragma unroll
        for (int q = 0; q < 4; ++q) {
          u32x2 v = {pack2(acc[mt][nt][q * 4], acc[mt][nt][q * 4 + 1]), pack2(acc[mt][nt][q * 4 + 2], acc[mt][nt][q * 4 + 3])};
          *(u32x2*)(y + (size_t)t * DM + chb + mt * 32 + q * 8 + h * 4) = v;
        }
    }
  }
};
struct EpiQ {
  u16* Q; const float* cosT; const float* sinT; const float* rs; int n0;
  DI void operator()(f32x16 (&acc)[2][2], int chb, int tokb, int l32, int h) {
    const int seg = chb >> 6, head = seg / 3, part = seg - head * 3;
#pragma unroll
    for (int nt = 0; nt < 2; ++nt) {
      const int t = tokb + nt * 32 + l32; const float r = rs[tokb - n0 + nt * 32 + l32] * QSCALE;
      u16* dst = Q + ((size_t)head * S + t) * 192;
      if (part < 2) {
#pragma unroll
        for (int mt = 0; mt < 2; ++mt)
#pragma unroll
          for (int q = 0; q < 4; ++q) {
            u32x2 v = {pack2(acc[mt][nt][q * 4] * r, acc[mt][nt][q * 4 + 1] * r), pack2(acc[mt][nt][q * 4 + 2] * r, acc[mt][nt][q * 4 + 3] * r)};
            *(u32x2*)(dst + part * 64 + mt * 32 + q * 8 + h * 4) = v;
          }
      } else {
#pragma unroll
        for (int q = 0; q < 4; ++q) {
          const int d = q * 8 + h * 4;
          const f32x4 c = *(const f32x4*)(cosT + (size_t)t * 32 + d), s = *(const f32x4*)(sinT + (size_t)t * 32 + d);
          float o1[4], o2[4];
#pragma unroll
          for (int j = 0; j < 4; ++j) { const float x1 = acc[0][nt][q * 4 + j], x2 = acc[1][nt][q * 4 + j]; o1[j] = (x1 * c[j] - x2 * s[j]) * r; o2[j] = (x2 * c[j] + x1 * s[j]) * r; }
          u32x2 v1 = {pack2(o1[0], o1[1]), pack2(o1[2], o1[3])}, v2 = {pack2(o2[0], o2[1]), pack2(o2[2], o2[3])};
          *(u32x2*)(dst + 128 + d) = v1; *(u32x2*)(dst + 160 + d) = v2;
        }
      }
    }
  }
};
DI int permpos(int k64) { const int kk = k64 & 15; return (k64 & 48) | (((kk >> 2) & 1) * 8 + (kk >> 3) * 4 + (kk & 3)); }
struct EpiKV {
  u16* K; u16* Vt; const float* rs; int n0;
  DI void operator()(f32x16 (&acc)[2][2], int chb, int tokb, int l32, int h) {
    const int seg = chb >> 6, head = seg >> 2, part = seg & 3;
#pragma unroll
    for (int nt = 0; nt < 2; ++nt) {
      const int t = tokb + nt * 32 + l32; const float r = rs[tokb - n0 + nt * 32 + l32];
      if (part < 2) {
        u16* dst = K + ((size_t)head * S + t) * 192 + part * 64;
#pragma unroll
        for (int mt = 0; mt < 2; ++mt)
#pragma unroll
          for (int q = 0; q < 4; ++q) {
            u32x2 v = {pack2(acc[mt][nt][q * 4] * r, acc[mt][nt][q * 4 + 1] * r), pack2(acc[mt][nt][q * 4 + 2] * r, acc[mt][nt][q * 4 + 3] * r)};
            *(u32x2*)(dst + mt * 32 + q * 8 + h * 4) = v;
          }
      } else {
        u16* dst = Vt + (((size_t)head * (S / 64) + (t >> 6)) * 128 + (part - 2) * 64) * 64 + permpos(t & 63);
#pragma unroll
        for (int mt = 0; mt < 2; ++mt)
#pragma unroll
          for (int i = 0; i < 16; ++i) { const int dv = mt * 32 + (i & 3) + 8 * (i >> 2) + 4 * h; dst[dv * 64] = tobf(acc[mt][nt][i] * r); }
      }
    }
  }
};

DI void row_rstd(float* rs, const u16* X, int ldx, int K) {
  const int tid = otid(), tl = tid >> 2, sub = tid & 3;
  const u16* src = X + (size_t)tl * ldx; float ss = 0.f;
  for (int c = sub; c < (K >> 3); c += 4) {
    u32x4 v = *(const u32x4*)(src + c * 8);
#pragma unroll
    for (int j = 0; j < 4; ++j) { const float a = bflo(v[j]), b = bfhi(v[j]); ss += a * a + b * b; }
  }
  ss += __shfl_xor(ss, 1); ss += __shfl_xor(ss, 2);
  if (sub == 0) rs[tl] = rsqrtf(ss / (float)K + EPS);
}

DI void krope_tile(const P& p, int n0) {
  const int tid = otid(), t = n0 + (tid >> 2), i0 = (tid & 3) * 8;
  const u16* z = (const u16*)(p.ws + WS_Z) + (size_t)t * ZLD + Z_KR;
  const float* cosT = (const float*)(p.ws + WS_COS) + (size_t)t * 32 + i0; const float* sinT = (const float*)(p.ws + WS_SIN) + (size_t)t * 32 + i0;
  u32x4 a = *(const u32x4*)(z + i0), b = *(const u32x4*)(z + 32 + i0);
  f32x4 c0 = *(const f32x4*)cosT, c1 = *(const f32x4*)(cosT + 4), s0 = *(const f32x4*)sinT, s1 = *(const f32x4*)(sinT + 4);
  float x1[8], x2[8], c[8], s[8];
#pragma unroll
  for (int j = 0; j < 4; ++j) { x1[2 * j] = bflo(a[j]); x1[2 * j + 1] = bfhi(a[j]); x2[2 * j] = bflo(b[j]); x2[2 * j + 1] = bfhi(b[j]); c[j] = c0[j]; c[4 + j] = c1[j]; s[j] = s0[j]; s[4 + j] = s1[j]; }
  u32x4 o1, o2;
#pragma unroll
  for (int j = 0; j < 4; ++j) {
    o1[j] = pack2(x1[2 * j] * c[2 * j] - x2[2 * j] * s[2 * j], x1[2 * j + 1] * c[2 * j + 1] - x2[2 * j + 1] * s[2 * j + 1]);
    o2[j] = pack2(x2[2 * j] * c[2 * j] + x1[2 * j] * s[2 * j], x2[2 * j + 1] * c[2 * j + 1] + x1[2 * j + 1] * s[2 * j + 1]);
  }
  u16* K = (u16*)(p.ws + WS_K);
#pragma unroll
  for (int hd = 0; hd < 4; ++hd) { u16* dst = K + ((size_t)hd * S + t) * 192 + 128 + i0; *(u32x4*)dst = o1; *(u32x4*)(dst + 32) = o2; }
}

DI void sgu_job(unsigned char* lds, const P& p, int layer, int nb) {
  const int tid = otid(), lane = tid & 63, wave = wave_of(tid);
  const int n0 = nb * 128;
  const u16* z = (const u16*)(p.ws + WS_Z);
  u16* vT = (u16*)lds;
  {
    const int j = tid >> 2, sub = tid & 3; const u16* src = z + (size_t)(n0 + j) * ZLD + Z_V + sub * 64;
    float v[64]; float s = 0.f;
#pragma unroll
    for (int c = 0; c < 8; ++c) { u32x4 u = *(const u32x4*)(src + c * 8);
#pragma unroll
      for (int k = 0; k < 4; ++k) { v[c * 8 + 2 * k] = bflo(u[k]); v[c * 8 + 2 * k + 1] = bfhi(u[k]); s += v[c * 8 + 2 * k] + v[c * 8 + 2 * k + 1]; } }
    s += __shfl_xor(s, 1); s += __shfl_xor(s, 2);
    const float mu = s * (1.f / 256.f); float q = 0.f;
#pragma unroll
    for (int c = 0; c < 64; ++c) { const float d = v[c] - mu; q += d * d; }
    q += __shfl_xor(q, 1); q += __shfl_xor(q, 2);
    const float rstd = rsqrtf(q * (1.f / 256.f) + EPS);
    const float* g = p.sgu_ln_g + layer * 256 + sub * 64; const float* b = p.sgu_ln_b + layer * 256 + sub * 64;
#pragma unroll
    for (int c4 = 0; c4 < 16; ++c4) { const f32x4 gg = *(const f32x4*)(g + c4 * 4), bb = *(const f32x4*)(b + c4 * 4);
#pragma unroll
      for (int k = 0; k < 4; ++k) vT[(sub * 64 + c4 * 4 + k) * 136 + j] = tobf((v[c4 * 4 + k] - mu) * rstd * gg[k] + bb[k]); }
  }
  __syncthreads();
  const int wm = wave & 3, wn = wave >> 2, l32 = lane & 31, h = lane >> 5;
  f32x16 acc[2][2]; acc[0][0] = zero16(); acc[0][1] = zero16(); acc[1][0] = zero16(); acc[1][1] = zero16();
  const u16* W = (const u16*)(p.ws + WS_SGUW) + (size_t)(layer * 4 + wm) * 128 * 128;
#pragma unroll
  for (int kk = 0; kk < 8; ++kk) {
    bf16x8 a0 = *(const bf16x8*)(vT + (wm * 64 + l32) * 136 + kk * 16 + h * 8);
    bf16x8 a1 = *(const bf16x8*)(vT + (wm * 64 + 32 + l32) * 136 + kk * 16 + h * 8);
    bf16x8 b0 = *(const bf16x8*)(W + (wn * 64 + l32) * 128 + kk * 16 + h * 8);
    bf16x8 b1 = *(const bf16x8*)(W + (wn * 64 + 32 + l32) * 128 + kk * 16 + h * 8);
    acc[0][0] = MFMA(a0, b0, acc[0][0]); acc[0][1] = MFMA(a0, b1, acc[0][1]);
    acc[1][0] = MFMA(a1, b0, acc[1][0]); acc[1][1] = MFMA(a1, b1, acc[1][1]);
  }
  u16* Y = (u16*)(p.ws + WS_HY);
#pragma unroll
  for (int nt = 0; nt < 2; ++nt) {
    const int i = wn * 64 + nt * 32 + l32, t = n0 + i; const float bias = p.sgu_b[(layer * 4 + wm) * 128 + i];
#pragma unroll
    for (int mt = 0; mt < 2; ++mt)
#pragma unroll
      for (int q = 0; q < 4; ++q) {
        const int c = wm * 64 + mt * 32 + q * 8 + h * 4;
        const u32x2 u = *(const u32x2*)(z + (size_t)t * ZLD + Z_U + c), g = *(const u32x2*)(z + (size_t)t * ZLD + Z_SG + c);
        const float o0 = bflo(u[0]) * (acc[mt][nt][q * 4] + bias) * silu(bflo(g[0])), o1 = bfhi(u[0]) * (acc[mt][nt][q * 4 + 1] + bias) * silu(bfhi(g[0]));
        const float o2 = bflo(u[1]) * (acc[mt][nt][q * 4 + 2] + bias) * silu(bflo(g[1])), o3 = bfhi(u[1]) * (acc[mt][nt][q * 4 + 3] + bias) * silu(bfhi(g[1]));
        u32x2 v = {pack2(o0, o1), pack2(o2, o3)};
        *(u32x2*)(Y + (size_t)t * DM + c) = v;
      }
  }
}

template <int W>
DI void pool_win(const u16* zp, int t0, u16* prow) {
  unsigned v[32 + W];
#pragma unroll
  for (int i = 0; i < 32 + W; ++i) { const int t = t0 - W + i; v[i] = (t >= 0) ? *(const unsigned*)(zp + (size_t)max(t, 0) * ZLD) : 0u; }
  float s0 = 0.f, s1 = 0.f;
#pragma unroll
  for (int i = 0; i < W; ++i) { s0 += bflo(v[i]); s1 += bfhi(v[i]); }
#pragma unroll
  for (int tt = 0; tt < 32; ++tt) {
    const float p0 = bflo(v[W + tt]), p1 = bfhi(v[W + tt]);
    s0 += p0 - bflo(v[tt]); s1 += p1 - bfhi(v[tt]);
    const float inv = 1.f / (float)min(t0 + tt + 1, W);
    *(unsigned*)(prow + tt * 264) = pack2(s0 * inv - p0, s1 * inv - p1);
  }
}
DI void pool_job(unsigned char* lds, const P& p, int layer, int nb) {
  const int tid = otid(), lane = tid & 63, wave = wave_of(tid);
  const int n0 = nb * 128;
  const u16* z = (const u16*)(p.ws + WS_Z);
  u16* pl = (u16*)lds;
  {
    const int g = wave & 3, c = g * 64 + (lane & 31) * 2, tq = (wave >> 2) * 2 + (lane >> 5);
    const u16* zp = z + Z_PI + c; const int t0 = n0 + tq * 32; u16* prow = pl + (tq * 32) * 264 + c;
    switch (g) { case 0: pool_win<2>(zp, t0, prow); break; case 1: pool_win<4>(zp, t0, prow); break; case 2: pool_win<8>(zp, t0, prow); break; default: pool_win<16>(zp, t0, prow); break; }
  }
  __syncthreads();
  const int wm = wave & 3, wn = wave >> 2, l32 = lane & 31, h = lane >> 5;
  f32x16 acc[2][2]; acc[0][0] = zero16(); acc[0][1] = zero16(); acc[1][0] = zero16(); acc[1][1] = zero16();
  const u16* W = (const u16*)(p.ws + WS_PWT) + (size_t)(layer * 4 + wm) * 64 * 64;
#pragma unroll
  for (int kk = 0; kk < 4; ++kk) {
    bf16x8 a0 = *(const bf16x8*)(W + (l32) * 64 + kk * 16 + h * 8);
    bf16x8 a1 = *(const bf16x8*)(W + (32 + l32) * 64 + kk * 16 + h * 8);
    bf16x8 b0 = *(const bf16x8*)(pl + (wn * 64 + l32) * 264 + wm * 64 + kk * 16 + h * 8);
    bf16x8 b1 = *(const bf16x8*)(pl + (wn * 64 + 32 + l32) * 264 + wm * 64 + kk * 16 + h * 8);
    acc[0][0] = MFMA(a0, b0, acc[0][0]); acc[0][1] = MFMA(a0, b1, acc[0][1]);
    acc[1][0] = MFMA(a1, b0, acc[1][0]); acc[1][1] = MFMA(a1, b1, acc[1][1]);
  }
  u16* Y = (u16*)(p.ws + WS_HY);
#pragma unroll
  for (int nt = 0; nt < 2; ++nt) {
    const int t = n0 + wn * 64 + nt * 32 + l32;
#pragma unroll
    for (int mt = 0; mt < 2; ++mt)
#pragma unroll
      for (int q = 0; q < 4; ++q) {
        const int c = wm * 64 + mt * 32 + q * 8 + h * 4;
        const f32x4 sc = *(const f32x4*)(p.pool_scale + layer * 256 + c);
        const u32x2 g = *(const u32x2*)(z + (size_t)t * ZLD + Z_PG + c);
        const float o0 = acc[mt][nt][q * 4] * sc[0] * silu(bflo(g[0])), o1 = acc[mt][nt][q * 4 + 1] * sc[1] * silu(bfhi(g[0]));
        const float o2 = acc[mt][nt][q * 4 + 2] * sc[2] * silu(bflo(g[1])), o3 = acc[mt][nt][q * 4 + 3] * sc[3] * silu(bfhi(g[1]));
        u32x2 v = {pack2(o0, o1), pack2(o2, o3)};
        *(u32x2*)(Y + (size_t)t * DM + 256 + c) = v;
      }
  }
}

DI void att_qk(f32x16& s, const unsigned char* krow, const bf16x8 (&qf)[12], float m) {
  bf16x8 ka[4], kb[4];
#pragma unroll
  for (int i = 0; i < 4; ++i) ka[i] = *(const bf16x8*)(krow + i * 32);
#pragma unroll
  for (int i = 0; i < 4; ++i) kb[i] = *(const bf16x8*)(krow + (4 + i) * 32);
  const float nm = -m;
#pragma unroll
  for (int i = 0; i < 16; ++i) s[i] = nm;
  __builtin_amdgcn_sched_barrier(0);
#pragma unroll
  for (int i = 0; i < 4; ++i) s = MFMA(ka[i], qf[i], s);
  __builtin_amdgcn_sched_barrier(0);
#pragma unroll
  for (int i = 0; i < 4; ++i) ka[i] = *(const bf16x8*)(krow + (8 + i) * 32);
  __builtin_amdgcn_sched_barrier(0);
#pragma unroll
  for (int i = 0; i < 4; ++i) s = MFMA(kb[i], qf[4 + i], s);
  __builtin_amdgcn_sched_barrier(0);
#pragma unroll
  for (int i = 0; i < 4; ++i) s = MFMA(ka[i], qf[8 + i], s);
  __builtin_amdgcn_sched_barrier(0);
}
DI void att_sm_pv(f32x16& s, const unsigned char* vrow, f32x16 (&O)[4], float& m, float& l, bool first) {
  bf16x8 vf[8];
#pragma unroll
  for (int mt = 0; mt < 4; ++mt) { vf[2 * mt] = *(const bf16x8*)(vrow + mt * 32 * 144); vf[2 * mt + 1] = *(const bf16x8*)(vrow + mt * 32 * 144 + 32); }
  __builtin_amdgcn_sched_barrier(0);
  float mx = fmaxf(fmaxf(s[0], s[1]), s[2]);
#pragma unroll
  for (int i = 3; i < 15; i += 2) mx = fmaxf(fmaxf(mx, s[i]), s[i + 1]);
  mx = fmaxf(mx, s[15]);
  if (first || __builtin_amdgcn_ballot_w64(mx > 8.f) != 0) {
    const float mxx = fmaxf(mx, __shfl_xor(mx, 32));
    const float d = first ? mxx : fmaxf(mxx, 0.f);
    const float alpha = first ? 1.f : ex2(-d);
    m += d; l *= alpha;
#pragma unroll
    for (int i = 0; i < 16; ++i) s[i] -= d;
#pragma unroll
    for (int mt = 0; mt < 4; ++mt)
#pragma unroll
      for (int i = 0; i < 16; ++i) O[mt][i] *= alpha;
  }
  float ps0 = 0.f, ps1 = 0.f;
#pragma unroll
  for (int i = 0; i < 16; i += 2) { s[i] = ex2(s[i]); s[i + 1] = ex2(s[i + 1]); ps0 += s[i]; ps1 += s[i + 1]; }
  l += ps0 + ps1;
  u32x4 p0 = {pack2(s[0], s[1]), pack2(s[2], s[3]), pack2(s[4], s[5]), pack2(s[6], s[7])};
  u32x4 p1 = {pack2(s[8], s[9]), pack2(s[10], s[11]), pack2(s[12], s[13]), pack2(s[14], s[15])};
  const bf16x8 pf0 = __builtin_bit_cast(bf16x8, p0), pf1 = __builtin_bit_cast(bf16x8, p1);
#pragma unroll
  for (int mt = 0; mt < 4; ++mt) { O[mt] = MFMA(vf[2 * mt], pf0, O[mt]); O[mt] = MFMA(vf[2 * mt + 1], pf1, O[mt]); }
}
DI void attn_item(unsigned char* lds, const P& p, int hd, int qb) {
  const int tid = otid(), lane = tid & 63, wave = wave_of(tid);
  const int wq = wave & 3, wk = wave >> 2, l32 = lane & 31, h = lane >> 5;
  const u16* Qg = (const u16*)(p.ws + WS_Q) + ((size_t)hd * S + qb * 128 + wq * 32 + l32) * 192 + h * 8;
  bf16x8 qf[12];
#pragma unroll
  for (int ks = 0; ks < 12; ++ks) qf[ks] = *(const bf16x8*)(Qg + ks * 16);
  const int ntile = 2 * qb + 2, mychunk = 2 * qb + (wq >> 1);
  const u16* Kg = (const u16*)(p.ws + WS_K) + (size_t)hd * S * 192 + tid * 8;
  const u16* Vg = (const u16*)(p.ws + WS_VT) + (size_t)hd * S * 128 + tid * 8;
  int kdst[3], vdst[2];
#pragma unroll
  for (int i = 0; i < 3; ++i) { const int c = tid + i * NT; kdst[i] = (c / 24) * 400 + (c % 24) * 16; }
#pragma unroll
  for (int i = 0; i < 2; ++i) { const int c = tid + i * NT; vdst[i] = 64 * 400 + (c >> 3) * 144 + (c & 7) * 16; }
  const int koff = (wk * 32 + l32) * 400 + h * 16;
  const int voff = 64 * 400 + l32 * 144 + (wk * 32 + h * 8) * 2;
  f32x16 O[4]; O[0] = zero16(); O[1] = zero16(); O[2] = zero16(); O[3] = zero16();
  float m = 0.f, l = 0.f;
  u32x4 rkA[3], rvA[2], rkB[3], rvB[2];
#define ATT_GLOAD(RK, RV, T) do { _Pragma("unroll") for (int i = 0; i < 3; ++i) RK[i] = *(const u32x4*)(Kg + (size_t)(T) * 64 * 192 + i * NT * 8); \
                                  _Pragma("unroll") for (int i = 0; i < 2; ++i) RV[i] = *(const u32x4*)(Vg + (size_t)(T) * 128 * 64 + i * NT * 8); } while (0)
#define ATT_LSTORE(RK, RV, ST) do { unsigned char* st_ = lds + (ST) * ATT_STAGE; _Pragma("unroll") for (int i = 0; i < 3; ++i) *(u32x4*)(st_ + kdst[i]) = RK[i]; \
                                    _Pragma("unroll") for (int i = 0; i < 2; ++i) *(u32x4*)(st_ + vdst[i]) = RV[i]; } while (0)
#define ATT_STEP(KT, RLK, RLV, RSK, RSV) do { \
    ATT_GLOAD(RLK, RLV, min((KT) + 2, ntile - 1));     \
    if ((KT) <= mychunk) { f32x16 s; att_qk(s, lds + ((KT) & 1) * ATT_STAGE + koff, qf, m); att_sm_pv(s, lds + ((KT) & 1) * ATT_STAGE + voff, O, m, l, (KT) == 0); } \
    if ((KT) + 1 < ntile) ATT_LSTORE(RSK, RSV, ((KT) + 1) & 1); \
    lds_barrier(); } while (0)
  ATT_GLOAD(rkA, rvA, 0);
  ATT_GLOAD(rkB, rvB, 1);
  ATT_LSTORE(rkA, rvA, 0);
  __syncthreads();
#pragma unroll 1
  for (int kt = 0; kt < ntile; kt += 2) {
    ATT_STEP(kt, rkA, rvA, rkB, rvB);
    ATT_STEP(kt + 1, rkB, rvB, rkA, rvA);
  }
  const float lt = l + __shfl_xor(l, 32);
  float* cO = (float*)lds; float* cm = (float*)(lds + 65536);
  if (wk == 1) {
#pragma unroll
    for (int mt = 0; mt < 4; ++mt)
#pragma unroll
      for (int i = 0; i < 16; ++i) cO[(wq * 64 + mt * 16 + i) * 64 + lane] = O[mt][i];
    cm[wq * 64 + lane] = m; cm[256 + wq * 64 + lane] = lt;
  }
  __syncthreads();
  if (wk == 0) {
    const float m1 = cm[wq * 64 + lane], l1 = cm[256 + wq * 64 + lane];
    const float mm = fmaxf(m, m1); float a0 = ex2(m - mm), a1 = ex2(m1 - mm);
    const float inv = 1.f / (lt * a0 + l1 * a1); a0 *= inv; a1 *= inv;
    const int t = qb * 128 + wq * 32 + l32;
    const u16* zg = (const u16*)(p.ws + WS_Z) + (size_t)t * ZLD + Z_MG + hd * 128;
    u16* Y = (u16*)(p.ws + WS_HY) + (size_t)t * DM + 512 + hd * 128;
#pragma unroll
    for (int mt = 0; mt < 4; ++mt)
#pragma unroll
      for (int q = 0; q < 4; ++q) {
        const int dv = mt * 32 + q * 8 + h * 4;
        const u32x2 g = *(const u32x2*)(zg + dv);
        float o[4];
#pragma unroll
        for (int j = 0; j < 4; ++j) o[j] = O[mt][q * 4 + j] * a0 + cO[(wq * 64 + mt * 16 + q * 4 + j) * 64 + lane] * a1;
        u32x2 v = {pack2(o[0] * silu(bflo(g[0])), o[1] * silu(bfhi(g[0]))), pack2(o[2] * silu(bflo(g[1])), o[3] * silu(bfhi(g[1])))};
        *(u32x2*)(Y + dv) = v;
      }
  }
  __syncthreads();
}

DI void transpose_tile(unsigned char* lds, const float* __restrict__ src, int ldsrc, u16* __restrict__ dst, int ldd, int k0, int n0, int nvalid, const float* gain) {
  float* tile = (float*)lds;
  const int tid = otid();
#pragma unroll
  for (int i = 0; i < 8; ++i) { const int idx = tid + i * NT, r = idx >> 6, cc = idx & 63, n = n0 + cc;
    float v = (n < nvalid) ? src[(size_t)(k0 + r) * ldsrc + n] : 0.f; if (gain) v *= gain[k0 + r]; tile[r * 65 + cc] = v; }
  __syncthreads();
#pragma unroll
  for (int i = 0; i < 8; ++i) { const int idx = tid + i * NT, r = idx >> 6, cc = idx & 63; dst[(size_t)(n0 + r) * ldd + k0 + cc] = tobf(tile[cc * 65 + r]); }
  __syncthreads();
}
DI float wave_sum(float v) { v += __shfl_xor(v, 32); v += __shfl_xor(v, 16); v += __shfl_xor(v, 8); v += __shfl_xor(v, 4); v += __shfl_xor(v, 2); v += __shfl_xor(v, 1); return v; }
DI void prenorm_row(const f32x4 (&v)[4], const float* g, u16* hrow, int lane) {
  float ss = 0.f;
#pragma unroll
  for (int i = 0; i < 4; ++i) ss += v[i][0] * v[i][0] + v[i][1] * v[i][1] + v[i][2] * v[i][2] + v[i][3] * v[i][3];
  ss = wave_sum(ss);
  const float r = rsqrtf(ss * (1.f / 1024.f) + EPS);
#pragma unroll
  for (int i = 0; i < 4; ++i) { const f32x4 gg = *(const f32x4*)(g + (lane + 64 * i) * 4);
    u32x2 o = {pack2(v[i][0] * r * gg[0], v[i][1] * r * gg[1]), pack2(v[i][2] * r * gg[2], v[i][3] * r * gg[3])};
    *(u32x2*)(hrow + (lane + 64 * i) * 4) = o; }
}

DI void phase_prep(unsigned char* lds, const P& p) {
  const int nb = gridDim.x, bid = blockIdx.x, tid = otid();
  u16* win = (u16*)(p.ws + WS_WIN); u16* wuq = (u16*)(p.ws + WS_WUQ); u16* wukv = (u16*)(p.ws + WS_WUKV); u16* wout = (u16*)(p.ws + WS_WOUT);
  for (int job = bid; job < 2 * 1032; job += nb) {
    const int layer = job / 1032; int r = job - layer * 1032;
    if (r < 640) { const int kt = r / 40, nt = r - kt * 40; transpose_tile(lds, p.w_in + (size_t)layer * 1024 * DIN, DIN, win + (size_t)layer * 2560 * 1024, 1024, kt * 64, nt * 64, DIN, nullptr); }
    else if (r < 712) { r -= 640; const int kt = r / 12, nt = r - kt * 12; transpose_tile(lds, p.w_uq + (size_t)layer * 384 * 768, 768, wuq + (size_t)layer * 768 * 384, 384, kt * 64, nt * 64, 768, p.q_norm_g + layer * 384); }
    else if (r < 776) { r -= 712; const int kt = r / 16, nt = r - kt * 16; transpose_tile(lds, p.w_ukv + (size_t)layer * 256 * 1024, 1024, wukv + (size_t)layer * 1024 * 256, 256, kt * 64, nt * 64, 1024, p.kv_norm_g + layer * 256); }
    else { r -= 776; const int kt = r / 16, nt = r - kt * 16; transpose_tile(lds, p.w_out + (size_t)layer * 1024 * 1024, 1024, wout + (size_t)layer * 1024 * 1024, 1024, kt * 64, nt * 64, 1024, nullptr); }
  }
  const int gtid = bid * NT + tid, gn = nb * NT;
  u16* sguw = (u16*)(p.ws + WS_SGUW);
  for (int idx = gtid; idx < 2 * 4 * 128 * 128; idx += gn) { const int i = (idx >> 7) & 127, j = idx & 127; sguw[idx] = ((j >> 6) <= (i >> 6)) ? tobf(p.sgu_w[idx]) : (u16)0; }
  u16* pwt = (u16*)(p.ws + WS_PWT);
  for (int idx = gtid; idx < 2 * 4 * 64 * 64; idx += gn) { const int lg = idx >> 12, d = (idx >> 6) & 63, c = idx & 63; pwt[idx] = tobf(p.pool_w[(lg * 64 + c) * 64 + d]); }
  float* cosT = (float*)(p.ws + WS_COS); float* sinT = (float*)(p.ws + WS_SIN);
  for (int idx = gtid; idx < S * 32; idx += gn) {
    const int t = idx >> 5, i = idx & 31; const float angf = (float)p.pos[t] * p.invfreq[i];
    const double a = (double)angf; const double k = rint(a * 0.15915494309189535); const double r = a - k * 6.283185307179586; const double r2 = r * r;
    double ts = r, ss = r, tc = 1.0, sc = 1.0;
#pragma unroll
    for (int n = 1; n <= 13; ++n) { ts *= -r2 * (1.0 / (double)((2 * n) * (2 * n + 1))); ss += ts; tc *= -r2 * (1.0 / (double)((2 * n - 1) * (2 * n))); sc += tc; }
    cosT[idx] = (float)sc; sinT[idx] = (float)ss;
  }
  u16* hb = (u16*)(p.ws + WS_HY);
  const int lane = tid & 63, wave = wave_of(tid);
  for (int row = bid * 8 + wave; row < S; row += nb * 8) {
    f32x4 v[4];
#pragma unroll
    for (int i = 0; i < 4; ++i) v[i] = *(const f32x4*)(p.x + (size_t)row * DM + (lane + 64 * i) * 4);
    prenorm_row(v, p.pre_g, hb + (size_t)row * DM, lane);
  }
}

DI void phase_post(const P& p, int layer) {
  const int nb = gridDim.x, bid = blockIdx.x, tid = otid(), lane = tid & 63, wave = wave_of(tid);
  const u16* yout = (const u16*)(p.ws + WS_Z); const float* xold = layer == 0 ? p.x : p.out;
  u16* hb = (u16*)(p.ws + WS_HY);
  for (int row = bid * 8 + wave; row < S; row += nb * 8) {
    f32x4 y[4]; float ss = 0.f;
#pragma unroll
    for (int i = 0; i < 4; ++i) { const u32x2 yb = *(const u32x2*)(yout + (size_t)row * DM + (lane + 64 * i) * 4); y[i] = (f32x4){bflo(yb[0]), bfhi(yb[0]), bflo(yb[1]), bfhi(yb[1])}; ss += y[i][0] * y[i][0] + y[i][1] * y[i][1] + y[i][2] * y[i][2] + y[i][3] * y[i][3]; }
    ss = wave_sum(ss);
    const float r = rsqrtf(ss * (1.f / 1024.f) + EPS);
#pragma unroll
    for (int i = 0; i < 4; ++i) {
      const f32x4 g = *(const f32x4*)(p.post_g + layer * DM + (lane + 64 * i) * 4); const f32x4 xo = *(const f32x4*)(xold + (size_t)row * DM + (lane + 64 * i) * 4);
      y[i] = xo + y[i] * r * g;
      *(f32x4*)(p.out + (size_t)row * DM + (lane + 64 * i) * 4) = y[i];
    }
    if (layer + 1 < DEPTH) prenorm_row(y, p.pre_g + (layer + 1) * DM, hb + (size_t)row * DM, lane);
  }
}

__global__ void __launch_bounds__(NT) mega(P p) {
  extern __shared__ __attribute__((aligned(16))) unsigned char lds[];
  cg::grid_group grid = cg::this_grid();
  const int nb = gridDim.x, bid = blockIdx.x;
  if (threadIdx.x < 4) ((unsigned*)(lds + XB_LDS_OFF))[threadIdx.x] = 0u;
  __syncthreads();
  XcdBarrier xbar = xcd_barrier_post((unsigned*)(p.ws + WS_BAR), (volatile LAS unsigned*)(lds + XB_LDS_OFF));
  unsigned* xcnt = (unsigned*)(p.ws + WS_BAR + 14336);
  unsigned myslot = 0;
  if (threadIdx.x == 0) myslot = xb_add(&xcnt[16 * xbar.x], 1u);
  int vid = bid;
  int ph = 0;
#define RUN(ph_) ((ph_) >= p.ph_lo && (ph_) < p.ph_hi)
#define SEAM(ph_) do { if (RUN(ph_) && RUN((ph_) + 1)) { if (p.ph_hi < 0) grid.sync(); else xcd_barrier(xbar); } } while (0)
  for (int rep = 0; rep < (DUP == 5 ? 2 : 1); ++rep)
  if (RUN(ph)) phase_prep(lds, p);
  SEAM(ph); ++ph;
  if (p.ph_hi - p.ph_lo > 1) {
    if (threadIdx.x == 0) { bool even = (nb & 7) == 0; for (int j = 0; j < 8; ++j) even = even && (xb_ld(&xcnt[16 * j]) == (unsigned)(nb >> 3));
      ((volatile LAS unsigned*)(lds + XB_LDS_OFF))[2] = even ? (myslot * 8u + xbar.x) : (unsigned)bid; }
    __syncthreads();
    vid = __builtin_amdgcn_readfirstlane((int)((volatile LAS unsigned*)(lds + XB_LDS_OFF))[2]);
  }
#pragma unroll 1
  for (int layer = 0; layer < DEPTH; ++layer) {
    u16* hy = (u16*)(p.ws + WS_HY); u16* z = (u16*)(p.ws + WS_Z);
    float* rs = (float*)(lds + RS_OFF);
    for (int rep = 0; rep < (DUP == 1 ? 2 : 1); ++rep)
    if (RUN(ph)) {
      const u16* W = (const u16*)(p.ws + WS_WIN) + (size_t)layer * 2560 * 1024;
      EpiZ e{z};
      for (int job = vid; job < 1280; job += nb) { const int x = job & 7, j = job >> 3, g = j / 40, r = j - g * 40, mt = r >> 2, nt = 16 * x + 4 * g + (r & 3);
        gemm_tile(lds, W + (size_t)mt * 256 * 1024, hy + (size_t)nt * 128 * 1024, 1024, 1024, mt * 256, nt * 128, e); }
    }
    SEAM(ph); ++ph;
    for (int rep = 0; rep < (DUP == 2 ? 2 : 1); ++rep)
    if (RUN(ph)) {
      const float* cosT = (const float*)(p.ws + WS_COS); const float* sinT = (const float*)(p.ws + WS_SIN);
      for (int job = vid; job < 1152; job += nb) {
        __syncthreads();
        const int x = job & 7, j = job >> 3;
        if (j < 48) { const int ntl = j / 3, mt = j - ntl * 3, n0 = (16 * x + ntl) * 128;
          const u16* X = z + (size_t)n0 * ZLD + Z_CQ; row_rstd(rs, X, ZLD, 384);
          EpiQ e{(u16*)(p.ws + WS_Q), cosT, sinT, rs, n0};
          gemm_tile(lds, (const u16*)(p.ws + WS_WUQ) + (size_t)layer * 768 * 384 + (size_t)mt * 256 * 384, X, ZLD, 384, mt * 256, n0, e);
        } else if (j < 112) { const int j2 = j - 48, mt = j2 & 3, n0 = (16 * x + (j2 >> 2)) * 128;
          const u16* X = z + (size_t)n0 * ZLD + Z_CKV; row_rstd(rs, X, ZLD, 256);
          EpiKV e{(u16*)(p.ws + WS_K), (u16*)(p.ws + WS_VT), rs, n0};
          gemm_tile(lds, (const u16*)(p.ws + WS_WUKV) + (size_t)layer * 1024 * 256 + (size_t)mt * 256 * 256, X, ZLD, 256, mt * 256, n0, e);
          if (mt == 0) krope_tile(p, n0);
        } else if (j < 128) sgu_job(lds, p, layer, 16 * x + (j - 112));
        else pool_job(lds, p, layer, 16 * x + (j - 128));
      }
    }
    SEAM(ph); ++ph;
    for (int rep = 0; rep < (DUP == 3 ? 2 : 1); ++rep)
    if (RUN(ph)) {
      for (int it = vid; it < 256; it += nb) {
        const int hd = (it & 7) >> 1, pr = (it >> 3) * 2 + (it & 1);
        attn_item(lds, p, hd, 127 - pr);
        attn_item(lds, p, hd, pr);
      }
    }
    SEAM(ph); ++ph;
    for (int rep = 0; rep < (DUP == 4 ? 2 : 1); ++rep)
    if (RUN(ph)) {
      const u16* W = (const u16*)(p.ws + WS_WOUT) + (size_t)layer * 1024 * 1024;
      EpiOut e{(u16*)(p.ws + WS_Z)};
      for (int job = vid; job < 512; job += nb) { const int x = job & 7, j = job >> 3, mt = j & 3, nt = 16 * x + (j >> 2);
        gemm_tile(lds, W + (size_t)mt * 256 * 1024, hy + (size_t)nt * 128 * 1024, 1024, 1024, mt * 256, nt * 128, e); }
    }
    SEAM(ph); ++ph;
    for (int rep = 0; rep < ((DUP == 6 && layer == 0) ? 2 : 1); ++rep)
    if (RUN(ph)) phase_post(p, layer);
    SEAM(ph); ++ph;
  }
  if (p.ph_hi - p.ph_lo > 1) xcd_barrier(xbar);
}
constexpr int NPHASE = 1 + 5 * DEPTH;

extern "C" void kernel_launch(void* const* d_in, const int* in_sizes, int n_in, void* d_out, int out_size, void* d_ws, size_t ws_size, hipStream_t stream) {
  static int grid_blocks = 0;
  if (!grid_blocks) {
    int dev = 0, cus = 0, per_cu = 0;
    hipGetDevice(&dev);
    hipDeviceGetAttribute(&cus, hipDeviceAttributeMultiprocessorCount, dev);
    hipFuncSetAttribute((const void*)mega, hipFuncAttributeMaxDynamicSharedMemorySize, LDS_BYTES);
    hipOccupancyMaxActiveBlocksPerMultiprocessor(&per_cu, (const void*)mega, NT, LDS_BYTES);
    if (per_cu < 1) { fprintf(stderr, "occupancy query returned %d\n", per_cu); per_cu = 1; }
    if (per_cu > 1) per_cu = 1;
    grid_blocks = cus * per_cu;
    if (ws_size < WS_END) fprintf(stderr, "workspace too small: %zu < %zu\n", ws_size, (size_t)WS_END);
  }
  P p{};
  p.x = (const float*)d_in[0]; p.pos = (const int*)d_in[1]; p.pre_g = (const float*)d_in[2]; p.post_g = (const float*)d_in[3];
  p.w_in = (const float*)d_in[4]; p.sgu_w = (const float*)d_in[5]; p.sgu_b = (const float*)d_in[6]; p.sgu_ln_g = (const float*)d_in[7];
  p.sgu_ln_b = (const float*)d_in[8]; p.pool_w = (const float*)d_in[9]; p.pool_scale = (const float*)d_in[10]; p.q_norm_g = (const float*)d_in[11];
  p.w_uq = (const float*)d_in[12]; p.kv_norm_g = (const float*)d_in[13]; p.w_ukv = (const float*)d_in[14]; p.w_out = (const float*)d_in[15];
  p.out = (float*)d_out; p.ws = (unsigned char*)d_ws;
  for (int i = 0; i < 32; ++i) p.invfreq[i] = powf(10000.0f, -(float)(2 * i) / 64.0f);
  hipMemsetAsync((char*)d_ws + WS_BAR, 0, 16384, stream);
#if COOP
  p.ph_lo = 0; p.ph_hi = NPHASE;
  void* args[] = {&p};
  hipError_t e = hipLaunchCooperativeKernel((void*)mega, dim3(grid_blocks), dim3(NT), args, LDS_BYTES, stream);
  if (e != hipSuccess) fprintf(stderr, "cooperative launch failed: %s (grid %d)\n", hipGetErrorString(e), grid_blocks);
#else
  for (int ph = 0; ph < NPHASE; ++ph) { p.ph_lo = ph; p.ph_hi = ph + 1; hipLaunchKernelGGL(mega, dim3(grid_blocks), dim3(NT), LDS_BYTES, stream, p); }
#endif
}
```

```cpp
#include <hip/hip_runtime.h>
#include <hip/hip_cooperative_groups.h>
#include <cstdio>
#include <cmath>
namespace cg = cooperative_groups;

#define DI __device__ __forceinline__
typedef unsigned short u16;
using bf16x8 = __attribute__((ext_vector_type(8))) short;
using f32x16 = __attribute__((ext_vector_type(16))) float;
using f32x4  = __attribute__((ext_vector_type(4))) float;
using f32x2  = __attribute__((ext_vector_type(2))) float;
using u32x4  = __attribute__((ext_vector_type(4))) unsigned;
using u32x2  = __attribute__((ext_vector_type(2))) unsigned;
typedef __bf16 bf2_t __attribute__((ext_vector_type(2)));
#define MFMA(a, b, c) __builtin_amdgcn_mfma_f32_32x32x16_bf16((a), (b), (c), 0, 0, 0)

#ifndef COOP
#define COOP 1
#endif
#ifndef DUP
#define DUP 7
#endif

constexpr int S = 16384, DM = 1024, DIN = 2496, ZLD = 2560, NT = 512, DEPTH = 2;
constexpr float EPS = 1e-6f;
constexpr float QSCALE = 0.07216878364870322f * 1.4426950408889634f;
constexpr int Z_U = 0, Z_V = 256, Z_SG = 512, Z_PI = 768, Z_PG = 1024, Z_CQ = 1280, Z_CKV = 1664, Z_KR = 1920, Z_MG = 1984;

constexpr size_t WS_HY   = 0;
constexpr size_t WS_Z    = WS_HY + (size_t)S * 1024 * 2;
constexpr size_t WS_Q    = WS_Z + (size_t)S * ZLD * 2;
constexpr size_t WS_K    = WS_Q + (size_t)4 * S * 192 * 2;
constexpr size_t WS_VT   = WS_K + (size_t)4 * S * 192 * 2;
constexpr size_t WS_WIN  = WS_VT + (size_t)4 * S * 128 * 2;
constexpr size_t WS_WUQ  = WS_WIN + (size_t)2 * 2560 * 1024 * 2;
constexpr size_t WS_WUKV = WS_WUQ + (size_t)2 * 768 * 384 * 2;
constexpr size_t WS_WOUT = WS_WUKV + (size_t)2 * 1024 * 256 * 2;
constexpr size_t WS_SGUW = WS_WOUT + (size_t)2 * 1024 * 1024 * 2;
constexpr size_t WS_PWT  = WS_SGUW + (size_t)2 * 4 * 128 * 128 * 2;
constexpr size_t WS_COS  = WS_PWT + (size_t)2 * 4 * 64 * 64 * 2;
constexpr size_t WS_SIN  = WS_COS + (size_t)S * 32 * 4;
constexpr size_t WS_BAR  = WS_SIN + (size_t)S * 32 * 4;
constexpr size_t WS_END  = WS_BAR + 16384;

constexpr int GEMM_STAGE = 512 * 144;
constexpr int RS_OFF = 2 * GEMM_STAGE;
constexpr int XB_LDS_OFF = RS_OFF + 1024;
constexpr int LDS_BYTES = XB_LDS_OFF + 16;
constexpr int ATT_STAGE = 64 * 400 + 128 * 144;

struct P {
  const float* x; const int* pos; const float* pre_g; const float* post_g; const float* w_in; const float* sgu_w; const float* sgu_b;
  const float* sgu_ln_g; const float* sgu_ln_b; const float* pool_w; const float* pool_scale; const float* q_norm_g; const float* w_uq;
  const float* kv_norm_g; const float* w_ukv; const float* w_out;
  float* out; unsigned char* ws;
  float invfreq[32];
  int ph_lo, ph_hi;
};

DI int otid() { int t = threadIdx.x; asm volatile("" : "+v"(t)); return t; }
DI int wave_of(int tid) { return __builtin_amdgcn_readfirstlane(tid >> 6); }
DI void lds_barrier() { asm volatile("s_waitcnt lgkmcnt(0)" ::: "memory"); __builtin_amdgcn_s_barrier(); asm volatile("" ::: "memory"); }
DI unsigned pack2(float a, float b) { f32x2 v = {a, b}; return __builtin_bit_cast(unsigned, __builtin_convertvector(v, bf2_t)); }
DI u16 tobf(float a) { return (u16)(pack2(a, 0.f) & 0xffffu); }
DI float bflo(unsigned u) { return __uint_as_float(u << 16); }
DI float bfhi(unsigned u) { return __uint_as_float(u & 0xffff0000u); }
DI float silu(float x) { return x / (1.f + __expf(-x)); }
DI float ex2(float x) { return __builtin_amdgcn_exp2f(x); }
DI f32x16 zero16() { f32x16 z; for (int i = 0; i < 16; ++i) z[i] = 0.f; return z; }

#define XB_TMO      128
#define XB_XCNT(j)  (256  + 64 * (j))
#define XB_XSUB(j)  (1280 + 64 * (j))
#define XB_XGEN(j)  (2304 + 64 * (j))
#define XB_TOP      3328
#define XB_TOPGEN   3392
#define XCD_BAR_WORDS 3456
#define XB_SPIN_CAP (1u << 18)
#define LAS __attribute__((address_space(3)))

__device__ __forceinline__ unsigned xb_ld(unsigned* p)              { return __hip_atomic_load(p, __ATOMIC_RELAXED, __HIP_MEMORY_SCOPE_AGENT); }
__device__ __forceinline__ unsigned xb_add(unsigned* p, unsigned v) { return __hip_atomic_fetch_add(p, v, __ATOMIC_RELAXED, __HIP_MEMORY_SCOPE_AGENT); }
__device__ __forceinline__ unsigned xb_xcc_id() { return (unsigned)__builtin_amdgcn_s_getreg((3 << 11) | 20) & 0xFu; }
#define XB_SPIN(cond, bar) do { unsigned _sp = 0; while (cond) { __builtin_amdgcn_s_sleep(1); \
    if ((++_sp & 255u) == 0u) { if (xb_ld(&(bar)[XB_TMO])) break; if (_sp > XB_SPIN_CAP) { atomicAdd(&(bar)[XB_TMO], 1u); break; } } } } while (0)

struct XcdBarrier {
    unsigned* bar; unsigned x;
    volatile LAS unsigned* st;
};

__device__ __forceinline__ XcdBarrier xcd_barrier_post(unsigned* bar, volatile LAS unsigned* st) {
    XcdBarrier b; b.bar = bar; b.x = xb_xcc_id(); b.st = st;
    if (threadIdx.x == 0) (void)xb_add(&bar[XB_XCNT(b.x)], 1u);
    return b;
}
__device__ __forceinline__ void xcd_barrier_complete(unsigned* bar, unsigned x, unsigned& nloc, unsigned& nx) {
    const unsigned G = gridDim.x * gridDim.y * gridDim.z;
    unsigned sum, cnt, mine, sp = 0u;
    for (;;) {
        sum = 0u; cnt = 0u; mine = 0u;
#pragma unroll
        for (unsigned j = 0; j < 16; ++j) { const unsigned c = xb_ld(&bar[XB_XCNT(j)]); sum += c; cnt += (c > 0u) ? 1u : 0u; mine = (j == x) ? c : mine; }
        if (sum == G) break;
        __builtin_amdgcn_s_sleep(1);
        if ((++sp & 255u) == 0u) { if (xb_ld(&bar[XB_TMO])) break; if (sp > XB_SPIN_CAP) { atomicAdd(&bar[XB_TMO], 1u); break; } }
    }
    nloc = mine > 0u ? mine : 1u; nx = cnt > 0u ? cnt : 1u;
}

__device__ __forceinline__ void xcd_barrier(const XcdBarrier& b) {
    asm volatile("s_waitcnt vmcnt(0)" ::: "memory");
    __syncthreads();
    if (threadIdx.x == 0) {
        unsigned* bar = b.bar;
        __builtin_amdgcn_s_waitcnt(0);
        unsigned nloc = b.st[0], nx = b.st[1];
        if (nloc == 0u) { xcd_barrier_complete(bar, b.x, nloc, nx); b.st[0] = nloc; b.st[1] = nx; }
        const unsigned old = xb_add(&bar[XB_XSUB(b.x)], 1u);
        const unsigned gen = old / nloc;
        if (old + 1u == (gen + 1u) * nloc) {
            __builtin_amdgcn_fence(__ATOMIC_RELEASE, "agent");
            asm volatile("s_waitcnt vmcnt(0)" ::: "memory");
            const unsigned og = xb_add(&bar[XB_TOP], 1u);
            const unsigned tg = og / nx;
            if (og + 1u == (tg + 1u) * nx) xb_add(&bar[XB_TOPGEN], 1u);
            else XB_SPIN(xb_ld(&bar[XB_TOPGEN]) == tg, bar);
            __builtin_amdgcn_fence(__ATOMIC_ACQUIRE, "agent");
            xb_add(&bar[XB_XGEN(b.x)], 1u);
            asm volatile("s_waitcnt vmcnt(0)" ::: "memory");
        } else {
            XB_SPIN(xb_ld(&bar[XB_XGEN(b.x)]) == gen, bar);
            __builtin_amdgcn_fence(__ATOMIC_ACQUIRE, "agent");
            asm volatile("s_waitcnt vmcnt(0)" ::: "memory");
        }
    }
    __syncthreads();
}


template <int NTW, class Epi>
DI void gemm_tile(unsigned char* lds, const u16* __restrict__ A, const u16* __restrict__ X, int ldx, int K, int m0, int n0, Epi& epi) {
  const int tid = otid(), lane = tid & 63, wave = wave_of(tid);
  const int wm = wave & 3, wn = wave >> 2, l32 = lane & 31, h = lane >> 5;
  f32x16 acc[2][NTW];
#pragma unroll
  for (int i = 0; i < 2; ++i)
#pragma unroll
    for (int j = 0; j < NTW; ++j) acc[i][j] = zero16();
  const int nk = K >> 6;
  const int lrow = tid >> 3, lcol = tid & 7;
  const u16* ga = A + (size_t)lrow * K + lcol * 8;
  const u16* gx = X + (size_t)lrow * ldx + lcol * 8;
  u32x4 ra[4], rb[NTW];
#pragma unroll
  for (int i = 0; i < 4; ++i) ra[i] = *(const u32x4*)(ga + (size_t)i * 64 * K);
#pragma unroll
  for (int i = 0; i < NTW; ++i) rb[i] = *(const u32x4*)(gx + (size_t)i * 64 * ldx);
  {
    unsigned char* as = lds; unsigned char* bs = lds + 256 * 144;
#pragma unroll
    for (int i = 0; i < 4; ++i) *(u32x4*)(as + (lrow + i * 64) * 144 + lcol * 16) = ra[i];
#pragma unroll
    for (int i = 0; i < NTW; ++i) *(u32x4*)(bs + (lrow + i * 64) * 144 + lcol * 16) = rb[i];
  }
  __syncthreads();
#pragma unroll 1
  for (int ks = 0; ks < nk; ++ks) {
    const bool more = ks + 1 < nk;
    if (more) {
#pragma unroll
      for (int i = 0; i < 4; ++i) ra[i] = *(const u32x4*)(ga + (size_t)i * 64 * K + (ks + 1) * 64);
#pragma unroll
      for (int i = 0; i < NTW; ++i) rb[i] = *(const u32x4*)(gx + (size_t)i * 64 * ldx + (ks + 1) * 64);
    }
    const unsigned char* as = lds + (ks & 1) * GEMM_STAGE + (wm * 64 + l32) * 144 + h * 16;
    const unsigned char* bs = lds + (ks & 1) * GEMM_STAGE + 256 * 144 + (wn * NTW * 32 + l32) * 144 + h * 16;
#pragma unroll
    for (int kk = 0; kk < 4; ++kk) {
      bf16x8 a0 = *(const bf16x8*)(as + kk * 32), a1 = *(const bf16x8*)(as + 32 * 144 + kk * 32);
      bf16x8 b[NTW];
#pragma unroll
      for (int j = 0; j < NTW; ++j) b[j] = *(const bf16x8*)(bs + j * 32 * 144 + kk * 32);
#pragma unroll
      for (int j = 0; j < NTW; ++j) { acc[0][j] = MFMA(a0, b[j], acc[0][j]); acc[1][j] = MFMA(a1, b[j], acc[1][j]); }
    }
    if (more) {
      unsigned char* as2 = lds + ((ks + 1) & 1) * GEMM_STAGE; unsigned char* bs2 = as2 + 256 * 144;
#pragma unroll
      for (int i = 0; i < 4; ++i) *(u32x4*)(as2 + (lrow + i * 64) * 144 + lcol * 16) = ra[i];
#pragma unroll
      for (int i = 0; i < NTW; ++i) *(u32x4*)(bs2 + (lrow + i * 64) * 144 + lcol * 16) = rb[i];
    }
    __syncthreads();
  }
  epi(acc, m0 + wm * 64, n0 + wn * NTW * 32, l32, h);
}

struct EpiZ {
  u16* z;
  template <int NTW> DI void operator()(f32x16 (&acc)[2][NTW], int chb, int tokb, int l32, int h) {
#pragma unroll
    for (int nt = 0; nt < NTW; ++nt) { const int t = tokb + nt * 32 + l32;
#pragma unroll
      for (int mt = 0; mt < 2; ++mt)
#pragma unroll
        for (int q = 0; q < 4; ++q) {
          u32x2 v = {pack2(acc[mt][nt][q * 4], acc[mt][nt][q * 4 + 1]), pack2(acc[mt][nt][q * 4 + 2], acc[mt][nt][q * 4 + 3])};
          *(u32x2*)(z + (size_t)t * ZLD + chb + mt * 32 + q * 8 + h * 4) = v;
        }
    }
  }
};
struct EpiOut {
  u16* y;
  template <int NTW> DI void operator()(f32x16 (&acc)[2][NTW], int chb, int tokb, int l32, int h) {
#pragma unroll
    for (int nt = 0; nt < NTW; ++nt) { const int t = tokb + nt * 32 + l32;
#pragma unroll
      for (int mt = 0; mt < 2; ++mt)
#pragma unroll
        for (int q = 0; q < 4; ++q) {
          u32x2 v = {pack2(acc[mt][nt][q * 4], acc[mt][nt][q * 4 + 1]), pack2(acc[mt][nt][q * 4 + 2], acc[mt][nt][q * 4 + 3])};
          *(u32x2*)(y + (size_t)t * DM + chb + mt * 32 + q * 8 + h * 4) = v;
        }
    }
  }
};
struct EpiQ {
  u16* Q; const float* cosT; const float* sinT; const float* rs; int n0;
  template <int NTW> DI void operator()(f32x16 (&acc)[2][NTW], int chb, int tokb, int l32, int h) {
    const int seg = chb >> 6, head = seg / 3, part = seg - head * 3;
#pragma unroll
    for (int nt = 0; nt < NTW; ++nt) {
      const int t = tokb + nt * 32 + l32; const float r = rs[tokb - n0 + nt * 32 + l32] * QSCALE;
      u16* dst = Q + ((size_t)head * S + t) * 192;
      if (part < 2) {
#pragma unroll
        for (int mt = 0; mt < 2; ++mt)
#pragma unroll
          for (int q = 0; q < 4; ++q) {
            u32x2 v = {pack2(acc[mt][nt][q * 4] * r, acc[mt][nt][q * 4 + 1] * r), pack2(acc[mt][nt][q * 4 + 2] * r, acc[mt][nt][q * 4 + 3] * r)};
            *(u32x2*)(dst + part * 64 + mt * 32 + q * 8 + h * 4) = v;
          }
      } else {
#pragma unroll
        for (int q = 0; q < 4; ++q) {
          const int d = q * 8 + h * 4;
          const f32x4 c = *(const f32x4*)(cosT + (size_t)t * 32 + d), s = *(const f32x4*)(sinT + (size_t)t * 32 + d);
          float o1[4], o2[4];
#pragma unroll
          for (int j = 0; j < 4; ++j) { const float x1 = acc[0][nt][q * 4 + j], x2 = acc[1][nt][q * 4 + j]; o1[j] = (x1 * c[j] - x2 * s[j]) * r; o2[j] = (x2 * c[j] + x1 * s[j]) * r; }
          u32x2 v1 = {pack2(o1[0], o1[1]), pack2(o1[2], o1[3])}, v2 = {pack2(o2[0], o2[1]), pack2(o2[2], o2[3])};
          *(u32x2*)(dst + 128 + d) = v1; *(u32x2*)(dst + 160 + d) = v2;
        }
      }
    }
  }
};
DI int permpos(int k64) { const int kk = k64 & 15; return (k64 & 48) | (((kk >> 2) & 1) * 8 + (kk >> 3) * 4 + (kk & 3)); }
struct EpiKV {
  u16* K; u16* Vt; const float* rs; int n0;
  template <int NTW> DI void operator()(f32x16 (&acc)[2][NTW], int chb, int tokb, int l32, int h) {
    const int seg = chb >> 6, head = seg >> 2, part = seg & 3;
#pragma unroll
    for (int nt = 0; nt < NTW; ++nt) {
      const int t = tokb + nt * 32 + l32; const float r = rs[tokb - n0 + nt * 32 + l32];
      if (part < 2) {
        u16* dst = K + ((size_t)head * S + t) * 192 + part * 64;
#pragma unroll
        for (int mt = 0; mt < 2; ++mt)
#pragma unroll
          for (int q = 0; q < 4; ++q) {
            u32x2 v = {pack2(acc[mt][nt][q * 4] * r, acc[mt][nt][q * 4 + 1] * r), pack2(acc[mt][nt][q * 4 + 2] * r, acc[mt][nt][q * 4 + 3] * r)};
            *(u32x2*)(dst + mt * 32 + q * 8 + h * 4) = v;
          }
      } else {
        u16* dst = Vt + (((size_t)head * (S / 64) + (t >> 6)) * 128 + (part - 2) * 64) * 64 + permpos(t & 63);
#pragma unroll
        for (int mt = 0; mt < 2; ++mt)
#pragma unroll
          for (int i = 0; i < 16; ++i) { const int dv = mt * 32 + (i & 3) + 8 * (i >> 2) + 4 * h; dst[dv * 64] = tobf(acc[mt][nt][i] * r); }
      }
    }
  }
};

DI void row_rstd(float* rs, const u16* X, int ldx, int K) {
  const int tid = otid(), tl = tid >> 2, sub = tid & 3;
  const u16* src = X + (size_t)tl * ldx; float ss = 0.f;
  for (int c = sub; c < (K >> 3); c += 4) {
    u32x4 v = *(const u32x4*)(src + c * 8);
#pragma unroll
    for (int j = 0; j < 4; ++j) { const float a = bflo(v[j]), b = bfhi(v[j]); ss += a * a + b * b; }
  }
  ss += __shfl_xor(ss, 1); ss += __shfl_xor(ss, 2);
  if (sub == 0) rs[tl] = rsqrtf(ss / (float)K + EPS);
}

DI void krope_tile(const P& p, int n0) {
  const int tid = otid(), t = n0 + (tid >> 2), i0 = (tid & 3) * 8;
  const u16* z = (const u16*)(p.ws + WS_Z) + (size_t)t * ZLD + Z_KR;
  const float* cosT = (const float*)(p.ws + WS_COS) + (size_t)t * 32 + i0; const float* sinT = (const float*)(p.ws + WS_SIN) + (size_t)t * 32 + i0;
  u32x4 a = *(const u32x4*)(z + i0), b = *(const u32x4*)(z + 32 + i0);
  f32x4 c0 = *(const f32x4*)cosT, c1 = *(const f32x4*)(cosT + 4), s0 = *(const f32x4*)sinT, s1 = *(const f32x4*)(sinT + 4);
  float x1[8], x2[8], c[8], s[8];
#pragma unroll
  for (int j = 0; j < 4; ++j) { x1[2 * j] = bflo(a[j]); x1[2 * j + 1] = bfhi(a[j]); x2[2 * j] = bflo(b[j]); x2[2 * j + 1] = bfhi(b[j]); c[j] = c0[j]; c[4 + j] = c1[j]; s[j] = s0[j]; s[4 + j] = s1[j]; }
  u32x4 o1, o2;
#pragma unroll
  for (int j = 0; j < 4; ++j) {
    o1[j] = pack2(x1[2 * j] * c[2 * j] - x2[2 * j] * s[2 * j], x1[2 * j + 1] * c[2 * j + 1] - x2[2 * j + 1] * s[2 * j + 1]);
    o2[j] = pack2(x2[2 * j] * c[2 * j] + x1[2 * j] * s[2 * j], x2[2 * j + 1] * c[2 * j + 1] + x1[2 * j + 1] * s[2 * j + 1]);
  }
  u16* K = (u16*)(p.ws + WS_K);
#pragma unroll
  for (int hd = 0; hd < 4; ++hd) { u16* dst = K + ((size_t)hd * S + t) * 192 + 128 + i0; *(u32x4*)dst = o1; *(u32x4*)(dst + 32) = o2; }
}

DI void sgu_job(unsigned char* lds, const P& p, int layer, int nb) {
  const int tid = otid(), lane = tid & 63, wave = wave_of(tid);
  const int n0 = nb * 128;
  const u16* z = (const u16*)(p.ws + WS_Z);
  u16* vT = (u16*)lds;
  {
    const int j = tid >> 2, sub = tid & 3; const u16* src = z + (size_t)(n0 + j) * ZLD + Z_V + sub * 64;
    float v[64]; float s = 0.f;
#pragma unroll
    for (int c = 0; c < 8; ++c) { u32x4 u = *(const u32x4*)(src + c * 8);
#pragma unroll
      for (int k = 0; k < 4; ++k) { v[c * 8 + 2 * k] = bflo(u[k]); v[c * 8 + 2 * k + 1] = bfhi(u[k]); s += v[c * 8 + 2 * k] + v[c * 8 + 2 * k + 1]; } }
    s += __shfl_xor(s, 1); s += __shfl_xor(s, 2);
    const float mu = s * (1.f / 256.f); float q = 0.f;
#pragma unroll
    for (int c = 0; c < 64; ++c) { const float d = v[c] - mu; q += d * d; }
    q += __shfl_xor(q, 1); q += __shfl_xor(q, 2);
    const float rstd = rsqrtf(q * (1.f / 256.f) + EPS);
    const float* g = p.sgu_ln_g + layer * 256 + sub * 64; const float* b = p.sgu_ln_b + layer * 256 + sub * 64;
#pragma unroll
    for (int c4 = 0; c4 < 16; ++c4) { const f32x4 gg = *(const f32x4*)(g + c4 * 4), bb = *(const f32x4*)(b + c4 * 4);
#pragma unroll
      for (int k = 0; k < 4; ++k) vT[(sub * 64 + c4 * 4 + k) * 136 + j] = tobf((v[c4 * 4 + k] - mu) * rstd * gg[k] + bb[k]); }
  }
  __syncthreads();
  const int wm = wave & 3, wn = wave >> 2, l32 = lane & 31, h = lane >> 5;
  f32x16 acc[2][2]; acc[0][0] = zero16(); acc[0][1] = zero16(); acc[1][0] = zero16(); acc[1][1] = zero16();
  const u16* W = (const u16*)(p.ws + WS_SGUW) + (size_t)(layer * 4 + wm) * 128 * 128;
#pragma unroll
  for (int kk = 0; kk < 8; ++kk) {
    bf16x8 a0 = *(const bf16x8*)(vT + (wm * 64 + l32) * 136 + kk * 16 + h * 8);
    bf16x8 a1 = *(const bf16x8*)(vT + (wm * 64 + 32 + l32) * 136 + kk * 16 + h * 8);
    bf16x8 b0 = *(const bf16x8*)(W + (wn * 64 + l32) * 128 + kk * 16 + h * 8);
    bf16x8 b1 = *(const bf16x8*)(W + (wn * 64 + 32 + l32) * 128 + kk * 16 + h * 8);
    acc[0][0] = MFMA(a0, b0, acc[0][0]); acc[0][1] = MFMA(a0, b1, acc[0][1]);
    acc[1][0] = MFMA(a1, b0, acc[1][0]); acc[1][1] = MFMA(a1, b1, acc[1][1]);
  }
  u16* Y = (u16*)(p.ws + WS_HY);
#pragma unroll
  for (int nt = 0; nt < 2; ++nt) {
    const int i = wn * 64 + nt * 32 + l32, t = n0 + i; const float bias = p.sgu_b[(layer * 4 + wm) * 128 + i];
#pragma unroll
    for (int mt = 0; mt < 2; ++mt)
#pragma unroll
      for (int q = 0; q < 4; ++q) {
        const int c = wm * 64 + mt * 32 + q * 8 + h * 4;
        const u32x2 u = *(const u32x2*)(z + (size_t)t * ZLD + Z_U + c), g = *(const u32x2*)(z + (size_t)t * ZLD + Z_SG + c);
        const float o0 = bflo(u[0]) * (acc[mt][nt][q * 4] + bias) * silu(bflo(g[0])), o1 = bfhi(u[0]) * (acc[mt][nt][q * 4 + 1] + bias) * silu(bfhi(g[0]));
        const float o2 = bflo(u[1]) * (acc[mt][nt][q * 4 + 2] + bias) * silu(bflo(g[1])), o3 = bfhi(u[1]) * (acc[mt][nt][q * 4 + 3] + bias) * silu(bfhi(g[1]));
        u32x2 v = {pack2(o0, o1), pack2(o2, o3)};
        *(u32x2*)(Y + (size_t)t * DM + c) = v;
      }
  }
}

template <int W>
DI void pool_win(const u16* zp, int t0, u16* prow) {
  unsigned v[32 + W];
#pragma unroll
  for (int i = 0; i < 32 + W; ++i) { const int t = t0 - W + i; v[i] = (t >= 0) ? *(const unsigned*)(zp + (size_t)max(t, 0) * ZLD) : 0u; }
  float s0 = 0.f, s1 = 0.f;
#pragma unroll
  for (int i = 0; i < W; ++i) { s0 += bflo(v[i]); s1 += bfhi(v[i]); }
#pragma unroll
  for (int tt = 0; tt < 32; ++tt) {
    const float p0 = bflo(v[W + tt]), p1 = bfhi(v[W + tt]);
    s0 += p0 - bflo(v[tt]); s1 += p1 - bfhi(v[tt]);
    const float inv = 1.f / (float)min(t0 + tt + 1, W);
    *(unsigned*)(prow + tt * 264) = pack2(s0 * inv - p0, s1 * inv - p1);
  }
}
DI void pool_job(unsigned char* lds, const P& p, int layer, int nb) {
  const int tid = otid(), lane = tid & 63, wave = wave_of(tid);
  const int n0 = nb * 128;
  const u16* z = (const u16*)(p.ws + WS_Z);
  u16* pl = (u16*)lds;
  {
    const int g = wave & 3, c = g * 64 + (lane & 31) * 2, tq = (wave >> 2) * 2 + (lane >> 5);
    const u16* zp = z + Z_PI + c; const int t0 = n0 + tq * 32; u16* prow = pl + (tq * 32) * 264 + c;
    switch (g) { case 0: pool_win<2>(zp, t0, prow); break; case 1: pool_win<4>(zp, t0, prow); break; case 2: pool_win<8>(zp, t0, prow); break; default: pool_win<16>(zp, t0, prow); break; }
  }
  __syncthreads();
  const int wm = wave & 3, wn = wave >> 2, l32 = lane & 31, h = lane >> 5;
  f32x16 acc[2][2]; acc[0][0] = zero16(); acc[0][1] = zero16(); acc[1][0] = zero16(); acc[1][1] = zero16();
  const u16* W = (const u16*)(p.ws + WS_PWT) + (size_t)(layer * 4 + wm) * 64 * 64;
#pragma unroll
  for (int kk = 0; kk < 4; ++kk) {
    bf16x8 a0 = *(const bf16x8*)(W + (l32) * 64 + kk * 16 + h * 8);
    bf16x8 a1 = *(const bf16x8*)(W + (32 + l32) * 64 + kk * 16 + h * 8);
    bf16x8 b0 = *(const bf16x8*)(pl + (wn * 64 + l32) * 264 + wm * 64 + kk * 16 + h * 8);
    bf16x8 b1 = *(const bf16x8*)(pl + (wn * 64 + 32 + l32) * 264 + wm * 64 + kk * 16 + h * 8);
    acc[0][0] = MFMA(a0, b0, acc[0][0]); acc[0][1] = MFMA(a0, b1, acc[0][1]);
    acc[1][0] = MFMA(a1, b0, acc[1][0]); acc[1][1] = MFMA(a1, b1, acc[1][1]);
  }
  u16* Y = (u16*)(p.ws + WS_HY);
#pragma unroll
  for (int nt = 0; nt < 2; ++nt) {
    const int t = n0 + wn * 64 + nt * 32 + l32;
#pragma unroll
    for (int mt = 0; mt < 2; ++mt)
#pragma unroll
      for (int q = 0; q < 4; ++q) {
        const int c = wm * 64 + mt * 32 + q * 8 + h * 4;
        const f32x4 sc = *(const f32x4*)(p.pool_scale + layer * 256 + c);
        const u32x2 g = *(const u32x2*)(z + (size_t)t * ZLD + Z_PG + c);
        const float o0 = acc[mt][nt][q * 4] * sc[0] * silu(bflo(g[0])), o1 = acc[mt][nt][q * 4 + 1] * sc[1] * silu(bfhi(g[0]));
        const float o2 = acc[mt][nt][q * 4 + 2] * sc[2] * silu(bflo(g[1])), o3 = acc[mt][nt][q * 4 + 3] * sc[3] * silu(bfhi(g[1]));
        u32x2 v = {pack2(o0, o1), pack2(o2, o3)};
        *(u32x2*)(Y + (size_t)t * DM + 256 + c) = v;
      }
  }
}

DI void att_qk(f32x16& s, const unsigned char* krow, const bf16x8 (&qf)[12], float m) {
  bf16x8 ka[4], kb[4];
#pragma unroll
  for (int i = 0; i < 4; ++i) ka[i] = *(const bf16x8*)(krow + i * 32);
#pragma unroll
  for (int i = 0; i < 4; ++i) kb[i] = *(const bf16x8*)(krow + (4 + i) * 32);
  const float nm = -m;
#pragma unroll
  for (int i = 0; i < 16; ++i) s[i] = nm;
  __builtin_amdgcn_sched_barrier(0);
#pragma unroll
  for (int i = 0; i < 4; ++i) s = MFMA(ka[i], qf[i], s);
  __builtin_amdgcn_sched_barrier(0);
#pragma unroll
  for (int i = 0; i < 4; ++i) ka[i] = *(const bf16x8*)(krow + (8 + i) * 32);
  __builtin_amdgcn_sched_barrier(0);
#pragma unroll
  for (int i = 0; i < 4; ++i) s = MFMA(kb[i], qf[4 + i], s);
  __builtin_amdgcn_sched_barrier(0);
#pragma unroll
  for (int i = 0; i < 4; ++i) s = MFMA(ka[i], qf[8 + i], s);
  __builtin_amdgcn_sched_barrier(0);
}
DI void att_sm_pv(f32x16& s, const unsigned char* vrow, f32x16 (&O)[4], float& m, float& l, bool first) {
  bf16x8 vf[8];
#pragma unroll
  for (int mt = 0; mt < 4; ++mt) { vf[2 * mt] = *(const bf16x8*)(vrow + mt * 32 * 144); vf[2 * mt + 1] = *(const bf16x8*)(vrow + mt * 32 * 144 + 32); }
  __builtin_amdgcn_sched_barrier(0);
  float mx = fmaxf(fmaxf(s[0], s[1]), s[2]);
#pragma unroll
  for (int i = 3; i < 15; i += 2) mx = fmaxf(fmaxf(mx, s[i]), s[i + 1]);
  mx = fmaxf(mx, s[15]);
  if (first || __builtin_amdgcn_ballot_w64(mx > 8.f) != 0) {
    const float mxx = fmaxf(mx, __shfl_xor(mx, 32));
    const float d = first ? mxx : fmaxf(mxx, 0.f);
    const float alpha = first ? 1.f : ex2(-d);
    m += d; l *= alpha;
#pragma unroll
    for (int i = 0; i < 16; ++i) s[i] -= d;
#pragma unroll
    for (int mt = 0; mt < 4; ++mt)
#pragma unroll
      for (int i = 0; i < 16; ++i) O[mt][i] *= alpha;
  }
  float ps0 = 0.f, ps1 = 0.f;
#pragma unroll
  for (int i = 0; i < 16; i += 2) { s[i] = ex2(s[i]); s[i + 1] = ex2(s[i + 1]); ps0 += s[i]; ps1 += s[i + 1]; }
  l += ps0 + ps1;
  u32x4 p0 = {pack2(s[0], s[1]), pack2(s[2], s[3]), pack2(s[4], s[5]), pack2(s[6], s[7])};
  u32x4 p1 = {pack2(s[8], s[9]), pack2(s[10], s[11]), pack2(s[12], s[13]), pack2(s[14], s[15])};
  const bf16x8 pf0 = __builtin_bit_cast(bf16x8, p0), pf1 = __builtin_bit_cast(bf16x8, p1);
#pragma unroll
  for (int mt = 0; mt < 4; ++mt) { O[mt] = MFMA(vf[2 * mt], pf0, O[mt]); O[mt] = MFMA(vf[2 * mt + 1], pf1, O[mt]); }
}
DI void attn_item(unsigned char* lds, const P& p, int hd, int qb) {
  const int tid = otid(), lane = tid & 63, wave = wave_of(tid);
  const int wq = wave & 3, wk = wave >> 2, l32 = lane & 31, h = lane >> 5;
  const u16* Qg = (const u16*)(p.ws + WS_Q) + ((size_t)hd * S + qb * 128 + wq * 32 + l32) * 192 + h * 8;
  bf16x8 qf[12];
#pragma unroll
  for (int ks = 0; ks < 12; ++ks) qf[ks] = *(const bf16x8*)(Qg + ks * 16);
  const int ntile = 2 * qb + 2, mychunk = 2 * qb + (wq >> 1);
  const u16* Kg = (const u16*)(p.ws + WS_K) + (size_t)hd * S * 192 + tid * 8;
  const u16* Vg = (const u16*)(p.ws + WS_VT) + (size_t)hd * S * 128 + tid * 8;
  int kdst[3], vdst[2];
#pragma unroll
  for (int i = 0; i < 3; ++i) { const int c = tid + i * NT; kdst[i] = (c / 24) * 400 + (c % 24) * 16; }
#pragma unroll
  for (int i = 0; i < 2; ++i) { const int c = tid + i * NT; vdst[i] = 64 * 400 + (c >> 3) * 144 + (c & 7) * 16; }
  const int koff = (wk * 32 + l32) * 400 + h * 16;
  const int voff = 64 * 400 + l32 * 144 + (wk * 32 + h * 8) * 2;
  f32x16 O[4]; O[0] = zero16(); O[1] = zero16(); O[2] = zero16(); O[3] = zero16();
  float m = 0.f, l = 0.f;
  u32x4 rkA[3], rvA[2], rkB[3], rvB[2];
#define ATT_GLOAD(RK, RV, T) do { _Pragma("unroll") for (int i = 0; i < 3; ++i) RK[i] = *(const u32x4*)(Kg + (size_t)(T) * 64 * 192 + i * NT * 8); \
                                  _Pragma("unroll") for (int i = 0; i < 2; ++i) RV[i] = *(const u32x4*)(Vg + (size_t)(T) * 128 * 64 + i * NT * 8); } while (0)
#define ATT_LSTORE(RK, RV, ST) do { unsigned char* st_ = lds + (ST) * ATT_STAGE; _Pragma("unroll") for (int i = 0; i < 3; ++i) *(u32x4*)(st_ + kdst[i]) = RK[i]; \
                                    _Pragma("unroll") for (int i = 0; i < 2; ++i) *(u32x4*)(st_ + vdst[i]) = RV[i]; } while (0)
#define ATT_STEP(KT, RLK, RLV, RSK, RSV) do { \
    ATT_GLOAD(RLK, RLV, min((KT) + 2, ntile - 1));     \
    if ((KT) <= mychunk) { f32x16 s; att_qk(s, lds + ((KT) & 1) * ATT_STAGE + koff, qf, m); att_sm_pv(s, lds + ((KT) & 1) * ATT_STAGE + voff, O, m, l, (KT) == 0); } \
    if ((KT) + 1 < ntile) ATT_LSTORE(RSK, RSV, ((KT) + 1) & 1); \
    lds_barrier(); } while (0)
  ATT_GLOAD(rkA, rvA, 0);
  ATT_GLOAD(rkB, rvB, 1);
  ATT_LSTORE(rkA, rvA, 0);
  __syncthreads();
#pragma unroll 1
  for (int kt = 0; kt < ntile; kt += 2) {
    ATT_STEP(kt, rkA, rvA, rkB, rvB);
    ATT_STEP(kt + 1, rkB, rvB, rkA, rvA);
  }
  const float lt = l + __shfl_xor(l, 32);
  float* cO = (float*)lds; float* cm = (float*)(lds + 65536);
  if (wk == 1) {
#pragma unroll
    for (int mt = 0; mt < 4; ++mt)
#pragma unroll
      for (int i = 0; i < 16; ++i) cO[(wq * 64 + mt * 16 + i) * 64 + lane] = O[mt][i];
    cm[wq * 64 + lane] = m; cm[256 + wq * 64 + lane] = lt;
  }
  __syncthreads();
  if (wk == 0) {
    const float m1 = cm[wq * 64 + lane], l1 = cm[256 + wq * 64 + lane];
    const float mm = fmaxf(m, m1); float a0 = ex2(m - mm), a1 = ex2(m1 - mm);
    const float inv = 1.f / (lt * a0 + l1 * a1); a0 *= inv; a1 *= inv;
    const int t = qb * 128 + wq * 32 + l32;
    const u16* zg = (const u16*)(p.ws + WS_Z) + (size_t)t * ZLD + Z_MG + hd * 128;
    u16* Y = (u16*)(p.ws + WS_HY) + (size_t)t * DM + 512 + hd * 128;
#pragma unroll
    for (int mt = 0; mt < 4; ++mt)
#pragma unroll
      for (int q = 0; q < 4; ++q) {
        const int dv = mt * 32 + q * 8 + h * 4;
        const u32x2 g = *(const u32x2*)(zg + dv);
        float o[4];
#pragma unroll
        for (int j = 0; j < 4; ++j) o[j] = O[mt][q * 4 + j] * a0 + cO[(wq * 64 + mt * 16 + q * 4 + j) * 64 + lane] * a1;
        u32x2 v = {pack2(o[0] * silu(bflo(g[0])), o[1] * silu(bfhi(g[0]))), pack2(o[2] * silu(bflo(g[1])), o[3] * silu(bfhi(g[1])))};
        *(u32x2*)(Y + dv) = v;
      }
  }
  __syncthreads();
}

DI void transpose_tile(unsigned char* lds, const float* __restrict__ src, int ldsrc, u16* __restrict__ dst, int ldd, int k0, int n0, int nvalid, const float* gain) {
  float* tile = (float*)lds;
  const int tid = otid();
#pragma unroll
  for (int i = 0; i < 8; ++i) { const int idx = tid + i * NT, r = idx >> 6, cc = idx & 63, n = n0 + cc;
    float v = (n < nvalid) ? src[(size_t)(k0 + r) * ldsrc + n] : 0.f; if (gain) v *= gain[k0 + r]; tile[r * 65 + cc] = v; }
  __syncthreads();
#pragma unroll
  for (int i = 0; i < 8; ++i) { const int idx = tid + i * NT, r = idx >> 6, cc = idx & 63; dst[(size_t)(n0 + r) * ldd + k0 + cc] = tobf(tile[cc * 65 + r]); }
  __syncthreads();
}
DI float wave_sum(float v) { v += __shfl_xor(v, 32); v += __shfl_xor(v, 16); v += __shfl_xor(v, 8); v += __shfl_xor(v, 4); v += __shfl_xor(v, 2); v += __shfl_xor(v, 1); return v; }
DI void prenorm_row(const f32x4 (&v)[4], const float* g, u16* hrow, int lane) {
  float ss = 0.f;
#pragma unroll
  for (int i = 0; i < 4; ++i) ss += v[i][0] * v[i][0] + v[i][1] * v[i][1] + v[i][2] * v[i][2] + v[i][3] * v[i][3];
  ss = wave_sum(ss);
  const float r = rsqrtf(ss * (1.f / 1024.f) + EPS);
#pragma unroll
  for (int i = 0; i < 4; ++i) { const f32x4 gg = *(const f32x4*)(g + (lane + 64 * i) * 4);
    u32x2 o = {pack2(v[i][0] * r * gg[0], v[i][1] * r * gg[1]), pack2(v[i][2] * r * gg[2], v[i][3] * r * gg[3])};
    *(u32x2*)(hrow + (lane + 64 * i) * 4) = o; }
}

DI void phase_prep(unsigned char* lds, const P& p) {
  const int nb = gridDim.x, bid = blockIdx.x, tid = otid();
  u16* win = (u16*)(p.ws + WS_WIN); u16* wuq = (u16*)(p.ws + WS_WUQ); u16* wukv = (u16*)(p.ws + WS_WUKV); u16* wout = (u16*)(p.ws + WS_WOUT);
  for (int job = bid; job < 2 * 1032; job += nb) {
    const int layer = job / 1032; int r = job - layer * 1032;
    if (r < 640) { const int kt = r / 40, nt = r - kt * 40; transpose_tile(lds, p.w_in + (size_t)layer * 1024 * DIN, DIN, win + (size_t)layer * 2560 * 1024, 1024, kt * 64, nt * 64, DIN, nullptr); }
    else if (r < 712) { r -= 640; const int kt = r / 12, nt = r - kt * 12; transpose_tile(lds, p.w_uq + (size_t)layer * 384 * 768, 768, wuq + (size_t)layer * 768 * 384, 384, kt * 64, nt * 64, 768, p.q_norm_g + layer * 384); }
    else if (r < 776) { r -= 712; const int kt = r / 16, nt = r - kt * 16; transpose_tile(lds, p.w_ukv + (size_t)layer * 256 * 1024, 1024, wukv + (size_t)layer * 1024 * 256, 256, kt * 64, nt * 64, 1024, p.kv_norm_g + layer * 256); }
    else { r -= 776; const int kt = r / 16, nt = r - kt * 16; transpose_tile(lds, p.w_out + (size_t)layer * 1024 * 1024, 1024, wout + (size_t)layer * 1024 * 1024, 1024, kt * 64, nt * 64, 1024, nullptr); }
  }
  const int gtid = bid * NT + tid, gn = nb * NT;
  u16* sguw = (u16*)(p.ws + WS_SGUW);
  for (int idx = gtid; idx < 2 * 4 * 128 * 128; idx += gn) { const int i = (idx >> 7) & 127, j = idx & 127; sguw[idx] = ((j >> 6) <= (i >> 6)) ? tobf(p.sgu_w[idx]) : (u16)0; }
  u16* pwt = (u16*)(p.ws + WS_PWT);
  for (int idx = gtid; idx < 2 * 4 * 64 * 64; idx += gn) { const int lg = idx >> 12, d = (idx >> 6) & 63, c = idx & 63; pwt[idx] = tobf(p.pool_w[(lg * 64 + c) * 64 + d]); }
  float* cosT = (float*)(p.ws + WS_COS); float* sinT = (float*)(p.ws + WS_SIN);
  for (int idx = gtid; idx < S * 32; idx += gn) {
    const int t = idx >> 5, i = idx & 31; const float angf = (float)p.pos[t] * p.invfreq[i];
    const double a = (double)angf; const double k = rint(a * 0.15915494309189535); const double r = a - k * 6.283185307179586; const double r2 = r * r;
    double ts = r, ss = r, tc = 1.0, sc = 1.0;
#pragma unroll
    for (int n = 1; n <= 13; ++n) { ts *= -r2 * (1.0 / (double)((2 * n) * (2 * n + 1))); ss += ts; tc *= -r2 * (1.0 / (double)((2 * n - 1) * (2 * n))); sc += tc; }
    cosT[idx] = (float)sc; sinT[idx] = (float)ss;
  }
  u16* hb = (u16*)(p.ws + WS_HY);
  const int lane = tid & 63, wave = wave_of(tid);
  for (int row = bid * 8 + wave; row < S; row += nb * 8) {
    f32x4 v[4];
#pragma unroll
    for (int i = 0; i < 4; ++i) v[i] = *(const f32x4*)(p.x + (size_t)row * DM + (lane + 64 * i) * 4);
    prenorm_row(v, p.pre_g, hb + (size_t)row * DM, lane);
  }
}

DI void phase_post(const P& p, int layer) {
  const int nb = gridDim.x, bid = blockIdx.x, tid = otid(), lane = tid & 63, wave = wave_of(tid);
  const u16* yout = (const u16*)(p.ws + WS_Z); const float* xold = layer == 0 ? p.x : p.out;
  u16* hb = (u16*)(p.ws + WS_HY);
  for (int row = bid * 8 + wave; row < S; row += nb * 8) {
    f32x4 y[4]; float ss = 0.f;
#pragma unroll
    for (int i = 0; i < 4; ++i) { const u32x2 yb = *(const u32x2*)(yout + (size_t)row * DM + (lane + 64 * i) * 4); y[i] = (f32x4){bflo(yb[0]), bfhi(yb[0]), bflo(yb[1]), bfhi(yb[1])}; ss += y[i][0] * y[i][0] + y[i][1] * y[i][1] + y[i][2] * y[i][2] + y[i][3] * y[i][3]; }
    ss = wave_sum(ss);
    const float r = rsqrtf(ss * (1.f / 1024.f) + EPS);
#pragma unroll
    for (int i = 0; i < 4; ++i) {
      const f32x4 g = *(const f32x4*)(p.post_g + layer * DM + (lane + 64 * i) * 4); const f32x4 xo = *(const f32x4*)(xold + (size_t)row * DM + (lane + 64 * i) * 4);
      y[i] = xo + y[i] * r * g;
      *(f32x4*)(p.out + (size_t)row * DM + (lane + 64 * i) * 4) = y[i];
    }
    if (layer + 1 < DEPTH) prenorm_row(y, p.pre_g + (layer + 1) * DM, hb + (size_t)row * DM, lane);
  }
}

__global__ void __launch_bounds__(NT) mega(P p) {
  extern __shared__ __attribute__((aligned(16))) unsigned char lds[];
  cg::grid_group grid = cg::this_grid();
  const int nb = gridDim.x, bid = blockIdx.x;
  if (threadIdx.x < 4) ((unsigned*)(lds + XB_LDS_OFF))[threadIdx.x] = 0u;
  __syncthreads();
  XcdBarrier xbar = xcd_barrier_post((unsigned*)(p.ws + WS_BAR), (volatile LAS unsigned*)(lds + XB_LDS_OFF));
  unsigned* xcnt = (unsigned*)(p.ws + WS_BAR + 14336);
  unsigned myslot = 0;
  if (threadIdx.x == 0) myslot = xb_add(&xcnt[16 * xbar.x], 1u);
  int vid = bid;
  int ph = 0;
#define RUN(ph_) ((ph_) >= p.ph_lo && (ph_) < p.ph_hi)
#define SEAM(ph_) do { if (RUN(ph_) && RUN((ph_) + 1)) { if (p.ph_hi < 0) grid.sync(); else xcd_barrier(xbar); } } while (0)
  for (int rep = 0; rep < (DUP == 5 ? 2 : 1); ++rep)
  if (RUN(ph)) phase_prep(lds, p);
  SEAM(ph); ++ph;
  if (p.ph_hi - p.ph_lo > 1) {
    if (threadIdx.x == 0) { bool even = (nb & 7) == 0; for (int j = 0; j < 8; ++j) even = even && (xb_ld(&xcnt[16 * j]) == (unsigned)(nb >> 3));
      ((volatile LAS unsigned*)(lds + XB_LDS_OFF))[2] = even ? (myslot * 8u + xbar.x) : (unsigned)bid; }
    __syncthreads();
    vid = __builtin_amdgcn_readfirstlane((int)((volatile LAS unsigned*)(lds + XB_LDS_OFF))[2]);
  }
#pragma unroll 1
  for (int layer = 0; layer < DEPTH; ++layer) {
    u16* hy = (u16*)(p.ws + WS_HY); u16* z = (u16*)(p.ws + WS_Z);
    float* rs = (float*)(lds + RS_OFF);
    for (int rep = 0; rep < (DUP == 1 ? 2 : 1); ++rep)
    if (RUN(ph)) {
      const u16* W = (const u16*)(p.ws + WS_WIN) + (size_t)layer * 2560 * 1024;
      EpiZ e{z};
      for (int job = vid; job < 768; job += nb) { const int x = job & 7, j = job >> 3;
        if (j < 64) { const int mt = j & 7, tt = 8 * x + (j >> 3);
          gemm_tile<4>(lds, W + (size_t)mt * 256 * 1024, hy + (size_t)tt * 256 * 1024, 1024, 1024, mt * 256, tt * 256, e); }
        else { const int js = j - 64, mt = 8 + (js & 1), nt = 16 * x + (js >> 1);
          gemm_tile<2>(lds, W + (size_t)mt * 256 * 1024, hy + (size_t)nt * 128 * 1024, 1024, 1024, mt * 256, nt * 128, e); }
      }
    }
    SEAM(ph); ++ph;
    for (int rep = 0; rep < (DUP == 2 ? 2 : 1); ++rep)
    if (RUN(ph)) {
      const float* cosT = (const float*)(p.ws + WS_COS); const float* sinT = (const float*)(p.ws + WS_SIN);
      for (int job = vid; job < 1152; job += nb) {
        __syncthreads();
        const int x = job & 7, j = job >> 3;
        if (j < 48) { const int ntl = j / 3, mt = j - ntl * 3, n0 = (16 * x + ntl) * 128;
          const u16* X = z + (size_t)n0 * ZLD + Z_CQ; row_rstd(rs, X, ZLD, 384);
          EpiQ e{(u16*)(p.ws + WS_Q), cosT, sinT, rs, n0};
          gemm_tile<2>(lds, (const u16*)(p.ws + WS_WUQ) + (size_t)layer * 768 * 384 + (size_t)mt * 256 * 384, X, ZLD, 384, mt * 256, n0, e);
        } else if (j < 112) { const int j2 = j - 48, mt = j2 & 3, n0 = (16 * x + (j2 >> 2)) * 128;
          const u16* X = z + (size_t)n0 * ZLD + Z_CKV; row_rstd(rs, X, ZLD, 256);
          EpiKV e{(u16*)(p.ws + WS_K), (u16*)(p.ws + WS_VT), rs, n0};
          gemm_tile<2>(lds, (const u16*)(p.ws + WS_WUKV) + (size_t)layer * 1024 * 256 + (size_t)mt * 256 * 256, X, ZLD, 256, mt * 256, n0, e);
          if (mt == 0) krope_tile(p, n0);
        } else if (j < 128) sgu_job(lds, p, layer, 16 * x + (j - 112));
        else pool_job(lds, p, layer, 16 * x + (j - 128));
      }
    }
    SEAM(ph); ++ph;
    for (int rep = 0; rep < (DUP == 3 ? 2 : 1); ++rep)
    if (RUN(ph)) {
      for (int it = vid; it < 256; it += nb) {
        const int hd = (it & 7) >> 1, pr = (it >> 3) * 2 + (it & 1);
        attn_item(lds, p, hd, 127 - pr);
        attn_item(lds, p, hd, pr);
      }
    }
    SEAM(ph); ++ph;
    for (int rep = 0; rep < (DUP == 4 ? 2 : 1); ++rep)
    if (RUN(ph)) {
      const u16* W = (const u16*)(p.ws + WS_WOUT) + (size_t)layer * 1024 * 1024;
      EpiOut e{(u16*)(p.ws + WS_Z)};
      for (int job = vid; job < 256; job += nb) { const int x = job & 7, j = job >> 3, mt = j & 3, tt = 8 * x + (j >> 2);
        gemm_tile<4>(lds, W + (size_t)mt * 256 * 1024, hy + (size_t)tt * 256 * 1024, 1024, 1024, mt * 256, tt * 256, e); }
    }
    SEAM(ph); ++ph;
    for (int rep = 0; rep < ((DUP == 6 && layer == 0) ? 2 : 1); ++rep)
    if (RUN(ph)) phase_post(p, layer);
    SEAM(ph); ++ph;
  }
  if (p.ph_hi - p.ph_lo > 1) xcd_barrier(xbar);
}
constexpr int NPHASE = 1 + 5 * DEPTH;

extern "C" void kernel_launch(void* const* d_in, const int* in_sizes, int n_in, void* d_out, int out_size, void* d_ws, size_t ws_size, hipStream_t stream) {
  static int grid_blocks = 0;
  if (!grid_blocks) {
    int dev = 0, cus = 0, per_cu = 0;
    hipGetDevice(&dev);
    hipDeviceGetAttribute(&cus, hipDeviceAttributeMultiprocessorCount, dev);
    hipFuncSetAttribute((const void*)mega, hipFuncAttributeMaxDynamicSharedMemorySize, LDS_BYTES);
    hipOccupancyMaxActiveBlocksPerMultiprocessor(&per_cu, (const void*)mega, NT, LDS_BYTES);
    if (per_cu < 1) { fprintf(stderr, "occupancy query returned %d\n", per_cu); per_cu = 1; }
    if (per_cu > 1) per_cu = 1;
    grid_blocks = cus * per_cu;
    if (ws_size < WS_END) fprintf(stderr, "workspace too small: %zu < %zu\n", ws_size, (size_t)WS_END);
  }
  P p{};
  p.x = (const float*)d_in[0]; p.pos = (const int*)d_in[1]; p.pre_g = (const float*)d_in[2]; p.post_g = (const float*)d_in[3];
  p.w_in = (const float*)d_in[4]; p.sgu_w = (const float*)d_in[5]; p.sgu_b = (const float*)d_in[6]; p.sgu_ln_g = (const float*)d_in[7];
  p.sgu_ln_b = (const float*)d_in[8]; p.pool_w = (const float*)d_in[9]; p.pool_scale = (const float*)d_in[10]; p.q_norm_g = (const float*)d_in[11];
  p.w_uq = (const float*)d_in[12]; p.kv_norm_g = (const float*)d_in[13]; p.w_ukv = (const float*)d_in[14]; p.w_out = (const float*)d_in[15];
  p.out = (float*)d_out; p.ws = (unsigned char*)d_ws;
  for (int i = 0; i < 32; ++i) p.invfreq[i] = powf(10000.0f, -(float)(2 * i) / 64.0f);
  hipMemsetAsync((char*)d_ws + WS_BAR, 0, 16384, stream);
#if COOP
  p.ph_lo = 0; p.ph_hi = NPHASE;
  void* args[] = {&p};
  hipError_t e = hipLaunchCooperativeKernel((void*)mega, dim3(grid_blocks), dim3(NT), args, LDS_BYTES, stream);
  if (e != hipSuccess) fprintf(stderr, "cooperative launch failed: %s (grid %d)\n", hipGetErrorString(e), grid_blocks);
#else
  for (int ph = 0; ph < NPHASE; ++ph) { p.ph_lo = ph; p.ph_hi = ph + 1; hipLaunchKernelGGL(mega, dim3(grid_blocks), dim3(NT), LDS_BYTES, stream, p); }
#endif
}
```

```cpp
#include <hip/hip_runtime.h>
#include <hip/hip_cooperative_groups.h>
#include <cstdio>
#include <cmath>
namespace cg = cooperative_groups;

#define DI __device__ __forceinline__
typedef unsigned short u16;
using bf16x8 = __attribute__((ext_vector_type(8))) short;
using f32x16 = __attribute__((ext_vector_type(16))) float;
using f32x4  = __attribute__((ext_vector_type(4))) float;
using f32x2  = __attribute__((ext_vector_type(2))) float;
using u32x4  = __attribute__((ext_vector_type(4))) unsigned;
using u32x2  = __attribute__((ext_vector_type(2))) unsigned;
typedef __bf16 bf2_t __attribute__((ext_vector_type(2)));
#define MFMA(a, b, c) __builtin_amdgcn_mfma_f32_32x32x16_bf16((a), (b), (c), 0, 0, 0)

#ifndef COOP
#define COOP 1
#endif
#ifndef DUP
#define DUP 7
#endif

constexpr int S = 16384, DM = 1024, DIN = 2496, ZLD = 2560, NT = 512, DEPTH = 2;
constexpr float EPS = 1e-6f;
constexpr float QSCALE = 0.07216878364870322f * 1.4426950408889634f;
constexpr int Z_U = 0, Z_V = 256, Z_SG = 512, Z_PI = 768, Z_PG = 1024, Z_CQ = 1280, Z_CKV = 1664, Z_KR = 1920, Z_MG = 1984;

constexpr size_t WS_HY   = 0;
constexpr size_t WS_Z    = WS_HY + (size_t)S * 1024 * 2;
constexpr size_t WS_Q    = WS_Z + (size_t)S * ZLD * 2;
constexpr size_t WS_K    = WS_Q + (size_t)4 * S * 192 * 2;
constexpr size_t WS_VT   = WS_K + (size_t)4 * S * 192 * 2;
constexpr size_t WS_WIN  = WS_VT + (size_t)4 * S * 128 * 2;
constexpr size_t WS_WUQ  = WS_WIN + (size_t)2 * 2560 * 1024 * 2;
constexpr size_t WS_WUKV = WS_WUQ + (size_t)2 * 768 * 384 * 2;
constexpr size_t WS_WOUT = WS_WUKV + (size_t)2 * 1024 * 256 * 2;
constexpr size_t WS_SGUW = WS_WOUT + (size_t)2 * 1024 * 1024 * 2;
constexpr size_t WS_PWT  = WS_SGUW + (size_t)2 * 4 * 128 * 128 * 2;
constexpr size_t WS_COS  = WS_PWT + (size_t)2 * 4 * 64 * 64 * 2;
constexpr size_t WS_SIN  = WS_COS + (size_t)S * 32 * 4;
constexpr size_t WS_BAR  = WS_SIN + (size_t)S * 32 * 4;
constexpr size_t WS_END  = WS_BAR + 16384;

constexpr int GEMM_STAGE = 512 * 144;
constexpr int RS_OFF = 2 * GEMM_STAGE;
constexpr int XB_LDS_OFF = RS_OFF + 1024;
constexpr int LDS_BYTES = XB_LDS_OFF + 16;
constexpr int ATT_STAGE = 64 * 400 + 128 * 144;

struct P {
  const float* x; const int* pos; const float* pre_g; const float* post_g; const float* w_in; const float* sgu_w; const float* sgu_b;
  const float* sgu_ln_g; const float* sgu_ln_b; const float* pool_w; const float* pool_scale; const float* q_norm_g; const float* w_uq;
  const float* kv_norm_g; const float* w_ukv; const float* w_out;
  float* out; unsigned char* ws;
  float invfreq[32];
  int ph_lo, ph_hi;
};

DI int otid() { int t = threadIdx.x; asm volatile("" : "+v"(t)); return t; }
DI int wave_of(int tid) { return __builtin_amdgcn_readfirstlane(tid >> 6); }
DI void lds_barrier() { asm volatile("s_waitcnt lgkmcnt(0)" ::: "memory"); __builtin_amdgcn_s_barrier(); asm volatile("" ::: "memory"); }
DI unsigned pack2(float a, float b) { f32x2 v = {a, b}; return __builtin_bit_cast(unsigned, __builtin_convertvector(v, bf2_t)); }
DI u16 tobf(float a) { return (u16)(pack2(a, 0.f) & 0xffffu); }
DI float bflo(unsigned u) { return __uint_as_float(u << 16); }
DI float bfhi(unsigned u) { return __uint_as_float(u & 0xffff0000u); }
DI float silu(float x) { return x / (1.f + __expf(-x)); }
DI float ex2(float x) { return __builtin_amdgcn_exp2f(x); }
DI f32x16 zero16() { f32x16 z; for (int i = 0; i < 16; ++i) z[i] = 0.f; return z; }

#define XB_TMO      128
#define XB_XCNT(j)  (256  + 64 * (j))
#define XB_XSUB(j)  (1280 + 64 * (j))
#define XB_XGEN(j)  (2304 + 64 * (j))
#define XB_TOP      3328
#define XB_TOPGEN   3392
#define XCD_BAR_WORDS 3456
#define XB_SPIN_CAP (1u << 18)
#define LAS __attribute__((address_space(3)))

__device__ __forceinline__ unsigned xb_ld(unsigned* p)              { return __hip_atomic_load(p, __ATOMIC_RELAXED, __HIP_MEMORY_SCOPE_AGENT); }
__device__ __forceinline__ unsigned xb_add(unsigned* p, unsigned v) { return __hip_atomic_fetch_add(p, v, __ATOMIC_RELAXED, __HIP_MEMORY_SCOPE_AGENT); }
__device__ __forceinline__ unsigned xb_xcc_id() { return (unsigned)__builtin_amdgcn_s_getreg((3 << 11) | 20) & 0xFu; }
#define XB_SPIN(cond, bar) do { unsigned _sp = 0; while (cond) { __builtin_amdgcn_s_sleep(1); \
    if ((++_sp & 255u) == 0u) { if (xb_ld(&(bar)[XB_TMO])) break; if (_sp > XB_SPIN_CAP) { atomicAdd(&(bar)[XB_TMO], 1u); break; } } } } while (0)

struct XcdBarrier {
    unsigned* bar; unsigned x;
    volatile LAS unsigned* st;
};

__device__ __forceinline__ XcdBarrier xcd_barrier_post(unsigned* bar, volatile LAS unsigned* st) {
    XcdBarrier b; b.bar = bar; b.x = xb_xcc_id(); b.st = st;
    if (threadIdx.x == 0) (void)xb_add(&bar[XB_XCNT(b.x)], 1u);
    return b;
}
__device__ __forceinline__ void xcd_barrier_complete(unsigned* bar, unsigned x, unsigned& nloc, unsigned& nx) {
    const unsigned G = gridDim.x * gridDim.y * gridDim.z;
    unsigned sum, cnt, mine, sp = 0u;
    for (;;) {
        sum = 0u; cnt = 0u; mine = 0u;
#pragma unroll
        for (unsigned j = 0; j < 16; ++j) { const unsigned c = xb_ld(&bar[XB_XCNT(j)]); sum += c; cnt += (c > 0u) ? 1u : 0u; mine = (j == x) ? c : mine; }
        if (sum == G) break;
        __builtin_amdgcn_s_sleep(1);
        if ((++sp & 255u) == 0u) { if (xb_ld(&bar[XB_TMO])) break; if (sp > XB_SPIN_CAP) { atomicAdd(&bar[XB_TMO], 1u); break; } }
    }
    nloc = mine > 0u ? mine : 1u; nx = cnt > 0u ? cnt : 1u;
}

__device__ __forceinline__ void xcd_barrier(const XcdBarrier& b) {
    asm volatile("s_waitcnt vmcnt(0)" ::: "memory");
    __syncthreads();
    if (threadIdx.x == 0) {
        unsigned* bar = b.bar;
        __builtin_amdgcn_s_waitcnt(0);
        unsigned nloc = b.st[0], nx = b.st[1];
        if (nloc == 0u) { xcd_barrier_complete(bar, b.x, nloc, nx); b.st[0] = nloc; b.st[1] = nx; }
        const unsigned old = xb_add(&bar[XB_XSUB(b.x)], 1u);
        const unsigned gen = old / nloc;
        if (old + 1u == (gen + 1u) * nloc) {
            __builtin_amdgcn_fence(__ATOMIC_RELEASE, "agent");
            asm volatile("s_waitcnt vmcnt(0)" ::: "memory");
            const unsigned og = xb_add(&bar[XB_TOP], 1u);
            const unsigned tg = og / nx;
            if (og + 1u == (tg + 1u) * nx) xb_add(&bar[XB_TOPGEN], 1u);
            else XB_SPIN(xb_ld(&bar[XB_TOPGEN]) == tg, bar);
            __builtin_amdgcn_fence(__ATOMIC_ACQUIRE, "agent");
            xb_add(&bar[XB_XGEN(b.x)], 1u);
            asm volatile("s_waitcnt vmcnt(0)" ::: "memory");
        } else {
            XB_SPIN(xb_ld(&bar[XB_XGEN(b.x)]) == gen, bar);
            __builtin_amdgcn_fence(__ATOMIC_ACQUIRE, "agent");
            asm volatile("s_waitcnt vmcnt(0)" ::: "memory");
        }
    }
    __syncthreads();
}


template <int NTW, class Epi>
DI void gemm_tile(unsigned char* lds, const u16* __restrict__ A, const u16* __restrict__ X, int ldx, int K, int m0, int n0, Epi& epi) {
  const int tid = otid(), lane = tid & 63, wave = wave_of(tid);
  const int wm = wave & 3, wn = wave >> 2, l32 = lane & 31, h = lane >> 5;
  f32x16 acc[2][NTW];
#pragma unroll
  for (int i = 0; i < 2; ++i)
#pragma unroll
    for (int j = 0; j < NTW; ++j) acc[i][j] = zero16();
  const int nk = K >> 6;
  const int lrow = tid >> 3, lcol = tid & 7;
  const u16* ga = A + (size_t)lrow * K + lcol * 8;
  const u16* gx = X + (size_t)lrow * ldx + lcol * 8;
  u32x4 ra[4], rb[NTW];
#pragma unroll
  for (int i = 0; i < 4; ++i) ra[i] = *(const u32x4*)(ga + (size_t)i * 64 * K);
#pragma unroll
  for (int i = 0; i < NTW; ++i) rb[i] = *(const u32x4*)(gx + (size_t)i * 64 * ldx);
  {
    unsigned char* as = lds; unsigned char* bs = lds + 256 * 144;
#pragma unroll
    for (int i = 0; i < 4; ++i) *(u32x4*)(as + (lrow + i * 64) * 144 + lcol * 16) = ra[i];
#pragma unroll
    for (int i = 0; i < NTW; ++i) *(u32x4*)(bs + (lrow + i * 64) * 144 + lcol * 16) = rb[i];
  }
  __syncthreads();
#pragma unroll 1
  for (int ks = 0; ks < nk; ++ks) {
    const bool more = ks + 1 < nk;
    if (more) {
#pragma unroll
      for (int i = 0; i < 4; ++i) ra[i] = *(const u32x4*)(ga + (size_t)i * 64 * K + (ks + 1) * 64);
#pragma unroll
      for (int i = 0; i < NTW; ++i) rb[i] = *(const u32x4*)(gx + (size_t)i * 64 * ldx + (ks + 1) * 64);
    }
    const unsigned char* as = lds + (ks & 1) * GEMM_STAGE + (wm * 64 + l32) * 144 + h * 16;
    const unsigned char* bs = lds + (ks & 1) * GEMM_STAGE + 256 * 144 + (wn * NTW * 32 + l32) * 144 + h * 16;
#pragma unroll
    for (int kk = 0; kk < 4; ++kk) {
      bf16x8 a0 = *(const bf16x8*)(as + kk * 32), a1 = *(const bf16x8*)(as + 32 * 144 + kk * 32);
      bf16x8 b[NTW];
#pragma unroll
      for (int j = 0; j < NTW; ++j) b[j] = *(const bf16x8*)(bs + j * 32 * 144 + kk * 32);
#pragma unroll
      for (int j = 0; j < NTW; ++j) { acc[0][j] = MFMA(a0, b[j], acc[0][j]); acc[1][j] = MFMA(a1, b[j], acc[1][j]); }
    }
    if (more) {
      unsigned char* as2 = lds + ((ks + 1) & 1) * GEMM_STAGE; unsigned char* bs2 = as2 + 256 * 144;
#pragma unroll
      for (int i = 0; i < 4; ++i) *(u32x4*)(as2 + (lrow + i * 64) * 144 + lcol * 16) = ra[i];
#pragma unroll
      for (int i = 0; i < NTW; ++i) *(u32x4*)(bs2 + (lrow + i * 64) * 144 + lcol * 16) = rb[i];
    }
    __syncthreads();
  }
  epi(acc, m0 + wm * 64, n0 + wn * NTW * 32, l32, h);
}

struct EpiZ {
  u16* z;
  template <int NTW> DI void operator()(f32x16 (&acc)[2][NTW], int chb, int tokb, int l32, int h) {
#pragma unroll
    for (int nt = 0; nt < NTW; ++nt) { const int t = tokb + nt * 32 + l32;
#pragma unroll
      for (int mt = 0; mt < 2; ++mt)
#pragma unroll
        for (int q = 0; q < 4; ++q) {
          u32x2 v = {pack2(acc[mt][nt][q * 4], acc[mt][nt][q * 4 + 1]), pack2(acc[mt][nt][q * 4 + 2], acc[mt][nt][q * 4 + 3])};
          *(u32x2*)(z + (size_t)t * ZLD + chb + mt * 32 + q * 8 + h * 4) = v;
        }
    }
  }
};
struct EpiOut {
  u16* y;
  template <int NTW> DI void operator()(f32x16 (&acc)[2][NTW], int chb, int tokb, int l32, int h) {
#pragma unroll
    for (int nt = 0; nt < NTW; ++nt) { const int t = tokb + nt * 32 + l32;
#pragma unroll
      for (int mt = 0; mt < 2; ++mt)
#pragma unroll
        for (int q = 0; q < 4; ++q) {
          u32x2 v = {pack2(acc[mt][nt][q * 4], acc[mt][nt][q * 4 + 1]), pack2(acc[mt][nt][q * 4 + 2], acc[mt][nt][q * 4 + 3])};
          *(u32x2*)(y + (size_t)t * DM + chb + mt * 32 + q * 8 + h * 4) = v;
        }
    }
  }
};
struct EpiQ {
  u16* Q; const float* cosT; const float* sinT; const float* rs; int n0;
  template <int NTW> DI void operator()(f32x16 (&acc)[2][NTW], int chb, int tokb, int l32, int h) {
    const int seg = chb >> 6, head = seg / 3, part = seg - head * 3;
#pragma unroll
    for (int nt = 0; nt < NTW; ++nt) {
      const int t = tokb + nt * 32 + l32; const float r = rs[tokb - n0 + nt * 32 + l32] * QSCALE;
      u16* dst = Q + ((size_t)head * S + t) * 192;
      if (part < 2) {
#pragma unroll
        for (int mt = 0; mt < 2; ++mt)
#pragma unroll
          for (int q = 0; q < 4; ++q) {
            u32x2 v = {pack2(acc[mt][nt][q * 4] * r, acc[mt][nt][q * 4 + 1] * r), pack2(acc[mt][nt][q * 4 + 2] * r, acc[mt][nt][q * 4 + 3] * r)};
            *(u32x2*)(dst + part * 64 + mt * 32 + q * 8 + h * 4) = v;
          }
      } else {
#pragma unroll
        for (int q = 0; q < 4; ++q) {
          const int d = q * 8 + h * 4;
          const f32x4 c = *(const f32x4*)(cosT + (size_t)t * 32 + d), s = *(const f32x4*)(sinT + (size_t)t * 32 + d);
          float o1[4], o2[4];
#pragma unroll
          for (int j = 0; j < 4; ++j) { const float x1 = acc[0][nt][q * 4 + j], x2 = acc[1][nt][q * 4 + j]; o1[j] = (x1 * c[j] - x2 * s[j]) * r; o2[j] = (x2 * c[j] + x1 * s[j]) * r; }
          u32x2 v1 = {pack2(o1[0], o1[1]), pack2(o1[2], o1[3])}, v2 = {pack2(o2[0], o2[1]), pack2(o2[2], o2[3])};
          *(u32x2*)(dst + 128 + d) = v1; *(u32x2*)(dst + 160 + d) = v2;
        }
      }
    }
  }
};
DI int permpos(int k64) { const int kk = k64 & 15; return (k64 & 48) | (((kk >> 2) & 1) * 8 + (kk >> 3) * 4 + (kk & 3)); }
struct EpiKV {
  u16* K; u16* Vt; const float* rs; int n0;
  template <int NTW> DI void operator()(f32x16 (&acc)[2][NTW], int chb, int tokb, int l32, int h) {
    const int seg = chb >> 6, head = seg >> 2, part = seg & 3;
#pragma unroll
    for (int nt = 0; nt < NTW; ++nt) {
      const int t = tokb + nt * 32 + l32; const float r = rs[tokb - n0 + nt * 32 + l32];
      if (part < 2) {
        u16* dst = K + ((size_t)head * S + t) * 192 + part * 64;
#pragma unroll
        for (int mt = 0; mt < 2; ++mt)
#pragma unroll
          for (int q = 0; q < 4; ++q) {
            u32x2 v = {pack2(acc[mt][nt][q * 4] * r, acc[mt][nt][q * 4 + 1] * r), pack2(acc[mt][nt][q * 4 + 2] * r, acc[mt][nt][q * 4 + 3] * r)};
            *(u32x2*)(dst + mt * 32 + q * 8 + h * 4) = v;
          }
      } else {
        u16* dst = Vt + (((size_t)head * (S / 64) + (t >> 6)) * 128 + (part - 2) * 64) * 64 + permpos(t & 63);
#pragma unroll
        for (int mt = 0; mt < 2; ++mt)
#pragma unroll
          for (int i = 0; i < 16; ++i) { const int dv = mt * 32 + (i & 3) + 8 * (i >> 2) + 4 * h; dst[dv * 64] = tobf(acc[mt][nt][i] * r); }
      }
    }
  }
};

DI void row_rstd(float* rs, const u16* X, int ldx, int K) {
  const int tid = otid(), tl = tid >> 2, sub = tid & 3;
  const u16* src = X + (size_t)tl * ldx; float ss = 0.f;
  for (int c = sub; c < (K >> 3); c += 4) {
    u32x4 v = *(const u32x4*)(src + c * 8);
#pragma unroll
    for (int j = 0; j < 4; ++j) { const float a = bflo(v[j]), b = bfhi(v[j]); ss += a * a + b * b; }
  }
  ss += __shfl_xor(ss, 1); ss += __shfl_xor(ss, 2);
  if (sub == 0) rs[tl] = rsqrtf(ss / (float)K + EPS);
}

DI void krope_tile(const P& p, int n0) {
  const int tid = otid(), t = n0 + (tid >> 2), i0 = (tid & 3) * 8;
  const u16* z = (const u16*)(p.ws + WS_Z) + (size_t)t * ZLD + Z_KR;
  const float* cosT = (const float*)(p.ws + WS_COS) + (size_t)t * 32 + i0; const float* sinT = (const float*)(p.ws + WS_SIN) + (size_t)t * 32 + i0;
  u32x4 a = *(const u32x4*)(z + i0), b = *(const u32x4*)(z + 32 + i0);
  f32x4 c0 = *(const f32x4*)cosT, c1 = *(const f32x4*)(cosT + 4), s0 = *(const f32x4*)sinT, s1 = *(const f32x4*)(sinT + 4);
  float x1[8], x2[8], c[8], s[8];
#pragma unroll
  for (int j = 0; j < 4; ++j) { x1[2 * j] = bflo(a[j]); x1[2 * j + 1] = bfhi(a[j]); x2[2 * j] = bflo(b[j]); x2[2 * j + 1] = bfhi(b[j]); c[j] = c0[j]; c[4 + j] = c1[j]; s[j] = s0[j]; s[4 + j] = s1[j]; }
  u32x4 o1, o2;
#pragma unroll
  for (int j = 0; j < 4; ++j) {
    o1[j] = pack2(x1[2 * j] * c[2 * j] - x2[2 * j] * s[2 * j], x1[2 * j + 1] * c[2 * j + 1] - x2[2 * j + 1] * s[2 * j + 1]);
    o2[j] = pack2(x2[2 * j] * c[2 * j] + x1[2 * j] * s[2 * j], x2[2 * j + 1] * c[2 * j + 1] + x1[2 * j + 1] * s[2 * j + 1]);
  }
  u16* K = (u16*)(p.ws + WS_K);
#pragma unroll
  for (int hd = 0; hd < 4; ++hd) { u16* dst = K + ((size_t)hd * S + t) * 192 + 128 + i0; *(u32x4*)dst = o1; *(u32x4*)(dst + 32) = o2; }
}

DI void sgu_job(unsigned char* lds, const P& p, int layer, int nb) {
  const int tid = otid(), lane = tid & 63, wave = wave_of(tid);
  const int n0 = nb * 128;
  const u16* z = (const u16*)(p.ws + WS_Z);
  u16* vT = (u16*)lds;
  {
    const int j = tid >> 2, sub = tid & 3; const u16* src = z + (size_t)(n0 + j) * ZLD + Z_V + sub * 64;
    float v[64]; float s = 0.f;
#pragma unroll
    for (int c = 0; c < 8; ++c) { u32x4 u = *(const u32x4*)(src + c * 8);
#pragma unroll
      for (int k = 0; k < 4; ++k) { v[c * 8 + 2 * k] = bflo(u[k]); v[c * 8 + 2 * k + 1] = bfhi(u[k]); s += v[c * 8 + 2 * k] + v[c * 8 + 2 * k + 1]; } }
    s += __shfl_xor(s, 1); s += __shfl_xor(s, 2);
    const float mu = s * (1.f / 256.f); float q = 0.f;
#pragma unroll
    for (int c = 0; c < 64; ++c) { const float d = v[c] - mu; q += d * d; }
    q += __shfl_xor(q, 1); q += __shfl_xor(q, 2);
    const float rstd = rsqrtf(q * (1.f / 256.f) + EPS);
    const float* g = p.sgu_ln_g + layer * 256 + sub * 64; const float* b = p.sgu_ln_b + layer * 256 + sub * 64;
#pragma unroll
    for (int c4 = 0; c4 < 16; ++c4) { const f32x4 gg = *(const f32x4*)(g + c4 * 4), bb = *(const f32x4*)(b + c4 * 4);
#pragma unroll
      for (int k = 0; k < 4; ++k) vT[(sub * 64 + c4 * 4 + k) * 136 + j] = tobf((v[c4 * 4 + k] - mu) * rstd * gg[k] + bb[k]); }
  }
  __syncthreads();
  const int wm = wave & 3, wn = wave >> 2, l32 = lane & 31, h = lane >> 5;
  f32x16 acc[2][2]; acc[0][0] = zero16(); acc[0][1] = zero16(); acc[1][0] = zero16(); acc[1][1] = zero16();
  const u16* W = (const u16*)(p.ws + WS_SGUW) + (size_t)(layer * 4 + wm) * 128 * 128;
#pragma unroll
  for (int kk = 0; kk < 8; ++kk) {
    bf16x8 a0 = *(const bf16x8*)(vT + (wm * 64 + l32) * 136 + kk * 16 + h * 8);
    bf16x8 a1 = *(const bf16x8*)(vT + (wm * 64 + 32 + l32) * 136 + kk * 16 + h * 8);
    bf16x8 b0 = *(const bf16x8*)(W + (wn * 64 + l32) * 128 + kk * 16 + h * 8);
    bf16x8 b1 = *(const bf16x8*)(W + (wn * 64 + 32 + l32) * 128 + kk * 16 + h * 8);
    acc[0][0] = MFMA(a0, b0, acc[0][0]); acc[0][1] = MFMA(a0, b1, acc[0][1]);
    acc[1][0] = MFMA(a1, b0, acc[1][0]); acc[1][1] = MFMA(a1, b1, acc[1][1]);
  }
  u16* Y = (u16*)(p.ws + WS_HY);
#pragma unroll
  for (int nt = 0; nt < 2; ++nt) {
    const int i = wn * 64 + nt * 32 + l32, t = n0 + i; const float bias = p.sgu_b[(layer * 4 + wm) * 128 + i];
#pragma unroll
    for (int mt = 0; mt < 2; ++mt)
#pragma unroll
      for (int q = 0; q < 4; ++q) {
        const int c = wm * 64 + mt * 32 + q * 8 + h * 4;
        const u32x2 u = *(const u32x2*)(z + (size_t)t * ZLD + Z_U + c), g = *(const u32x2*)(z + (size_t)t * ZLD + Z_SG + c);
        const float o0 = bflo(u[0]) * (acc[mt][nt][q * 4] + bias) * silu(bflo(g[0])), o1 = bfhi(u[0]) * (acc[mt][nt][q * 4 + 1] + bias) * silu(bfhi(g[0]));
        const float o2 = bflo(u[1]) * (acc[mt][nt][q * 4 + 2] + bias) * silu(bflo(g[1])), o3 = bfhi(u[1]) * (acc[mt][nt][q * 4 + 3] + bias) * silu(bfhi(g[1]));
        u32x2 v = {pack2(o0, o1), pack2(o2, o3)};
        *(u32x2*)(Y + (size_t)t * DM + c) = v;
      }
  }
}

template <int W>
DI void pool_win(const u16* zp, int t0, u16* prow) {
  unsigned v[32 + W];
#pragma unroll
  for (int i = 0; i < 32 + W; ++i) { const int t = t0 - W + i; v[i] = (t >= 0) ? *(const unsigned*)(zp + (size_t)max(t, 0) * ZLD) : 0u; }
  float s0 = 0.f, s1 = 0.f;
#pragma unroll
  for (int i = 0; i < W; ++i) { s0 += bflo(v[i]); s1 += bfhi(v[i]); }
#pragma unroll
  for (int tt = 0; tt < 32; ++tt) {
    const float p0 = bflo(v[W + tt]), p1 = bfhi(v[W + tt]);
    s0 += p0 - bflo(v[tt]); s1 += p1 - bfhi(v[tt]);
    const float inv = 1.f / (float)min(t0 + tt + 1, W);
    *(unsigned*)(prow + tt * 264) = pack2(s0 * inv - p0, s1 * inv - p1);
  }
}
DI void pool_job(unsigned char* lds, const P& p, int layer, int nb) {
  const int tid = otid(), lane = tid & 63, wave = wave_of(tid);
  const int n0 = nb * 128;
  const u16* z = (const u16*)(p.ws + WS_Z);
  u16* pl = (u16*)lds;
  {
    const int g = wave & 3, c = g * 64 + (lane & 31) * 2, tq = (wave >> 2) * 2 + (lane >> 5);
    const u16* zp = z + Z_PI + c; const int t0 = n0 + tq * 32; u16* prow = pl + (tq * 32) * 264 + c;
    switch (g) { case 0: pool_win<2>(zp, t0, prow); break; case 1: pool_win<4>(zp, t0, prow); break; case 2: pool_win<8>(zp, t0, prow); break; default: pool_win<16>(zp, t0, prow); break; }
  }
  __syncthreads();
  const int wm = wave & 3, wn = wave >> 2, l32 = lane & 31, h = lane >> 5;
  f32x16 acc[2][2]; acc[0][0] = zero16(); acc[0][1] = zero16(); acc[1][0] = zero16(); acc[1][1] = zero16();
  const u16* W = (const u16*)(p.ws + WS_PWT) + (size_t)(layer * 4 + wm) * 64 * 64;
#pragma unroll
  for (int kk = 0; kk < 4; ++kk) {
    bf16x8 a0 = *(const bf16x8*)(W + (l32) * 64 + kk * 16 + h * 8);
    bf16x8 a1 = *(const bf16x8*)(W + (32 + l32) * 64 + kk * 16 + h * 8);
    bf16x8 b0 = *(const bf16x8*)(pl + (wn * 64 + l32) * 264 + wm * 64 + kk * 16 + h * 8);
    bf16x8 b1 = *(const bf16x8*)(pl + (wn * 64 + 32 + l32) * 264 + wm * 64 + kk * 16 + h * 8);
    acc[0][0] = MFMA(a0, b0, acc[0][0]); acc[0][1] = MFMA(a0, b1, acc[0][1]);
    acc[1][0] = MFMA(a1, b0, acc[1][0]); acc[1][1] = MFMA(a1, b1, acc[1][1]);
  }
  u16* Y = (u16*)(p.ws + WS_HY);
#pragma unroll
  for (int nt = 0; nt < 2; ++nt) {
    const int t = n0 + wn * 64 + nt * 32 + l32;
#pragma unroll
    for (int mt = 0; mt < 2; ++mt)
#pragma unroll
      for (int q = 0; q < 4; ++q) {
        const int c = wm * 64 + mt * 32 + q * 8 + h * 4;
        const f32x4 sc = *(const f32x4*)(p.pool_scale + layer * 256 + c);
        const u32x2 g = *(const u32x2*)(z + (size_t)t * ZLD + Z_PG + c);
        const float o0 = acc[mt][nt][q * 4] * sc[0] * silu(bflo(g[0])), o1 = acc[mt][nt][q * 4 + 1] * sc[1] * silu(bfhi(g[0]));
        const float o2 = acc[mt][nt][q * 4 + 2] * sc[2] * silu(bflo(g[1])), o3 = acc[mt][nt][q * 4 + 3] * sc[3] * silu(bfhi(g[1]));
        u32x2 v = {pack2(o0, o1), pack2(o2, o3)};
        *(u32x2*)(Y + (size_t)t * DM + 256 + c) = v;
      }
  }
}

DI void att_qk(f32x16& s, const unsigned char* krow, const bf16x8 (&qf)[12], float m) {
  bf16x8 ka[4], kb[4];
#pragma unroll
  for (int i = 0; i < 4; ++i) ka[i] = *(const bf16x8*)(krow + i * 32);
#pragma unroll
  for (int i = 0; i < 4; ++i) kb[i] = *(const bf16x8*)(krow + (4 + i) * 32);
  const float nm = -m;
#pragma unroll
  for (int i = 0; i < 16; ++i) s[i] = nm;
  __builtin_amdgcn_sched_barrier(0);
#pragma unroll
  for (int i = 0; i < 4; ++i) s = MFMA(ka[i], qf[i], s);
  __builtin_amdgcn_sched_barrier(0);
#pragma unroll
  for (int i = 0; i < 4; ++i) ka[i] = *(const bf16x8*)(krow + (8 + i) * 32);
  __builtin_amdgcn_sched_barrier(0);
#pragma unroll
  for (int i = 0; i < 4; ++i) s = MFMA(kb[i], qf[4 + i], s);
  __builtin_amdgcn_sched_barrier(0);
#pragma unroll
  for (int i = 0; i < 4; ++i) s = MFMA(ka[i], qf[8 + i], s);
  __builtin_amdgcn_sched_barrier(0);
}
DI void att_sm_pv(f32x16& s, const unsigned char* vrow, f32x16 (&O)[4], float& m, float& l, bool first) {
  bf16x8 vf[8];
#pragma unroll
  for (int mt = 0; mt < 4; ++mt) { vf[2 * mt] = *(const bf16x8*)(vrow + mt * 32 * 144); vf[2 * mt + 1] = *(const bf16x8*)(vrow + mt * 32 * 144 + 32); }
  __builtin_amdgcn_sched_barrier(0);
  float mx = fmaxf(fmaxf(s[0], s[1]), s[2]);
#pragma unroll
  for (int i = 3; i < 15; i += 2) mx = fmaxf(fmaxf(mx, s[i]), s[i + 1]);
  mx = fmaxf(mx, s[15]);
  if (first || __builtin_amdgcn_ballot_w64(mx > 8.f) != 0) {
    const float mxx = fmaxf(mx, __shfl_xor(mx, 32));
    const float d = first ? mxx : fmaxf(mxx, 0.f);
    const float alpha = first ? 1.f : ex2(-d);
    m += d; l *= alpha;
#pragma unroll
    for (int i = 0; i < 16; ++i) s[i] -= d;
#pragma unroll
    for (int mt = 0; mt < 4; ++mt)
#pragma unroll
      for (int i = 0; i < 16; ++i) O[mt][i] *= alpha;
  }
  float ps0 = 0.f, ps1 = 0.f;
#pragma unroll
  for (int i = 0; i < 16; i += 2) { s[i] = ex2(s[i]); s[i + 1] = ex2(s[i + 1]); ps0 += s[i]; ps1 += s[i + 1]; }
  l += ps0 + ps1;
  u32x4 p0 = {pack2(s[0], s[1]), pack2(s[2], s[3]), pack2(s[4], s[5]), pack2(s[6], s[7])};
  u32x4 p1 = {pack2(s[8], s[9]), pack2(s[10], s[11]), pack2(s[12], s[13]), pack2(s[14], s[15])};
  const bf16x8 pf0 = __builtin_bit_cast(bf16x8, p0), pf1 = __builtin_bit_cast(bf16x8, p1);
#pragma unroll
  for (int mt = 0; mt < 4; ++mt) { O[mt] = MFMA(vf[2 * mt], pf0, O[mt]); O[mt] = MFMA(vf[2 * mt + 1], pf1, O[mt]); }
}
DI void attn_item(unsigned char* lds, const P& p, int hd, int qb) {
  const int tid = otid(), lane = tid & 63, wave = wave_of(tid);
  const int wq = wave & 3, wk = wave >> 2, l32 = lane & 31, h = lane >> 5;
  const u16* Qg = (const u16*)(p.ws + WS_Q) + ((size_t)hd * S + qb * 128 + wq * 32 + l32) * 192 + h * 8;
  bf16x8 qf[12];
#pragma unroll
  for (int ks = 0; ks < 12; ++ks) qf[ks] = *(const bf16x8*)(Qg + ks * 16);
  const int ntile = 2 * qb + 2, mychunk = 2 * qb + (wq >> 1);
  const u16* Kg = (const u16*)(p.ws + WS_K) + (size_t)hd * S * 192 + tid * 8;
  const u16* Vg = (const u16*)(p.ws + WS_VT) + (size_t)hd * S * 128 + tid * 8;
  int kdst[3], vdst[2];
#pragma unroll
  for (int i = 0; i < 3; ++i) { const int c = tid + i * NT; kdst[i] = (c / 24) * 400 + (c % 24) * 16; }
#pragma unroll
  for (int i = 0; i < 2; ++i) { const int c = tid + i * NT; vdst[i] = 64 * 400 + (c >> 3) * 144 + (c & 7) * 16; }
  const int koff = (wk * 32 + l32) * 400 + h * 16;
  const int voff = 64 * 400 + l32 * 144 + (wk * 32 + h * 8) * 2;
  f32x16 O[4]; O[0] = zero16(); O[1] = zero16(); O[2] = zero16(); O[3] = zero16();
  float m = 0.f, l = 0.f;
  u32x4 rkA[3], rvA[2], rkB[3], rvB[2];
#define ATT_GLOAD(RK, RV, T) do { _Pragma("unroll") for (int i = 0; i < 3; ++i) RK[i] = *(const u32x4*)(Kg + (size_t)(T) * 64 * 192 + i * NT * 8); \
                                  _Pragma("unroll") for (int i = 0; i < 2; ++i) RV[i] = *(const u32x4*)(Vg + (size_t)(T) * 128 * 64 + i * NT * 8); } while (0)
#define ATT_LSTORE(RK, RV, ST) do { unsigned char* st_ = lds + (ST) * ATT_STAGE; _Pragma("unroll") for (int i = 0; i < 3; ++i) *(u32x4*)(st_ + kdst[i]) = RK[i]; \
                                    _Pragma("unroll") for (int i = 0; i < 2; ++i) *(u32x4*)(st_ + vdst[i]) = RV[i]; } while (0)
#define ATT_STEP(KT, RLK, RLV, RSK, RSV) do { \
    ATT_GLOAD(RLK, RLV, min((KT) + 2, ntile - 1));     \
    if ((KT) <= mychunk) { f32x16 s; att_qk(s, lds + ((KT) & 1) * ATT_STAGE + koff, qf, m); att_sm_pv(s, lds + ((KT) & 1) * ATT_STAGE + voff, O, m, l, (KT) == 0); } \
    if ((KT) + 1 < ntile) ATT_LSTORE(RSK, RSV, ((KT) + 1) & 1); \
    lds_barrier(); } while (0)
  ATT_GLOAD(rkA, rvA, 0);
  ATT_GLOAD(rkB, rvB, 1);
  ATT_LSTORE(rkA, rvA, 0);
  __syncthreads();
#pragma unroll 1
  for (int kt = 0; kt < ntile; kt += 2) {
    ATT_STEP(kt, rkA, rvA, rkB, rvB);
    ATT_STEP(kt + 1, rkB, rvB, rkA, rvA);
  }
  const float lt = l + __shfl_xor(l, 32);
  float* cO = (float*)lds; float* cm = (float*)(lds + 65536);
  if (wk == 1) {
#pragma unroll
    for (int mt = 0; mt < 4; ++mt)
#pragma unroll
      for (int i = 0; i < 16; ++i) cO[(wq * 64 + mt * 16 + i) * 64 + lane] = O[mt][i];
    cm[wq * 64 + lane] = m; cm[256 + wq * 64 + lane] = lt;
  }
  __syncthreads();
  if (wk == 0) {
    const float m1 = cm[wq * 64 + lane], l1 = cm[256 + wq * 64 + lane];
    const float mm = fmaxf(m, m1); float a0 = ex2(m - mm), a1 = ex2(m1 - mm);
    const float inv = 1.f / (lt * a0 + l1 * a1); a0 *= inv; a1 *= inv;
    const int t = qb * 128 + wq * 32 + l32;
    const u16* zg = (const u16*)(p.ws + WS_Z) + (size_t)t * ZLD + Z_MG + hd * 128;
    u16* Y = (u16*)(p.ws + WS_HY) + (size_t)t * DM + 512 + hd * 128;
#pragma unroll
    for (int mt = 0; mt < 4; ++mt)
#pragma unroll
      for (int q = 0; q < 4; ++q) {
        const int dv = mt * 32 + q * 8 + h * 4;
        const u32x2 g = *(const u32x2*)(zg + dv);
        float o[4];
#pragma unroll
        for (int j = 0; j < 4; ++j) o[j] = O[mt][q * 4 + j] * a0 + cO[(wq * 64 + mt * 16 + q * 4 + j) * 64 + lane] * a1;
        u32x2 v = {pack2(o[0] * silu(bflo(g[0])), o[1] * silu(bfhi(g[0]))), pack2(o[2] * silu(bflo(g[1])), o[3] * silu(bfhi(g[1])))};
        *(u32x2*)(Y + dv) = v;
      }
  }
  __syncthreads();
}

DI void transpose_tile(unsigned char* lds, const float* __restrict__ src, int ldsrc, u16* __restrict__ dst, int ldd, int k0, int n0, int nvalid, const float* gain) {
  float* tile = (float*)lds;
  const int tid = otid();
#pragma unroll
  for (int i = 0; i < 8; ++i) { const int idx = tid + i * NT, r = idx >> 6, cc = idx & 63, n = n0 + cc;
    float v = (n < nvalid) ? src[(size_t)(k0 + r) * ldsrc + n] : 0.f; if (gain) v *= gain[k0 + r]; tile[r * 65 + cc] = v; }
  __syncthreads();
#pragma unroll
  for (int i = 0; i < 8; ++i) { const int idx = tid + i * NT, r = idx >> 6, cc = idx & 63; dst[(size_t)(n0 + r) * ldd + k0 + cc] = tobf(tile[cc * 65 + r]); }
  __syncthreads();
}
DI float wave_sum(float v) { v += __shfl_xor(v, 32); v += __shfl_xor(v, 16); v += __shfl_xor(v, 8); v += __shfl_xor(v, 4); v += __shfl_xor(v, 2); v += __shfl_xor(v, 1); return v; }
DI void prenorm_row(const f32x4 (&v)[4], const float* g, u16* hrow, int lane) {
  float ss = 0.f;
#pragma unroll
  for (int i = 0; i < 4; ++i) ss += v[i][0] * v[i][0] + v[i][1] * v[i][1] + v[i][2] * v[i][2] + v[i][3] * v[i][3];
  ss = wave_sum(ss);
  const float r = rsqrtf(ss * (1.f / 1024.f) + EPS);
#pragma unroll
  for (int i = 0; i < 4; ++i) { const f32x4 gg = *(const f32x4*)(g + (lane + 64 * i) * 4);
    u32x2 o = {pack2(v[i][0] * r * gg[0], v[i][1] * r * gg[1]), pack2(v[i][2] * r * gg[2], v[i][3] * r * gg[3])};
    *(u32x2*)(hrow + (lane + 64 * i) * 4) = o; }
}

DI void phase_prep(unsigned char* lds, const P& p) {
  const int nb = gridDim.x, bid = blockIdx.x, tid = otid();
  u16* win = (u16*)(p.ws + WS_WIN); u16* wuq = (u16*)(p.ws + WS_WUQ); u16* wukv = (u16*)(p.ws + WS_WUKV); u16* wout = (u16*)(p.ws + WS_WOUT);
  for (int job = bid; job < 2 * 1032; job += nb) {
    const int layer = job / 1032; int r = job - layer * 1032;
    if (r < 640) { const int kt = r / 40, nt = r - kt * 40; transpose_tile(lds, p.w_in + (size_t)layer * 1024 * DIN, DIN, win + (size_t)layer * 2560 * 1024, 1024, kt * 64, nt * 64, DIN, nullptr); }
    else if (r < 712) { r -= 640; const int kt = r / 12, nt = r - kt * 12; transpose_tile(lds, p.w_uq + (size_t)layer * 384 * 768, 768, wuq + (size_t)layer * 768 * 384, 384, kt * 64, nt * 64, 768, p.q_norm_g + layer * 384); }
    else if (r < 776) { r -= 712; const int kt = r / 16, nt = r - kt * 16; transpose_tile(lds, p.w_ukv + (size_t)layer * 256 * 1024, 1024, wukv + (size_t)layer * 1024 * 256, 256, kt * 64, nt * 64, 1024, p.kv_norm_g + layer * 256); }
    else { r -= 776; const int kt = r / 16, nt = r - kt * 16; transpose_tile(lds, p.w_out + (size_t)layer * 1024 * 1024, 1024, wout + (size_t)layer * 1024 * 1024, 1024, kt * 64, nt * 64, 1024, nullptr); }
  }
  const int gtid = bid * NT + tid, gn = nb * NT;
  u16* sguw = (u16*)(p.ws + WS_SGUW);
  for (int idx = gtid; idx < 2 * 4 * 128 * 128; idx += gn) { const int i = (idx >> 7) & 127, j = idx & 127; sguw[idx] = ((j >> 6) <= (i >> 6)) ? tobf(p.sgu_w[idx]) : (u16)0; }
  u16* pwt = (u16*)(p.ws + WS_PWT);
  for (int idx = gtid; idx < 2 * 4 * 64 * 64; idx += gn) { const int lg = idx >> 12, d = (idx >> 6) & 63, c = idx & 63; pwt[idx] = tobf(p.pool_w[(lg * 64 + c) * 64 + d]); }
  float* cosT = (float*)(p.ws + WS_COS); float* sinT = (float*)(p.ws + WS_SIN);
  for (int idx = gtid; idx < S * 32; idx += gn) {
    const int t = idx >> 5, i = idx & 31; const float angf = (float)p.pos[t] * p.invfreq[i];
    const double a = (double)angf; const double k = rint(a * 0.15915494309189535); const double r = a - k * 6.283185307179586; const double r2 = r * r;
    double ts = r, ss = r, tc = 1.0, sc = 1.0;
#pragma unroll
    for (int n = 1; n <= 13; ++n) { ts *= -r2 * (1.0 / (double)((2 * n) * (2 * n + 1))); ss += ts; tc *= -r2 * (1.0 / (double)((2 * n - 1) * (2 * n))); sc += tc; }
    cosT[idx] = (float)sc; sinT[idx] = (float)ss;
  }
  u16* hb = (u16*)(p.ws + WS_HY);
  const int lane = tid & 63, wave = wave_of(tid);
  for (int row = bid * 8 + wave; row < S; row += nb * 16) {
    const int row2 = row + nb * 8; const bool has2 = row2 < S;
    f32x4 v[4], v2[4];
#pragma unroll
    for (int i = 0; i < 4; ++i) v[i] = *(const f32x4*)(p.x + (size_t)row * DM + (lane + 64 * i) * 4);
    if (has2) {
#pragma unroll
      for (int i = 0; i < 4; ++i) v2[i] = *(const f32x4*)(p.x + (size_t)row2 * DM + (lane + 64 * i) * 4);
    }
    prenorm_row(v, p.pre_g, hb + (size_t)row * DM, lane);
    if (has2) prenorm_row(v2, p.pre_g, hb + (size_t)row2 * DM, lane);
  }
}

DI void post_load(const u16* yout, const float* xold, int row, int lane, f32x4 (&y)[4], f32x4 (&xo)[4]) {
#pragma unroll
  for (int i = 0; i < 4; ++i) { const u32x2 yb = *(const u32x2*)(yout + (size_t)row * DM + (lane + 64 * i) * 4); y[i] = (f32x4){bflo(yb[0]), bfhi(yb[0]), bflo(yb[1]), bfhi(yb[1])};
    xo[i] = *(const f32x4*)(xold + (size_t)row * DM + (lane + 64 * i) * 4); }
}
DI void post_finish(const P& p, int layer, int row, int lane, f32x4 (&y)[4], const f32x4 (&xo)[4], u16* hb) {
  float ss = 0.f;
#pragma unroll
  for (int i = 0; i < 4; ++i) ss += y[i][0] * y[i][0] + y[i][1] * y[i][1] + y[i][2] * y[i][2] + y[i][3] * y[i][3];
  ss = wave_sum(ss);
  const float r = rsqrtf(ss * (1.f / 1024.f) + EPS);
#pragma unroll
  for (int i = 0; i < 4; ++i) {
    const f32x4 g = *(const f32x4*)(p.post_g + layer * DM + (lane + 64 * i) * 4);
    y[i] = xo[i] + y[i] * r * g;
    *(f32x4*)(p.out + (size_t)row * DM + (lane + 64 * i) * 4) = y[i];
  }
  if (layer + 1 < DEPTH) prenorm_row(y, p.pre_g + (layer + 1) * DM, hb + (size_t)row * DM, lane);
}
DI void phase_post(const P& p, int layer) {
  const int nb = gridDim.x, bid = blockIdx.x, tid = otid(), lane = tid & 63, wave = wave_of(tid);
  const u16* yout = (const u16*)(p.ws + WS_Z); const float* xold = layer == 0 ? p.x : p.out;
  u16* hb = (u16*)(p.ws + WS_HY);
  for (int row = bid * 8 + wave; row < S; row += nb * 16) {
    const int row2 = row + nb * 8; const bool has2 = row2 < S;
    f32x4 y0[4], x0[4], y1[4], x1[4];
    post_load(yout, xold, row, lane, y0, x0);
    if (has2) post_load(yout, xold, row2, lane, y1, x1);
    post_finish(p, layer, row, lane, y0, x0, hb);
    if (has2) post_finish(p, layer, row2, lane, y1, x1, hb);
  }
}

__global__ void __launch_bounds__(NT) mega(P p) {
  extern __shared__ __attribute__((aligned(16))) unsigned char lds[];
  cg::grid_group grid = cg::this_grid();
  const int nb = gridDim.x, bid = blockIdx.x;
  if (threadIdx.x < 4) ((unsigned*)(lds + XB_LDS_OFF))[threadIdx.x] = 0u;
  __syncthreads();
  XcdBarrier xbar = xcd_barrier_post((unsigned*)(p.ws + WS_BAR), (volatile LAS unsigned*)(lds + XB_LDS_OFF));
  unsigned* xcnt = (unsigned*)(p.ws + WS_BAR + 14336);
  unsigned myslot = 0;
  if (threadIdx.x == 0) myslot = xb_add(&xcnt[16 * xbar.x], 1u);
  int vid = bid;
  int ph = 0;
#define RUN(ph_) ((ph_) >= p.ph_lo && (ph_) < p.ph_hi)
#define SEAM(ph_) do { if (RUN(ph_) && RUN((ph_) + 1)) { if (p.ph_hi < 0) grid.sync(); else xcd_barrier(xbar); } } while (0)
  for (int rep = 0; rep < (DUP == 5 ? 2 : 1); ++rep)
  if (RUN(ph)) phase_prep(lds, p);
  SEAM(ph); ++ph;
  if (p.ph_hi - p.ph_lo > 1) {
    if (threadIdx.x == 0) { bool even = (nb & 7) == 0; for (int j = 0; j < 8; ++j) even = even && (xb_ld(&xcnt[16 * j]) == (unsigned)(nb >> 3));
      ((volatile LAS unsigned*)(lds + XB_LDS_OFF))[2] = even ? (myslot * 8u + xbar.x) : (unsigned)bid; }
    __syncthreads();
    vid = __builtin_amdgcn_readfirstlane((int)((volatile LAS unsigned*)(lds + XB_LDS_OFF))[2]);
  }
#pragma unroll 1
  for (int layer = 0; layer < DEPTH; ++layer) {
    u16* hy = (u16*)(p.ws + WS_HY); u16* z = (u16*)(p.ws + WS_Z);
    float* rs = (float*)(lds + RS_OFF);
    for (int rep = 0; rep < (DUP == 1 ? 2 : 1); ++rep)
    if (RUN(ph)) {
      const u16* W = (const u16*)(p.ws + WS_WIN) + (size_t)layer * 2560 * 1024;
      EpiZ e{z};
      for (int job = vid; job < 768; job += nb) { const int x = job & 7, j = job >> 3;
        if (j < 64) { const int mt = j & 7, tt = 8 * x + (j >> 3);
          gemm_tile<4>(lds, W + (size_t)mt * 256 * 1024, hy + (size_t)tt * 256 * 1024, 1024, 1024, mt * 256, tt * 256, e); }
        else { const int js = j - 64, mt = 8 + (js & 1), nt = 16 * x + (js >> 1);
          gemm_tile<2>(lds, W + (size_t)mt * 256 * 1024, hy + (size_t)nt * 128 * 1024, 1024, 1024, mt * 256, nt * 128, e); }
      }
    }
    SEAM(ph); ++ph;
    for (int rep = 0; rep < (DUP == 2 ? 2 : 1); ++rep)
    if (RUN(ph)) {
      const float* cosT = (const float*)(p.ws + WS_COS); const float* sinT = (const float*)(p.ws + WS_SIN);
      for (int job = vid; job < 1152; job += nb) {
        __syncthreads();
        const int x = job & 7, j = job >> 3;
        if (j < 48) { const int ntl = j / 3, mt = j - ntl * 3, n0 = (16 * x + ntl) * 128;
          const u16* X = z + (size_t)n0 * ZLD + Z_CQ; row_rstd(rs, X, ZLD, 384);
          EpiQ e{(u16*)(p.ws + WS_Q), cosT, sinT, rs, n0};
          gemm_tile<2>(lds, (const u16*)(p.ws + WS_WUQ) + (size_t)layer * 768 * 384 + (size_t)mt * 256 * 384, X, ZLD, 384, mt * 256, n0, e);
        } else if (j < 112) { const int j2 = j - 48, mt = j2 & 3, n0 = (16 * x + (j2 >> 2)) * 128;
          const u16* X = z + (size_t)n0 * ZLD + Z_CKV; row_rstd(rs, X, ZLD, 256);
          EpiKV e{(u16*)(p.ws + WS_K), (u16*)(p.ws + WS_VT), rs, n0};
          gemm_tile<2>(lds, (const u16*)(p.ws + WS_WUKV) + (size_t)layer * 1024 * 256 + (size_t)mt * 256 * 256, X, ZLD, 256, mt * 256, n0, e);
          if (mt == 0) krope_tile(p, n0);
        } else if (j < 128) sgu_job(lds, p, layer, 16 * x + (j - 112));
        else pool_job(lds, p, layer, 16 * x + (j - 128));
      }
    }
    SEAM(ph); ++ph;
    for (int rep = 0; rep < (DUP == 3 ? 2 : 1); ++rep)
    if (RUN(ph)) {
      for (int it = vid; it < 256; it += nb) {
        const int hd = (it & 7) >> 1, pr = (it >> 3) * 2 + (it & 1);
        attn_item(lds, p, hd, 127 - pr);
        attn_item(lds, p, hd, pr);
      }
    }
    SEAM(ph); ++ph;
    for (int rep = 0; rep < (DUP == 4 ? 2 : 1); ++rep)
    if (RUN(ph)) {
      const u16* W = (const u16*)(p.ws + WS_WOUT) + (size_t)layer * 1024 * 1024;
      EpiOut e{(u16*)(p.ws + WS_Z)};
      for (int job = vid; job < 256; job += nb) { const int x = job & 7, j = job >> 3, mt = j & 3, tt = 8 * x + (j >> 2);
        gemm_tile<4>(lds, W + (size_t)mt * 256 * 1024, hy + (size_t)tt * 256 * 1024, 1024, 1024, mt * 256, tt * 256, e); }
    }
    SEAM(ph); ++ph;
    for (int rep = 0; rep < ((DUP == 6 && layer == 0) ? 2 : 1); ++rep)
    if (RUN(ph)) phase_post(p, layer);
    SEAM(ph); ++ph;
  }
  if (p.ph_hi - p.ph_lo > 1) xcd_barrier(xbar);
}
constexpr int NPHASE = 1 + 5 * DEPTH;

extern "C" void kernel_launch(void* const* d_in, const int* in_sizes, int n_in, void* d_out, int out_size, void* d_ws, size_t ws_size, hipStream_t stream) {
  static int grid_blocks = 0;
  if (!grid_blocks) {
    int dev = 0, cus = 0, per_cu = 0;
    hipGetDevice(&dev);
    hipDeviceGetAttribute(&cus, hipDeviceAttributeMultiprocessorCount, dev);
    hipFuncSetAttribute((const void*)mega, hipFuncAttributeMaxDynamicSharedMemorySize, LDS_BYTES);
    hipOccupancyMaxActiveBlocksPerMultiprocessor(&per_cu, (const void*)mega, NT, LDS_BYTES);
    if (per_cu < 1) { fprintf(stderr, "occupancy query returned %d\n", per_cu); per_cu = 1; }
    if (per_cu > 1) per_cu = 1;
    grid_blocks = cus * per_cu;
    if (ws_size < WS_END) fprintf(stderr, "workspace too small: %zu < %zu\n", ws_size, (size_t)WS_END);
  }
  P p{};
  p.x = (const float*)d_in[0]; p.pos = (const int*)d_in[1]; p.pre_g = (const float*)d_in[2]; p.post_g = (const float*)d_in[3];
  p.w_in = (const float*)d_in[4]; p.sgu_w = (const float*)d_in[5]; p.sgu_b = (const float*)d_in[6]; p.sgu_ln_g = (const float*)d_in[7];
  p.sgu_ln_b = (const float*)d_in[8]; p.pool_w = (const float*)d_in[9]; p.pool_scale = (const float*)d_in[10]; p.q_norm_g = (const float*)d_in[11];
  p.w_uq = (const float*)d_in[12]; p.kv_norm_g = (const float*)d_in[13]; p.w_ukv = (const float*)d_in[14]; p.w_out = (const float*)d_in[15];
  p.out = (float*)d_out; p.ws = (unsigned char*)d_ws;
  for (int i = 0; i < 32; ++i) p.invfreq[i] = powf(10000.0f, -(float)(2 * i) / 64.0f);
  hipMemsetAsync((char*)d_ws + WS_BAR, 0, 16384, stream);
#if COOP
  p.ph_lo = 0; p.ph_hi = NPHASE;
  void* args[] = {&p};
  hipError_t e = hipLaunchCooperativeKernel((void*)mega, dim3(grid_blocks), dim3(NT), args, LDS_BYTES, stream);
  if (e != hipSuccess) fprintf(stderr, "cooperative launch failed: %s (grid %d)\n", hipGetErrorString(e), grid_blocks);
#else
  for (int ph = 0; ph < NPHASE; ++ph) { p.ph_lo = ph; p.ph_hi = ph + 1; hipLaunchKernelGGL(mega, dim3(grid_blocks), dim3(NT), LDS_BYTES, stream, p); }
#endif
}
```

```cpp
#include <hip/hip_runtime.h>
#include <hip/hip_cooperative_groups.h>
#include <cstdio>
#include <cmath>
namespace cg = cooperative_groups;

#define DI __device__ __forceinline__
typedef unsigned short u16;
using bf16x8 = __attribute__((ext_vector_type(8))) short;
using f32x16 = __attribute__((ext_vector_type(16))) float;
using f32x4  = __attribute__((ext_vector_type(4))) float;
using f32x2  = __attribute__((ext_vector_type(2))) float;
using u32x4  = __attribute__((ext_vector_type(4))) unsigned;
using u32x2  = __attribute__((ext_vector_type(2))) unsigned;
typedef __bf16 bf2_t __attribute__((ext_vector_type(2)));
#define MFMA(a, b, c) __builtin_amdgcn_mfma_f32_32x32x16_bf16((a), (b), (c), 0, 0, 0)

#ifndef COOP
#define COOP 1
#endif
#ifndef DUP
#define DUP 7
#endif

constexpr int S = 16384, DM = 1024, DIN = 2496, ZLD = 2560, NT = 512, DEPTH = 2;
constexpr float EPS = 1e-6f;
constexpr float QSCALE = 0.07216878364870322f * 1.4426950408889634f;
constexpr int Z_U = 0, Z_V = 256, Z_SG = 512, Z_PI = 768, Z_PG = 1024, Z_CQ = 1280, Z_CKV = 1664, Z_KR = 1920, Z_MG = 1984;

constexpr size_t WS_HY   = 0;
constexpr size_t WS_Z    = WS_HY + (size_t)S * 1024 * 2;
constexpr size_t WS_Q    = WS_Z + (size_t)S * ZLD * 2;
constexpr size_t WS_K    = WS_Q + (size_t)4 * S * 192 * 2;
constexpr size_t WS_VT   = WS_K + (size_t)4 * S * 192 * 2;
constexpr size_t WS_WIN  = WS_VT + (size_t)4 * S * 128 * 2;
constexpr size_t WS_WUQ  = WS_WIN + (size_t)2 * 2560 * 1024 * 2;
constexpr size_t WS_WUKV = WS_WUQ + (size_t)2 * 768 * 384 * 2;
constexpr size_t WS_WOUT = WS_WUKV + (size_t)2 * 1024 * 256 * 2;
constexpr size_t WS_SGUW = WS_WOUT + (size_t)2 * 1024 * 1024 * 2;
constexpr size_t WS_PWT  = WS_SGUW + (size_t)2 * 4 * 128 * 128 * 2;
constexpr size_t WS_COS  = WS_PWT + (size_t)2 * 4 * 64 * 64 * 2;
constexpr size_t WS_SIN  = WS_COS + (size_t)S * 32 * 4;
constexpr size_t WS_BAR  = WS_SIN + (size_t)S * 32 * 4;
constexpr size_t WS_END  = WS_BAR + 16384;

constexpr int GEMM_STAGE = 512 * 144;
constexpr int RS_OFF = 2 * GEMM_STAGE;
constexpr int XB_LDS_OFF = RS_OFF + 1024;
constexpr int LDS_BYTES = XB_LDS_OFF + 16;
constexpr int ATT_STAGE = 64 * 400 + 128 * 144;

struct P {
  const float* x; const int* pos; const float* pre_g; const float* post_g; const float* w_in; const float* sgu_w; const float* sgu_b;
  const float* sgu_ln_g; const float* sgu_ln_b; const float* pool_w; const float* pool_scale; const float* q_norm_g; const float* w_uq;
  const float* kv_norm_g; const float* w_ukv; const float* w_out;
  float* out; unsigned char* ws;
  float invfreq[32];
  int ph_lo, ph_hi;
};

DI int otid() { int t = threadIdx.x; asm volatile("" : "+v"(t)); return t; }
DI int wave_of(int tid) { return __builtin_amdgcn_readfirstlane(tid >> 6); }
DI void lds_barrier() { asm volatile("s_waitcnt lgkmcnt(0)" ::: "memory"); __builtin_amdgcn_s_barrier(); asm volatile("" ::: "memory"); }
DI unsigned pack2(float a, float b) { f32x2 v = {a, b}; return __builtin_bit_cast(unsigned, __builtin_convertvector(v, bf2_t)); }
DI u16 tobf(float a) { return (u16)(pack2(a, 0.f) & 0xffffu); }
DI float bflo(unsigned u) { return __uint_as_float(u << 16); }
DI float bfhi(unsigned u) { return __uint_as_float(u & 0xffff0000u); }
DI float silu(float x) { return x / (1.f + __expf(-x)); }
DI float ex2(float x) { return __builtin_amdgcn_exp2f(x); }
DI f32x16 zero16() { f32x16 z; for (int i = 0; i < 16; ++i) z[i] = 0.f; return z; }

#define XB_TMO      128
#define XB_XCNT(j)  (256  + 64 * (j))
#define XB_XSUB(j)  (1280 + 64 * (j))
#define XB_XGEN(j)  (2304 + 64 * (j))
#define XB_TOP      3328
#define XB_TOPGEN   3392
#define XCD_BAR_WORDS 3456
#define XB_SPIN_CAP (1u << 18)
#define LAS __attribute__((address_space(3)))

__device__ __forceinline__ unsigned xb_ld(unsigned* p)              { return __hip_atomic_load(p, __ATOMIC_RELAXED, __HIP_MEMORY_SCOPE_AGENT); }
__device__ __forceinline__ unsigned xb_add(unsigned* p, unsigned v) { return __hip_atomic_fetch_add(p, v, __ATOMIC_RELAXED, __HIP_MEMORY_SCOPE_AGENT); }
__device__ __forceinline__ unsigned xb_xcc_id() { return (unsigned)__builtin_amdgcn_s_getreg((3 << 11) | 20) & 0xFu; }
#define XB_SPIN(cond, bar) do { unsigned _sp = 0; while (cond) { __builtin_amdgcn_s_sleep(1); \
    if ((++_sp & 255u) == 0u) { if (xb_ld(&(bar)[XB_TMO])) break; if (_sp > XB_SPIN_CAP) { atomicAdd(&(bar)[XB_TMO], 1u); break; } } } } while (0)

struct XcdBarrier {
    unsigned* bar; unsigned x;
    volatile LAS unsigned* st;
};

__device__ __forceinline__ XcdBarrier xcd_barrier_post(unsigned* bar, volatile LAS unsigned* st) {
    XcdBarrier b; b.bar = bar; b.x = xb_xcc_id(); b.st = st;
    if (threadIdx.x == 0) (void)xb_add(&bar[XB_XCNT(b.x)], 1u);
    return b;
}
__device__ __forceinline__ void xcd_barrier_complete(unsigned* bar, unsigned x, unsigned& nloc, unsigned& nx) {
    const unsigned G = gridDim.x * gridDim.y * gridDim.z;
    unsigned sum, cnt, mine, sp = 0u;
    for (;;) {
        sum = 0u; cnt = 0u; mine = 0u;
#pragma unroll
        for (unsigned j = 0; j < 16; ++j) { const unsigned c = xb_ld(&bar[XB_XCNT(j)]); sum += c; cnt += (c > 0u) ? 1u : 0u; mine = (j == x) ? c : mine; }
        if (sum == G) break;
        __builtin_amdgcn_s_sleep(1);
        if ((++sp & 255u) == 0u) { if (xb_ld(&bar[XB_TMO])) break; if (sp > XB_SPIN_CAP) { atomicAdd(&bar[XB_TMO], 1u); break; } }
    }
    nloc = mine > 0u ? mine : 1u; nx = cnt > 0u ? cnt : 1u;
}

__device__ __forceinline__ void xcd_barrier(const XcdBarrier& b) {
    asm volatile("s_waitcnt vmcnt(0)" ::: "memory");
    __syncthreads();
    if (threadIdx.x == 0) {
        unsigned* bar = b.bar;
        __builtin_amdgcn_s_waitcnt(0);
        unsigned nloc = b.st[0], nx = b.st[1];
        if (nloc == 0u) { xcd_barrier_complete(bar, b.x, nloc, nx); b.st[0] = nloc; b.st[1] = nx; }
        const unsigned old = xb_add(&bar[XB_XSUB(b.x)], 1u);
        const unsigned gen = old / nloc;
        if (old + 1u == (gen + 1u) * nloc) {
            __builtin_amdgcn_fence(__ATOMIC_RELEASE, "agent");
            asm volatile("s_waitcnt vmcnt(0)" ::: "memory");
            const unsigned og = xb_add(&bar[XB_TOP], 1u);
            const unsigned tg = og / nx;
            if (og + 1u == (tg + 1u) * nx) xb_add(&bar[XB_TOPGEN], 1u);
            else XB_SPIN(xb_ld(&bar[XB_TOPGEN]) == tg, bar);
            __builtin_amdgcn_fence(__ATOMIC_ACQUIRE, "agent");
            xb_add(&bar[XB_XGEN(b.x)], 1u);
            asm volatile("s_waitcnt vmcnt(0)" ::: "memory");
        } else {
            XB_SPIN(xb_ld(&bar[XB_XGEN(b.x)]) == gen, bar);
            __builtin_amdgcn_fence(__ATOMIC_ACQUIRE, "agent");
            asm volatile("s_waitcnt vmcnt(0)" ::: "memory");
        }
    }
    __syncthreads();
}


namespace pg8 {
#define PG8_LAS __attribute__((address_space(3)))
typedef unsigned short bf16_t;
typedef short bf16x8 __attribute__((ext_vector_type(8)));
typedef float f32x4 __attribute__((ext_vector_type(4)));
typedef unsigned u32x4 __attribute__((ext_vector_type(4)));
constexpr int BM = 256, BK = 64, HALF = 128, HTB = HALF * BK * 2  , STAGE_BYTES = 8 * HTB, NXCD = 8, WGM = 8;

__host__ __device__ __forceinline__ int lds_byte(int r, int c) { const int st = (r >> 4) * 2 + (c >> 5), rr = r & 15, cc = c & 31, ob = rr * 64 + cc * 2; return st * 1024 + (ob ^ (((ob >> 9) & 1) << 5)); }
__host__ __device__ __forceinline__ void stage_rc(int b, int& R, int& C) { const int st = b / 1024, sb = b % 1024, swz = sb ^ (((sb >> 9) & 1) << 5); R = (st >> 1) * 16 + swz / 64; C = (st & 1) * 32 + (swz % 64) / 2; }
__host__ __device__ __forceinline__ int perm32(int rho) { const int n = rho >> 4, i = rho & 15; return 8 * (i >> 2) + 4 * n + (i & 3); }

struct Unit { int pm, pn; };
struct Gemm { const bf16_t* A; const bf16_t* Bt; int M, N, K; };

struct StaticOrder {
    int nM, nN, nwg, G, c;
    __host__ __device__ void init(int M, int N, int G_, int c_) { nM = M / BM; nN = N / BM; nwg = nM * nN; G = G_; c = c_; }
    __host__ __device__ bool next(int i, Unit& u) const {
        const long L = (long)i * G + c; if (L >= nwg) return false;
        int wgid = (int)L; { const int q = nwg / NXCD, r = nwg % NXCD, xcd = wgid % NXCD, off = wgid / NXCD; wgid = (xcd < r ? xcd * (q + 1) : r * (q + 1) + (xcd - r) * q) + off; }
        const int nig = WGM * nN, gid = wgid / nig, fm = gid * WGM, gsz = (nM - fm) < WGM ? (nM - fm) : WGM;
        u.pm = fm + ((wgid % nig) % gsz); u.pn = (wgid % nig) / gsz; return true;
    }
    __device__ __forceinline__ void a_ready(const Unit&) const {}
    __device__ __forceinline__ void done(const Unit&) const {}
};
__device__ __forceinline__ unsigned cvt_pk_bf16(float lo, float hi) { unsigned r; asm volatile("v_cvt_pk_bf16_f32 %0, %1, %2" : "=v"(r) : "v"(lo), "v"(hi)); return r; }
typedef float f32x2 __attribute__((ext_vector_type(2)));
__device__ __forceinline__ f32x2 gelu_pk(f32x2 v) {
    const f32x2 av = __builtin_elementwise_abs(v), d = av * 0.2316418882f + 1.0f;
    f32x2 t; t.x = __builtin_amdgcn_rcpf(d.x); t.y = __builtin_amdgcn_rcpf(d.y);
    f32x2 q = t * 0.5307027145f + (-0.7265760135f); q = q * t + 0.7107068705f; q = q * t + (-0.142248368f); q = q * t + 0.127414796f; q = q * t;
    const f32x2 s = (v * v) * (-0.72134752044f);
    f32x2 e; e.x = __builtin_amdgcn_exp2f(s.x); e.y = __builtin_amdgcn_exp2f(s.y);
    const f32x2 m = v * (q * e), r = v - m;
    f32x2 o; o.x = v.x < 0.f ? m.x : r.x; o.y = v.y < 0.f ? m.y : r.y; return o;
}

template <int ACT  > struct EpiBf16 {
    static constexpr bool PERM = true, AFTER_DRAIN = false;
    bf16_t* O; int ldc; const float* bias; int split_cols; size_t split_stride;
    __device__ __forceinline__ void operator()(const f32x4 (&acc)[2][2][4][2], const Unit& u, int wr, int wc, int fr, int fq) const {
        const int row0 = u.pm * BM + wr * 64 + fr; int colt = u.pn * BM; bf16_t* base = O;
        if (split_cols) { const int t = colt / split_cols; base += (size_t)t * split_stride; colt -= t * split_cols; }
        const int col0 = colt + wc * 32 + 8 * fq, bcol0 = u.pn * BM + wc * 32 + 8 * fq;
        f32x4 bv[2][2];
#pragma unroll
        for (int bj = 0; bj < 2; ++bj)
#pragma unroll
            for (int n = 0; n < 2; ++n) bv[bj][n] = bias ? *(const f32x4*)(bias + bcol0 + bj * HALF + 4 * n) : (f32x4){0.f, 0.f, 0.f, 0.f};
#pragma unroll
        for (int ai = 0; ai < 2; ++ai)
#pragma unroll
            for (int m = 0; m < 4; ++m) { bf16_t* rowp = base + (size_t)(row0 + ai * HALF + m * 16) * ldc + col0;
#pragma unroll
                for (int bj = 0; bj < 2; ++bj) { f32x4 v0 = acc[ai][bj][m][0] + bv[bj][0], v1 = acc[ai][bj][m][1] + bv[bj][1];
                    if (ACT == 1) { f32x2 a = gelu_pk((f32x2){v0[0], v0[1]}), b = gelu_pk((f32x2){v0[2], v0[3]}), c = gelu_pk((f32x2){v1[0], v1[1]}), d = gelu_pk((f32x2){v1[2], v1[3]});
                        v0 = (f32x4){a.x, a.y, b.x, b.y}; v1 = (f32x4){c.x, c.y, d.x, d.y}; }
                    if (ACT == 2) {
#pragma unroll
                        for (int j = 0; j < 4; ++j) { v0[j] = 0.5f * v0[j] * (1.0f + erff(v0[j] * 0.70710678f)); v1[j] = 0.5f * v1[j] * (1.0f + erff(v1[j] * 0.70710678f)); } }
                    u32x4 w; w.x = cvt_pk_bf16(v0[0], v0[1]); w.y = cvt_pk_bf16(v0[2], v0[3]); w.z = cvt_pk_bf16(v1[0], v1[1]); w.w = cvt_pk_bf16(v1[2], v1[3]);
                    *(u32x4*)(rowp + bj * HALF) = w; } }
    }
};

template <class Epi, class Sched, bool STAMP = false>
__device__ __forceinline__ void gemm_phase(PG8_LAS unsigned char* lds, const Gemm g, const Sched& S, const Epi& E, unsigned long long* stamps) {
    const int tid = otid(), wid = __builtin_amdgcn_readfirstlane(tid >> 6), lane = tid & 63, wr = wid >> 2, wc = wid & 3, fr = lane & 15, fq = lane >> 4;
    const int K = g.K, nt = K / BK;
    int ts_lo = 0, ts_hi = 0, nts = 0; const unsigned long long rt_entry = STAMP ? (unsigned long long)wall_clock64() : 0ull;
#define PG8_STAMP() do { if (STAMP && wid == 0 && nts < 64) { const unsigned long long _c = (unsigned long long)clock64(); \
        ts_lo = (lane == nts) ? (int)(unsigned)_c : ts_lo; ts_hi = (lane == nts) ? (int)(unsigned)(_c >> 32) : ts_hi; ++nts; } } while (0)
    PG8_STAMP();
    unsigned voffA[2], voffB[2];
#pragma unroll
    for (int i = 0; i < 2; ++i) { int R, C; stage_rc(tid * 16 + i * 8192, R, C); const int Rb = Epi::PERM ? ((R & ~31) + perm32(R & 31)) : R;
        voffA[i] = (unsigned)(R * K + C) * 2u; voffB[i] = (unsigned)(Rb * K + C) * 2u; }
    const size_t kstep = (size_t)(BK * 2);
    const size_t hstep = (size_t)HALF * K * 2;
    const size_t tstep = 2 * hstep;
    const unsigned ldsw = (unsigned)wid * 1024u;
    const int aoff = lds_byte(wr * 64 + fr, fq * 8), boff = lds_byte(wc * 32 + fr, fq * 8);
#define PG8_SA(b, h) (((b) * 2 + (h)) * HTB)
#define PG8_SB(b, h) ((4 + (b) * 2 + (h)) * HTB)
#define PG8_STAGE(bufoff, gbase, voff) do { _Pragma("unroll") for (int _i = 0; _i < 2; ++_i) \
        __builtin_amdgcn_global_load_lds((const unsigned*)((const char*)(gbase) + (voff)[_i]), (PG8_LAS unsigned*)(lds + (bufoff) + ldsw + _i * 8192), 16, 0, 0); } while (0)
#define PG8_LDA(dst, b, h) do { _Pragma("unroll") for (int m = 0; m < 4; ++m) _Pragma("unroll") for (int k = 0; k < 2; ++k) dst[m][k] = *(const PG8_LAS bf16x8*)(lds + PG8_SA(b, h) + aoff + m * 2048 + k * 1024); } while (0)
#define PG8_LDB(dst, b, h) do { _Pragma("unroll") for (int n = 0; n < 2; ++n) _Pragma("unroll") for (int k = 0; k < 2; ++k) dst[n][k] = *(const PG8_LAS bf16x8*)(lds + PG8_SB(b, h) + boff + n * 2048 + k * 1024); } while (0)
#define PG8_MMA(ai, bj, At, Bt) do { __builtin_amdgcn_s_setprio(1); _Pragma("unroll") for (int m = 0; m < 4; ++m) _Pragma("unroll") for (int n = 0; n < 2; ++n) _Pragma("unroll") for (int k = 0; k < 2; ++k) \
        acc[ai][bj][m][n] = __builtin_amdgcn_mfma_f32_16x16x32_bf16(Bt[n][k], At[m][k], acc[ai][bj][m][n], 0, 0, 0); __builtin_amdgcn_s_setprio(0); } while (0)
#define PG8_WAIT_V(n) asm volatile("s_waitcnt vmcnt(" #n ")" ::: "memory")
#define PG8_WAIT_L(n) asm volatile("s_waitcnt lgkmcnt(" #n ")" ::: "memory")
#define PG8_BAR __builtin_amdgcn_s_barrier()
#define PG8_SCHED __builtin_amdgcn_sched_barrier(0)
    Unit cur, nxt; int ui = 0;
    if (!S.next(0, cur)) return;
    f32x4 acc[2][2][4][2];
#pragma unroll
    for (int a = 0; a < 2; ++a)
#pragma unroll
        for (int b = 0; b < 2; ++b)
#pragma unroll
            for (int m = 0; m < 4; ++m)
#pragma unroll
                for (int n = 0; n < 2; ++n) acc[a][b][m][n] = (f32x4){0.f, 0.f, 0.f, 0.f};
    bf16x8 At[4][2], B0[2][2], B1[2][2];
    const char* cA = (const char*)g.A + (size_t)cur.pm * tstep; const char* cB = (const char*)g.Bt + (size_t)cur.pn * tstep;
    S.a_ready(cur);
    PG8_STAGE(PG8_SB(0, 0), cB, voffB); PG8_STAGE(PG8_SA(0, 0), cA, voffA); PG8_STAGE(PG8_SB(0, 1), cB + hstep, voffB); PG8_STAGE(PG8_SA(0, 1), cA + hstep, voffA);
    if (wr == 1) PG8_BAR;
    PG8_WAIT_V(4); PG8_BAR;
    PG8_STAGE(PG8_SB(1, 0), cB + kstep, voffB); PG8_STAGE(PG8_SA(1, 0), cA + kstep, voffA); PG8_STAGE(PG8_SB(1, 1), cB + hstep + kstep, voffB);
    PG8_WAIT_V(6); PG8_BAR;
    PG8_STAMP();
    for (;;) {
        const bool has_next = S.next(ui + 1, nxt);
        const char* nA = has_next ? (const char*)g.A + (size_t)nxt.pm * tstep : cA; const char* nB = has_next ? (const char*)g.Bt + (size_t)nxt.pn * tstep : cB;
        for (int t = 0; t < nt; t += 2) {
            const bool last = (t == nt - 2);
            const char* a1 = cA + (size_t)(t + 1) * kstep;
            const char* a2 = last ? nA : cA + (size_t)(t + 2) * kstep; const char* b2 = last ? nB : cB + (size_t)(t + 2) * kstep;
            const char* a3 = a2 + kstep; const char* b3 = b2 + kstep;
            if (last && has_next) S.a_ready(nxt);
            PG8_LDB(B0, 0, 0); PG8_SCHED; PG8_LDA(At, 0, 0); PG8_STAGE(PG8_SA(1, 1), a1 + hstep, voffA);
            PG8_WAIT_L(8); PG8_BAR; PG8_WAIT_L(0); PG8_MMA(0, 0, At, B0); PG8_BAR; PG8_SCHED;
            PG8_LDB(B1, 0, 1); PG8_STAGE(PG8_SB(0, 0), b2, voffB);
            PG8_BAR; PG8_WAIT_L(0); PG8_MMA(0, 1, At, B1); PG8_BAR;
            PG8_LDA(At, 0, 1); PG8_STAGE(PG8_SA(0, 0), a2, voffA);
            PG8_BAR; PG8_WAIT_L(0); PG8_MMA(1, 0, At, B0); PG8_BAR; PG8_SCHED;
            PG8_STAGE(PG8_SB(0, 1), b2 + hstep, voffB);
            PG8_WAIT_V(6); PG8_BAR; PG8_MMA(1, 1, At, B1); PG8_BAR;
            PG8_LDB(B0, 1, 0); PG8_SCHED; PG8_LDA(At, 1, 0); PG8_STAGE(PG8_SA(0, 1), a2 + hstep, voffA);
            PG8_WAIT_L(8); PG8_BAR; PG8_WAIT_L(0); PG8_MMA(0, 0, At, B0); PG8_BAR; PG8_SCHED;
            PG8_LDB(B1, 1, 1); PG8_STAGE(PG8_SB(1, 0), b3, voffB);
            PG8_BAR; PG8_WAIT_L(0); PG8_MMA(0, 1, At, B1); PG8_BAR;
            PG8_LDA(At, 1, 1); PG8_STAGE(PG8_SA(1, 0), a3, voffA);
            PG8_BAR; PG8_WAIT_L(0); PG8_MMA(1, 0, At, B0); PG8_BAR; PG8_SCHED;
            PG8_STAGE(PG8_SB(1, 1), b3 + hstep, voffB);
            PG8_WAIT_V(6); PG8_BAR; PG8_MMA(1, 1, At, B1); PG8_BAR;
        }
        PG8_STAMP();
        if constexpr (!Epi::AFTER_DRAIN) { E(acc, cur, wr, wc, fr, fq); S.done(cur); }
        PG8_STAMP();
        if (!has_next) break;
#pragma unroll
        for (int a = 0; a < 2; ++a)
#pragma unroll
            for (int b = 0; b < 2; ++b)
#pragma unroll
                for (int m = 0; m < 4; ++m)
#pragma unroll
                    for (int n = 0; n < 2; ++n) acc[a][b][m][n] = (f32x4){0.f, 0.f, 0.f, 0.f};
        cur = nxt; cA = nA; cB = nB; ++ui;
    }
    PG8_WAIT_V(0);
    if (wr == 0) PG8_BAR;
    PG8_BAR;
    if constexpr (Epi::AFTER_DRAIN) { E.fused(acc, cur, wr, wc, fr, fq, lds, wid, lane); S.done(cur); }
    PG8_STAMP();
    if (STAMP && wid == 0) { stamps[lane] = lane < nts ? (((unsigned long long)(unsigned)ts_hi << 32) | (unsigned)ts_lo) : 0ull;
        if (lane == 62) stamps[62] = rt_entry; if (lane == 63) stamps[63] = (unsigned long long)wall_clock64(); }
#undef PG8_STAMP
#undef PG8_SA
#undef PG8_SB
#undef PG8_STAGE
#undef PG8_LDA
#undef PG8_LDB
#undef PG8_MMA
#undef PG8_WAIT_V
#undef PG8_WAIT_L
#undef PG8_BAR
#undef PG8_SCHED
}
}
template <int NTW, class Epi>
DI void gemm_tile(unsigned char* lds, const u16* __restrict__ A, const u16* __restrict__ X, int ldx, int K, int m0, int n0, Epi& epi) {
  const int tid = otid(), lane = tid & 63, wave = wave_of(tid);
  const int wm = wave & 3, wn = wave >> 2, l32 = lane & 31, h = lane >> 5;
  f32x16 acc[2][NTW];
#pragma unroll
  for (int i = 0; i < 2; ++i)
#pragma unroll
    for (int j = 0; j < NTW; ++j) acc[i][j] = zero16();
  const int nk = K >> 6;
  const int lrow = tid >> 3, lcol = tid & 7;
  const u16* ga = A + (size_t)lrow * K + lcol * 8;
  const u16* gx = X + (size_t)lrow * ldx + lcol * 8;
  u32x4 ra[4], rb[NTW];
#pragma unroll
  for (int i = 0; i < 4; ++i) ra[i] = *(const u32x4*)(ga + (size_t)i * 64 * K);
#pragma unroll
  for (int i = 0; i < NTW; ++i) rb[i] = *(const u32x4*)(gx + (size_t)i * 64 * ldx);
  {
    unsigned char* as = lds; unsigned char* bs = lds + 256 * 144;
#pragma unroll
    for (int i = 0; i < 4; ++i) *(u32x4*)(as + (lrow + i * 64) * 144 + lcol * 16) = ra[i];
#pragma unroll
    for (int i = 0; i < NTW; ++i) *(u32x4*)(bs + (lrow + i * 64) * 144 + lcol * 16) = rb[i];
  }
  __syncthreads();
#pragma unroll 1
  for (int ks = 0; ks < nk; ++ks) {
    const bool more = ks + 1 < nk;
    if (more) {
#pragma unroll
      for (int i = 0; i < 4; ++i) ra[i] = *(const u32x4*)(ga + (size_t)i * 64 * K + (ks + 1) * 64);
#pragma unroll
      for (int i = 0; i < NTW; ++i) rb[i] = *(const u32x4*)(gx + (size_t)i * 64 * ldx + (ks + 1) * 64);
    }
    const unsigned char* as = lds + (ks & 1) * GEMM_STAGE + (wm * 64 + l32) * 144 + h * 16;
    const unsigned char* bs = lds + (ks & 1) * GEMM_STAGE + 256 * 144 + (wn * NTW * 32 + l32) * 144 + h * 16;
#pragma unroll
    for (int kk = 0; kk < 4; ++kk) {
      bf16x8 a0 = *(const bf16x8*)(as + kk * 32), a1 = *(const bf16x8*)(as + 32 * 144 + kk * 32);
      bf16x8 b[NTW];
#pragma unroll
      for (int j = 0; j < NTW; ++j) b[j] = *(const bf16x8*)(bs + j * 32 * 144 + kk * 32);
#pragma unroll
      for (int j = 0; j < NTW; ++j) { acc[0][j] = MFMA(a0, b[j], acc[0][j]); acc[1][j] = MFMA(a1, b[j], acc[1][j]); }
    }
    if (more) {
      unsigned char* as2 = lds + ((ks + 1) & 1) * GEMM_STAGE; unsigned char* bs2 = as2 + 256 * 144;
#pragma unroll
      for (int i = 0; i < 4; ++i) *(u32x4*)(as2 + (lrow + i * 64) * 144 + lcol * 16) = ra[i];
#pragma unroll
      for (int i = 0; i < NTW; ++i) *(u32x4*)(bs2 + (lrow + i * 64) * 144 + lcol * 16) = rb[i];
    }
    __syncthreads();
  }
  epi(acc, m0 + wm * 64, n0 + wn * NTW * 32, l32, h);
}

struct EpiZ {
  u16* z;
  template <int NTW> DI void operator()(f32x16 (&acc)[2][NTW], int chb, int tokb, int l32, int h) {
#pragma unroll
    for (int nt = 0; nt < NTW; ++nt) { const int t = tokb + nt * 32 + l32;
#pragma unroll
      for (int mt = 0; mt < 2; ++mt)
#pragma unroll
        for (int q = 0; q < 4; ++q) {
          u32x2 v = {pack2(acc[mt][nt][q * 4], acc[mt][nt][q * 4 + 1]), pack2(acc[mt][nt][q * 4 + 2], acc[mt][nt][q * 4 + 3])};
          *(u32x2*)(z + (size_t)t * ZLD + chb + mt * 32 + q * 8 + h * 4) = v;
        }
    }
  }
};
struct EpiOut {
  u16* y;
  template <int NTW> DI void operator()(f32x16 (&acc)[2][NTW], int chb, int tokb, int l32, int h) {
#pragma unroll
    for (int nt = 0; nt < NTW; ++nt) { const int t = tokb + nt * 32 + l32;
#pragma unroll
      for (int mt = 0; mt < 2; ++mt)
#pragma unroll
        for (int q = 0; q < 4; ++q) {
          u32x2 v = {pack2(acc[mt][nt][q * 4], acc[mt][nt][q * 4 + 1]), pack2(acc[mt][nt][q * 4 + 2], acc[mt][nt][q * 4 + 3])};
          *(u32x2*)(y + (size_t)t * DM + chb + mt * 32 + q * 8 + h * 4) = v;
        }
    }
  }
};
struct EpiQ {
  u16* Q; const float* cosT; const float* sinT; const float* rs; int n0;
  template <int NTW> DI void operator()(f32x16 (&acc)[2][NTW], int chb, int tokb, int l32, int h) {
    const int seg = chb >> 6, head = seg / 3, part = seg - head * 3;
#pragma unroll
    for (int nt = 0; nt < NTW; ++nt) {
      const int t = tokb + nt * 32 + l32; const float r = rs[tokb - n0 + nt * 32 + l32] * QSCALE;
      u16* dst = Q + ((size_t)head * S + t) * 192;
      if (part < 2) {
#pragma unroll
        for (int mt = 0; mt < 2; ++mt)
#pragma unroll
          for (int q = 0; q < 4; ++q) {
            u32x2 v = {pack2(acc[mt][nt][q * 4] * r, acc[mt][nt][q * 4 + 1] * r), pack2(acc[mt][nt][q * 4 + 2] * r, acc[mt][nt][q * 4 + 3] * r)};
            *(u32x2*)(dst + part * 64 + mt * 32 + q * 8 + h * 4) = v;
          }
      } else {
#pragma unroll
        for (int q = 0; q < 4; ++q) {
          const int d = q * 8 + h * 4;
          const f32x4 c = *(const f32x4*)(cosT + (size_t)t * 32 + d), s = *(const f32x4*)(sinT + (size_t)t * 32 + d);
          float o1[4], o2[4];
#pragma unroll
          for (int j = 0; j < 4; ++j) { const float x1 = acc[0][nt][q * 4 + j], x2 = acc[1][nt][q * 4 + j]; o1[j] = (x1 * c[j] - x2 * s[j]) * r; o2[j] = (x2 * c[j] + x1 * s[j]) * r; }
          u32x2 v1 = {pack2(o1[0], o1[1]), pack2(o1[2], o1[3])}, v2 = {pack2(o2[0], o2[1]), pack2(o2[2], o2[3])};
          *(u32x2*)(dst + 128 + d) = v1; *(u32x2*)(dst + 160 + d) = v2;
        }
      }
    }
  }
};
DI int permpos(int k64) { const int kk = k64 & 15; return (k64 & 48) | (((kk >> 2) & 1) * 8 + (kk >> 3) * 4 + (kk & 3)); }
struct EpiKV {
  u16* K; u16* Vt; const float* rs; int n0;
  template <int NTW> DI void operator()(f32x16 (&acc)[2][NTW], int chb, int tokb, int l32, int h) {
    const int seg = chb >> 6, head = seg >> 2, part = seg & 3;
#pragma unroll
    for (int nt = 0; nt < NTW; ++nt) {
      const int t = tokb + nt * 32 + l32; const float r = rs[tokb - n0 + nt * 32 + l32];
      if (part < 2) {
        u16* dst = K + ((size_t)head * S + t) * 192 + part * 64;
#pragma unroll
        for (int mt = 0; mt < 2; ++mt)
#pragma unroll
          for (int q = 0; q < 4; ++q) {
            u32x2 v = {pack2(acc[mt][nt][q * 4] * r, acc[mt][nt][q * 4 + 1] * r), pack2(acc[mt][nt][q * 4 + 2] * r, acc[mt][nt][q * 4 + 3] * r)};
            *(u32x2*)(dst + mt * 32 + q * 8 + h * 4) = v;
          }
      } else {
        u16* dst = Vt + (((size_t)head * (S / 64) + (t >> 6)) * 128 + (part - 2) * 64) * 64 + permpos(t & 63);
#pragma unroll
        for (int mt = 0; mt < 2; ++mt)
#pragma unroll
          for (int i = 0; i < 16; ++i) { const int dv = mt * 32 + (i & 3) + 8 * (i >> 2) + 4 * h; dst[dv * 64] = tobf(acc[mt][nt][i] * r); }
      }
    }
  }
};

DI void row_rstd(float* rs, const u16* X, int ldx, int K) {
  const int tid = otid(), tl = tid >> 2, sub = tid & 3;
  const u16* src = X + (size_t)tl * ldx; float ss = 0.f;
  for (int c = sub; c < (K >> 3); c += 4) {
    u32x4 v = *(const u32x4*)(src + c * 8);
#pragma unroll
    for (int j = 0; j < 4; ++j) { const float a = bflo(v[j]), b = bfhi(v[j]); ss += a * a + b * b; }
  }
  ss += __shfl_xor(ss, 1); ss += __shfl_xor(ss, 2);
  if (sub == 0) rs[tl] = rsqrtf(ss / (float)K + EPS);
}

DI void krope_tile(const P& p, int n0) {
  const int tid = otid(), t = n0 + (tid >> 2), i0 = (tid & 3) * 8;
  const u16* z = (const u16*)(p.ws + WS_Z) + (size_t)t * ZLD + Z_KR;
  const float* cosT = (const float*)(p.ws + WS_COS) + (size_t)t * 32 + i0; const float* sinT = (const float*)(p.ws + WS_SIN) + (size_t)t * 32 + i0;
  u32x4 a = *(const u32x4*)(z + i0), b = *(const u32x4*)(z + 32 + i0);
  f32x4 c0 = *(const f32x4*)cosT, c1 = *(const f32x4*)(cosT + 4), s0 = *(const f32x4*)sinT, s1 = *(const f32x4*)(sinT + 4);
  float x1[8], x2[8], c[8], s[8];
#pragma unroll
  for (int j = 0; j < 4; ++j) { x1[2 * j] = bflo(a[j]); x1[2 * j + 1] = bfhi(a[j]); x2[2 * j] = bflo(b[j]); x2[2 * j + 1] = bfhi(b[j]); c[j] = c0[j]; c[4 + j] = c1[j]; s[j] = s0[j]; s[4 + j] = s1[j]; }
  u32x4 o1, o2;
#pragma unroll
  for (int j = 0; j < 4; ++j) {
    o1[j] = pack2(x1[2 * j] * c[2 * j] - x2[2 * j] * s[2 * j], x1[2 * j + 1] * c[2 * j + 1] - x2[2 * j + 1] * s[2 * j + 1]);
    o2[j] = pack2(x2[2 * j] * c[2 * j] + x1[2 * j] * s[2 * j], x2[2 * j + 1] * c[2 * j + 1] + x1[2 * j + 1] * s[2 * j + 1]);
  }
  u16* K = (u16*)(p.ws + WS_K);
#pragma unroll
  for (int hd = 0; hd < 4; ++hd) { u16* dst = K + ((size_t)hd * S + t) * 192 + 128 + i0; *(u32x4*)dst = o1; *(u32x4*)(dst + 32) = o2; }
}

DI void sgu_job(unsigned char* lds, const P& p, int layer, int nb) {
  const int tid = otid(), lane = tid & 63, wave = wave_of(tid);
  const int n0 = nb * 128;
  const u16* z = (const u16*)(p.ws + WS_Z);
  u16* vT = (u16*)lds;
  {
    const int j = tid >> 2, sub = tid & 3; const u16* src = z + (size_t)(n0 + j) * ZLD + Z_V + sub * 64;
    float v[64]; float s = 0.f;
#pragma unroll
    for (int c = 0; c < 8; ++c) { u32x4 u = *(const u32x4*)(src + c * 8);
#pragma unroll
      for (int k = 0; k < 4; ++k) { v[c * 8 + 2 * k] = bflo(u[k]); v[c * 8 + 2 * k + 1] = bfhi(u[k]); s += v[c * 8 + 2 * k] + v[c * 8 + 2 * k + 1]; } }
    s += __shfl_xor(s, 1); s += __shfl_xor(s, 2);
    const float mu = s * (1.f / 256.f); float q = 0.f;
#pragma unroll
    for (int c = 0; c < 64; ++c) { const float d = v[c] - mu; q += d * d; }
    q += __shfl_xor(q, 1); q += __shfl_xor(q, 2);
    const float rstd = rsqrtf(q * (1.f / 256.f) + EPS);
    const float* g = p.sgu_ln_g + layer * 256 + sub * 64; const float* b = p.sgu_ln_b + layer * 256 + sub * 64;
#pragma unroll
    for (int c4 = 0; c4 < 16; ++c4) { const f32x4 gg = *(const f32x4*)(g + c4 * 4), bb = *(const f32x4*)(b + c4 * 4);
#pragma unroll
      for (int k = 0; k < 4; ++k) vT[(sub * 64 + c4 * 4 + k) * 136 + j] = tobf((v[c4 * 4 + k] - mu) * rstd * gg[k] + bb[k]); }
  }
  __syncthreads();
  const int wm = wave & 3, wn = wave >> 2, l32 = lane & 31, h = lane >> 5;
  f32x16 acc[2][2]; acc[0][0] = zero16(); acc[0][1] = zero16(); acc[1][0] = zero16(); acc[1][1] = zero16();
  const u16* W = (const u16*)(p.ws + WS_SGUW) + (size_t)(layer * 4 + wm) * 128 * 128;
#pragma unroll
  for (int kk = 0; kk < 8; ++kk) {
    bf16x8 a0 = *(const bf16x8*)(vT + (wm * 64 + l32) * 136 + kk * 16 + h * 8);
    bf16x8 a1 = *(const bf16x8*)(vT + (wm * 64 + 32 + l32) * 136 + kk * 16 + h * 8);
    bf16x8 b0 = *(const bf16x8*)(W + (wn * 64 + l32) * 128 + kk * 16 + h * 8);
    bf16x8 b1 = *(const bf16x8*)(W + (wn * 64 + 32 + l32) * 128 + kk * 16 + h * 8);
    acc[0][0] = MFMA(a0, b0, acc[0][0]); acc[0][1] = MFMA(a0, b1, acc[0][1]);
    acc[1][0] = MFMA(a1, b0, acc[1][0]); acc[1][1] = MFMA(a1, b1, acc[1][1]);
  }
  u16* Y = (u16*)(p.ws + WS_HY);
#pragma unroll
  for (int nt = 0; nt < 2; ++nt) {
    const int i = wn * 64 + nt * 32 + l32, t = n0 + i; const float bias = p.sgu_b[(layer * 4 + wm) * 128 + i];
#pragma unroll
    for (int mt = 0; mt < 2; ++mt)
#pragma unroll
      for (int q = 0; q < 4; ++q) {
        const int c = wm * 64 + mt * 32 + q * 8 + h * 4;
        const u32x2 u = *(const u32x2*)(z + (size_t)t * ZLD + Z_U + c), g = *(const u32x2*)(z + (size_t)t * ZLD + Z_SG + c);
        const float o0 = bflo(u[0]) * (acc[mt][nt][q * 4] + bias) * silu(bflo(g[0])), o1 = bfhi(u[0]) * (acc[mt][nt][q * 4 + 1] + bias) * silu(bfhi(g[0]));
        const float o2 = bflo(u[1]) * (acc[mt][nt][q * 4 + 2] + bias) * silu(bflo(g[1])), o3 = bfhi(u[1]) * (acc[mt][nt][q * 4 + 3] + bias) * silu(bfhi(g[1]));
        u32x2 v = {pack2(o0, o1), pack2(o2, o3)};
        *(u32x2*)(Y + (size_t)t * DM + c) = v;
      }
  }
}

template <int W>
DI void pool_win(const u16* zp, int t0, u16* prow) {
  unsigned v[32 + W];
#pragma unroll
  for (int i = 0; i < 32 + W; ++i) { const int t = t0 - W + i; v[i] = (t >= 0) ? *(const unsigned*)(zp + (size_t)max(t, 0) * ZLD) : 0u; }
  float s0 = 0.f, s1 = 0.f;
#pragma unroll
  for (int i = 0; i < W; ++i) { s0 += bflo(v[i]); s1 += bfhi(v[i]); }
#pragma unroll
  for (int tt = 0; tt < 32; ++tt) {
    const float p0 = bflo(v[W + tt]), p1 = bfhi(v[W + tt]);
    s0 += p0 - bflo(v[tt]); s1 += p1 - bfhi(v[tt]);
    const float inv = 1.f / (float)min(t0 + tt + 1, W);
    *(unsigned*)(prow + tt * 264) = pack2(s0 * inv - p0, s1 * inv - p1);
  }
}
DI void pool_job(unsigned char* lds, const P& p, int layer, int nb) {
  const int tid = otid(), lane = tid & 63, wave = wave_of(tid);
  const int n0 = nb * 128;
  const u16* z = (const u16*)(p.ws + WS_Z);
  u16* pl = (u16*)lds;
  {
    const int g = wave & 3, c = g * 64 + (lane & 31) * 2, tq = (wave >> 2) * 2 + (lane >> 5);
    const u16* zp = z + Z_PI + c; const int t0 = n0 + tq * 32; u16* prow = pl + (tq * 32) * 264 + c;
    switch (g) { case 0: pool_win<2>(zp, t0, prow); break; case 1: pool_win<4>(zp, t0, prow); break; case 2: pool_win<8>(zp, t0, prow); break; default: pool_win<16>(zp, t0, prow); break; }
  }
  __syncthreads();
  const int wm = wave & 3, wn = wave >> 2, l32 = lane & 31, h = lane >> 5;
  f32x16 acc[2][2]; acc[0][0] = zero16(); acc[0][1] = zero16(); acc[1][0] = zero16(); acc[1][1] = zero16();
  const u16* W = (const u16*)(p.ws + WS_PWT) + (size_t)(layer * 4 + wm) * 64 * 64;
#pragma unroll
  for (int kk = 0; kk < 4; ++kk) {
    bf16x8 a0 = *(const bf16x8*)(W + (l32) * 64 + kk * 16 + h * 8);
    bf16x8 a1 = *(const bf16x8*)(W + (32 + l32) * 64 + kk * 16 + h * 8);
    bf16x8 b0 = *(const bf16x8*)(pl + (wn * 64 + l32) * 264 + wm * 64 + kk * 16 + h * 8);
    bf16x8 b1 = *(const bf16x8*)(pl + (wn * 64 + 32 + l32) * 264 + wm * 64 + kk * 16 + h * 8);
    acc[0][0] = MFMA(a0, b0, acc[0][0]); acc[0][1] = MFMA(a0, b1, acc[0][1]);
    acc[1][0] = MFMA(a1, b0, acc[1][0]); acc[1][1] = MFMA(a1, b1, acc[1][1]);
  }
  u16* Y = (u16*)(p.ws + WS_HY);
#pragma unroll
  for (int nt = 0; nt < 2; ++nt) {
    const int t = n0 + wn * 64 + nt * 32 + l32;
#pragma unroll
    for (int mt = 0; mt < 2; ++mt)
#pragma unroll
      for (int q = 0; q < 4; ++q) {
        const int c = wm * 64 + mt * 32 + q * 8 + h * 4;
        const f32x4 sc = *(const f32x4*)(p.pool_scale + layer * 256 + c);
        const u32x2 g = *(const u32x2*)(z + (size_t)t * ZLD + Z_PG + c);
        const float o0 = acc[mt][nt][q * 4] * sc[0] * silu(bflo(g[0])), o1 = acc[mt][nt][q * 4 + 1] * sc[1] * silu(bfhi(g[0]));
        const float o2 = acc[mt][nt][q * 4 + 2] * sc[2] * silu(bflo(g[1])), o3 = acc[mt][nt][q * 4 + 3] * sc[3] * silu(bfhi(g[1]));
        u32x2 v = {pack2(o0, o1), pack2(o2, o3)};
        *(u32x2*)(Y + (size_t)t * DM + 256 + c) = v;
      }
  }
}

DI void att_qk(f32x16& s, const unsigned char* krow, const bf16x8 (&qf)[12], float m) {
  bf16x8 ka[4], kb[4];
#pragma unroll
  for (int i = 0; i < 4; ++i) ka[i] = *(const bf16x8*)(krow + i * 32);
#pragma unroll
  for (int i = 0; i < 4; ++i) kb[i] = *(const bf16x8*)(krow + (4 + i) * 32);
  const float nm = -m;
#pragma unroll
  for (int i = 0; i < 16; ++i) s[i] = nm;
  __builtin_amdgcn_sched_barrier(0);
#pragma unroll
  for (int i = 0; i < 4; ++i) s = MFMA(ka[i], qf[i], s);
  __builtin_amdgcn_sched_barrier(0);
#pragma unroll
  for (int i = 0; i < 4; ++i) ka[i] = *(const bf16x8*)(krow + (8 + i) * 32);
  __builtin_amdgcn_sched_barrier(0);
#pragma unroll
  for (int i = 0; i < 4; ++i) s = MFMA(kb[i], qf[4 + i], s);
  __builtin_amdgcn_sched_barrier(0);
#pragma unroll
  for (int i = 0; i < 4; ++i) s = MFMA(ka[i], qf[8 + i], s);
  __builtin_amdgcn_sched_barrier(0);
}
DI void att_sm_pv(f32x16& s, const unsigned char* vrow, f32x16 (&O)[4], float& m, float& l, bool first) {
  bf16x8 vf[8];
#pragma unroll
  for (int mt = 0; mt < 4; ++mt) { vf[2 * mt] = *(const bf16x8*)(vrow + mt * 32 * 144); vf[2 * mt + 1] = *(const bf16x8*)(vrow + mt * 32 * 144 + 32); }
  __builtin_amdgcn_sched_barrier(0);
  float mx = fmaxf(fmaxf(s[0], s[1]), s[2]);
#pragma unroll
  for (int i = 3; i < 15; i += 2) mx = fmaxf(fmaxf(mx, s[i]), s[i + 1]);
  mx = fmaxf(mx, s[15]);
  if (first || __builtin_amdgcn_ballot_w64(mx > 8.f) != 0) {
    const float mxx = fmaxf(mx, __shfl_xor(mx, 32));
    const float d = first ? mxx : fmaxf(mxx, 0.f);
    const float alpha = first ? 1.f : ex2(-d);
    m += d; l *= alpha;
#pragma unroll
    for (int i = 0; i < 16; ++i) s[i] -= d;
#pragma unroll
    for (int mt = 0; mt < 4; ++mt)
#pragma unroll
      for (int i = 0; i < 16; ++i) O[mt][i] *= alpha;
  }
  float ps0 = 0.f, ps1 = 0.f;
#pragma unroll
  for (int i = 0; i < 16; i += 2) { s[i] = ex2(s[i]); s[i + 1] = ex2(s[i + 1]); ps0 += s[i]; ps1 += s[i + 1]; }
  l += ps0 + ps1;
  u32x4 p0 = {pack2(s[0], s[1]), pack2(s[2], s[3]), pack2(s[4], s[5]), pack2(s[6], s[7])};
  u32x4 p1 = {pack2(s[8], s[9]), pack2(s[10], s[11]), pack2(s[12], s[13]), pack2(s[14], s[15])};
  const bf16x8 pf0 = __builtin_bit_cast(bf16x8, p0), pf1 = __builtin_bit_cast(bf16x8, p1);
#pragma unroll
  for (int mt = 0; mt < 4; ++mt) { O[mt] = MFMA(vf[2 * mt], pf0, O[mt]); O[mt] = MFMA(vf[2 * mt + 1], pf1, O[mt]); }
}
DI void attn_item(unsigned char* lds, const P& p, int hd, int qb) {
  const int tid = otid(), lane = tid & 63, wave = wave_of(tid);
  const int wq = wave & 3, wk = wave >> 2, l32 = lane & 31, h = lane >> 5;
  const u16* Qg = (const u16*)(p.ws + WS_Q) + ((size_t)hd * S + qb * 128 + wq * 32 + l32) * 192 + h * 8;
  bf16x8 qf[12];
#pragma unroll
  for (int ks = 0; ks < 12; ++ks) qf[ks] = *(const bf16x8*)(Qg + ks * 16);
  const int ntile = 2 * qb + 2, mychunk = 2 * qb + (wq >> 1);
  const u16* Kg = (const u16*)(p.ws + WS_K) + (size_t)hd * S * 192 + tid * 8;
  const u16* Vg = (const u16*)(p.ws + WS_VT) + (size_t)hd * S * 128 + tid * 8;
  int kdst[3], vdst[2];
#pragma unroll
  for (int i = 0; i < 3; ++i) { const int c = tid + i * NT; kdst[i] = (c / 24) * 400 + (c % 24) * 16; }
#pragma unroll
  for (int i = 0; i < 2; ++i) { const int c = tid + i * NT; vdst[i] = 64 * 400 + (c >> 3) * 144 + (c & 7) * 16; }
  const int koff = (wk * 32 + l32) * 400 + h * 16;
  const int voff = 64 * 400 + l32 * 144 + (wk * 32 + h * 8) * 2;
  f32x16 O[4]; O[0] = zero16(); O[1] = zero16(); O[2] = zero16(); O[3] = zero16();
  float m = 0.f, l = 0.f;
  u32x4 rkA[3], rvA[2], rkB[3], rvB[2];
#define ATT_GLOAD(RK, RV, T) do { _Pragma("unroll") for (int i = 0; i < 3; ++i) RK[i] = *(const u32x4*)(Kg + (size_t)(T) * 64 * 192 + i * NT * 8); \
                                  _Pragma("unroll") for (int i = 0; i < 2; ++i) RV[i] = *(const u32x4*)(Vg + (size_t)(T) * 128 * 64 + i * NT * 8); } while (0)
#define ATT_LSTORE(RK, RV, ST) do { unsigned char* st_ = lds + (ST) * ATT_STAGE; _Pragma("unroll") for (int i = 0; i < 3; ++i) *(u32x4*)(st_ + kdst[i]) = RK[i]; \
                                    _Pragma("unroll") for (int i = 0; i < 2; ++i) *(u32x4*)(st_ + vdst[i]) = RV[i]; } while (0)
#define ATT_STEP(KT, RLK, RLV, RSK, RSV) do { \
    ATT_GLOAD(RLK, RLV, min((KT) + 2, ntile - 1));     \
    if ((KT) <= mychunk) { f32x16 s; att_qk(s, lds + ((KT) & 1) * ATT_STAGE + koff, qf, m); att_sm_pv(s, lds + ((KT) & 1) * ATT_STAGE + voff, O, m, l, (KT) == 0); } \
    if ((KT) + 1 < ntile) ATT_LSTORE(RSK, RSV, ((KT) + 1) & 1); \
    lds_barrier(); } while (0)
  ATT_GLOAD(rkA, rvA, 0);
  ATT_GLOAD(rkB, rvB, 1);
  ATT_LSTORE(rkA, rvA, 0);
  __syncthreads();
#pragma unroll 1
  for (int kt = 0; kt < ntile; kt += 2) {
    ATT_STEP(kt, rkA, rvA, rkB, rvB);
    ATT_STEP(kt + 1, rkB, rvB, rkA, rvA);
  }
  const float lt = l + __shfl_xor(l, 32);
  float* cO = (float*)lds; float* cm = (float*)(lds + 65536);
  if (wk == 1) {
#pragma unroll
    for (int mt = 0; mt < 4; ++mt)
#pragma unroll
      for (int i = 0; i < 16; ++i) cO[(wq * 64 + mt * 16 + i) * 64 + lane] = O[mt][i];
    cm[wq * 64 + lane] = m; cm[256 + wq * 64 + lane] = lt;
  }
  __syncthreads();
  if (wk == 0) {
    const float m1 = cm[wq * 64 + lane], l1 = cm[256 + wq * 64 + lane];
    const float mm = fmaxf(m, m1); float a0 = ex2(m - mm), a1 = ex2(m1 - mm);
    const float inv = 1.f / (lt * a0 + l1 * a1); a0 *= inv; a1 *= inv;
    const int t = qb * 128 + wq * 32 + l32;
    const u16* zg = (const u16*)(p.ws + WS_Z) + (size_t)t * ZLD + Z_MG + hd * 128;
    u16* Y = (u16*)(p.ws + WS_HY) + (size_t)t * DM + 512 + hd * 128;
#pragma unroll
    for (int mt = 0; mt < 4; ++mt)
#pragma unroll
      for (int q = 0; q < 4; ++q) {
        const int dv = mt * 32 + q * 8 + h * 4;
        const u32x2 g = *(const u32x2*)(zg + dv);
        float o[4];
#pragma unroll
        for (int j = 0; j < 4; ++j) o[j] = O[mt][q * 4 + j] * a0 + cO[(wq * 64 + mt * 16 + q * 4 + j) * 64 + lane] * a1;
        u32x2 v = {pack2(o[0] * silu(bflo(g[0])), o[1] * silu(bfhi(g[0]))), pack2(o[2] * silu(bflo(g[1])), o[3] * silu(bfhi(g[1])))};
        *(u32x2*)(Y + dv) = v;
      }
  }
  __syncthreads();
}

DI void transpose_tile(unsigned char* lds, const float* __restrict__ src, int ldsrc, u16* __restrict__ dst, int ldd, int k0, int n0, int nvalid, const float* gain) {
  float* tile = (float*)lds;
  const int tid = otid();
#pragma unroll
  for (int i = 0; i < 8; ++i) { const int idx = tid + i * NT, r = idx >> 6, cc = idx & 63, n = n0 + cc;
    float v = (n < nvalid) ? src[(size_t)(k0 + r) * ldsrc + n] : 0.f; if (gain) v *= gain[k0 + r]; tile[r * 65 + cc] = v; }
  __syncthreads();
#pragma unroll
  for (int i = 0; i < 8; ++i) { const int idx = tid + i * NT, r = idx >> 6, cc = idx & 63; dst[(size_t)(n0 + r) * ldd + k0 + cc] = tobf(tile[cc * 65 + r]); }
  __syncthreads();
}
DI float wave_sum(float v) { v += __shfl_xor(v, 32); v += __shfl_xor(v, 16); v += __shfl_xor(v, 8); v += __shfl_xor(v, 4); v += __shfl_xor(v, 2); v += __shfl_xor(v, 1); return v; }
DI void prenorm_row(const f32x4 (&v)[4], const float* g, u16* hrow, int lane) {
  float ss = 0.f;
#pragma unroll
  for (int i = 0; i < 4; ++i) ss += v[i][0] * v[i][0] + v[i][1] * v[i][1] + v[i][2] * v[i][2] + v[i][3] * v[i][3];
  ss = wave_sum(ss);
  const float r = rsqrtf(ss * (1.f / 1024.f) + EPS);
#pragma unroll
  for (int i = 0; i < 4; ++i) { const f32x4 gg = *(const f32x4*)(g + (lane + 64 * i) * 4);
    u32x2 o = {pack2(v[i][0] * r * gg[0], v[i][1] * r * gg[1]), pack2(v[i][2] * r * gg[2], v[i][3] * r * gg[3])};
    *(u32x2*)(hrow + (lane + 64 * i) * 4) = o; }
}

DI void phase_prep(unsigned char* lds, const P& p) {
  const int nb = gridDim.x, bid = blockIdx.x, tid = otid();
  u16* win = (u16*)(p.ws + WS_WIN); u16* wuq = (u16*)(p.ws + WS_WUQ); u16* wukv = (u16*)(p.ws + WS_WUKV); u16* wout = (u16*)(p.ws + WS_WOUT);
  for (int job = bid; job < 2 * 1032; job += nb) {
    const int layer = job / 1032; int r = job - layer * 1032;
    if (r < 640) { const int kt = r / 40, nt = r - kt * 40; transpose_tile(lds, p.w_in + (size_t)layer * 1024 * DIN, DIN, win + (size_t)layer * 2560 * 1024, 1024, kt * 64, nt * 64, DIN, nullptr); }
    else if (r < 712) { r -= 640; const int kt = r / 12, nt = r - kt * 12; transpose_tile(lds, p.w_uq + (size_t)layer * 384 * 768, 768, wuq + (size_t)layer * 768 * 384, 384, kt * 64, nt * 64, 768, p.q_norm_g + layer * 384); }
    else if (r < 776) { r -= 712; const int kt = r / 16, nt = r - kt * 16; transpose_tile(lds, p.w_ukv + (size_t)layer * 256 * 1024, 1024, wukv + (size_t)layer * 1024 * 256, 256, kt * 64, nt * 64, 1024, p.kv_norm_g + layer * 256); }
    else { r -= 776; const int kt = r / 16, nt = r - kt * 16; transpose_tile(lds, p.w_out + (size_t)layer * 1024 * 1024, 1024, wout + (size_t)layer * 1024 * 1024, 1024, kt * 64, nt * 64, 1024, nullptr); }
  }
  const int gtid = bid * NT + tid, gn = nb * NT;
  u16* sguw = (u16*)(p.ws + WS_SGUW);
  for (int idx = gtid; idx < 2 * 4 * 128 * 128; idx += gn) { const int i = (idx >> 7) & 127, j = idx & 127; sguw[idx] = ((j >> 6) <= (i >> 6)) ? tobf(p.sgu_w[idx]) : (u16)0; }
  u16* pwt = (u16*)(p.ws + WS_PWT);
  for (int idx = gtid; idx < 2 * 4 * 64 * 64; idx += gn) { const int lg = idx >> 12, d = (idx >> 6) & 63, c = idx & 63; pwt[idx] = tobf(p.pool_w[(lg * 64 + c) * 64 + d]); }
  float* cosT = (float*)(p.ws + WS_COS); float* sinT = (float*)(p.ws + WS_SIN);
  for (int idx = gtid; idx < S * 32; idx += gn) {
    const int t = idx >> 5, i = idx & 31; const float angf = (float)p.pos[t] * p.invfreq[i];
    const double a = (double)angf; const double k = rint(a * 0.15915494309189535); const double r = a - k * 6.283185307179586; const double r2 = r * r;
    double ts = r, ss = r, tc = 1.0, sc = 1.0;
#pragma unroll
    for (int n = 1; n <= 13; ++n) { ts *= -r2 * (1.0 / (double)((2 * n) * (2 * n + 1))); ss += ts; tc *= -r2 * (1.0 / (double)((2 * n - 1) * (2 * n))); sc += tc; }
    cosT[idx] = (float)sc; sinT[idx] = (float)ss;
  }
  u16* hb = (u16*)(p.ws + WS_HY);
  const int lane = tid & 63, wave = wave_of(tid);
  for (int row = bid * 8 + wave; row < S; row += nb * 16) {
    const int row2 = row + nb * 8; const bool has2 = row2 < S;
    f32x4 v[4], v2[4];
#pragma unroll
    for (int i = 0; i < 4; ++i) v[i] = *(const f32x4*)(p.x + (size_t)row * DM + (lane + 64 * i) * 4);
    if (has2) {
#pragma unroll
      for (int i = 0; i < 4; ++i) v2[i] = *(const f32x4*)(p.x + (size_t)row2 * DM + (lane + 64 * i) * 4);
    }
    prenorm_row(v, p.pre_g, hb + (size_t)row * DM, lane);
    if (has2) prenorm_row(v2, p.pre_g, hb + (size_t)row2 * DM, lane);
  }
}

DI void post_load(const u16* yout, const float* xold, int row, int lane, f32x4 (&y)[4], f32x4 (&xo)[4]) {
#pragma unroll
  for (int i = 0; i < 4; ++i) { const u32x2 yb = *(const u32x2*)(yout + (size_t)row * DM + (lane + 64 * i) * 4); y[i] = (f32x4){bflo(yb[0]), bfhi(yb[0]), bflo(yb[1]), bfhi(yb[1])};
    xo[i] = *(const f32x4*)(xold + (size_t)row * DM + (lane + 64 * i) * 4); }
}
DI void post_finish(const P& p, int layer, int row, int lane, f32x4 (&y)[4], const f32x4 (&xo)[4], u16* hb) {
  float ss = 0.f;
#pragma unroll
  for (int i = 0; i < 4; ++i) ss += y[i][0] * y[i][0] + y[i][1] * y[i][1] + y[i][2] * y[i][2] + y[i][3] * y[i][3];
  ss = wave_sum(ss);
  const float r = rsqrtf(ss * (1.f / 1024.f) + EPS);
#pragma unroll
  for (int i = 0; i < 4; ++i) {
    const f32x4 g = *(const f32x4*)(p.post_g + layer * DM + (lane + 64 * i) * 4);
    y[i] = xo[i] + y[i] * r * g;
    *(f32x4*)(p.out + (size_t)row * DM + (lane + 64 * i) * 4) = y[i];
  }
  if (layer + 1 < DEPTH) prenorm_row(y, p.pre_g + (layer + 1) * DM, hb + (size_t)row * DM, lane);
}
DI void phase_post(const P& p, int layer) {
  const int nb = gridDim.x, bid = blockIdx.x, tid = otid(), lane = tid & 63, wave = wave_of(tid);
  const u16* yout = (const u16*)(p.ws + WS_Z); const float* xold = layer == 0 ? p.x : p.out;
  u16* hb = (u16*)(p.ws + WS_HY);
  for (int row = bid * 8 + wave; row < S; row += nb * 16) {
    const int row2 = row + nb * 8; const bool has2 = row2 < S;
    f32x4 y0[4], x0[4], y1[4], x1[4];
    post_load(yout, xold, row, lane, y0, x0);
    if (has2) post_load(yout, xold, row2, lane, y1, x1);
    post_finish(p, layer, row, lane, y0, x0, hb);
    if (has2) post_finish(p, layer, row2, lane, y1, x1, hb);
  }
}

__global__ void __launch_bounds__(NT) mega(P p) {
  extern __shared__ __attribute__((aligned(16))) unsigned char lds[];
  cg::grid_group grid = cg::this_grid();
  const int nb = gridDim.x, bid = blockIdx.x;
  if (threadIdx.x < 4) ((unsigned*)(lds + XB_LDS_OFF))[threadIdx.x] = 0u;
  __syncthreads();
  XcdBarrier xbar = xcd_barrier_post((unsigned*)(p.ws + WS_BAR), (volatile LAS unsigned*)(lds + XB_LDS_OFF));
  unsigned* xcnt = (unsigned*)(p.ws + WS_BAR + 14336);
  unsigned myslot = 0;
  if (threadIdx.x == 0) myslot = xb_add(&xcnt[16 * xbar.x], 1u);
  int vid = bid;
  int ph = 0;
#define RUN(ph_) ((ph_) >= p.ph_lo && (ph_) < p.ph_hi)
#define SEAM(ph_) do { if (RUN(ph_) && RUN((ph_) + 1)) { if (p.ph_hi < 0) grid.sync(); else xcd_barrier(xbar); } } while (0)
  for (int rep = 0; rep < (DUP == 5 ? 2 : 1); ++rep)
  if (RUN(ph)) phase_prep(lds, p);
  SEAM(ph); ++ph;
  if (p.ph_hi - p.ph_lo > 1) {
    if (threadIdx.x == 0) { bool even = (nb & 7) == 0; for (int j = 0; j < 8; ++j) even = even && (xb_ld(&xcnt[16 * j]) == (unsigned)(nb >> 3));
      ((volatile LAS unsigned*)(lds + XB_LDS_OFF))[2] = even ? (myslot * 8u + xbar.x) : (unsigned)bid; }
    __syncthreads();
    vid = __builtin_amdgcn_readfirstlane((int)((volatile LAS unsigned*)(lds + XB_LDS_OFF))[2]);
  }
#pragma unroll 1
  for (int layer = 0; layer < DEPTH; ++layer) {
    u16* hy = (u16*)(p.ws + WS_HY); u16* z = (u16*)(p.ws + WS_Z);
    float* rs = (float*)(lds + RS_OFF);
    for (int rep = 0; rep < (DUP == 1 ? 2 : 1); ++rep)
    if (RUN(ph)) {
      const u16* W = (const u16*)(p.ws + WS_WIN) + (size_t)layer * 2560 * 1024;
      { pg8::Gemm g{hy, W, S, 2560, 1024}; pg8::StaticOrder so; so.init(S, 2560, nb, vid);
        pg8::EpiBf16<0> E{z, ZLD, nullptr, 0, 0};
        pg8::gemm_phase<pg8::EpiBf16<0>, pg8::StaticOrder, false>((PG8_LAS unsigned char*)lds, g, so, E, nullptr); }
    }
    SEAM(ph); ++ph;
    for (int rep = 0; rep < (DUP == 2 ? 2 : 1); ++rep)
    if (RUN(ph)) {
      const float* cosT = (const float*)(p.ws + WS_COS); const float* sinT = (const float*)(p.ws + WS_SIN);
      for (int job = vid; job < 1152; job += nb) {
        __syncthreads();
        const int x = job & 7, j = job >> 3;
        if (j < 48) { const int ntl = j / 3, mt = j - ntl * 3, n0 = (16 * x + ntl) * 128;
          const u16* X = z + (size_t)n0 * ZLD + Z_CQ; row_rstd(rs, X, ZLD, 384);
          EpiQ e{(u16*)(p.ws + WS_Q), cosT, sinT, rs, n0};
          gemm_tile<2>(lds, (const u16*)(p.ws + WS_WUQ) + (size_t)layer * 768 * 384 + (size_t)mt * 256 * 384, X, ZLD, 384, mt * 256, n0, e);
        } else if (j < 112) { const int j2 = j - 48, mt = j2 & 3, n0 = (16 * x + (j2 >> 2)) * 128;
          const u16* X = z + (size_t)n0 * ZLD + Z_CKV; row_rstd(rs, X, ZLD, 256);
          EpiKV e{(u16*)(p.ws + WS_K), (u16*)(p.ws + WS_VT), rs, n0};
          gemm_tile<2>(lds, (const u16*)(p.ws + WS_WUKV) + (size_t)layer * 1024 * 256 + (size_t)mt * 256 * 256, X, ZLD, 256, mt * 256, n0, e);
          if (mt == 0) krope_tile(p, n0);
        } else if (j < 128) sgu_job(lds, p, layer, 16 * x + (j - 112));
        else pool_job(lds, p, layer, 16 * x + (j - 128));
      }
    }
    SEAM(ph); ++ph;
    for (int rep = 0; rep < (DUP == 3 ? 2 : 1); ++rep)
    if (RUN(ph)) {
      for (int it = vid; it < 256; it += nb) {
        const int hd = (it & 7) >> 1, pr = (it >> 3) * 2 + (it & 1);
        attn_item(lds, p, hd, 127 - pr);
        attn_item(lds, p, hd, pr);
      }
    }
    SEAM(ph); ++ph;
    for (int rep = 0; rep < (DUP == 4 ? 2 : 1); ++rep)
    if (RUN(ph)) {
      const u16* W = (const u16*)(p.ws + WS_WOUT) + (size_t)layer * 1024 * 1024;
      { pg8::Gemm g{hy, W, S, 1024, 1024}; pg8::StaticOrder so; so.init(S, 1024, nb, vid);
        pg8::EpiBf16<0> E{(u16*)(p.ws + WS_Z), 1024, nullptr, 0, 0};
        pg8::gemm_phase<pg8::EpiBf16<0>, pg8::StaticOrder, false>((PG8_LAS unsigned char*)lds, g, so, E, nullptr); }
    }
    SEAM(ph); ++ph;
    for (int rep = 0; rep < ((DUP == 6 && layer == 0) ? 2 : 1); ++rep)
    if (RUN(ph)) phase_post(p, layer);
    SEAM(ph); ++ph;
  }
  if (p.ph_hi - p.ph_lo > 1) xcd_barrier(xbar);
}
constexpr int NPHASE = 1 + 5 * DEPTH;

extern "C" void kernel_launch(void* const* d_in, const int* in_sizes, int n_in, void* d_out, int out_size, void* d_ws, size_t ws_size, hipStream_t stream) {
  static int grid_blocks = 0;
  if (!grid_blocks) {
    int dev = 0, cus = 0, per_cu = 0;
    hipGetDevice(&dev);
    hipDeviceGetAttribute(&cus, hipDeviceAttributeMultiprocessorCount, dev);
    hipFuncSetAttribute((const void*)mega, hipFuncAttributeMaxDynamicSharedMemorySize, LDS_BYTES);
    hipOccupancyMaxActiveBlocksPerMultiprocessor(&per_cu, (const void*)mega, NT, LDS_BYTES);
    if (per_cu < 1) { fprintf(stderr, "occupancy query returned %d\n", per_cu); per_cu = 1; }
    if (per_cu > 1) per_cu = 1;
    grid_blocks = cus * per_cu;
    if (ws_size < WS_END) fprintf(stderr, "workspace too small: %zu < %zu\n", ws_size, (size_t)WS_END);
  }
  P p{};
  p.x = (const float*)d_in[0]; p.pos = (const int*)d_in[1]; p.pre_g = (const float*)d_in[2]; p.post_g = (const float*)d_in[3];
  p.w_in = (const float*)d_in[4]; p.sgu_w = (const float*)d_in[5]; p.sgu_b = (const float*)d_in[6]; p.sgu_ln_g = (const float*)d_in[7];
  p.sgu_ln_b = (const float*)d_in[8]; p.pool_w = (const float*)d_in[9]; p.pool_scale = (const float*)d_in[10]; p.q_norm_g = (const float*)d_in[11];
  p.w_uq = (const float*)d_in[12]; p.kv_norm_g = (const float*)d_in[13]; p.w_ukv = (const float*)d_in[14]; p.w_out = (const float*)d_in[15];
  p.out = (float*)d_out; p.ws = (unsigned char*)d_ws;
  for (int i = 0; i < 32; ++i) p.invfreq[i] = powf(10000.0f, -(float)(2 * i) / 64.0f);
  hipMemsetAsync((char*)d_ws + WS_BAR, 0, 16384, stream);
#if COOP
  p.ph_lo = 0; p.ph_hi = NPHASE;
  void* args[] = {&p};
  hipError_t e = hipLaunchCooperativeKernel((void*)mega, dim3(grid_blocks), dim3(NT), args, LDS_BYTES, stream);
  if (e != hipSuccess) fprintf(stderr, "cooperative launch failed: %s (grid %d)\n", hipGetErrorString(e), grid_blocks);
#else
  for (int ph = 0; ph < NPHASE; ++ph) { p.ph_lo = ph; p.ph_hi = ph + 1; hipLaunchKernelGGL(mega, dim3(grid_blocks), dim3(NT), LDS_BYTES, stream, p); }
#endif
}
```

```cpp
#include <hip/hip_runtime.h>
#include <hip/hip_cooperative_groups.h>
#include <cstdio>
#include <cmath>
namespace cg = cooperative_groups;

#define DI __device__ __forceinline__
typedef unsigned short u16;
using bf16x8 = __attribute__((ext_vector_type(8))) short;
using f32x16 = __attribute__((ext_vector_type(16))) float;
using f32x4  = __attribute__((ext_vector_type(4))) float;
using f32x2  = __attribute__((ext_vector_type(2))) float;
using u32x4  = __attribute__((ext_vector_type(4))) unsigned;
using u32x2  = __attribute__((ext_vector_type(2))) unsigned;
typedef __bf16 bf2_t __attribute__((ext_vector_type(2)));
#define MFMA(a, b, c) __builtin_amdgcn_mfma_f32_32x32x16_bf16((a), (b), (c), 0, 0, 0)

#ifndef COOP
#define COOP 1
#endif
#ifndef DUP
#define DUP 7
#endif

constexpr int S = 16384, DM = 1024, DIN = 2496, ZLD = 2560, NT = 512, DEPTH = 2;
constexpr float EPS = 1e-6f;
constexpr float QSCALE = 0.07216878364870322f * 1.4426950408889634f;
constexpr int Z_U = 0, Z_V = 256, Z_SG = 512, Z_PI = 768, Z_PG = 1024, Z_CQ = 1280, Z_CKV = 1664, Z_KR = 1920, Z_MG = 1984;

constexpr size_t WS_HY   = 0;
constexpr size_t WS_Z    = WS_HY + (size_t)S * 1024 * 2;
constexpr size_t WS_Q    = WS_Z + (size_t)S * ZLD * 2;
constexpr size_t WS_K    = WS_Q + (size_t)4 * S * 192 * 2;
constexpr size_t WS_VT   = WS_K + (size_t)4 * S * 192 * 2;
constexpr size_t WS_WIN  = WS_VT + (size_t)4 * S * 128 * 2;
constexpr size_t WS_WUQ  = WS_WIN + (size_t)2 * 2560 * 1024 * 2;
constexpr size_t WS_WUKV = WS_WUQ + (size_t)2 * 768 * 384 * 2;
constexpr size_t WS_WOUT = WS_WUKV + (size_t)2 * 1024 * 256 * 2;
constexpr size_t WS_SGUW = WS_WOUT + (size_t)2 * 1024 * 1024 * 2;
constexpr size_t WS_PWT  = WS_SGUW + (size_t)2 * 4 * 128 * 128 * 2;
constexpr size_t WS_COS  = WS_PWT + (size_t)2 * 4 * 64 * 64 * 2;
constexpr size_t WS_SIN  = WS_COS + (size_t)S * 32 * 4;
constexpr size_t WS_BAR  = WS_SIN + (size_t)S * 32 * 4;
constexpr size_t WS_END  = WS_BAR + 16384;

constexpr int GEMM_STAGE = 512 * 144;
constexpr int RS_OFF = 2 * GEMM_STAGE;
constexpr int XB_LDS_OFF = RS_OFF + 1024;
constexpr int LDS_BYTES = XB_LDS_OFF + 16;
constexpr int ATT_STAGE = 64 * 400 + 128 * 144;

struct P {
  const float* x; const int* pos; const float* pre_g; const float* post_g; const float* w_in; const float* sgu_w; const float* sgu_b;
  const float* sgu_ln_g; const float* sgu_ln_b; const float* pool_w; const float* pool_scale; const float* q_norm_g; const float* w_uq;
  const float* kv_norm_g; const float* w_ukv; const float* w_out;
  float* out; unsigned char* ws;
  float invfreq[32];
  int ph_lo, ph_hi;
};

DI int otid() { int t = threadIdx.x; asm volatile("" : "+v"(t)); return t; }
DI int wave_of(int tid) { return __builtin_amdgcn_readfirstlane(tid >> 6); }
DI void lds_barrier() { asm volatile("s_waitcnt lgkmcnt(0)" ::: "memory"); __builtin_amdgcn_s_barrier(); asm volatile("" ::: "memory"); }
DI unsigned pack2(float a, float b) { f32x2 v = {a, b}; return __builtin_bit_cast(unsigned, __builtin_convertvector(v, bf2_t)); }
DI u16 tobf(float a) { return (u16)(pack2(a, 0.f) & 0xffffu); }
DI float bflo(unsigned u) { return __uint_as_float(u << 16); }
DI float bfhi(unsigned u) { return __uint_as_float(u & 0xffff0000u); }
DI float silu(float x) { return x / (1.f + __expf(-x)); }
DI float ex2(float x) { return __builtin_amdgcn_exp2f(x); }
DI f32x16 zero16() { f32x16 z; for (int i = 0; i < 16; ++i) z[i] = 0.f; return z; }

#define XB_TMO      128
#define XB_XCNT(j)  (256  + 64 * (j))
#define XB_XSUB(j)  (1280 + 64 * (j))
#define XB_XGEN(j)  (2304 + 64 * (j))
#define XB_TOP      3328
#define XB_TOPGEN   3392
#define XCD_BAR_WORDS 3456
#define XB_SPIN_CAP (1u << 18)
#define LAS __attribute__((address_space(3)))

__device__ __forceinline__ unsigned xb_ld(unsigned* p)              { return __hip_atomic_load(p, __ATOMIC_RELAXED, __HIP_MEMORY_SCOPE_AGENT); }
__device__ __forceinline__ unsigned xb_add(unsigned* p, unsigned v) { return __hip_atomic_fetch_add(p, v, __ATOMIC_RELAXED, __HIP_MEMORY_SCOPE_AGENT); }
__device__ __forceinline__ unsigned xb_xcc_id() { return (unsigned)__builtin_amdgcn_s_getreg((3 << 11) | 20) & 0xFu; }
#define XB_SPIN(cond, bar) do { unsigned _sp = 0; while (cond) { __builtin_amdgcn_s_sleep(1); \
    if ((++_sp & 255u) == 0u) { if (xb_ld(&(bar)[XB_TMO])) break; if (_sp > XB_SPIN_CAP) { atomicAdd(&(bar)[XB_TMO], 1u); break; } } } } while (0)

struct XcdBarrier {
    unsigned* bar; unsigned x;
    volatile LAS unsigned* st;
};

__device__ __forceinline__ XcdBarrier xcd_barrier_post(unsigned* bar, volatile LAS unsigned* st) {
    XcdBarrier b; b.bar = bar; b.x = xb_xcc_id(); b.st = st;
    if (threadIdx.x == 0) (void)xb_add(&bar[XB_XCNT(b.x)], 1u);
    return b;
}
__device__ __forceinline__ void xcd_barrier_complete(unsigned* bar, unsigned x, unsigned& nloc, unsigned& nx) {
    const unsigned G = gridDim.x * gridDim.y * gridDim.z;
    unsigned sum, cnt, mine, sp = 0u;
    for (;;) {
        sum = 0u; cnt = 0u; mine = 0u;
#pragma unroll
        for (unsigned j = 0; j < 16; ++j) { const unsigned c = xb_ld(&bar[XB_XCNT(j)]); sum += c; cnt += (c > 0u) ? 1u : 0u; mine = (j == x) ? c : mine; }
        if (sum == G) break;
        __builtin_amdgcn_s_sleep(1);
        if ((++sp & 255u) == 0u) { if (xb_ld(&bar[XB_TMO])) break; if (sp > XB_SPIN_CAP) { atomicAdd(&bar[XB_TMO], 1u); break; } }
    }
    nloc = mine > 0u ? mine : 1u; nx = cnt > 0u ? cnt : 1u;
}

__device__ __forceinline__ void xcd_barrier(const XcdBarrier& b) {
    asm volatile("s_waitcnt vmcnt(0)" ::: "memory");
    __syncthreads();
    if (threadIdx.x == 0) {
        unsigned* bar = b.bar;
        __builtin_amdgcn_s_waitcnt(0);
        unsigned nloc = b.st[0], nx = b.st[1];
        if (nloc == 0u) { xcd_barrier_complete(bar, b.x, nloc, nx); b.st[0] = nloc; b.st[1] = nx; }
        const unsigned old = xb_add(&bar[XB_XSUB(b.x)], 1u);
        const unsigned gen = old / nloc;
        if (old + 1u == (gen + 1u) * nloc) {
            __builtin_amdgcn_fence(__ATOMIC_RELEASE, "agent");
            asm volatile("s_waitcnt vmcnt(0)" ::: "memory");
            const unsigned og = xb_add(&bar[XB_TOP], 1u);
            const unsigned tg = og / nx;
            if (og + 1u == (tg + 1u) * nx) xb_add(&bar[XB_TOPGEN], 1u);
            else XB_SPIN(xb_ld(&bar[XB_TOPGEN]) == tg, bar);
            __builtin_amdgcn_fence(__ATOMIC_ACQUIRE, "agent");
            xb_add(&bar[XB_XGEN(b.x)], 1u);
            asm volatile("s_waitcnt vmcnt(0)" ::: "memory");
        } else {
            XB_SPIN(xb_ld(&bar[XB_XGEN(b.x)]) == gen, bar);
            __builtin_amdgcn_fence(__ATOMIC_ACQUIRE, "agent");
            asm volatile("s_waitcnt vmcnt(0)" ::: "memory");
        }
    }
    __syncthreads();
}


namespace pg8 {
#define PG8_LAS __attribute__((address_space(3)))
typedef unsigned short bf16_t;
typedef short bf16x8 __attribute__((ext_vector_type(8)));
typedef float f32x4 __attribute__((ext_vector_type(4)));
typedef unsigned u32x4 __attribute__((ext_vector_type(4)));
constexpr int BM = 256, BK = 64, HALF = 128, HTB = HALF * BK * 2  , STAGE_BYTES = 8 * HTB, NXCD = 8, WGM = 8;

__host__ __device__ __forceinline__ int lds_byte(int r, int c) { const int st = (r >> 4) * 2 + (c >> 5), rr = r & 15, cc = c & 31, ob = rr * 64 + cc * 2; return st * 1024 + (ob ^ (((ob >> 9) & 1) << 5)); }
__host__ __device__ __forceinline__ void stage_rc(int b, int& R, int& C) { const int st = b / 1024, sb = b % 1024, swz = sb ^ (((sb >> 9) & 1) << 5); R = (st >> 1) * 16 + swz / 64; C = (st & 1) * 32 + (swz % 64) / 2; }
__host__ __device__ __forceinline__ int perm32(int rho) { const int n = rho >> 4, i = rho & 15; return 8 * (i >> 2) + 4 * n + (i & 3); }

struct Unit { int pm, pn; };
struct Gemm { const bf16_t* A; const bf16_t* Bt; int M, N, K; };

struct StaticOrder {
    int nM, nN, nwg, G, c;
    __host__ __device__ void init(int M, int N, int G_, int c_) { nM = M / BM; nN = N / BM; nwg = nM * nN; G = G_; c = c_; }
    __host__ __device__ bool next(int i, Unit& u) const {
        const long L = (long)i * G + c; if (L >= nwg) return false;
        int wgid = (int)L; { const int q = nwg / NXCD, r = nwg % NXCD, xcd = wgid % NXCD, off = wgid / NXCD; wgid = (xcd < r ? xcd * (q + 1) : r * (q + 1) + (xcd - r) * q) + off; }
        const int nig = WGM * nN, gid = wgid / nig, fm = gid * WGM, gsz = (nM - fm) < WGM ? (nM - fm) : WGM;
        u.pm = fm + ((wgid % nig) % gsz); u.pn = (wgid % nig) / gsz; return true;
    }
    __device__ __forceinline__ void a_ready(const Unit&) const {}
    __device__ __forceinline__ void done(const Unit&) const {}
};
__device__ __forceinline__ unsigned cvt_pk_bf16(float lo, float hi) { unsigned r; asm volatile("v_cvt_pk_bf16_f32 %0, %1, %2" : "=v"(r) : "v"(lo), "v"(hi)); return r; }
typedef float f32x2 __attribute__((ext_vector_type(2)));
__device__ __forceinline__ f32x2 gelu_pk(f32x2 v) {
    const f32x2 av = __builtin_elementwise_abs(v), d = av * 0.2316418882f + 1.0f;
    f32x2 t; t.x = __builtin_amdgcn_rcpf(d.x); t.y = __builtin_amdgcn_rcpf(d.y);
    f32x2 q = t * 0.5307027145f + (-0.7265760135f); q = q * t + 0.7107068705f; q = q * t + (-0.142248368f); q = q * t + 0.127414796f; q = q * t;
    const f32x2 s = (v * v) * (-0.72134752044f);
    f32x2 e; e.x = __builtin_amdgcn_exp2f(s.x); e.y = __builtin_amdgcn_exp2f(s.y);
    const f32x2 m = v * (q * e), r = v - m;
    f32x2 o; o.x = v.x < 0.f ? m.x : r.x; o.y = v.y < 0.f ? m.y : r.y; return o;
}

template <int ACT  > struct EpiBf16 {
    static constexpr bool PERM = true, AFTER_DRAIN = false;
    bf16_t* O; int ldc; const float* bias; int split_cols; size_t split_stride;
    __device__ __forceinline__ void operator()(const f32x4 (&acc)[2][2][4][2], const Unit& u, int wr, int wc, int fr, int fq) const {
        const int row0 = u.pm * BM + wr * 64 + fr; int colt = u.pn * BM; bf16_t* base = O;
        if (split_cols) { const int t = colt / split_cols; base += (size_t)t * split_stride; colt -= t * split_cols; }
        const int col0 = colt + wc * 32 + 8 * fq, bcol0 = u.pn * BM + wc * 32 + 8 * fq;
        f32x4 bv[2][2];
#pragma unroll
        for (int bj = 0; bj < 2; ++bj)
#pragma unroll
            for (int n = 0; n < 2; ++n) bv[bj][n] = bias ? *(const f32x4*)(bias + bcol0 + bj * HALF + 4 * n) : (f32x4){0.f, 0.f, 0.f, 0.f};
#pragma unroll
        for (int ai = 0; ai < 2; ++ai)
#pragma unroll
            for (int m = 0; m < 4; ++m) { bf16_t* rowp = base + (size_t)(row0 + ai * HALF + m * 16) * ldc + col0;
#pragma unroll
                for (int bj = 0; bj < 2; ++bj) { f32x4 v0 = acc[ai][bj][m][0] + bv[bj][0], v1 = acc[ai][bj][m][1] + bv[bj][1];
                    if (ACT == 1) { f32x2 a = gelu_pk((f32x2){v0[0], v0[1]}), b = gelu_pk((f32x2){v0[2], v0[3]}), c = gelu_pk((f32x2){v1[0], v1[1]}), d = gelu_pk((f32x2){v1[2], v1[3]});
                        v0 = (f32x4){a.x, a.y, b.x, b.y}; v1 = (f32x4){c.x, c.y, d.x, d.y}; }
                    if (ACT == 2) {
#pragma unroll
                        for (int j = 0; j < 4; ++j) { v0[j] = 0.5f * v0[j] * (1.0f + erff(v0[j] * 0.70710678f)); v1[j] = 0.5f * v1[j] * (1.0f + erff(v1[j] * 0.70710678f)); } }
                    u32x4 w; w.x = cvt_pk_bf16(v0[0], v0[1]); w.y = cvt_pk_bf16(v0[2], v0[3]); w.z = cvt_pk_bf16(v1[0], v1[1]); w.w = cvt_pk_bf16(v1[2], v1[3]);
                    *(u32x4*)(rowp + bj * HALF) = w; } }
    }
};

template <class Epi, class Sched, bool STAMP = false>
__device__ __forceinline__ void gemm_phase(PG8_LAS unsigned char* lds, const Gemm g, const Sched& S, const Epi& E, unsigned long long* stamps) {
    const int tid = otid(), wid = __builtin_amdgcn_readfirstlane(tid >> 6), lane = tid & 63, wr = wid >> 2, wc = wid & 3, fr = lane & 15, fq = lane >> 4;
    const int K = g.K, nt = K / BK;
    int ts_lo = 0, ts_hi = 0, nts = 0; const unsigned long long rt_entry = STAMP ? (unsigned long long)wall_clock64() : 0ull;
#define PG8_STAMP() do { if (STAMP && wid == 0 && nts < 64) { const unsigned long long _c = (unsigned long long)clock64(); \
        ts_lo = (lane == nts) ? (int)(unsigned)_c : ts_lo; ts_hi = (lane == nts) ? (int)(unsigned)(_c >> 32) : ts_hi; ++nts; } } while (0)
    PG8_STAMP();
    unsigned voffA[2], voffB[2];
#pragma unroll
    for (int i = 0; i < 2; ++i) { int R, C; stage_rc(tid * 16 + i * 8192, R, C); const int Rb = Epi::PERM ? ((R & ~31) + perm32(R & 31)) : R;
        voffA[i] = (unsigned)(R * K + C) * 2u; voffB[i] = (unsigned)(Rb * K + C) * 2u; }
    const size_t kstep = (size_t)(BK * 2);
    const size_t hstep = (size_t)HALF * K * 2;
    const size_t tstep = 2 * hstep;
    const unsigned ldsw = (unsigned)wid * 1024u;
    const int aoff = lds_byte(wr * 64 + fr, fq * 8), boff = lds_byte(wc * 32 + fr, fq * 8);
#define PG8_SA(b, h) (((b) * 2 + (h)) * HTB)
#define PG8_SB(b, h) ((4 + (b) * 2 + (h)) * HTB)
#define PG8_STAGE(bufoff, gbase, voff) do { _Pragma("unroll") for (int _i = 0; _i < 2; ++_i) \
        __builtin_amdgcn_global_load_lds((const unsigned*)((const char*)(gbase) + (voff)[_i]), (PG8_LAS unsigned*)(lds + (bufoff) + ldsw + _i * 8192), 16, 0, 0); } while (0)
#define PG8_LDA(dst, b, h) do { _Pragma("unroll") for (int m = 0; m < 4; ++m) _Pragma("unroll") for (int k = 0; k < 2; ++k) dst[m][k] = *(const PG8_LAS bf16x8*)(lds + PG8_SA(b, h) + aoff + m * 2048 + k * 1024); } while (0)
#define PG8_LDB(dst, b, h) do { _Pragma("unroll") for (int n = 0; n < 2; ++n) _Pragma("unroll") for (int k = 0; k < 2; ++k) dst[n][k] = *(const PG8_LAS bf16x8*)(lds + PG8_SB(b, h) + boff + n * 2048 + k * 1024); } while (0)
#define PG8_MMA(ai, bj, At, Bt) do { __builtin_amdgcn_s_setprio(1); _Pragma("unroll") for (int m = 0; m < 4; ++m) _Pragma("unroll") for (int n = 0; n < 2; ++n) _Pragma("unroll") for (int k = 0; k < 2; ++k) \
        acc[ai][bj][m][n] = __builtin_amdgcn_mfma_f32_16x16x32_bf16(Bt[n][k], At[m][k], acc[ai][bj][m][n], 0, 0, 0); __builtin_amdgcn_s_setprio(0); } while (0)
#define PG8_WAIT_V(n) asm volatile("s_waitcnt vmcnt(" #n ")" ::: "memory")
#define PG8_WAIT_L(n) asm volatile("s_waitcnt lgkmcnt(" #n ")" ::: "memory")
#define PG8_BAR __builtin_amdgcn_s_barrier()
#define PG8_SCHED __builtin_amdgcn_sched_barrier(0)
    Unit cur, nxt; int ui = 0;
    if (!S.next(0, cur)) return;
    f32x4 acc[2][2][4][2];
#pragma unroll
    for (int a = 0; a < 2; ++a)
#pragma unroll
        for (int b = 0; b < 2; ++b)
#pragma unroll
            for (int m = 0; m < 4; ++m)
#pragma unroll
                for (int n = 0; n < 2; ++n) acc[a][b][m][n] = (f32x4){0.f, 0.f, 0.f, 0.f};
    bf16x8 At[4][2], B0[2][2], B1[2][2];
    const char* cA = (const char*)g.A + (size_t)cur.pm * tstep; const char* cB = (const char*)g.Bt + (size_t)cur.pn * tstep;
    S.a_ready(cur);
    PG8_STAGE(PG8_SB(0, 0), cB, voffB); PG8_STAGE(PG8_SA(0, 0), cA, voffA); PG8_STAGE(PG8_SB(0, 1), cB + hstep, voffB); PG8_STAGE(PG8_SA(0, 1), cA + hstep, voffA);
    if (wr == 1) PG8_BAR;
    PG8_WAIT_V(4); PG8_BAR;
    PG8_STAGE(PG8_SB(1, 0), cB + kstep, voffB); PG8_STAGE(PG8_SA(1, 0), cA + kstep, voffA); PG8_STAGE(PG8_SB(1, 1), cB + hstep + kstep, voffB);
    PG8_WAIT_V(6); PG8_BAR;
    PG8_STAMP();
    for (;;) {
        const bool has_next = S.next(ui + 1, nxt);
        const char* nA = has_next ? (const char*)g.A + (size_t)nxt.pm * tstep : cA; const char* nB = has_next ? (const char*)g.Bt + (size_t)nxt.pn * tstep : cB;
        for (int t = 0; t < nt; t += 2) {
            const bool last = (t == nt - 2);
            const char* a1 = cA + (size_t)(t + 1) * kstep;
            const char* a2 = last ? nA : cA + (size_t)(t + 2) * kstep; const char* b2 = last ? nB : cB + (size_t)(t + 2) * kstep;
            const char* a3 = a2 + kstep; const char* b3 = b2 + kstep;
            if (last && has_next) S.a_ready(nxt);
            PG8_LDB(B0, 0, 0); PG8_SCHED; PG8_LDA(At, 0, 0); PG8_STAGE(PG8_SA(1, 1), a1 + hstep, voffA);
            PG8_WAIT_L(8); PG8_BAR; PG8_WAIT_L(0); PG8_MMA(0, 0, At, B0); PG8_BAR; PG8_SCHED;
            PG8_LDB(B1, 0, 1); PG8_STAGE(PG8_SB(0, 0), b2, voffB);
            PG8_BAR; PG8_WAIT_L(0); PG8_MMA(0, 1, At, B1); PG8_BAR;
            PG8_LDA(At, 0, 1); PG8_STAGE(PG8_SA(0, 0), a2, voffA);
            PG8_BAR; PG8_WAIT_L(0); PG8_MMA(1, 0, At, B0); PG8_BAR; PG8_SCHED;
            PG8_STAGE(PG8_SB(0, 1), b2 + hstep, voffB);
            PG8_WAIT_V(6); PG8_BAR; PG8_MMA(1, 1, At, B1); PG8_BAR;
            PG8_LDB(B0, 1, 0); PG8_SCHED; PG8_LDA(At, 1, 0); PG8_STAGE(PG8_SA(0, 1), a2 + hstep, voffA);
            PG8_WAIT_L(8); PG8_BAR; PG8_WAIT_L(0); PG8_MMA(0, 0, At, B0); PG8_BAR; PG8_SCHED;
            PG8_LDB(B1, 1, 1); PG8_STAGE(PG8_SB(1, 0), b3, voffB);
            PG8_BAR; PG8_WAIT_L(0); PG8_MMA(0, 1, At, B1); PG8_BAR;
            PG8_LDA(At, 1, 1); PG8_STAGE(PG8_SA(1, 0), a3, voffA);
            PG8_BAR; PG8_WAIT_L(0); PG8_MMA(1, 0, At, B0); PG8_BAR; PG8_SCHED;
            PG8_STAGE(PG8_SB(1, 1), b3 + hstep, voffB);
            PG8_WAIT_V(6); PG8_BAR; PG8_MMA(1, 1, At, B1); PG8_BAR;
        }
        PG8_STAMP();
        if constexpr (!Epi::AFTER_DRAIN) { E(acc, cur, wr, wc, fr, fq); S.done(cur); }
        PG8_STAMP();
        if (!has_next) break;
#pragma unroll
        for (int a = 0; a < 2; ++a)
#pragma unroll
            for (int b = 0; b < 2; ++b)
#pragma unroll
                for (int m = 0; m < 4; ++m)
#pragma unroll
                    for (int n = 0; n < 2; ++n) acc[a][b][m][n] = (f32x4){0.f, 0.f, 0.f, 0.f};
        cur = nxt; cA = nA; cB = nB; ++ui;
    }
    PG8_WAIT_V(0);
    if (wr == 0) PG8_BAR;
    PG8_BAR;
    if constexpr (Epi::AFTER_DRAIN) { E.fused(acc, cur, wr, wc, fr, fq, lds, wid, lane); S.done(cur); }
    PG8_STAMP();
    if (STAMP && wid == 0) { stamps[lane] = lane < nts ? (((unsigned long long)(unsigned)ts_hi << 32) | (unsigned)ts_lo) : 0ull;
        if (lane == 62) stamps[62] = rt_entry; if (lane == 63) stamps[63] = (unsigned long long)wall_clock64(); }
#undef PG8_STAMP
#undef PG8_SA
#undef PG8_SB
#undef PG8_STAGE
#undef PG8_LDA
#undef PG8_LDB
#undef PG8_MMA
#undef PG8_WAIT_V
#undef PG8_WAIT_L
#undef PG8_BAR
#undef PG8_SCHED
}
}
template <int NTW, class Epi>
DI void gemm_tile(unsigned char* lds, const u16* __restrict__ A, const u16* __restrict__ X, int ldx, int K, int m0, int n0, Epi& epi) {
  const int tid = otid(), lane = tid & 63, wave = wave_of(tid);
  const int wm = wave & 3, wn = wave >> 2, l32 = lane & 31, h = lane >> 5;
  f32x16 acc[2][NTW];
#pragma unroll
  for (int i = 0; i < 2; ++i)
#pragma unroll
    for (int j = 0; j < NTW; ++j) acc[i][j] = zero16();
  const int nk = K >> 6;
  const int lrow = tid >> 3, lcol = tid & 7;
  const u16* ga = A + (size_t)lrow * K + lcol * 8;
  const u16* gx = X + (size_t)lrow * ldx + lcol * 8;
  u32x4 ra[4], rb[NTW];
#pragma unroll
  for (int i = 0; i < 4; ++i) ra[i] = *(const u32x4*)(ga + (size_t)i * 64 * K);
#pragma unroll
  for (int i = 0; i < NTW; ++i) rb[i] = *(const u32x4*)(gx + (size_t)i * 64 * ldx);
  {
    unsigned char* as = lds; unsigned char* bs = lds + 256 * 144;
#pragma unroll
    for (int i = 0; i < 4; ++i) *(u32x4*)(as + (lrow + i * 64) * 144 + lcol * 16) = ra[i];
#pragma unroll
    for (int i = 0; i < NTW; ++i) *(u32x4*)(bs + (lrow + i * 64) * 144 + lcol * 16) = rb[i];
  }
  __syncthreads();
#pragma unroll 1
  for (int ks = 0; ks < nk; ++ks) {
    const bool more = ks + 1 < nk;
    if (more) {
#pragma unroll
      for (int i = 0; i < 4; ++i) ra[i] = *(const u32x4*)(ga + (size_t)i * 64 * K + (ks + 1) * 64);
#pragma unroll
      for (int i = 0; i < NTW; ++i) rb[i] = *(const u32x4*)(gx + (size_t)i * 64 * ldx + (ks + 1) * 64);
    }
    const unsigned char* as = lds + (ks & 1) * GEMM_STAGE + (wm * 64 + l32) * 144 + h * 16;
    const unsigned char* bs = lds + (ks & 1) * GEMM_STAGE + 256 * 144 + (wn * NTW * 32 + l32) * 144 + h * 16;
#pragma unroll
    for (int kk = 0; kk < 4; ++kk) {
      bf16x8 a0 = *(const bf16x8*)(as + kk * 32), a1 = *(const bf16x8*)(as + 32 * 144 + kk * 32);
      bf16x8 b[NTW];
#pragma unroll
      for (int j = 0; j < NTW; ++j) b[j] = *(const bf16x8*)(bs + j * 32 * 144 + kk * 32);
#pragma unroll
      for (int j = 0; j < NTW; ++j) { acc[0][j] = MFMA(a0, b[j], acc[0][j]); acc[1][j] = MFMA(a1, b[j], acc[1][j]); }
    }
    if (more) {
      unsigned char* as2 = lds + ((ks + 1) & 1) * GEMM_STAGE; unsigned char* bs2 = as2 + 256 * 144;
#pragma unroll
      for (int i = 0; i < 4; ++i) *(u32x4*)(as2 + (lrow + i * 64) * 144 + lcol * 16) = ra[i];
#pragma unroll
      for (int i = 0; i < NTW; ++i) *(u32x4*)(bs2 + (lrow + i * 64) * 144 + lcol * 16) = rb[i];
    }
    __syncthreads();
  }
  epi(acc, m0 + wm * 64, n0 + wn * NTW * 32, l32, h);
}

struct EpiZ {
  u16* z;
  template <int NTW> DI void operator()(f32x16 (&acc)[2][NTW], int chb, int tokb, int l32, int h) {
#pragma unroll
    for (int nt = 0; nt < NTW; ++nt) { const int t = tokb + nt * 32 + l32;
#pragma unroll
      for (int mt = 0; mt < 2; ++mt)
#pragma unroll
        for (int q = 0; q < 4; ++q) {
          u32x2 v = {pack2(acc[mt][nt][q * 4], acc[mt][nt][q * 4 + 1]), pack2(acc[mt][nt][q * 4 + 2], acc[mt][nt][q * 4 + 3])};
          *(u32x2*)(z + (size_t)t * ZLD + chb + mt * 32 + q * 8 + h * 4) = v;
        }
    }
  }
};
struct EpiOut {
  u16* y;
  template <int NTW> DI void operator()(f32x16 (&acc)[2][NTW], int chb, int tokb, int l32, int h) {
#pragma unroll
    for (int nt = 0; nt < NTW; ++nt) { const int t = tokb + nt * 32 + l32;
#pragma unroll
      for (int mt = 0; mt < 2; ++mt)
#pragma unroll
        for (int q = 0; q < 4; ++q) {
          u32x2 v = {pack2(acc[mt][nt][q * 4], acc[mt][nt][q * 4 + 1]), pack2(acc[mt][nt][q * 4 + 2], acc[mt][nt][q * 4 + 3])};
          *(u32x2*)(y + (size_t)t * DM + chb + mt * 32 + q * 8 + h * 4) = v;
        }
    }
  }
};
struct EpiQ {
  u16* Q; const float* cosT; const float* sinT; const float* rs; int n0;
  template <int NTW> DI void operator()(f32x16 (&acc)[2][NTW], int chb, int tokb, int l32, int h) {
    const int seg = chb >> 6, head = seg / 3, part = seg - head * 3;
#pragma unroll
    for (int nt = 0; nt < NTW; ++nt) {
      const int t = tokb + nt * 32 + l32; const float r = rs[tokb - n0 + nt * 32 + l32] * QSCALE;
      u16* dst = Q + ((size_t)head * S + t) * 192;
      if (part < 2) {
#pragma unroll
        for (int mt = 0; mt < 2; ++mt)
#pragma unroll
          for (int q = 0; q < 4; ++q) {
            u32x2 v = {pack2(acc[mt][nt][q * 4] * r, acc[mt][nt][q * 4 + 1] * r), pack2(acc[mt][nt][q * 4 + 2] * r, acc[mt][nt][q * 4 + 3] * r)};
            *(u32x2*)(dst + part * 64 + mt * 32 + q * 8 + h * 4) = v;
          }
      } else {
#pragma unroll
        for (int q = 0; q < 4; ++q) {
          const int d = q * 8 + h * 4;
          const f32x4 c = *(const f32x4*)(cosT + (size_t)t * 32 + d), s = *(const f32x4*)(sinT + (size_t)t * 32 + d);
          float o1[4], o2[4];
#pragma unroll
          for (int j = 0; j < 4; ++j) { const float x1 = acc[0][nt][q * 4 + j], x2 = acc[1][nt][q * 4 + j]; o1[j] = (x1 * c[j] - x2 * s[j]) * r; o2[j] = (x2 * c[j] + x1 * s[j]) * r; }
          u32x2 v1 = {pack2(o1[0], o1[1]), pack2(o1[2], o1[3])}, v2 = {pack2(o2[0], o2[1]), pack2(o2[2], o2[3])};
          *(u32x2*)(dst + 128 + d) = v1; *(u32x2*)(dst + 160 + d) = v2;
        }
      }
    }
  }
};
DI int permpos(int k64) { const int kk = k64 & 15; return (k64 & 48) | (((kk >> 2) & 1) * 8 + (kk >> 3) * 4 + (kk & 3)); }
struct EpiKV {
  u16* K; u16* Vt; const float* rs; int n0;
  template <int NTW> DI void operator()(f32x16 (&acc)[2][NTW], int chb, int tokb, int l32, int h) {
    const int seg = chb >> 6, head = seg >> 2, part = seg & 3;
#pragma unroll
    for (int nt = 0; nt < NTW; ++nt) {
      const int t = tokb + nt * 32 + l32; const float r = rs[tokb - n0 + nt * 32 + l32];
      if (part < 2) {
        u16* dst = K + ((size_t)head * S + t) * 192 + part * 64;
#pragma unroll
        for (int mt = 0; mt < 2; ++mt)
#pragma unroll
          for (int q = 0; q < 4; ++q) {
            u32x2 v = {pack2(acc[mt][nt][q * 4] * r, acc[mt][nt][q * 4 + 1] * r), pack2(acc[mt][nt][q * 4 + 2] * r, acc[mt][nt][q * 4 + 3] * r)};
            *(u32x2*)(dst + mt * 32 + q * 8 + h * 4) = v;
          }
      } else {
        u16* dst = Vt + (((size_t)head * (S / 64) + (t >> 6)) * 128 + (part - 2) * 64) * 64 + permpos(t & 63);
#pragma unroll
        for (int mt = 0; mt < 2; ++mt)
#pragma unroll
          for (int i = 0; i < 16; ++i) { const int dv = mt * 32 + (i & 3) + 8 * (i >> 2) + 4 * h; dst[dv * 64] = tobf(acc[mt][nt][i] * r); }
      }
    }
  }
};

DI void row_rstd(float* rs, const u16* X, int ldx, int K) {
  const int tid = otid(), tl = tid >> 2, sub = tid & 3;
  const u16* src = X + (size_t)tl * ldx; float ss = 0.f;
  for (int c = sub; c < (K >> 3); c += 4) {
    u32x4 v = *(const u32x4*)(src + c * 8);
#pragma unroll
    for (int j = 0; j < 4; ++j) { const float a = bflo(v[j]), b = bfhi(v[j]); ss += a * a + b * b; }
  }
  ss += __shfl_xor(ss, 1); ss += __shfl_xor(ss, 2);
  if (sub == 0) rs[tl] = rsqrtf(ss / (float)K + EPS);
}

DI void krope_tile(const P& p, int n0) {
  const int tid = otid(), t = n0 + (tid >> 2), i0 = (tid & 3) * 8;
  const u16* z = (const u16*)(p.ws + WS_Z) + (size_t)t * ZLD + Z_KR;
  const float* cosT = (const float*)(p.ws + WS_COS) + (size_t)t * 32 + i0; const float* sinT = (const float*)(p.ws + WS_SIN) + (size_t)t * 32 + i0;
  u32x4 a = *(const u32x4*)(z + i0), b = *(const u32x4*)(z + 32 + i0);
  f32x4 c0 = *(const f32x4*)cosT, c1 = *(const f32x4*)(cosT + 4), s0 = *(const f32x4*)sinT, s1 = *(const f32x4*)(sinT + 4);
  float x1[8], x2[8], c[8], s[8];
#pragma unroll
  for (int j = 0; j < 4; ++j) { x1[2 * j] = bflo(a[j]); x1[2 * j + 1] = bfhi(a[j]); x2[2 * j] = bflo(b[j]); x2[2 * j + 1] = bfhi(b[j]); c[j] = c0[j]; c[4 + j] = c1[j]; s[j] = s0[j]; s[4 + j] = s1[j]; }
  u32x4 o1, o2;
#pragma unroll
  for (int j = 0; j < 4; ++j) {
    o1[j] = pack2(x1[2 * j] * c[2 * j] - x2[2 * j] * s[2 * j], x1[2 * j + 1] * c[2 * j + 1] - x2[2 * j + 1] * s[2 * j + 1]);
    o2[j] = pack2(x2[2 * j] * c[2 * j] + x1[2 * j] * s[2 * j], x2[2 * j + 1] * c[2 * j + 1] + x1[2 * j + 1] * s[2 * j + 1]);
  }
  u16* K = (u16*)(p.ws + WS_K);
#pragma unroll
  for (int hd = 0; hd < 4; ++hd) { u16* dst = K + ((size_t)hd * S + t) * 192 + 128 + i0; *(u32x4*)dst = o1; *(u32x4*)(dst + 32) = o2; }
}

DI void sgu_job(unsigned char* lds, const P& p, int layer, int nb) {
  const int tid = otid(), lane = tid & 63, wave = wave_of(tid);
  const int n0 = nb * 128;
  const u16* z = (const u16*)(p.ws + WS_Z);
  u16* vT = (u16*)lds;
  {
    const int j = tid >> 2, sub = tid & 3; const u16* src = z + (size_t)(n0 + j) * ZLD + Z_V + sub * 64;
    float v[64]; float s = 0.f;
#pragma unroll
    for (int c = 0; c < 8; ++c) { u32x4 u = *(const u32x4*)(src + c * 8);
#pragma unroll
      for (int k = 0; k < 4; ++k) { v[c * 8 + 2 * k] = bflo(u[k]); v[c * 8 + 2 * k + 1] = bfhi(u[k]); s += v[c * 8 + 2 * k] + v[c * 8 + 2 * k + 1]; } }
    s += __shfl_xor(s, 1); s += __shfl_xor(s, 2);
    const float mu = s * (1.f / 256.f); float q = 0.f;
#pragma unroll
    for (int c = 0; c < 64; ++c) { const float d = v[c] - mu; q += d * d; }
    q += __shfl_xor(q, 1); q += __shfl_xor(q, 2);
    const float rstd = rsqrtf(q * (1.f / 256.f) + EPS);
    const float* g = p.sgu_ln_g + layer * 256 + sub * 64; const float* b = p.sgu_ln_b + layer * 256 + sub * 64;
#pragma unroll
    for (int c4 = 0; c4 < 16; ++c4) { const f32x4 gg = *(const f32x4*)(g + c4 * 4), bb = *(const f32x4*)(b + c4 * 4);
#pragma unroll
      for (int k = 0; k < 4; ++k) vT[(sub * 64 + c4 * 4 + k) * 136 + j] = tobf((v[c4 * 4 + k] - mu) * rstd * gg[k] + bb[k]); }
  }
  __syncthreads();
  const int wm = wave & 3, wn = wave >> 2, l32 = lane & 31, h = lane >> 5;
  f32x16 acc[2][2]; acc[0][0] = zero16(); acc[0][1] = zero16(); acc[1][0] = zero16(); acc[1][1] = zero16();
  const u16* W = (const u16*)(p.ws + WS_SGUW) + (size_t)(layer * 4 + wm) * 128 * 128;
#pragma unroll
  for (int kk = 0; kk < 8; ++kk) {
    bf16x8 a0 = *(const bf16x8*)(vT + (wm * 64 + l32) * 136 + kk * 16 + h * 8);
    bf16x8 a1 = *(const bf16x8*)(vT + (wm * 64 + 32 + l32) * 136 + kk * 16 + h * 8);
    bf16x8 b0 = *(const bf16x8*)(W + (wn * 64 + l32) * 128 + kk * 16 + h * 8);
    bf16x8 b1 = *(const bf16x8*)(W + (wn * 64 + 32 + l32) * 128 + kk * 16 + h * 8);
    acc[0][0] = MFMA(a0, b0, acc[0][0]); acc[0][1] = MFMA(a0, b1, acc[0][1]);
    acc[1][0] = MFMA(a1, b0, acc[1][0]); acc[1][1] = MFMA(a1, b1, acc[1][1]);
  }
  u16* Y = (u16*)(p.ws + WS_HY);
#pragma unroll
  for (int nt = 0; nt < 2; ++nt) {
    const int i = wn * 64 + nt * 32 + l32, t = n0 + i; const float bias = p.sgu_b[(layer * 4 + wm) * 128 + i];
#pragma unroll
    for (int mt = 0; mt < 2; ++mt)
#pragma unroll
      for (int q = 0; q < 4; ++q) {
        const int c = wm * 64 + mt * 32 + q * 8 + h * 4;
        const u32x2 u = *(const u32x2*)(z + (size_t)t * ZLD + Z_U + c), g = *(const u32x2*)(z + (size_t)t * ZLD + Z_SG + c);
        const float o0 = bflo(u[0]) * (acc[mt][nt][q * 4] + bias) * silu(bflo(g[0])), o1 = bfhi(u[0]) * (acc[mt][nt][q * 4 + 1] + bias) * silu(bfhi(g[0]));
        const float o2 = bflo(u[1]) * (acc[mt][nt][q * 4 + 2] + bias) * silu(bflo(g[1])), o3 = bfhi(u[1]) * (acc[mt][nt][q * 4 + 3] + bias) * silu(bfhi(g[1]));
        u32x2 v = {pack2(o0, o1), pack2(o2, o3)};
        *(u32x2*)(Y + (size_t)t * DM + c) = v;
      }
  }
}

template <int W>
DI void pool_win(const u16* zp, int t0, u16* prow) {
  unsigned v[32 + W];
#pragma unroll
  for (int i = 0; i < 32 + W; ++i) { const int t = t0 - W + i; v[i] = (t >= 0) ? *(const unsigned*)(zp + (size_t)max(t, 0) * ZLD) : 0u; }
  float s0 = 0.f, s1 = 0.f;
#pragma unroll
  for (int i = 0; i < W; ++i) { s0 += bflo(v[i]); s1 += bfhi(v[i]); }
#pragma unroll
  for (int tt = 0; tt < 32; ++tt) {
    const float p0 = bflo(v[W + tt]), p1 = bfhi(v[W + tt]);
    s0 += p0 - bflo(v[tt]); s1 += p1 - bfhi(v[tt]);
    const float inv = 1.f / (float)min(t0 + tt + 1, W);
    *(unsigned*)(prow + tt * 264) = pack2(s0 * inv - p0, s1 * inv - p1);
  }
}
DI void pool_job(unsigned char* lds, const P& p, int layer, int nb) {
  const int tid = otid(), lane = tid & 63, wave = wave_of(tid);
  const int n0 = nb * 128;
  const u16* z = (const u16*)(p.ws + WS_Z);
  u16* pl = (u16*)lds;
  {
    const int g = wave & 3, c = g * 64 + (lane & 31) * 2, tq = (wave >> 2) * 2 + (lane >> 5);
    const u16* zp = z + Z_PI + c; const int t0 = n0 + tq * 32; u16* prow = pl + (tq * 32) * 264 + c;
    switch (g) { case 0: pool_win<2>(zp, t0, prow); break; case 1: pool_win<4>(zp, t0, prow); break; case 2: pool_win<8>(zp, t0, prow); break; default: pool_win<16>(zp, t0, prow); break; }
  }
  __syncthreads();
  const int wm = wave & 3, wn = wave >> 2, l32 = lane & 31, h = lane >> 5;
  f32x16 acc[2][2]; acc[0][0] = zero16(); acc[0][1] = zero16(); acc[1][0] = zero16(); acc[1][1] = zero16();
  const u16* W = (const u16*)(p.ws + WS_PWT) + (size_t)(layer * 4 + wm) * 64 * 64;
#pragma unroll
  for (int kk = 0; kk < 4; ++kk) {
    bf16x8 a0 = *(const bf16x8*)(W + (l32) * 64 + kk * 16 + h * 8);
    bf16x8 a1 = *(const bf16x8*)(W + (32 + l32) * 64 + kk * 16 + h * 8);
    bf16x8 b0 = *(const bf16x8*)(pl + (wn * 64 + l32) * 264 + wm * 64 + kk * 16 + h * 8);
    bf16x8 b1 = *(const bf16x8*)(pl + (wn * 64 + 32 + l32) * 264 + wm * 64 + kk * 16 + h * 8);
    acc[0][0] = MFMA(a0, b0, acc[0][0]); acc[0][1] = MFMA(a0, b1, acc[0][1]);
    acc[1][0] = MFMA(a1, b0, acc[1][0]); acc[1][1] = MFMA(a1, b1, acc[1][1]);
  }
  u16* Y = (u16*)(p.ws + WS_HY);
#pragma unroll
  for (int nt = 0; nt < 2; ++nt) {
    const int t = n0 + wn * 64 + nt * 32 + l32;
#pragma unroll
    for (int mt = 0; mt < 2; ++mt)
#pragma unroll
      for (int q = 0; q < 4; ++q) {
        const int c = wm * 64 + mt * 32 + q * 8 + h * 4;
        const f32x4 sc = *(const f32x4*)(p.pool_scale + layer * 256 + c);
        const u32x2 g = *(const u32x2*)(z + (size_t)t * ZLD + Z_PG + c);
        const float o0 = acc[mt][nt][q * 4] * sc[0] * silu(bflo(g[0])), o1 = acc[mt][nt][q * 4 + 1] * sc[1] * silu(bfhi(g[0]));
        const float o2 = acc[mt][nt][q * 4 + 2] * sc[2] * silu(bflo(g[1])), o3 = acc[mt][nt][q * 4 + 3] * sc[3] * silu(bfhi(g[1]));
        u32x2 v = {pack2(o0, o1), pack2(o2, o3)};
        *(u32x2*)(Y + (size_t)t * DM + 256 + c) = v;
      }
  }
}

DI void att_qk(f32x16& s, const unsigned char* krow, const bf16x8 (&qf)[12], float m) {
  bf16x8 ka[4], kb[4];
#pragma unroll
  for (int i = 0; i < 4; ++i) ka[i] = *(const bf16x8*)(krow + i * 32);
#pragma unroll
  for (int i = 0; i < 4; ++i) kb[i] = *(const bf16x8*)(krow + (4 + i) * 32);
  const float nm = -m;
#pragma unroll
  for (int i = 0; i < 16; ++i) s[i] = nm;
  __builtin_amdgcn_sched_barrier(0);
#pragma unroll
  for (int i = 0; i < 4; ++i) s = MFMA(ka[i], qf[i], s);
  __builtin_amdgcn_sched_barrier(0);
#pragma unroll
  for (int i = 0; i < 4; ++i) ka[i] = *(const bf16x8*)(krow + (8 + i) * 32);
  __builtin_amdgcn_sched_barrier(0);
#pragma unroll
  for (int i = 0; i < 4; ++i) s = MFMA(kb[i], qf[4 + i], s);
  __builtin_amdgcn_sched_barrier(0);
#pragma unroll
  for (int i = 0; i < 4; ++i) s = MFMA(ka[i], qf[8 + i], s);
  __builtin_amdgcn_sched_barrier(0);
}
DI void att_sm_pv(f32x16& s, const unsigned char* vrow, f32x16 (&O)[4], float& m, float& l, bool first) {
  bf16x8 vf[8];
#pragma unroll
  for (int mt = 0; mt < 4; ++mt) { vf[2 * mt] = *(const bf16x8*)(vrow + mt * 32 * 144); vf[2 * mt + 1] = *(const bf16x8*)(vrow + mt * 32 * 144 + 32); }
  __builtin_amdgcn_sched_barrier(0);
  float mx = fmaxf(fmaxf(s[0], s[1]), s[2]);
#pragma unroll
  for (int i = 3; i < 15; i += 2) mx = fmaxf(fmaxf(mx, s[i]), s[i + 1]);
  mx = fmaxf(mx, s[15]);
  if (first || __builtin_amdgcn_ballot_w64(mx > 8.f) != 0) {
    const float mxx = fmaxf(mx, __shfl_xor(mx, 32));
    const float d = first ? mxx : fmaxf(mxx, 0.f);
    const float alpha = first ? 1.f : ex2(-d);
    m += d; l *= alpha;
#pragma unroll
    for (int i = 0; i < 16; ++i) s[i] -= d;
#pragma unroll
    for (int mt = 0; mt < 4; ++mt)
#pragma unroll
      for (int i = 0; i < 16; ++i) O[mt][i] *= alpha;
  }
  float ps0 = 0.f, ps1 = 0.f;
#pragma unroll
  for (int i = 0; i < 16; i += 2) { s[i] = ex2(s[i]); s[i + 1] = ex2(s[i + 1]); ps0 += s[i]; ps1 += s[i + 1]; }
  l += ps0 + ps1;
  u32x4 p0 = {pack2(s[0], s[1]), pack2(s[2], s[3]), pack2(s[4], s[5]), pack2(s[6], s[7])};
  u32x4 p1 = {pack2(s[8], s[9]), pack2(s[10], s[11]), pack2(s[12], s[13]), pack2(s[14], s[15])};
  const bf16x8 pf0 = __builtin_bit_cast(bf16x8, p0), pf1 = __builtin_bit_cast(bf16x8, p1);
#pragma unroll
  for (int mt = 0; mt < 4; ++mt) { O[mt] = MFMA(vf[2 * mt], pf0, O[mt]); O[mt] = MFMA(vf[2 * mt + 1], pf1, O[mt]); }
}
DI void attn_item(unsigned char* lds, const P& p, int hd, int qb) {
  const int tid = otid(), lane = tid & 63, wave = wave_of(tid);
  const int wq = wave & 3, wk = wave >> 2, l32 = lane & 31, h = lane >> 5;
  const u16* Qg = (const u16*)(p.ws + WS_Q) + ((size_t)hd * S + qb * 128 + wq * 32 + l32) * 192 + h * 8;
  bf16x8 qf[12];
#pragma unroll
  for (int ks = 0; ks < 12; ++ks) qf[ks] = *(const bf16x8*)(Qg + ks * 16);
  const int ntile = 2 * qb + 2, mychunk = 2 * qb + (wq >> 1);
  const u16* Kg = (const u16*)(p.ws + WS_K) + (size_t)hd * S * 192 + tid * 8;
  const u16* Vg = (const u16*)(p.ws + WS_VT) + (size_t)hd * S * 128 + tid * 8;
  int kdst[3], vdst[2];
#pragma unroll
  for (int i = 0; i < 3; ++i) { const int c = tid + i * NT; kdst[i] = (c / 24) * 400 + (c % 24) * 16; }
#pragma unroll
  for (int i = 0; i < 2; ++i) { const int c = tid + i * NT; vdst[i] = 64 * 400 + (c >> 3) * 144 + (c & 7) * 16; }
  const int koff = (wk * 32 + l32) * 400 + h * 16;
  const int voff = 64 * 400 + l32 * 144 + (wk * 32 + h * 8) * 2;
  f32x16 O[4]; O[0] = zero16(); O[1] = zero16(); O[2] = zero16(); O[3] = zero16();
  float m = 0.f, l = 0.f;
  u32x4 rkA[3], rvA[2], rkB[3], rvB[2];
#define ATT_GLOAD(RK, RV, T) do { _Pragma("unroll") for (int i = 0; i < 3; ++i) RK[i] = *(const u32x4*)(Kg + (size_t)(T) * 64 * 192 + i * NT * 8); \
                                  _Pragma("unroll") for (int i = 0; i < 2; ++i) RV[i] = *(const u32x4*)(Vg + (size_t)(T) * 128 * 64 + i * NT * 8); } while (0)
#define ATT_LSTORE(RK, RV, ST) do { unsigned char* st_ = lds + (ST) * ATT_STAGE; _Pragma("unroll") for (int i = 0; i < 3; ++i) *(u32x4*)(st_ + kdst[i]) = RK[i]; \
                                    _Pragma("unroll") for (int i = 0; i < 2; ++i) *(u32x4*)(st_ + vdst[i]) = RV[i]; } while (0)
#define ATT_STEP(KT, RLK, RLV, RSK, RSV) do { \
    ATT_GLOAD(RLK, RLV, min((KT) + 2, ntile - 1));     \
    if ((KT) <= mychunk) { f32x16 s; att_qk(s, lds + ((KT) & 1) * ATT_STAGE + koff, qf, m); att_sm_pv(s, lds + ((KT) & 1) * ATT_STAGE + voff, O, m, l, (KT) == 0); } \
    if ((KT) + 1 < ntile) ATT_LSTORE(RSK, RSV, ((KT) + 1) & 1); \
    lds_barrier(); } while (0)
  ATT_GLOAD(rkA, rvA, 0);
  ATT_GLOAD(rkB, rvB, 1);
  ATT_LSTORE(rkA, rvA, 0);
  __syncthreads();
#pragma unroll 1
  for (int kt = 0; kt < ntile; kt += 2) {
    ATT_STEP(kt, rkA, rvA, rkB, rvB);
    ATT_STEP(kt + 1, rkB, rvB, rkA, rvA);
  }
  const float lt = l + __shfl_xor(l, 32);
  float* cO = (float*)lds; float* cm = (float*)(lds + 65536);
  if (wk == 1) {
#pragma unroll
    for (int mt = 0; mt < 4; ++mt)
#pragma unroll
      for (int i = 0; i < 16; ++i) cO[(wq * 64 + mt * 16 + i) * 64 + lane] = O[mt][i];
    cm[wq * 64 + lane] = m; cm[256 + wq * 64 + lane] = lt;
  }
  __syncthreads();
  if (wk == 0) {
    const float m1 = cm[wq * 64 + lane], l1 = cm[256 + wq * 64 + lane];
    const float mm = fmaxf(m, m1); float a0 = ex2(m - mm), a1 = ex2(m1 - mm);
    const float inv = 1.f / (lt * a0 + l1 * a1); a0 *= inv; a1 *= inv;
    const int t = qb * 128 + wq * 32 + l32;
    const u16* zg = (const u16*)(p.ws + WS_Z) + (size_t)t * ZLD + Z_MG + hd * 128;
    u16* Y = (u16*)(p.ws + WS_HY) + (size_t)t * DM + 512 + hd * 128;
#pragma unroll
    for (int mt = 0; mt < 4; ++mt)
#pragma unroll
      for (int q = 0; q < 4; ++q) {
        const int dv = mt * 32 + q * 8 + h * 4;
        const u32x2 g = *(const u32x2*)(zg + dv);
        float o[4];
#pragma unroll
        for (int j = 0; j < 4; ++j) o[j] = O[mt][q * 4 + j] * a0 + cO[(wq * 64 + mt * 16 + q * 4 + j) * 64 + lane] * a1;
        u32x2 v = {pack2(o[0] * silu(bflo(g[0])), o[1] * silu(bfhi(g[0]))), pack2(o[2] * silu(bflo(g[1])), o[3] * silu(bfhi(g[1])))};
        *(u32x2*)(Y + dv) = v;
      }
  }
  __syncthreads();
}

DI void transpose_tile(unsigned char* lds, const float* __restrict__ src, int ldsrc, u16* __restrict__ dst, int ldd, int k0, int n0, int nvalid, const float* gain) {
  float* tile = (float*)lds;
  const int tid = otid();
#pragma unroll
  for (int i = 0; i < 8; ++i) { const int idx = tid + i * NT, r = idx >> 6, cc = idx & 63, n = n0 + cc;
    float v = (n < nvalid) ? src[(size_t)(k0 + r) * ldsrc + n] : 0.f; if (gain) v *= gain[k0 + r]; tile[r * 65 + cc] = v; }
  __syncthreads();
#pragma unroll
  for (int i = 0; i < 8; ++i) { const int idx = tid + i * NT, r = idx >> 6, cc = idx & 63; dst[(size_t)(n0 + r) * ldd + k0 + cc] = tobf(tile[cc * 65 + r]); }
  __syncthreads();
}
DI float wave_sum(float v) { v += __shfl_xor(v, 32); v += __shfl_xor(v, 16); v += __shfl_xor(v, 8); v += __shfl_xor(v, 4); v += __shfl_xor(v, 2); v += __shfl_xor(v, 1); return v; }
DI void prenorm_row(const f32x4 (&v)[4], const float* g, u16* hrow, int lane) {
  float ss = 0.f;
#pragma unroll
  for (int i = 0; i < 4; ++i) ss += v[i][0] * v[i][0] + v[i][1] * v[i][1] + v[i][2] * v[i][2] + v[i][3] * v[i][3];
  ss = wave_sum(ss);
  const float r = rsqrtf(ss * (1.f / 1024.f) + EPS);
#pragma unroll
  for (int i = 0; i < 4; ++i) { const f32x4 gg = *(const f32x4*)(g + (lane + 64 * i) * 4);
    u32x2 o = {pack2(v[i][0] * r * gg[0], v[i][1] * r * gg[1]), pack2(v[i][2] * r * gg[2], v[i][3] * r * gg[3])};
    *(u32x2*)(hrow + (lane + 64 * i) * 4) = o; }
}

DI void phase_prep(unsigned char* lds, const P& p) {
  const int nb = gridDim.x, bid = blockIdx.x, tid = otid();
  u16* win = (u16*)(p.ws + WS_WIN); u16* wuq = (u16*)(p.ws + WS_WUQ); u16* wukv = (u16*)(p.ws + WS_WUKV); u16* wout = (u16*)(p.ws + WS_WOUT);
  for (int job = bid; job < 2 * 1032; job += nb) {
    const int layer = job / 1032; int r = job - layer * 1032;
    if (r < 640) { const int kt = r / 40, nt = r - kt * 40; transpose_tile(lds, p.w_in + (size_t)layer * 1024 * DIN, DIN, win + (size_t)layer * 2560 * 1024, 1024, kt * 64, nt * 64, DIN, nullptr); }
    else if (r < 712) { r -= 640; const int kt = r / 12, nt = r - kt * 12; transpose_tile(lds, p.w_uq + (size_t)layer * 384 * 768, 768, wuq + (size_t)layer * 768 * 384, 384, kt * 64, nt * 64, 768, p.q_norm_g + layer * 384); }
    else if (r < 776) { r -= 712; const int kt = r / 16, nt = r - kt * 16; transpose_tile(lds, p.w_ukv + (size_t)layer * 256 * 1024, 1024, wukv + (size_t)layer * 1024 * 256, 256, kt * 64, nt * 64, 1024, p.kv_norm_g + layer * 256); }
    else { r -= 776; const int kt = r / 16, nt = r - kt * 16; transpose_tile(lds, p.w_out + (size_t)layer * 1024 * 1024, 1024, wout + (size_t)layer * 1024 * 1024, 1024, kt * 64, nt * 64, 1024, nullptr); }
  }
  const int gtid = bid * NT + tid, gn = nb * NT;
  u16* sguw = (u16*)(p.ws + WS_SGUW);
  for (int idx = gtid; idx < 2 * 4 * 128 * 128; idx += gn) { const int i = (idx >> 7) & 127, j = idx & 127; sguw[idx] = ((j >> 6) <= (i >> 6)) ? tobf(p.sgu_w[idx]) : (u16)0; }
  u16* pwt = (u16*)(p.ws + WS_PWT);
  for (int idx = gtid; idx < 2 * 4 * 64 * 64; idx += gn) { const int lg = idx >> 12, d = (idx >> 6) & 63, c = idx & 63; pwt[idx] = tobf(p.pool_w[(lg * 64 + c) * 64 + d]); }
  float* cosT = (float*)(p.ws + WS_COS); float* sinT = (float*)(p.ws + WS_SIN);
  for (int idx = gtid; idx < S * 32; idx += gn) {
    const int t = idx >> 5, i = idx & 31; const float angf = (float)p.pos[t] * p.invfreq[i];
    const double a = (double)angf; const double k = rint(a * 0.15915494309189535); const double r = a - k * 6.283185307179586; const double r2 = r * r;
    double ts = r, ss = r, tc = 1.0, sc = 1.0;
#pragma unroll
    for (int n = 1; n <= 13; ++n) { ts *= -r2 * (1.0 / (double)((2 * n) * (2 * n + 1))); ss += ts; tc *= -r2 * (1.0 / (double)((2 * n - 1) * (2 * n))); sc += tc; }
    cosT[idx] = (float)sc; sinT[idx] = (float)ss;
  }
  u16* hb = (u16*)(p.ws + WS_HY);
  const int lane = tid & 63, wave = wave_of(tid);
  for (int row = bid * 8 + wave; row < S; row += nb * 16) {
    const int row2 = row + nb * 8; const bool has2 = row2 < S;
    f32x4 v[4], v2[4];
#pragma unroll
    for (int i = 0; i < 4; ++i) v[i] = *(const f32x4*)(p.x + (size_t)row * DM + (lane + 64 * i) * 4);
    if (has2) {
#pragma unroll
      for (int i = 0; i < 4; ++i) v2[i] = *(const f32x4*)(p.x + (size_t)row2 * DM + (lane + 64 * i) * 4);
    }
    prenorm_row(v, p.pre_g, hb + (size_t)row * DM, lane);
    if (has2) prenorm_row(v2, p.pre_g, hb + (size_t)row2 * DM, lane);
  }
}

DI void post_load(const u16* yout, const float* xold, int row, int lane, f32x4 (&y)[4], f32x4 (&xo)[4]) {
#pragma unroll
  for (int i = 0; i < 4; ++i) { const u32x2 yb = *(const u32x2*)(yout + (size_t)row * DM + (lane + 64 * i) * 4); y[i] = (f32x4){bflo(yb[0]), bfhi(yb[0]), bflo(yb[1]), bfhi(yb[1])};
    xo[i] = *(const f32x4*)(xold + (size_t)row * DM + (lane + 64 * i) * 4); }
}
DI void post_finish(const P& p, int layer, int row, int lane, f32x4 (&y)[4], const f32x4 (&xo)[4], u16* hb) {
  float ss = 0.f;
#pragma unroll
  for (int i = 0; i < 4; ++i) ss += y[i][0] * y[i][0] + y[i][1] * y[i][1] + y[i][2] * y[i][2] + y[i][3] * y[i][3];
  ss = wave_sum(ss);
  const float r = rsqrtf(ss * (1.f / 1024.f) + EPS);
#pragma unroll
  for (int i = 0; i < 4; ++i) {
    const f32x4 g = *(const f32x4*)(p.post_g + layer * DM + (lane + 64 * i) * 4);
    y[i] = xo[i] + y[i] * r * g;
    *(f32x4*)(p.out + (size_t)row * DM + (lane + 64 * i) * 4) = y[i];
  }
  if (layer + 1 < DEPTH) prenorm_row(y, p.pre_g + (layer + 1) * DM, hb + (size_t)row * DM, lane);
}
DI void phase_post(const P& p, int layer) {
  const int nb = gridDim.x, bid = blockIdx.x, tid = otid(), lane = tid & 63, wave = wave_of(tid);
  const u16* yout = (const u16*)(p.ws + WS_Z); const float* xold = layer == 0 ? p.x : p.out;
  u16* hb = (u16*)(p.ws + WS_HY);
  for (int row = bid * 8 + wave; row < S; row += nb * 16) {
    const int row2 = row + nb * 8; const bool has2 = row2 < S;
    f32x4 y0[4], x0[4], y1[4], x1[4];
    post_load(yout, xold, row, lane, y0, x0);
    if (has2) post_load(yout, xold, row2, lane, y1, x1);
    post_finish(p, layer, row, lane, y0, x0, hb);
    if (has2) post_finish(p, layer, row2, lane, y1, x1, hb);
  }
}

__global__ void __launch_bounds__(NT) mega(P p) {
  extern __shared__ __attribute__((aligned(16))) unsigned char lds[];
  cg::grid_group grid = cg::this_grid();
  const int nb = gridDim.x, bid = blockIdx.x;
  if (threadIdx.x < 4) ((unsigned*)(lds + XB_LDS_OFF))[threadIdx.x] = 0u;
  __syncthreads();
  XcdBarrier xbar = xcd_barrier_post((unsigned*)(p.ws + WS_BAR), (volatile LAS unsigned*)(lds + XB_LDS_OFF));
  unsigned* xcnt = (unsigned*)(p.ws + WS_BAR + 14336);
  unsigned myslot = 0;
  if (threadIdx.x == 0) myslot = xb_add(&xcnt[16 * xbar.x], 1u);
  int vid = bid;
#define RUN(ph_) true
#define SEAM(ph_) do { if (p.ph_hi < 0) grid.sync(); else xcd_barrier(xbar); } while (0)
  if (RUN(ph)) phase_prep(lds, p);
  SEAM(0);
  {
    if (threadIdx.x == 0) { bool even = (nb & 7) == 0; for (int j = 0; j < 8; ++j) even = even && (xb_ld(&xcnt[16 * j]) == (unsigned)(nb >> 3));
      ((volatile LAS unsigned*)(lds + XB_LDS_OFF))[2] = even ? (myslot * 8u + xbar.x) : (unsigned)bid; }
    __syncthreads();
    vid = __builtin_amdgcn_readfirstlane((int)((volatile LAS unsigned*)(lds + XB_LDS_OFF))[2]);
  }
#pragma unroll 1
  for (int layer = 0; layer < DEPTH; ++layer) {
    u16* hy = (u16*)(p.ws + WS_HY); u16* z = (u16*)(p.ws + WS_Z);
    float* rs = (float*)(lds + RS_OFF);
    if (RUN(ph)) {
      const u16* W = (const u16*)(p.ws + WS_WIN) + (size_t)layer * 2560 * 1024;
      { pg8::Gemm g{hy, W, S, 2560, 1024}; pg8::StaticOrder so; so.init(S, 2560, nb, vid);
        pg8::EpiBf16<0> E{z, ZLD, nullptr, 0, 0};
        pg8::gemm_phase<pg8::EpiBf16<0>, pg8::StaticOrder, false>((PG8_LAS unsigned char*)lds, g, so, E, nullptr); }
    }
    SEAM(0);
    if (RUN(ph)) {
      const float* cosT = (const float*)(p.ws + WS_COS); const float* sinT = (const float*)(p.ws + WS_SIN);
      for (int job = vid; job < 1152; job += nb) {
        __syncthreads();
        const int x = job & 7, j = job >> 3;
        if (j < 48) { const int ntl = j / 3, mt = j - ntl * 3, n0 = (16 * x + ntl) * 128;
          const u16* X = z + (size_t)n0 * ZLD + Z_CQ; row_rstd(rs, X, ZLD, 384);
          EpiQ e{(u16*)(p.ws + WS_Q), cosT, sinT, rs, n0};
          gemm_tile<2>(lds, (const u16*)(p.ws + WS_WUQ) + (size_t)layer * 768 * 384 + (size_t)mt * 256 * 384, X, ZLD, 384, mt * 256, n0, e);
        } else if (j < 112) { const int j2 = j - 48, mt = j2 & 3, n0 = (16 * x + (j2 >> 2)) * 128;
          const u16* X = z + (size_t)n0 * ZLD + Z_CKV; row_rstd(rs, X, ZLD, 256);
          EpiKV e{(u16*)(p.ws + WS_K), (u16*)(p.ws + WS_VT), rs, n0};
          gemm_tile<2>(lds, (const u16*)(p.ws + WS_WUKV) + (size_t)layer * 1024 * 256 + (size_t)mt * 256 * 256, X, ZLD, 256, mt * 256, n0, e);
          if (mt == 0) krope_tile(p, n0);
        } else if (j < 128) sgu_job(lds, p, layer, 16 * x + (j - 112));
        else pool_job(lds, p, layer, 16 * x + (j - 128));
      }
    }
    SEAM(0);
    if (RUN(ph)) {
      for (int it = vid; it < 256; it += nb) {
        const int hd = (it & 7) >> 1, pr = (it >> 3) * 2 + (it & 1);
        attn_item(lds, p, hd, 127 - pr);
        attn_item(lds, p, hd, pr);
      }
    }
    SEAM(0);
    if (RUN(ph)) {
      const u16* W = (const u16*)(p.ws + WS_WOUT) + (size_t)layer * 1024 * 1024;
      { pg8::Gemm g{hy, W, S, 1024, 1024}; pg8::StaticOrder so; so.init(S, 1024, nb, vid);
        pg8::EpiBf16<0> E{(u16*)(p.ws + WS_Z), 1024, nullptr, 0, 0};
        pg8::gemm_phase<pg8::EpiBf16<0>, pg8::StaticOrder, false>((PG8_LAS unsigned char*)lds, g, so, E, nullptr); }
    }
    SEAM(0);
    if (RUN(ph)) phase_post(p, layer);
    SEAM(0);
  }
  xcd_barrier(xbar);
}
constexpr int NPHASE = 1 + 5 * DEPTH;

extern "C" void kernel_launch(void* const* d_in, const int* in_sizes, int n_in, void* d_out, int out_size, void* d_ws, size_t ws_size, hipStream_t stream) {
  static int grid_blocks = 0;
  if (!grid_blocks) {
    int dev = 0, cus = 0, per_cu = 0;
    hipGetDevice(&dev);
    hipDeviceGetAttribute(&cus, hipDeviceAttributeMultiprocessorCount, dev);
    hipFuncSetAttribute((const void*)mega, hipFuncAttributeMaxDynamicSharedMemorySize, LDS_BYTES);
    hipOccupancyMaxActiveBlocksPerMultiprocessor(&per_cu, (const void*)mega, NT, LDS_BYTES);
    if (per_cu < 1) { fprintf(stderr, "occupancy query returned %d\n", per_cu); per_cu = 1; }
    if (per_cu > 1) per_cu = 1;
    grid_blocks = cus * per_cu;
    if (ws_size < WS_END) fprintf(stderr, "workspace too small: %zu < %zu\n", ws_size, (size_t)WS_END);
  }
  P p{};
  p.x = (const float*)d_in[0]; p.pos = (const int*)d_in[1]; p.pre_g = (const float*)d_in[2]; p.post_g = (const float*)d_in[3];
  p.w_in = (const float*)d_in[4]; p.sgu_w = (const float*)d_in[5]; p.sgu_b = (const float*)d_in[6]; p.sgu_ln_g = (const float*)d_in[7];
  p.sgu_ln_b = (const float*)d_in[8]; p.pool_w = (const float*)d_in[9]; p.pool_scale = (const float*)d_in[10]; p.q_norm_g = (const float*)d_in[11];
  p.w_uq = (const float*)d_in[12]; p.kv_norm_g = (const float*)d_in[13]; p.w_ukv = (const float*)d_in[14]; p.w_out = (const float*)d_in[15];
  p.out = (float*)d_out; p.ws = (unsigned char*)d_ws;
  for (int i = 0; i < 32; ++i) p.invfreq[i] = powf(10000.0f, -(float)(2 * i) / 64.0f);
  hipMemsetAsync((char*)d_ws + WS_BAR, 0, 16384, stream);
  p.ph_lo = 0; p.ph_hi = NPHASE;
  void* args[] = {&p};
  hipError_t e = hipLaunchCooperativeKernel((void*)mega, dim3(grid_blocks), dim3(NT), args, LDS_BYTES, stream);
  if (e != hipSuccess) fprintf(stderr, "cooperative launch failed: %s (grid %d)\n", hipGetErrorString(e), grid_blocks);

}
```

```cpp
#include <hip/hip_runtime.h>
#include <hip/hip_cooperative_groups.h>
#include <cstdio>
#include <cmath>
namespace cg = cooperative_groups;

#define DI __device__ __forceinline__
typedef unsigned short u16;
using bf16x8 = __attribute__((ext_vector_type(8))) short;
using f32x16 = __attribute__((ext_vector_type(16))) float;
using f32x4  = __attribute__((ext_vector_type(4))) float;
using f32x2  = __attribute__((ext_vector_type(2))) float;
using u32x4  = __attribute__((ext_vector_type(4))) unsigned;
using u32x2  = __attribute__((ext_vector_type(2))) unsigned;
typedef __bf16 bf2_t __attribute__((ext_vector_type(2)));
#define MFMA(a, b, c) __builtin_amdgcn_mfma_f32_32x32x16_bf16((a), (b), (c), 0, 0, 0)

#ifndef COOP
#define COOP 1
#endif
#ifndef DUP
#define DUP 7
#endif

constexpr int S = 16384, DM = 1024, DIN = 2496, ZLD = 2560, NT = 512, DEPTH = 2;
constexpr float EPS = 1e-6f;
constexpr float QSCALE = 0.07216878364870322f * 1.4426950408889634f;
constexpr int Z_U = 0, Z_V = 256, Z_SG = 512, Z_PI = 768, Z_PG = 1024, Z_CQ = 1280, Z_CKV = 1664, Z_KR = 1920, Z_MG = 1984;

constexpr size_t WS_HY   = 0;
constexpr size_t WS_Z    = WS_HY + (size_t)S * 1024 * 2;
constexpr size_t WS_Q    = WS_Z + (size_t)S * ZLD * 2;
constexpr size_t WS_K    = WS_Q + (size_t)4 * S * 192 * 2;
constexpr size_t WS_VT   = WS_K + (size_t)4 * S * 192 * 2;
constexpr size_t WS_WIN  = WS_VT + (size_t)4 * S * 128 * 2;
constexpr size_t WS_WUQ  = WS_WIN + (size_t)2 * 2560 * 1024 * 2;
constexpr size_t WS_WUKV = WS_WUQ + (size_t)2 * 768 * 384 * 2;
constexpr size_t WS_WOUT = WS_WUKV + (size_t)2 * 1024 * 256 * 2;
constexpr size_t WS_SGUW = WS_WOUT + (size_t)2 * 1024 * 1024 * 2;
constexpr size_t WS_PWT  = WS_SGUW + (size_t)2 * 4 * 128 * 128 * 2;
constexpr size_t WS_COS  = WS_PWT + (size_t)2 * 4 * 64 * 64 * 2;
constexpr size_t WS_SIN  = WS_COS + (size_t)S * 32 * 4;
constexpr size_t WS_BAR  = WS_SIN + (size_t)S * 32 * 4;
constexpr size_t WS_END  = WS_BAR + 16384;

constexpr int GEMM_STAGE = 512 * 144;
constexpr int RS_OFF = 2 * GEMM_STAGE;
constexpr int XB_LDS_OFF = RS_OFF + 1024;
constexpr int LDS_BYTES = XB_LDS_OFF + 16;
constexpr int ATT_STAGE = 64 * 400 + 128 * 144;

struct P {
  const float* x; const int* pos; const float* pre_g; const float* post_g; const float* w_in; const float* sgu_w; const float* sgu_b;
  const float* sgu_ln_g; const float* sgu_ln_b; const float* pool_w; const float* pool_scale; const float* q_norm_g; const float* w_uq;
  const float* kv_norm_g; const float* w_ukv; const float* w_out;
  float* out; unsigned char* ws;
  float invfreq[32];
  int ph_lo, ph_hi;
};

DI int otid() { int t = threadIdx.x; asm volatile("" : "+v"(t)); return t; }
DI int wave_of(int tid) { return __builtin_amdgcn_readfirstlane(tid >> 6); }
DI void lds_barrier() { asm volatile("s_waitcnt lgkmcnt(0)" ::: "memory"); __builtin_amdgcn_s_barrier(); asm volatile("" ::: "memory"); }
DI unsigned pack2(float a, float b) { f32x2 v = {a, b}; return __builtin_bit_cast(unsigned, __builtin_convertvector(v, bf2_t)); }
DI u16 tobf(float a) { return (u16)(pack2(a, 0.f) & 0xffffu); }
DI float bflo(unsigned u) { return __uint_as_float(u << 16); }
DI float bfhi(unsigned u) { return __uint_as_float(u & 0xffff0000u); }
DI float silu(float x) { return x / (1.f + __expf(-x)); }
DI float ex2(float x) { return __builtin_amdgcn_exp2f(x); }
DI f32x16 zero16() { f32x16 z; for (int i = 0; i < 16; ++i) z[i] = 0.f; return z; }

DI int lane_now() { int l; asm volatile("v_mbcnt_lo_u32_b32 %0, -1, 0\n\tv_mbcnt_hi_u32_b32 %0, -1, %0" : "=v"(l)); return l; }
DI int tid_of(int wv) { return wv * 64 + lane_now(); }
#define XB_TMO      128
#define XB_XCNT(j)  (256  + 64 * (j))
#define XB_XSUB(j)  (1280 + 64 * (j))
#define XB_XGEN(j)  (2304 + 64 * (j))
#define XB_TOP      3328
#define XB_TOPGEN   3392
#define XCD_BAR_WORDS 3456
#define XB_SPIN_CAP (1u << 18)
#define LAS __attribute__((address_space(3)))

__device__ __forceinline__ unsigned xb_ld(unsigned* p)              { return __hip_atomic_load(p, __ATOMIC_RELAXED, __HIP_MEMORY_SCOPE_AGENT); }
__device__ __forceinline__ unsigned xb_add(unsigned* p, unsigned v) { return __hip_atomic_fetch_add(p, v, __ATOMIC_RELAXED, __HIP_MEMORY_SCOPE_AGENT); }
__device__ __forceinline__ unsigned xb_xcc_id() { return (unsigned)__builtin_amdgcn_s_getreg((3 << 11) | 20) & 0xFu; }
#define XB_SPIN(cond, bar) do { unsigned _sp = 0; while (cond) { __builtin_amdgcn_s_sleep(1); \
    if ((++_sp & 255u) == 0u) { if (xb_ld(&(bar)[XB_TMO])) break; if (_sp > XB_SPIN_CAP) { atomicAdd(&(bar)[XB_TMO], 1u); break; } } } } while (0)

struct XcdBarrier {
    unsigned* bar; unsigned x; int wv;
    volatile LAS unsigned* st;
};

__device__ __forceinline__ XcdBarrier xcd_barrier_post(unsigned* bar, volatile LAS unsigned* st) {
    XcdBarrier b; b.bar = bar; b.x = xb_xcc_id(); b.st = st;
    if (threadIdx.x == 0) (void)xb_add(&bar[XB_XCNT(b.x)], 1u);
    return b;
}
__device__ __forceinline__ void xcd_barrier_complete(unsigned* bar, unsigned x, unsigned& nloc, unsigned& nx) {
    const unsigned G = gridDim.x * gridDim.y * gridDim.z;
    unsigned sum, cnt, mine, sp = 0u;
    for (;;) {
        sum = 0u; cnt = 0u; mine = 0u;
#pragma unroll
        for (unsigned j = 0; j < 16; ++j) { const unsigned c = xb_ld(&bar[XB_XCNT(j)]); sum += c; cnt += (c > 0u) ? 1u : 0u; mine = (j == x) ? c : mine; }
        if (sum == G) break;
        __builtin_amdgcn_s_sleep(1);
        if ((++sp & 255u) == 0u) { if (xb_ld(&bar[XB_TMO])) break; if (sp > XB_SPIN_CAP) { atomicAdd(&bar[XB_TMO], 1u); break; } }
    }
    nloc = mine > 0u ? mine : 1u; nx = cnt > 0u ? cnt : 1u;
}

__device__ __forceinline__ void xcd_barrier(const XcdBarrier& b) {
    asm volatile("s_waitcnt vmcnt(0)" ::: "memory");
    __syncthreads();
    if (b.wv == 0 && lane_now() == 0) {
        unsigned* bar = b.bar;
        __builtin_amdgcn_s_waitcnt(0);
        unsigned nloc = b.st[0], nx = b.st[1];
        if (nloc == 0u) { xcd_barrier_complete(bar, b.x, nloc, nx); b.st[0] = nloc; b.st[1] = nx; }
        const unsigned old = xb_add(&bar[XB_XSUB(b.x)], 1u);
        const unsigned gen = old / nloc;
        if (old + 1u == (gen + 1u) * nloc) {
            __builtin_amdgcn_fence(__ATOMIC_RELEASE, "agent");
            asm volatile("s_waitcnt vmcnt(0)" ::: "memory");
            const unsigned og = xb_add(&bar[XB_TOP], 1u);
            const unsigned tg = og / nx;
            if (og + 1u == (tg + 1u) * nx) xb_add(&bar[XB_TOPGEN], 1u);
            else XB_SPIN(xb_ld(&bar[XB_TOPGEN]) == tg, bar);
            __builtin_amdgcn_fence(__ATOMIC_ACQUIRE, "agent");
            xb_add(&bar[XB_XGEN(b.x)], 1u);
            asm volatile("s_waitcnt vmcnt(0)" ::: "memory");
        } else {
            XB_SPIN(xb_ld(&bar[XB_XGEN(b.x)]) == gen, bar);
            __builtin_amdgcn_fence(__ATOMIC_ACQUIRE, "agent");
            asm volatile("s_waitcnt vmcnt(0)" ::: "memory");
        }
    }
    __syncthreads();
}


namespace pg8 {
#define PG8_LAS __attribute__((address_space(3)))
typedef unsigned short bf16_t;
typedef short bf16x8 __attribute__((ext_vector_type(8)));
typedef float f32x4 __attribute__((ext_vector_type(4)));
typedef unsigned u32x4 __attribute__((ext_vector_type(4)));
constexpr int BM = 256, BK = 64, HALF = 128, HTB = HALF * BK * 2  , STAGE_BYTES = 8 * HTB, NXCD = 8, WGM = 8;

__host__ __device__ __forceinline__ int lds_byte(int r, int c) { const int st = (r >> 4) * 2 + (c >> 5), rr = r & 15, cc = c & 31, ob = rr * 64 + cc * 2; return st * 1024 + (ob ^ (((ob >> 9) & 1) << 5)); }
__host__ __device__ __forceinline__ void stage_rc(int b, int& R, int& C) { const int st = b / 1024, sb = b % 1024, swz = sb ^ (((sb >> 9) & 1) << 5); R = (st >> 1) * 16 + swz / 64; C = (st & 1) * 32 + (swz % 64) / 2; }
__host__ __device__ __forceinline__ int perm32(int rho) { const int n = rho >> 4, i = rho & 15; return 8 * (i >> 2) + 4 * n + (i & 3); }

struct Unit { int pm, pn; };
struct Gemm { const bf16_t* A; const bf16_t* Bt; int M, N, K, lda; };

struct StaticOrder {
    int nM, nN, nwg, G, c;
    __host__ __device__ __forceinline__ void init(int M, int N, int G_, int c_) { nM = M / BM; nN = N / BM; nwg = nM * nN; G = G_; c = c_; }
    __host__ __device__ __forceinline__ bool next(int i, Unit& u) const {
        const long L = (long)i * G + c; if (L >= nwg) return false;
        int wgid = (int)L; { const int q = nwg / NXCD, r = nwg % NXCD, xcd = wgid % NXCD, off = wgid / NXCD; wgid = (xcd < r ? xcd * (q + 1) : r * (q + 1) + (xcd - r) * q) + off; }
        const int nig = WGM * nN, gid = wgid / nig, fm = gid * WGM, gsz = (nM - fm) < WGM ? (nM - fm) : WGM;
        u.pm = fm + ((wgid % nig) % gsz); u.pn = (wgid % nig) / gsz; return true;
    }
    __device__ __forceinline__ void a_ready(const Unit&) const {}
    __device__ __forceinline__ void done(const Unit&) const {}
};
__device__ __forceinline__ unsigned cvt_pk_bf16(float lo, float hi) { unsigned r; asm volatile("v_cvt_pk_bf16_f32 %0, %1, %2" : "=v"(r) : "v"(lo), "v"(hi)); return r; }
typedef float f32x2 __attribute__((ext_vector_type(2)));
__device__ __forceinline__ f32x2 gelu_pk(f32x2 v) {
    const f32x2 av = __builtin_elementwise_abs(v), d = av * 0.2316418882f + 1.0f;
    f32x2 t; t.x = __builtin_amdgcn_rcpf(d.x); t.y = __builtin_amdgcn_rcpf(d.y);
    f32x2 q = t * 0.5307027145f + (-0.7265760135f); q = q * t + 0.7107068705f; q = q * t + (-0.142248368f); q = q * t + 0.127414796f; q = q * t;
    const f32x2 s = (v * v) * (-0.72134752044f);
    f32x2 e; e.x = __builtin_amdgcn_exp2f(s.x); e.y = __builtin_amdgcn_exp2f(s.y);
    const f32x2 m = v * (q * e), r = v - m;
    f32x2 o; o.x = v.x < 0.f ? m.x : r.x; o.y = v.y < 0.f ? m.y : r.y; return o;
}

template <int ACT  > struct EpiBf16 {
    static constexpr bool PERM = true, AFTER_DRAIN = false;
    bf16_t* O; int ldc; const float* bias; int split_cols; size_t split_stride;
    __device__ __forceinline__ void operator()(const f32x4 (&acc)[2][2][4][2], const Unit& u, int wr, int wc, int fr, int fq) const {
        const int row0 = u.pm * BM + wr * 64 + fr; int colt = u.pn * BM; bf16_t* base = O;
        if (split_cols) { const int t = colt / split_cols; base += (size_t)t * split_stride; colt -= t * split_cols; }
        const int col0 = colt + wc * 32 + 8 * fq, bcol0 = u.pn * BM + wc * 32 + 8 * fq;
        f32x4 bv[2][2];
#pragma unroll
        for (int bj = 0; bj < 2; ++bj)
#pragma unroll
            for (int n = 0; n < 2; ++n) bv[bj][n] = bias ? *(const f32x4*)(bias + bcol0 + bj * HALF + 4 * n) : (f32x4){0.f, 0.f, 0.f, 0.f};
#pragma unroll
        for (int ai = 0; ai < 2; ++ai)
#pragma unroll
            for (int m = 0; m < 4; ++m) { bf16_t* rowp = base + (size_t)(row0 + ai * HALF + m * 16) * ldc + col0;
#pragma unroll
                for (int bj = 0; bj < 2; ++bj) { f32x4 v0 = acc[ai][bj][m][0] + bv[bj][0], v1 = acc[ai][bj][m][1] + bv[bj][1];
                    if (ACT == 1) { f32x2 a = gelu_pk((f32x2){v0[0], v0[1]}), b = gelu_pk((f32x2){v0[2], v0[3]}), c = gelu_pk((f32x2){v1[0], v1[1]}), d = gelu_pk((f32x2){v1[2], v1[3]});
                        v0 = (f32x4){a.x, a.y, b.x, b.y}; v1 = (f32x4){c.x, c.y, d.x, d.y}; }
                    if (ACT == 2) {
#pragma unroll
                        for (int j = 0; j < 4; ++j) { v0[j] = 0.5f * v0[j] * (1.0f + erff(v0[j] * 0.70710678f)); v1[j] = 0.5f * v1[j] * (1.0f + erff(v1[j] * 0.70710678f)); } }
                    u32x4 w; w.x = cvt_pk_bf16(v0[0], v0[1]); w.y = cvt_pk_bf16(v0[2], v0[3]); w.z = cvt_pk_bf16(v1[0], v1[1]); w.w = cvt_pk_bf16(v1[2], v1[3]);
                    *(u32x4*)(rowp + bj * HALF) = w; } }
    }
};

template <class Epi, class Sched, bool STAMP = false>
__device__ __forceinline__ void gemm_phase(PG8_LAS unsigned char* lds, const Gemm g, const Sched& S, const Epi& E, unsigned long long* stamps, int wv) {
    const int tid = tid_of(wv), wid = __builtin_amdgcn_readfirstlane(tid >> 6), lane = tid & 63, wr = wid >> 2, wc = wid & 3, fr = lane & 15, fq = lane >> 4;
    const int K = g.K, nt = K / BK;
    int ts_lo = 0, ts_hi = 0, nts = 0; const unsigned long long rt_entry = STAMP ? (unsigned long long)wall_clock64() : 0ull;
#define PG8_STAMP() do { if (STAMP && wid == 0 && nts < 64) { const unsigned long long _c = (unsigned long long)clock64(); \
        ts_lo = (lane == nts) ? (int)(unsigned)_c : ts_lo; ts_hi = (lane == nts) ? (int)(unsigned)(_c >> 32) : ts_hi; ++nts; } } while (0)
    PG8_STAMP();
    unsigned voffA[2], voffB[2];
#pragma unroll
    for (int i = 0; i < 2; ++i) { int R, C; stage_rc(tid * 16 + i * 8192, R, C); const int Rb = Epi::PERM ? ((R & ~31) + perm32(R & 31)) : R;
        voffA[i] = (unsigned)(R * g.lda + C) * 2u; voffB[i] = (unsigned)(Rb * K + C) * 2u; }
    const size_t kstep = (size_t)(BK * 2);
    const size_t hstep = (size_t)HALF * K * 2;
    const size_t tstep = 2 * hstep;
    const size_t hstepA = (size_t)HALF * g.lda * 2, tstepA = 2 * hstepA;
    const unsigned ldsw = (unsigned)wid * 1024u;
    const int aoff = lds_byte(wr * 64 + fr, fq * 8), boff = lds_byte(wc * 32 + fr, fq * 8);
#define PG8_SA(b, h) (((b) * 2 + (h)) * HTB)
#define PG8_SB(b, h) ((4 + (b) * 2 + (h)) * HTB)
#define PG8_STAGE(bufoff, gbase, voff) do { _Pragma("unroll") for (int _i = 0; _i < 2; ++_i) \
        __builtin_amdgcn_global_load_lds((const unsigned*)((const char*)(gbase) + (voff)[_i]), (PG8_LAS unsigned*)(lds + (bufoff) + ldsw + _i * 8192), 16, 0, 0); } while (0)
#define PG8_LDA(dst, b, h) do { _Pragma("unroll") for (int m = 0; m < 4; ++m) _Pragma("unroll") for (int k = 0; k < 2; ++k) dst[m][k] = *(const PG8_LAS bf16x8*)(lds + PG8_SA(b, h) + aoff + m * 2048 + k * 1024); } while (0)
#define PG8_LDB(dst, b, h) do { _Pragma("unroll") for (int n = 0; n < 2; ++n) _Pragma("unroll") for (int k = 0; k < 2; ++k) dst[n][k] = *(const PG8_LAS bf16x8*)(lds + PG8_SB(b, h) + boff + n * 2048 + k * 1024); } while (0)
#define PG8_MMA(ai, bj, At, Bt) do { __builtin_amdgcn_s_setprio(1); _Pragma("unroll") for (int m = 0; m < 4; ++m) _Pragma("unroll") for (int n = 0; n < 2; ++n) _Pragma("unroll") for (int k = 0; k < 2; ++k) \
        acc[ai][bj][m][n] = __builtin_amdgcn_mfma_f32_16x16x32_bf16(Bt[n][k], At[m][k], acc[ai][bj][m][n], 0, 0, 0); __builtin_amdgcn_s_setprio(0); } while (0)
#define PG8_WAIT_V(n) asm volatile("s_waitcnt vmcnt(" #n ")" ::: "memory")
#define PG8_WAIT_L(n) asm volatile("s_waitcnt lgkmcnt(" #n ")" ::: "memory")
#define PG8_BAR __builtin_amdgcn_s_barrier()
#define PG8_SCHED __builtin_amdgcn_sched_barrier(0)
    Unit cur, nxt; int ui = 0;
    if (!S.next(0, cur)) return;
    f32x4 acc[2][2][4][2];
#pragma unroll
    for (int a = 0; a < 2; ++a)
#pragma unroll
        for (int b = 0; b < 2; ++b)
#pragma unroll
            for (int m = 0; m < 4; ++m)
#pragma unroll
                for (int n = 0; n < 2; ++n) acc[a][b][m][n] = (f32x4){0.f, 0.f, 0.f, 0.f};
    bf16x8 At[4][2], B0[2][2], B1[2][2];
    const char* cA = (const char*)g.A + (size_t)cur.pm * tstepA; const char* cB = (const char*)g.Bt + (size_t)cur.pn * tstep;
    S.a_ready(cur);
    PG8_STAGE(PG8_SB(0, 0), cB, voffB); PG8_STAGE(PG8_SA(0, 0), cA, voffA); PG8_STAGE(PG8_SB(0, 1), cB + hstep, voffB); PG8_STAGE(PG8_SA(0, 1), cA + hstepA, voffA);
    if (wr == 1) PG8_BAR;
    PG8_WAIT_V(4); PG8_BAR;
    PG8_STAGE(PG8_SB(1, 0), cB + kstep, voffB); PG8_STAGE(PG8_SA(1, 0), cA + kstep, voffA); PG8_STAGE(PG8_SB(1, 1), cB + hstep + kstep, voffB);
    PG8_WAIT_V(6); PG8_BAR;
    PG8_STAMP();
    for (;;) {
        const bool has_next = S.next(ui + 1, nxt);
        const char* nA = has_next ? (const char*)g.A + (size_t)nxt.pm * tstepA : cA; const char* nB = has_next ? (const char*)g.Bt + (size_t)nxt.pn * tstep : cB;
        for (int t = 0; t < nt; t += 2) {
            const bool last = (t == nt - 2);
            const char* a1 = cA + (size_t)(t + 1) * kstep;
            const char* a2 = last ? nA : cA + (size_t)(t + 2) * kstep; const char* b2 = last ? nB : cB + (size_t)(t + 2) * kstep;
            const char* a3 = a2 + kstep; const char* b3 = b2 + kstep;
            if (last && has_next) S.a_ready(nxt);
            PG8_LDB(B0, 0, 0); PG8_SCHED; PG8_LDA(At, 0, 0); PG8_STAGE(PG8_SA(1, 1), a1 + hstepA, voffA);
            PG8_WAIT_L(8); PG8_BAR; PG8_WAIT_L(0); PG8_MMA(0, 0, At, B0); PG8_BAR; PG8_SCHED;
            PG8_LDB(B1, 0, 1); PG8_STAGE(PG8_SB(0, 0), b2, voffB);
            PG8_BAR; PG8_WAIT_L(0); PG8_MMA(0, 1, At, B1); PG8_BAR;
            PG8_LDA(At, 0, 1); PG8_STAGE(PG8_SA(0, 0), a2, voffA);
            PG8_BAR; PG8_WAIT_L(0); PG8_MMA(1, 0, At, B0); PG8_BAR; PG8_SCHED;
            PG8_STAGE(PG8_SB(0, 1), b2 + hstep, voffB);
            PG8_WAIT_V(6); PG8_BAR; PG8_MMA(1, 1, At, B1); PG8_BAR;
            PG8_LDB(B0, 1, 0); PG8_SCHED; PG8_LDA(At, 1, 0); PG8_STAGE(PG8_SA(0, 1), a2 + hstepA, voffA);
            PG8_WAIT_L(8); PG8_BAR; PG8_WAIT_L(0); PG8_MMA(0, 0, At, B0); PG8_BAR; PG8_SCHED;
            PG8_LDB(B1, 1, 1); PG8_STAGE(PG8_SB(1, 0), b3, voffB);
            PG8_BAR; PG8_WAIT_L(0); PG8_MMA(0, 1, At, B1); PG8_BAR;
            PG8_LDA(At, 1, 1); PG8_STAGE(PG8_SA(1, 0), a3, voffA);
            PG8_BAR; PG8_WAIT_L(0); PG8_MMA(1, 0, At, B0); PG8_BAR; PG8_SCHED;
            PG8_STAGE(PG8_SB(1, 1), b3 + hstep, voffB);
            PG8_WAIT_V(6); PG8_BAR; PG8_MMA(1, 1, At, B1); PG8_BAR;
        }
        PG8_STAMP();
        if constexpr (!Epi::AFTER_DRAIN) { E(acc, cur, wr, wc, fr, fq); S.done(cur); }
        PG8_STAMP();
        if (!has_next) break;
#pragma unroll
        for (int a = 0; a < 2; ++a)
#pragma unroll
            for (int b = 0; b < 2; ++b)
#pragma unroll
                for (int m = 0; m < 4; ++m)
#pragma unroll
                    for (int n = 0; n < 2; ++n) acc[a][b][m][n] = (f32x4){0.f, 0.f, 0.f, 0.f};
        cur = nxt; cA = nA; cB = nB; ++ui;
    }
    PG8_WAIT_V(0);
    if (wr == 0) PG8_BAR;
    PG8_BAR;
    if constexpr (Epi::AFTER_DRAIN) { E.fused(acc, cur, wr, wc, fr, fq, lds, wid, lane); S.done(cur); }
    PG8_STAMP();
    if (STAMP && wid == 0) { stamps[lane] = lane < nts ? (((unsigned long long)(unsigned)ts_hi << 32) | (unsigned)ts_lo) : 0ull;
        if (lane == 62) stamps[62] = rt_entry; if (lane == 63) stamps[63] = (unsigned long long)wall_clock64(); }
#undef PG8_STAMP
#undef PG8_SA
#undef PG8_SB
#undef PG8_STAGE
#undef PG8_LDA
#undef PG8_LDB
#undef PG8_MMA
#undef PG8_WAIT_V
#undef PG8_WAIT_L
#undef PG8_BAR
#undef PG8_SCHED
}
}
template <int NTW, class Epi>
DI void gemm_tile(unsigned char* lds, const u16* __restrict__ A, const u16* __restrict__ X, int ldx, int K, int m0, int n0, Epi& epi) {
  const int tid = otid(), lane = tid & 63, wave = wave_of(tid);
  const int wm = wave & 3, wn = wave >> 2, l32 = lane & 31, h = lane >> 5;
  f32x16 acc[2][NTW];
#pragma unroll
  for (int i = 0; i < 2; ++i)
#pragma unroll
    for (int j = 0; j < NTW; ++j) acc[i][j] = zero16();
  const int nk = K >> 6;
  const int lrow = tid >> 3, lcol = tid & 7;
  const u16* ga = A + (size_t)lrow * K + lcol * 8;
  const u16* gx = X + (size_t)lrow * ldx + lcol * 8;
  u32x4 ra[4], rb[NTW];
#pragma unroll
  for (int i = 0; i < 4; ++i) ra[i] = *(const u32x4*)(ga + (size_t)i * 64 * K);
#pragma unroll
  for (int i = 0; i < NTW; ++i) rb[i] = *(const u32x4*)(gx + (size_t)i * 64 * ldx);
  {
    unsigned char* as = lds; unsigned char* bs = lds + 256 * 144;
#pragma unroll
    for (int i = 0; i < 4; ++i) *(u32x4*)(as + (lrow + i * 64) * 144 + lcol * 16) = ra[i];
#pragma unroll
    for (int i = 0; i < NTW; ++i) *(u32x4*)(bs + (lrow + i * 64) * 144 + lcol * 16) = rb[i];
  }
  __syncthreads();
#pragma unroll 1
  for (int ks = 0; ks < nk; ++ks) {
    const bool more = ks + 1 < nk;
    if (more) {
#pragma unroll
      for (int i = 0; i < 4; ++i) ra[i] = *(const u32x4*)(ga + (size_t)i * 64 * K + (ks + 1) * 64);
#pragma unroll
      for (int i = 0; i < NTW; ++i) rb[i] = *(const u32x4*)(gx + (size_t)i * 64 * ldx + (ks + 1) * 64);
    }
    const unsigned char* as = lds + (ks & 1) * GEMM_STAGE + (wm * 64 + l32) * 144 + h * 16;
    const unsigned char* bs = lds + (ks & 1) * GEMM_STAGE + 256 * 144 + (wn * NTW * 32 + l32) * 144 + h * 16;
#pragma unroll
    for (int kk = 0; kk < 4; ++kk) {
      bf16x8 a0 = *(const bf16x8*)(as + kk * 32), a1 = *(const bf16x8*)(as + 32 * 144 + kk * 32);
      bf16x8 b[NTW];
#pragma unroll
      for (int j = 0; j < NTW; ++j) b[j] = *(const bf16x8*)(bs + j * 32 * 144 + kk * 32);
#pragma unroll
      for (int j = 0; j < NTW; ++j) { acc[0][j] = MFMA(a0, b[j], acc[0][j]); acc[1][j] = MFMA(a1, b[j], acc[1][j]); }
    }
    if (more) {
      unsigned char* as2 = lds + ((ks + 1) & 1) * GEMM_STAGE; unsigned char* bs2 = as2 + 256 * 144;
#pragma unroll
      for (int i = 0; i < 4; ++i) *(u32x4*)(as2 + (lrow + i * 64) * 144 + lcol * 16) = ra[i];
#pragma unroll
      for (int i = 0; i < NTW; ++i) *(u32x4*)(bs2 + (lrow + i * 64) * 144 + lcol * 16) = rb[i];
    }
    __syncthreads();
  }
  epi(acc, m0 + wm * 64, n0 + wn * NTW * 32, l32, h);
}

struct EpiZ {
  u16* z;
  template <int NTW> DI void operator()(f32x16 (&acc)[2][NTW], int chb, int tokb, int l32, int h) {
#pragma unroll
    for (int nt = 0; nt < NTW; ++nt) { const int t = tokb + nt * 32 + l32;
#pragma unroll
      for (int mt = 0; mt < 2; ++mt)
#pragma unroll
        for (int q = 0; q < 4; ++q) {
          u32x2 v = {pack2(acc[mt][nt][q * 4], acc[mt][nt][q * 4 + 1]), pack2(acc[mt][nt][q * 4 + 2], acc[mt][nt][q * 4 + 3])};
          *(u32x2*)(z + (size_t)t * ZLD + chb + mt * 32 + q * 8 + h * 4) = v;
        }
    }
  }
};
struct EpiOut {
  u16* y;
  template <int NTW> DI void operator()(f32x16 (&acc)[2][NTW], int chb, int tokb, int l32, int h) {
#pragma unroll
    for (int nt = 0; nt < NTW; ++nt) { const int t = tokb + nt * 32 + l32;
#pragma unroll
      for (int mt = 0; mt < 2; ++mt)
#pragma unroll
        for (int q = 0; q < 4; ++q) {
          u32x2 v = {pack2(acc[mt][nt][q * 4], acc[mt][nt][q * 4 + 1]), pack2(acc[mt][nt][q * 4 + 2], acc[mt][nt][q * 4 + 3])};
          *(u32x2*)(y + (size_t)t * DM + chb + mt * 32 + q * 8 + h * 4) = v;
        }
    }
  }
};
struct EpiQ {
  u16* Q; const float* cosT; const float* sinT; const float* rs; int n0;
  template <int NTW> DI void operator()(f32x16 (&acc)[2][NTW], int chb, int tokb, int l32, int h) {
    const int seg = chb >> 6, head = seg / 3, part = seg - head * 3;
#pragma unroll
    for (int nt = 0; nt < NTW; ++nt) {
      const int t = tokb + nt * 32 + l32; const float r = rs[tokb - n0 + nt * 32 + l32] * QSCALE;
      u16* dst = Q + ((size_t)head * S + t) * 192;
      if (part < 2) {
#pragma unroll
        for (int mt = 0; mt < 2; ++mt)
#pragma unroll
          for (int q = 0; q < 4; ++q) {
            u32x2 v = {pack2(acc[mt][nt][q * 4] * r, acc[mt][nt][q * 4 + 1] * r), pack2(acc[mt][nt][q * 4 + 2] * r, acc[mt][nt][q * 4 + 3] * r)};
            *(u32x2*)(dst + part * 64 + mt * 32 + q * 8 + h * 4) = v;
          }
      } else {
#pragma unroll
        for (int q = 0; q < 4; ++q) {
          const int d = q * 8 + h * 4;
          const f32x4 c = *(const f32x4*)(cosT + (size_t)t * 32 + d), s = *(const f32x4*)(sinT + (size_t)t * 32 + d);
          float o1[4], o2[4];
#pragma unroll
          for (int j = 0; j < 4; ++j) { const float x1 = acc[0][nt][q * 4 + j], x2 = acc[1][nt][q * 4 + j]; o1[j] = (x1 * c[j] - x2 * s[j]) * r; o2[j] = (x2 * c[j] + x1 * s[j]) * r; }
          u32x2 v1 = {pack2(o1[0], o1[1]), pack2(o1[2], o1[3])}, v2 = {pack2(o2[0], o2[1]), pack2(o2[2], o2[3])};
          *(u32x2*)(dst + 128 + d) = v1; *(u32x2*)(dst + 160 + d) = v2;
        }
      }
    }
  }
};
DI int permpos(int k64) { const int kk = k64 & 15; return (k64 & 48) | (((kk >> 2) & 1) * 8 + (kk >> 3) * 4 + (kk & 3)); }
struct EpiKV {
  u16* K; u16* Vt; const float* rs; int n0;
  template <int NTW> DI void operator()(f32x16 (&acc)[2][NTW], int chb, int tokb, int l32, int h) {
    const int seg = chb >> 6, head = seg >> 2, part = seg & 3;
#pragma unroll
    for (int nt = 0; nt < NTW; ++nt) {
      const int t = tokb + nt * 32 + l32; const float r = rs[tokb - n0 + nt * 32 + l32];
      if (part < 2) {
        u16* dst = K + ((size_t)head * S + t) * 192 + part * 64;
#pragma unroll
        for (int mt = 0; mt < 2; ++mt)
#pragma unroll
          for (int q = 0; q < 4; ++q) {
            u32x2 v = {pack2(acc[mt][nt][q * 4] * r, acc[mt][nt][q * 4 + 1] * r), pack2(acc[mt][nt][q * 4 + 2] * r, acc[mt][nt][q * 4 + 3] * r)};
            *(u32x2*)(dst + mt * 32 + q * 8 + h * 4) = v;
          }
      } else {
        u16* dst = Vt + (((size_t)head * (S / 64) + (t >> 6)) * 128 + (part - 2) * 64) * 64 + permpos(t & 63);
#pragma unroll
        for (int mt = 0; mt < 2; ++mt)
#pragma unroll
          for (int i = 0; i < 16; ++i) { const int dv = mt * 32 + (i & 3) + 8 * (i >> 2) + 4 * h; dst[dv * 64] = tobf(acc[mt][nt][i] * r); }
      }
    }
  }
};

struct EpiQ2 {
  static constexpr bool PERM = true, AFTER_DRAIN = false;
  u16* Q; const PG8_LAS float* rs;
  DI void operator()(const pg8::f32x4 (&acc)[2][2][4][2], const pg8::Unit& u, int wr, int wc, int fr, int fq) const {
    asm volatile("" : "+v"(fr), "+v"(fq));
    int cb[2];
#pragma unroll
    for (int bj = 0; bj < 2; ++bj) { const int c0 = u.pn * 256 + bj * 128 + wc * 32 + 8 * fq, head = c0 / 192; cb[bj] = head * (S * 192) + (c0 - head * 192); }
    const int rl0 = wr * 64 + fr; u16* q0 = Q + (size_t)(u.pm * 256 + rl0) * 192; const PG8_LAS float* rs0 = rs + rl0;
#pragma unroll
    for (int ai = 0; ai < 2; ++ai)
#pragma unroll
      for (int m = 0; m < 4; ++m) { const float sc = rs0[ai * 128 + m * 16] * QSCALE; u16* qr = q0 + (ai * 128 + m * 16) * 192;
#pragma unroll
        for (int bj = 0; bj < 2; ++bj) { const pg8::f32x4 v0 = acc[ai][bj][m][0] * sc, v1 = acc[ai][bj][m][1] * sc;
          u32x4 w = {pack2(v0[0], v0[1]), pack2(v0[2], v0[3]), pack2(v1[0], v1[1]), pack2(v1[2], v1[3])};
          *(u32x4*)(qr + cb[bj]) = w; }
        asm volatile("" ::: "memory"); }
  }
};
struct EpiKV2 {
  static constexpr bool PERM = true, AFTER_DRAIN = false;
  u16* K; u16* Vt; const PG8_LAS float* rs;
  DI void operator()(const pg8::f32x4 (&acc)[2][2][4][2], const pg8::Unit& u, int wr, int wc, int fr, int fq) const {
    asm volatile("" : "+v"(fr), "+v"(fq));
    const int head = u.pn, d0 = wc * 32 + 8 * fq, rl0 = wr * 64 + fr;
    u16* k0 = K + ((size_t)head * S + u.pm * 256 + rl0) * 192 + d0; const PG8_LAS float* rs0 = rs + rl0;
    u16* v0p = Vt + (((size_t)head * (S / 64) + u.pm * 4 + wr) * 128 + d0) * 64 + permpos(fr);
#pragma unroll
    for (int ai = 0; ai < 2; ++ai)
#pragma unroll
      for (int m = 0; m < 4; ++m) { const float sc = rs0[ai * 128 + m * 16];
        { const pg8::f32x4 v0 = acc[ai][0][m][0] * sc, v1 = acc[ai][0][m][1] * sc;
          u32x4 w = {pack2(v0[0], v0[1]), pack2(v0[2], v0[3]), pack2(v1[0], v1[1]), pack2(v1[2], v1[3])};
          *(u32x4*)(k0 + (ai * 128 + m * 16) * 192) = w; }
        { const pg8::f32x4 v0 = acc[ai][1][m][0] * sc, v1 = acc[ai][1][m][1] * sc;
          u16* dst = v0p + ai * (2 * 128 * 64) + m * 16;
#pragma unroll
          for (int j = 0; j < 4; ++j) { dst[j * 64] = tobf(v0[j]); dst[(4 + j) * 64] = tobf(v1[j]); } }
        asm volatile("" ::: "memory"); }
  }
};
DI void row_rstd256(float* rs, const u16* X, int ldx, int K, int wv) {
  const int tid = tid_of(wv), tl = tid >> 1, sub = tid & 1;
  const u16* src = X + (size_t)tl * ldx; float ss = 0.f;
  for (int c = sub; c < (K >> 3); c += 2) {
    u32x4 v = *(const u32x4*)(src + c * 8);
#pragma unroll
    for (int j = 0; j < 4; ++j) { const float a = bflo(v[j]), b = bfhi(v[j]); ss += a * a + b * b; }
  }
  ss += __shfl_xor(ss, 1);
  if (sub == 0) rs[tl] = rsqrtf(ss / (float)K + EPS);
}
DI void row_rstd(float* rs, const u16* X, int ldx, int K) {
  const int tid = otid(), tl = tid >> 2, sub = tid & 3;
  const u16* src = X + (size_t)tl * ldx; float ss = 0.f;
  for (int c = sub; c < (K >> 3); c += 4) {
    u32x4 v = *(const u32x4*)(src + c * 8);
#pragma unroll
    for (int j = 0; j < 4; ++j) { const float a = bflo(v[j]), b = bfhi(v[j]); ss += a * a + b * b; }
  }
  ss += __shfl_xor(ss, 1); ss += __shfl_xor(ss, 2);
  if (sub == 0) rs[tl] = rsqrtf(ss / (float)K + EPS);
}

DI void krope_tile(const P& p, int n0) {
  const int tid = tid_of(p.ph_lo), t = n0 + (tid >> 2), i0 = (tid & 3) * 8;
  const u16* z = (const u16*)(p.ws + WS_Z) + (size_t)t * ZLD + Z_KR;
  const float* cosT = (const float*)(p.ws + WS_COS) + (size_t)t * 32 + i0; const float* sinT = (const float*)(p.ws + WS_SIN) + (size_t)t * 32 + i0;
  u32x4 a = *(const u32x4*)(z + i0), b = *(const u32x4*)(z + 32 + i0);
  f32x4 c0 = *(const f32x4*)cosT, c1 = *(const f32x4*)(cosT + 4), s0 = *(const f32x4*)sinT, s1 = *(const f32x4*)(sinT + 4);
  float x1[8], x2[8], c[8], s[8];
#pragma unroll
  for (int j = 0; j < 4; ++j) { x1[2 * j] = bflo(a[j]); x1[2 * j + 1] = bfhi(a[j]); x2[2 * j] = bflo(b[j]); x2[2 * j + 1] = bfhi(b[j]); c[j] = c0[j]; c[4 + j] = c1[j]; s[j] = s0[j]; s[4 + j] = s1[j]; }
  u32x4 o1, o2;
#pragma unroll
  for (int j = 0; j < 4; ++j) {
    o1[j] = pack2(x1[2 * j] * c[2 * j] - x2[2 * j] * s[2 * j], x1[2 * j + 1] * c[2 * j + 1] - x2[2 * j + 1] * s[2 * j + 1]);
    o2[j] = pack2(x2[2 * j] * c[2 * j] + x1[2 * j] * s[2 * j], x2[2 * j + 1] * c[2 * j + 1] + x1[2 * j + 1] * s[2 * j + 1]);
  }
  u16* K = (u16*)(p.ws + WS_K);
#pragma unroll
  for (int hd = 0; hd < 4; ++hd) { u16* dst = K + ((size_t)hd * S + t) * 192 + 128 + i0; *(u32x4*)dst = o1; *(u32x4*)(dst + 32) = o2; }
}

DI void sgu_job(unsigned char* lds, const P& p, int layer, int nb) {
  const int tid = tid_of(p.ph_lo), lane = tid & 63, wave = wave_of(tid);
  const int n0 = nb * 128;
  const u16* z = (const u16*)(p.ws + WS_Z);
  u16* vT = (u16*)lds;
  {
    const int j = tid >> 2, sub = tid & 3; const u16* src = z + (size_t)(n0 + j) * ZLD + Z_V + sub * 64;
    float v[64]; float s = 0.f;
#pragma unroll
    for (int c = 0; c < 8; ++c) { u32x4 u = *(const u32x4*)(src + c * 8);
#pragma unroll
      for (int k = 0; k < 4; ++k) { v[c * 8 + 2 * k] = bflo(u[k]); v[c * 8 + 2 * k + 1] = bfhi(u[k]); s += v[c * 8 + 2 * k] + v[c * 8 + 2 * k + 1]; } }
    s += __shfl_xor(s, 1); s += __shfl_xor(s, 2);
    const float mu = s * (1.f / 256.f); float q = 0.f;
#pragma unroll
    for (int c = 0; c < 64; ++c) { const float d = v[c] - mu; q += d * d; }
    q += __shfl_xor(q, 1); q += __shfl_xor(q, 2);
    const float rstd = rsqrtf(q * (1.f / 256.f) + EPS);
    const float* g = p.sgu_ln_g + layer * 256 + sub * 64; const float* b = p.sgu_ln_b + layer * 256 + sub * 64;
#pragma unroll
    for (int c4 = 0; c4 < 16; ++c4) { const f32x4 gg = *(const f32x4*)(g + c4 * 4), bb = *(const f32x4*)(b + c4 * 4);
#pragma unroll
      for (int k = 0; k < 4; ++k) vT[(sub * 64 + c4 * 4 + k) * 136 + j] = tobf((v[c4 * 4 + k] - mu) * rstd * gg[k] + bb[k]); }
  }
  __syncthreads();
  const int wm = wave & 3, wn = wave >> 2, l32 = lane & 31, h = lane >> 5;
  f32x16 acc[2][2]; acc[0][0] = zero16(); acc[0][1] = zero16(); acc[1][0] = zero16(); acc[1][1] = zero16();
  const u16* W = (const u16*)(p.ws + WS_SGUW) + (size_t)(layer * 4 + wm) * 128 * 128;
#pragma unroll
  for (int kk = 0; kk < 8; ++kk) {
    bf16x8 a0 = *(const bf16x8*)(vT + (wm * 64 + l32) * 136 + kk * 16 + h * 8);
    bf16x8 a1 = *(const bf16x8*)(vT + (wm * 64 + 32 + l32) * 136 + kk * 16 + h * 8);
    bf16x8 b0 = *(const bf16x8*)(W + (wn * 64 + l32) * 128 + kk * 16 + h * 8);
    bf16x8 b1 = *(const bf16x8*)(W + (wn * 64 + 32 + l32) * 128 + kk * 16 + h * 8);
    acc[0][0] = MFMA(a0, b0, acc[0][0]); acc[0][1] = MFMA(a0, b1, acc[0][1]);
    acc[1][0] = MFMA(a1, b0, acc[1][0]); acc[1][1] = MFMA(a1, b1, acc[1][1]);
  }
  u16* Y = (u16*)(p.ws + WS_HY);
#pragma unroll
  for (int nt = 0; nt < 2; ++nt) {
    const int i = wn * 64 + nt * 32 + l32, t = n0 + i; const float bias = p.sgu_b[(layer * 4 + wm) * 128 + i];
#pragma unroll
    for (int mt = 0; mt < 2; ++mt)
#pragma unroll
      for (int q = 0; q < 4; ++q) {
        const int c = wm * 64 + mt * 32 + q * 8 + h * 4;
        const u32x2 u = *(const u32x2*)(z + (size_t)t * ZLD + Z_U + c), g = *(const u32x2*)(z + (size_t)t * ZLD + Z_SG + c);
        const float o0 = bflo(u[0]) * (acc[mt][nt][q * 4] + bias) * silu(bflo(g[0])), o1 = bfhi(u[0]) * (acc[mt][nt][q * 4 + 1] + bias) * silu(bfhi(g[0]));
        const float o2 = bflo(u[1]) * (acc[mt][nt][q * 4 + 2] + bias) * silu(bflo(g[1])), o3 = bfhi(u[1]) * (acc[mt][nt][q * 4 + 3] + bias) * silu(bfhi(g[1]));
        u32x2 v = {pack2(o0, o1), pack2(o2, o3)};
        *(u32x2*)(Y + (size_t)t * DM + c) = v;
      }
  }
}

template <int W>
DI void pool_win(const u16* zp, int t0, u16* prow) {
  unsigned v[32 + W];
#pragma unroll
  for (int i = 0; i < 32 + W; ++i) { const int t = t0 - W + i; v[i] = (t >= 0) ? *(const unsigned*)(zp + (size_t)max(t, 0) * ZLD) : 0u; }
  float s0 = 0.f, s1 = 0.f;
#pragma unroll
  for (int i = 0; i < W; ++i) { s0 += bflo(v[i]); s1 += bfhi(v[i]); }
#pragma unroll
  for (int tt = 0; tt < 32; ++tt) {
    const float p0 = bflo(v[W + tt]), p1 = bfhi(v[W + tt]);
    s0 += p0 - bflo(v[tt]); s1 += p1 - bfhi(v[tt]);
    const float inv = 1.f / (float)min(t0 + tt + 1, W);
    *(unsigned*)(prow + tt * 264) = pack2(s0 * inv - p0, s1 * inv - p1);
  }
}
DI void pool_job(unsigned char* lds, const P& p, int layer, int nb) {
  const int tid = tid_of(p.ph_lo), lane = tid & 63, wave = wave_of(tid);
  const int n0 = nb * 128;
  const u16* z = (const u16*)(p.ws + WS_Z);
  u16* pl = (u16*)lds;
  {
    const int g = wave & 3, c = g * 64 + (lane & 31) * 2, tq = (wave >> 2) * 2 + (lane >> 5);
    const u16* zp = z + Z_PI + c; const int t0 = n0 + tq * 32; u16* prow = pl + (tq * 32) * 264 + c;
    switch (g) { case 0: pool_win<2>(zp, t0, prow); break; case 1: pool_win<4>(zp, t0, prow); break; case 2: pool_win<8>(zp, t0, prow); break; default: pool_win<16>(zp, t0, prow); break; }
  }
  __syncthreads();
  const int wm = wave & 3, wn = wave >> 2, l32 = lane & 31, h = lane >> 5;
  f32x16 acc[2][2]; acc[0][0] = zero16(); acc[0][1] = zero16(); acc[1][0] = zero16(); acc[1][1] = zero16();
  const u16* W = (const u16*)(p.ws + WS_PWT) + (size_t)(layer * 4 + wm) * 64 * 64;
#pragma unroll
  for (int kk = 0; kk < 4; ++kk) {
    bf16x8 a0 = *(const bf16x8*)(W + (l32) * 64 + kk * 16 + h * 8);
    bf16x8 a1 = *(const bf16x8*)(W + (32 + l32) * 64 + kk * 16 + h * 8);
    bf16x8 b0 = *(const bf16x8*)(pl + (wn * 64 + l32) * 264 + wm * 64 + kk * 16 + h * 8);
    bf16x8 b1 = *(const bf16x8*)(pl + (wn * 64 + 32 + l32) * 264 + wm * 64 + kk * 16 + h * 8);
    acc[0][0] = MFMA(a0, b0, acc[0][0]); acc[0][1] = MFMA(a0, b1, acc[0][1]);
    acc[1][0] = MFMA(a1, b0, acc[1][0]); acc[1][1] = MFMA(a1, b1, acc[1][1]);
  }
  u16* Y = (u16*)(p.ws + WS_HY);
#pragma unroll
  for (int nt = 0; nt < 2; ++nt) {
    const int t = n0 + wn * 64 + nt * 32 + l32;
#pragma unroll
    for (int mt = 0; mt < 2; ++mt)
#pragma unroll
      for (int q = 0; q < 4; ++q) {
        const int c = wm * 64 + mt * 32 + q * 8 + h * 4;
        const f32x4 sc = *(const f32x4*)(p.pool_scale + layer * 256 + c);
        const u32x2 g = *(const u32x2*)(z + (size_t)t * ZLD + Z_PG + c);
        const float o0 = acc[mt][nt][q * 4] * sc[0] * silu(bflo(g[0])), o1 = acc[mt][nt][q * 4 + 1] * sc[1] * silu(bfhi(g[0]));
        const float o2 = acc[mt][nt][q * 4 + 2] * sc[2] * silu(bflo(g[1])), o3 = acc[mt][nt][q * 4 + 3] * sc[3] * silu(bfhi(g[1]));
        u32x2 v = {pack2(o0, o1), pack2(o2, o3)};
        *(u32x2*)(Y + (size_t)t * DM + 256 + c) = v;
      }
  }
}

DI void att_qk(f32x16& s, const unsigned char* krow, const bf16x8 (&qf)[12], float m) {
  bf16x8 ka[4], kb[4];
#pragma unroll
  for (int i = 0; i < 4; ++i) ka[i] = *(const bf16x8*)(krow + i * 32);
#pragma unroll
  for (int i = 0; i < 4; ++i) kb[i] = *(const bf16x8*)(krow + (4 + i) * 32);
  const float nm = -m;
#pragma unroll
  for (int i = 0; i < 16; ++i) s[i] = nm;
  __builtin_amdgcn_sched_barrier(0);
#pragma unroll
  for (int i = 0; i < 4; ++i) s = MFMA(ka[i], qf[i], s);
  __builtin_amdgcn_sched_barrier(0);
#pragma unroll
  for (int i = 0; i < 4; ++i) ka[i] = *(const bf16x8*)(krow + (8 + i) * 32);
  __builtin_amdgcn_sched_barrier(0);
#pragma unroll
  for (int i = 0; i < 4; ++i) s = MFMA(kb[i], qf[4 + i], s);
  __builtin_amdgcn_sched_barrier(0);
#pragma unroll
  for (int i = 0; i < 4; ++i) s = MFMA(ka[i], qf[8 + i], s);
  __builtin_amdgcn_sched_barrier(0);
}
DI void att_sm_pv(f32x16& s, const unsigned char* vrow, f32x16 (&O)[4], float& m, float& l, bool first) {
  bf16x8 vf[8];
#pragma unroll
  for (int mt = 0; mt < 4; ++mt) { vf[2 * mt] = *(const bf16x8*)(vrow + mt * 32 * 144); vf[2 * mt + 1] = *(const bf16x8*)(vrow + mt * 32 * 144 + 32); }
  __builtin_amdgcn_sched_barrier(0);
  float mx = fmaxf(fmaxf(s[0], s[1]), s[2]);
#pragma unroll
  for (int i = 3; i < 15; i += 2) mx = fmaxf(fmaxf(mx, s[i]), s[i + 1]);
  mx = fmaxf(mx, s[15]);
  if (first || __builtin_amdgcn_ballot_w64(mx > 8.f) != 0) {
    const float mxx = fmaxf(mx, __shfl_xor(mx, 32));
    const float d = first ? mxx : fmaxf(mxx, 0.f);
    const float alpha = first ? 1.f : ex2(-d);
    m += d; l *= alpha;
#pragma unroll
    for (int i = 0; i < 16; ++i) s[i] -= d;
#pragma unroll
    for (int mt = 0; mt < 4; ++mt)
#pragma unroll
      for (int i = 0; i < 16; ++i) O[mt][i] *= alpha;
  }
  float ps0 = 0.f, ps1 = 0.f;
#pragma unroll
  for (int i = 0; i < 16; i += 2) { s[i] = ex2(s[i]); s[i + 1] = ex2(s[i + 1]); ps0 += s[i]; ps1 += s[i + 1]; }
  l += ps0 + ps1;
  u32x4 p0 = {pack2(s[0], s[1]), pack2(s[2], s[3]), pack2(s[4], s[5]), pack2(s[6], s[7])};
  u32x4 p1 = {pack2(s[8], s[9]), pack2(s[10], s[11]), pack2(s[12], s[13]), pack2(s[14], s[15])};
  const bf16x8 pf0 = __builtin_bit_cast(bf16x8, p0), pf1 = __builtin_bit_cast(bf16x8, p1);
#pragma unroll
  for (int mt = 0; mt < 4; ++mt) { O[mt] = MFMA(vf[2 * mt], pf0, O[mt]); O[mt] = MFMA(vf[2 * mt + 1], pf1, O[mt]); }
}
DI void attn_item(unsigned char* lds, const P& p, int hd, int qb, bool ropeq) {
  const int tid = tid_of(p.ph_lo), lane = tid & 63, wave = wave_of(tid);
  const int wq = wave & 3, wk = wave >> 2, l32 = lane & 31, h = lane >> 5;
  const u16* Qg = (const u16*)(p.ws + WS_Q) + ((size_t)hd * S + qb * 128 + wq * 32 + l32) * 192 + h * 8;
  bf16x8 qf[12];
#pragma unroll
  for (int ks = 0; ks < 12; ++ks) qf[ks] = *(const bf16x8*)(Qg + ks * 16);
  if (ropeq) {
    const int t = qb * 128 + wq * 32 + l32;
    const float* ct = (const float*)(p.ws + WS_COS) + (size_t)t * 32 + h * 8; const float* st = (const float*)(p.ws + WS_SIN) + (size_t)t * 32 + h * 8;
#pragma unroll
    for (int pr = 0; pr < 2; ++pr) {
      const f32x4 c0 = *(const f32x4*)(ct + pr * 16), c1 = *(const f32x4*)(ct + pr * 16 + 4), s0 = *(const f32x4*)(st + pr * 16), s1 = *(const f32x4*)(st + pr * 16 + 4);
      const u32x4 xa = __builtin_bit_cast(u32x4, qf[8 + pr]), xb = __builtin_bit_cast(u32x4, qf[10 + pr]);
      u32x4 oa, ob;
#pragma unroll
      for (int j = 0; j < 4; ++j) {
        const float cl = (j < 2) ? c0[2 * j] : c1[2 * j - 4], ch = (j < 2) ? c0[2 * j + 1] : c1[2 * j - 3], sl = (j < 2) ? s0[2 * j] : s1[2 * j - 4], sh = (j < 2) ? s0[2 * j + 1] : s1[2 * j - 3];
        const float a0 = bflo(xa[j]), a1 = bfhi(xa[j]), b0 = bflo(xb[j]), b1 = bfhi(xb[j]);
        oa[j] = pack2(a0 * cl - b0 * sl, a1 * ch - b1 * sh); ob[j] = pack2(b0 * cl + a0 * sl, b1 * ch + a1 * sh);
      }
      qf[8 + pr] = __builtin_bit_cast(bf16x8, oa); qf[10 + pr] = __builtin_bit_cast(bf16x8, ob);
    }
  }
  const int ntile = 2 * qb + 2, mychunk = 2 * qb + (wq >> 1);
  const u16* Kg = (const u16*)(p.ws + WS_K) + (size_t)hd * S * 192 + tid * 8;
  const u16* Vg = (const u16*)(p.ws + WS_VT) + (size_t)hd * S * 128 + tid * 8;
  int kdst[3], vdst[2];
#pragma unroll
  for (int i = 0; i < 3; ++i) { const int c = tid + i * NT; kdst[i] = (c / 24) * 400 + (c % 24) * 16; }
#pragma unroll
  for (int i = 0; i < 2; ++i) { const int c = tid + i * NT; vdst[i] = 64 * 400 + (c >> 3) * 144 + (c & 7) * 16; }
  const int koff = (wk * 32 + l32) * 400 + h * 16;
  const int voff = 64 * 400 + l32 * 144 + (wk * 32 + h * 8) * 2;
  f32x16 O[4]; O[0] = zero16(); O[1] = zero16(); O[2] = zero16(); O[3] = zero16();
  float m = 0.f, l = 0.f;
  u32x4 rkA[3], rvA[2], rkB[3], rvB[2];
#define ATT_GLOAD(RK, RV, T) do { _Pragma("unroll") for (int i = 0; i < 3; ++i) RK[i] = *(const u32x4*)(Kg + (size_t)(T) * 64 * 192 + i * NT * 8); \
                                  _Pragma("unroll") for (int i = 0; i < 2; ++i) RV[i] = *(const u32x4*)(Vg + (size_t)(T) * 128 * 64 + i * NT * 8); } while (0)
#define ATT_LSTORE(RK, RV, ST) do { unsigned char* st_ = lds + (ST) * ATT_STAGE; _Pragma("unroll") for (int i = 0; i < 3; ++i) *(u32x4*)(st_ + kdst[i]) = RK[i]; \
                                    _Pragma("unroll") for (int i = 0; i < 2; ++i) *(u32x4*)(st_ + vdst[i]) = RV[i]; } while (0)
#define ATT_STEP(KT, RLK, RLV, RSK, RSV) do { \
    ATT_GLOAD(RLK, RLV, min((KT) + 2, ntile - 1));     \
    if ((KT) <= mychunk) { f32x16 s; att_qk(s, lds + ((KT) & 1) * ATT_STAGE + koff, qf, m); att_sm_pv(s, lds + ((KT) & 1) * ATT_STAGE + voff, O, m, l, (KT) == 0); } \
    if ((KT) + 1 < ntile) ATT_LSTORE(RSK, RSV, ((KT) + 1) & 1); \
    lds_barrier(); } while (0)
  ATT_GLOAD(rkA, rvA, 0);
  ATT_GLOAD(rkB, rvB, 1);
  ATT_LSTORE(rkA, rvA, 0);
  __syncthreads();
#pragma unroll 1
  for (int kt = 0; kt < ntile; kt += 2) {
    ATT_STEP(kt, rkA, rvA, rkB, rvB);
    ATT_STEP(kt + 1, rkB, rvB, rkA, rvA);
  }
  const float lt = l + __shfl_xor(l, 32);
  float* cO = (float*)lds; float* cm = (float*)(lds + 65536);
  if (wk == 1) {
#pragma unroll
    for (int mt = 0; mt < 4; ++mt)
#pragma unroll
      for (int i = 0; i < 16; ++i) cO[(wq * 64 + mt * 16 + i) * 64 + lane] = O[mt][i];
    cm[wq * 64 + lane] = m; cm[256 + wq * 64 + lane] = lt;
  }
  __syncthreads();
  if (wk == 0) {
    const float m1 = cm[wq * 64 + lane], l1 = cm[256 + wq * 64 + lane];
    const float mm = fmaxf(m, m1); float a0 = ex2(m - mm), a1 = ex2(m1 - mm);
    const float inv = 1.f / (lt * a0 + l1 * a1); a0 *= inv; a1 *= inv;
    const int t = qb * 128 + wq * 32 + l32;
    const u16* zg = (const u16*)(p.ws + WS_Z) + (size_t)t * ZLD + Z_MG + hd * 128;
    u16* Y = (u16*)(p.ws + WS_HY) + (size_t)t * DM + 512 + hd * 128;
#pragma unroll
    for (int mt = 0; mt < 4; ++mt)
#pragma unroll
      for (int q = 0; q < 4; ++q) {
        const int dv = mt * 32 + q * 8 + h * 4;
        const u32x2 g = *(const u32x2*)(zg + dv);
        float o[4];
#pragma unroll
        for (int j = 0; j < 4; ++j) o[j] = O[mt][q * 4 + j] * a0 + cO[(wq * 64 + mt * 16 + q * 4 + j) * 64 + lane] * a1;
        u32x2 v = {pack2(o[0] * silu(bflo(g[0])), o[1] * silu(bfhi(g[0]))), pack2(o[2] * silu(bflo(g[1])), o[3] * silu(bfhi(g[1])))};
        *(u32x2*)(Y + dv) = v;
      }
  }
  __syncthreads();
}

DI void transpose_tile(unsigned char* lds, const float* __restrict__ src, int ldsrc, u16* __restrict__ dst, int ldd, int k0, int n0, int nvalid, const float* gain) {
  float* tile = (float*)lds;
  const int tid = otid();
#pragma unroll
  for (int i = 0; i < 8; ++i) { const int idx = tid + i * NT, r = idx >> 6, cc = idx & 63, n = n0 + cc;
    float v = (n < nvalid) ? src[(size_t)(k0 + r) * ldsrc + n] : 0.f; if (gain) v *= gain[k0 + r]; tile[r * 65 + cc] = v; }
  __syncthreads();
#pragma unroll
  for (int i = 0; i < 8; ++i) { const int idx = tid + i * NT, r = idx >> 6, cc = idx & 63; dst[(size_t)(n0 + r) * ldd + k0 + cc] = tobf(tile[cc * 65 + r]); }
  __syncthreads();
}
DI float wave_sum(float v) { v += __shfl_xor(v, 32); v += __shfl_xor(v, 16); v += __shfl_xor(v, 8); v += __shfl_xor(v, 4); v += __shfl_xor(v, 2); v += __shfl_xor(v, 1); return v; }
DI void prenorm_row(const f32x4 (&v)[4], const float* g, u16* hrow, int lane) {
  float ss = 0.f;
#pragma unroll
  for (int i = 0; i < 4; ++i) ss += v[i][0] * v[i][0] + v[i][1] * v[i][1] + v[i][2] * v[i][2] + v[i][3] * v[i][3];
  ss = wave_sum(ss);
  const float r = rsqrtf(ss * (1.f / 1024.f) + EPS);
#pragma unroll
  for (int i = 0; i < 4; ++i) { const f32x4 gg = *(const f32x4*)(g + (lane + 64 * i) * 4);
    u32x2 o = {pack2(v[i][0] * r * gg[0], v[i][1] * r * gg[1]), pack2(v[i][2] * r * gg[2], v[i][3] * r * gg[3])};
    *(u32x2*)(hrow + (lane + 64 * i) * 4) = o; }
}

DI void phase_prep(unsigned char* lds, const P& p) {
  const int nb = gridDim.x, bid = blockIdx.x, tid = otid();
  u16* win = (u16*)(p.ws + WS_WIN); u16* wuq = (u16*)(p.ws + WS_WUQ); u16* wukv = (u16*)(p.ws + WS_WUKV); u16* wout = (u16*)(p.ws + WS_WOUT);
  for (int job = bid; job < 2 * 1032; job += nb) {
    const int layer = job / 1032; int r = job - layer * 1032;
    if (r < 640) { const int kt = r / 40, nt = r - kt * 40; transpose_tile(lds, p.w_in + (size_t)layer * 1024 * DIN, DIN, win + (size_t)layer * 2560 * 1024, 1024, kt * 64, nt * 64, DIN, nullptr); }
    else if (r < 712) { r -= 640; const int kt = r / 12, nt = r - kt * 12; transpose_tile(lds, p.w_uq + (size_t)layer * 384 * 768, 768, wuq + (size_t)layer * 768 * 384, 384, kt * 64, nt * 64, 768, p.q_norm_g + layer * 384); }
    else if (r < 776) { r -= 712; const int kt = r / 16, nt = r - kt * 16; transpose_tile(lds, p.w_ukv + (size_t)layer * 256 * 1024, 1024, wukv + (size_t)layer * 1024 * 256, 256, kt * 64, nt * 64, 1024, p.kv_norm_g + layer * 256); }
    else { r -= 776; const int kt = r / 16, nt = r - kt * 16; transpose_tile(lds, p.w_out + (size_t)layer * 1024 * 1024, 1024, wout + (size_t)layer * 1024 * 1024, 1024, kt * 64, nt * 64, 1024, nullptr); }
  }
  const int gtid = bid * NT + tid, gn = nb * NT;
  u16* sguw = (u16*)(p.ws + WS_SGUW);
  for (int idx = gtid; idx < 2 * 4 * 128 * 128; idx += gn) { const int i = (idx >> 7) & 127, j = idx & 127; sguw[idx] = ((j >> 6) <= (i >> 6)) ? tobf(p.sgu_w[idx]) : (u16)0; }
  u16* pwt = (u16*)(p.ws + WS_PWT);
  for (int idx = gtid; idx < 2 * 4 * 64 * 64; idx += gn) { const int lg = idx >> 12, d = (idx >> 6) & 63, c = idx & 63; pwt[idx] = tobf(p.pool_w[(lg * 64 + c) * 64 + d]); }
  float* cosT = (float*)(p.ws + WS_COS); float* sinT = (float*)(p.ws + WS_SIN);
  for (int idx = gtid; idx < S * 32; idx += gn) {
    const int t = idx >> 5, i = idx & 31; const float angf = (float)p.pos[t] * p.invfreq[i];
    const double a = (double)angf; const double k = rint(a * 0.15915494309189535); const double r = a - k * 6.283185307179586; const double r2 = r * r;
    double ts = r, ss = r, tc = 1.0, sc = 1.0;
#pragma unroll
    for (int n = 1; n <= 13; ++n) { ts *= -r2 * (1.0 / (double)((2 * n) * (2 * n + 1))); ss += ts; tc *= -r2 * (1.0 / (double)((2 * n - 1) * (2 * n))); sc += tc; }
    cosT[idx] = (float)sc; sinT[idx] = (float)ss;
  }
  u16* hb = (u16*)(p.ws + WS_HY);
  const int lane = tid & 63, wave = wave_of(tid);
  for (int row = bid * 8 + wave; row < S; row += nb * 16) {
    const int row2 = row + nb * 8; const bool has2 = row2 < S;
    f32x4 v[4], v2[4];
#pragma unroll
    for (int i = 0; i < 4; ++i) v[i] = *(const f32x4*)(p.x + (size_t)row * DM + (lane + 64 * i) * 4);
    if (has2) {
#pragma unroll
      for (int i = 0; i < 4; ++i) v2[i] = *(const f32x4*)(p.x + (size_t)row2 * DM + (lane + 64 * i) * 4);
    }
    prenorm_row(v, p.pre_g, hb + (size_t)row * DM, lane);
    if (has2) prenorm_row(v2, p.pre_g, hb + (size_t)row2 * DM, lane);
  }
}

DI void post_load(const u16* yout, const float* xold, int row, int lane, f32x4 (&y)[4], f32x4 (&xo)[4]) {
#pragma unroll
  for (int i = 0; i < 4; ++i) { const u32x2 yb = *(const u32x2*)(yout + (size_t)row * DM + (lane + 64 * i) * 4); y[i] = (f32x4){bflo(yb[0]), bfhi(yb[0]), bflo(yb[1]), bfhi(yb[1])};
    xo[i] = *(const f32x4*)(xold + (size_t)row * DM + (lane + 64 * i) * 4); }
}
DI void post_finish(const P& p, int layer, int row, int lane, f32x4 (&y)[4], const f32x4 (&xo)[4], u16* hb) {
  float ss = 0.f;
#pragma unroll
  for (int i = 0; i < 4; ++i) ss += y[i][0] * y[i][0] + y[i][1] * y[i][1] + y[i][2] * y[i][2] + y[i][3] * y[i][3];
  ss = wave_sum(ss);
  const float r = rsqrtf(ss * (1.f / 1024.f) + EPS);
#pragma unroll
  for (int i = 0; i < 4; ++i) {
    const f32x4 g = *(const f32x4*)(p.post_g + layer * DM + (lane + 64 * i) * 4);
    y[i] = xo[i] + y[i] * r * g;
    *(f32x4*)(p.out + (size_t)row * DM + (lane + 64 * i) * 4) = y[i];
  }
  if (layer + 1 < DEPTH) prenorm_row(y, p.pre_g + (layer + 1) * DM, hb + (size_t)row * DM, lane);
}
DI void phase_post(const P& p, int layer) {
  const int nb = gridDim.x, bid = blockIdx.x, tid = tid_of(p.ph_lo), lane = tid & 63, wave = wave_of(tid);
  const u16* yout = (const u16*)(p.ws + WS_Z); const float* xold = layer == 0 ? p.x : p.out;
  u16* hb = (u16*)(p.ws + WS_HY);
  for (int row = bid * 8 + wave; row < S; row += nb * 16) {
    const int row2 = row + nb * 8; const bool has2 = row2 < S;
    f32x4 y0[4], x0[4], y1[4], x1[4];
    post_load(yout, xold, row, lane, y0, x0);
    if (has2) post_load(yout, xold, row2, lane, y1, x1);
    post_finish(p, layer, row, lane, y0, x0, hb);
    if (has2) post_finish(p, layer, row2, lane, y1, x1, hb);
  }
}

__global__ void __launch_bounds__(NT) mega(P p0) {
  const P& p = p0;
  extern __shared__ __attribute__((aligned(16))) unsigned char lds[];
  cg::grid_group grid = cg::this_grid();
  const int nb = gridDim.x, bid = blockIdx.x;
  const int wv0 = __builtin_amdgcn_readfirstlane((int)(threadIdx.x >> 6));
  if (threadIdx.x < 4) ((unsigned*)(lds + XB_LDS_OFF))[threadIdx.x] = 0u;
  __syncthreads();
  XcdBarrier xbar = xcd_barrier_post((unsigned*)(p.ws + WS_BAR), (volatile LAS unsigned*)(lds + XB_LDS_OFF)); xbar.wv = wv0;
  unsigned* xcnt = (unsigned*)(p.ws + WS_BAR + 14336);
  unsigned myslot = 0;
  if (threadIdx.x == 0) myslot = xb_add(&xcnt[16 * xbar.x], 1u);
  int vid = bid;
#define RUN(ph_) true
#define SEAM(ph_) do { if (p.ph_hi < 0) grid.sync(); else xcd_barrier(xbar); } while (0)
  if (RUN(ph)) phase_prep(lds, p);
  SEAM(0);
  {
    if (threadIdx.x == 0) { bool even = (nb & 7) == 0; for (int j = 0; j < 8; ++j) even = even && (xb_ld(&xcnt[16 * j]) == (unsigned)(nb >> 3));
      ((volatile LAS unsigned*)(lds + XB_LDS_OFF))[2] = even ? (myslot * 8u + xbar.x) : (unsigned)bid; }
    __syncthreads();
    vid = __builtin_amdgcn_readfirstlane((int)((volatile LAS unsigned*)(lds + XB_LDS_OFF))[2]);
  }
#pragma unroll 1
  for (int layer = 0; layer < DEPTH; ++layer) {
    P pl = p0; pl.ph_lo = wv0;
    u16* hy = (u16*)(pl.ws + WS_HY); u16* z = (u16*)(pl.ws + WS_Z);
    float* rs = (float*)(lds + RS_OFF);
    if (RUN(ph)) {
      const u16* W = (const u16*)(pl.ws + WS_WIN) + (size_t)layer * 2560 * 1024;
      { pg8::Gemm g{hy, W, S, 2560, 1024, 1024}; pg8::StaticOrder so; so.init(S, 2560, nb, vid);
        pg8::EpiBf16<0> E{z, ZLD, nullptr, 0, 0};
        pg8::gemm_phase<pg8::EpiBf16<0>, pg8::StaticOrder, false>((PG8_LAS unsigned char*)lds, g, so, E, nullptr, pl.ph_lo); }
    }
    SEAM(0);
    if (RUN(ph)) {
      const float* cosT = (const float*)(pl.ws + WS_COS); const float* sinT = (const float*)(pl.ws + WS_SIN);
      {
        pg8::StaticOrder so; pg8::Unit u;
        so.init(S, 768, nb, vid);
        if (so.next(0, u)) row_rstd256(rs, z + (size_t)u.pm * 256 * ZLD + Z_CQ, ZLD, 384, pl.ph_lo);
        __syncthreads();
        { pg8::Gemm g{z + Z_CQ, (const u16*)(pl.ws + WS_WUQ) + (size_t)layer * 768 * 384, S, 768, 384, ZLD}; EpiQ2 E{(u16*)(pl.ws + WS_Q), (const PG8_LAS float*)(lds + RS_OFF)};
          pg8::gemm_phase<EpiQ2, pg8::StaticOrder, false>((PG8_LAS unsigned char*)lds, g, so, E, nullptr, pl.ph_lo); }
        __syncthreads();
        so.init(S, 1024, nb, vid);
        if (so.next(0, u)) row_rstd256(rs, z + (size_t)u.pm * 256 * ZLD + Z_CKV, ZLD, 256, pl.ph_lo);
        __syncthreads();
        { pg8::Gemm g{z + Z_CKV, (const u16*)(pl.ws + WS_WUKV) + (size_t)layer * 1024 * 256, S, 1024, 256, ZLD}; EpiKV2 E{(u16*)(pl.ws + WS_K), (u16*)(pl.ws + WS_VT), (const PG8_LAS float*)(lds + RS_OFF)};
          pg8::gemm_phase<EpiKV2, pg8::StaticOrder, false>((PG8_LAS unsigned char*)lds, g, so, E, nullptr, pl.ph_lo); }
        if (vid < 128) krope_tile(pl, vid * 128);
        __syncthreads();
        if (vid < 128) sgu_job(lds, pl, layer, vid); else pool_job(lds, pl, layer, vid - 128);
      }
    }
    SEAM(0);
    if (RUN(ph)) {
      for (int it = vid; it < 256; it += nb) {
        const int hd = (it & 7) >> 1, pr = (it >> 3) * 2 + (it & 1);
        attn_item(lds, pl, hd, 127 - pr, true);
        attn_item(lds, pl, hd, pr, true);
      }
    }
    SEAM(0);
    if (RUN(ph)) {
      const u16* W = (const u16*)(pl.ws + WS_WOUT) + (size_t)layer * 1024 * 1024;
      { pg8::Gemm g{hy, W, S, 1024, 1024, 1024}; pg8::StaticOrder so; so.init(S, 1024, nb, vid);
        pg8::EpiBf16<0> E{(u16*)(pl.ws + WS_Z), 1024, nullptr, 0, 0};
        pg8::gemm_phase<pg8::EpiBf16<0>, pg8::StaticOrder, false>((PG8_LAS unsigned char*)lds, g, so, E, nullptr, pl.ph_lo); }
    }
    SEAM(0);
    if (RUN(ph)) phase_post(pl, layer);
    SEAM(0);
  }
  xcd_barrier(xbar);
}
constexpr int NPHASE = 1 + 5 * DEPTH;

extern "C" void kernel_launch(void* const* d_in, const int* in_sizes, int n_in, void* d_out, int out_size, void* d_ws, size_t ws_size, hipStream_t stream) {
  static int grid_blocks = 0;
  if (!grid_blocks) {
    int dev = 0, cus = 0, per_cu = 0;
    hipGetDevice(&dev);
    hipDeviceGetAttribute(&cus, hipDeviceAttributeMultiprocessorCount, dev);
    hipFuncSetAttribute((const void*)mega, hipFuncAttributeMaxDynamicSharedMemorySize, LDS_BYTES);
    hipOccupancyMaxActiveBlocksPerMultiprocessor(&per_cu, (const void*)mega, NT, LDS_BYTES);
    if (per_cu < 1) { fprintf(stderr, "occupancy query returned %d\n", per_cu); per_cu = 1; }
    if (per_cu > 1) per_cu = 1;
    grid_blocks = 256;
    if (cus * per_cu < 256) fprintf(stderr, "device offers %d co-resident workgroups, 256 needed\n", cus * per_cu);
    if (ws_size < WS_END) fprintf(stderr, "workspace too small: %zu < %zu\n", ws_size, (size_t)WS_END);
  }
  P p{};
  p.x = (const float*)d_in[0]; p.pos = (const int*)d_in[1]; p.pre_g = (const float*)d_in[2]; p.post_g = (const float*)d_in[3];
  p.w_in = (const float*)d_in[4]; p.sgu_w = (const float*)d_in[5]; p.sgu_b = (const float*)d_in[6]; p.sgu_ln_g = (const float*)d_in[7];
  p.sgu_ln_b = (const float*)d_in[8]; p.pool_w = (const float*)d_in[9]; p.pool_scale = (const float*)d_in[10]; p.q_norm_g = (const float*)d_in[11];
  p.w_uq = (const float*)d_in[12]; p.kv_norm_g = (const float*)d_in[13]; p.w_ukv = (const float*)d_in[14]; p.w_out = (const float*)d_in[15];
  p.out = (float*)d_out; p.ws = (unsigned char*)d_ws;
  for (int i = 0; i < 32; ++i) p.invfreq[i] = powf(10000.0f, -(float)(2 * i) / 64.0f);
  hipMemsetAsync((char*)d_ws + WS_BAR, 0, 16384, stream);
  p.ph_lo = 0; p.ph_hi = NPHASE;
  void* args[] = {&p};
  hipError_t e = hipLaunchCooperativeKernel((void*)mega, dim3(grid_blocks), dim3(NT), args, LDS_BYTES, stream);
  if (e != hipSuccess) fprintf(stderr, "cooperative launch failed: %s (grid %d)\n", hipGetErrorString(e), grid_blocks);

}
```

```cpp
#include <hip/hip_runtime.h>
#include <hip/hip_cooperative_groups.h>
#include <cstdio>
#include <cmath>
namespace cg = cooperative_groups;

#define DI __device__ __forceinline__
typedef unsigned short u16;
using bf16x8 = __attribute__((ext_vector_type(8))) short;
using f32x16 = __attribute__((ext_vector_type(16))) float;
using f32x4  = __attribute__((ext_vector_type(4))) float;
using f32x2  = __attribute__((ext_vector_type(2))) float;
using u32x4  = __attribute__((ext_vector_type(4))) unsigned;
using u32x2  = __attribute__((ext_vector_type(2))) unsigned;
typedef __bf16 bf2_t __attribute__((ext_vector_type(2)));
#define MFMA(a, b, c) __builtin_amdgcn_mfma_f32_32x32x16_bf16((a), (b), (c), 0, 0, 0)

#ifndef COOP
#define COOP 1
#endif
#ifndef DUP
#define DUP 7
#endif

constexpr int S = 16384, DM = 1024, DIN = 2496, ZLD = 2560, NT = 512, DEPTH = 2;
constexpr float EPS = 1e-6f;
constexpr float QSCALE = 0.07216878364870322f * 1.4426950408889634f;
constexpr int Z_U = 0, Z_V = 256, Z_SG = 512, Z_PI = 768, Z_PG = 1024, Z_CQ = 1280, Z_CKV = 1664, Z_KR = 1920, Z_MG = 1984;

constexpr size_t WS_HY   = 0;
constexpr size_t WS_Z    = WS_HY + (size_t)S * 1024 * 2;
constexpr size_t WS_Q    = WS_Z + (size_t)S * ZLD * 2;
constexpr size_t WS_K    = WS_Q + (size_t)4 * S * 192 * 2;
constexpr size_t WS_VT   = WS_K + (size_t)4 * S * 192 * 2;
constexpr size_t WS_WIN  = WS_VT + (size_t)4 * S * 128 * 2;
constexpr size_t WS_WUQ  = WS_WIN + (size_t)2 * 2560 * 1024 * 2;
constexpr size_t WS_WUKV = WS_WUQ + (size_t)2 * 768 * 384 * 2;
constexpr size_t WS_WOUT = WS_WUKV + (size_t)2 * 1024 * 256 * 2;
constexpr size_t WS_SGUW = WS_WOUT + (size_t)2 * 1024 * 1024 * 2;
constexpr size_t WS_PWT  = WS_SGUW + (size_t)2 * 4 * 128 * 128 * 2;
constexpr size_t WS_COS  = WS_PWT + (size_t)2 * 4 * 64 * 64 * 2;
constexpr size_t WS_SIN  = WS_COS + (size_t)S * 32 * 4;
constexpr size_t WS_BAR  = WS_SIN + (size_t)S * 32 * 4;
constexpr size_t WS_PART = WS_BAR + 16384;
constexpr size_t PART_BYTES = 8 * 64 * 64 * 4 + 2 * 8 * 64 * 4;
constexpr size_t WS_END  = WS_PART + 256 * PART_BYTES;

constexpr int GEMM_STAGE = 512 * 144;
constexpr int RS_OFF = 2 * GEMM_STAGE;
constexpr int XB_LDS_OFF = RS_OFF + 1024;
constexpr int LDS_BYTES = XB_LDS_OFF + 16;
constexpr int ATT_STAGE = 64 * 400 + 128 * 144;

struct P {
  const float* x; const int* pos; const float* pre_g; const float* post_g; const float* w_in; const float* sgu_w; const float* sgu_b;
  const float* sgu_ln_g; const float* sgu_ln_b; const float* pool_w; const float* pool_scale; const float* q_norm_g; const float* w_uq;
  const float* kv_norm_g; const float* w_ukv; const float* w_out;
  float* out; unsigned char* ws;
  float invfreq[32];
  int ph_lo, ph_hi;
};

DI int otid() { int t = threadIdx.x; asm volatile("" : "+v"(t)); return t; }
DI int wave_of(int tid) { return __builtin_amdgcn_readfirstlane(tid >> 6); }
DI void lds_barrier() { asm volatile("s_waitcnt lgkmcnt(0)" ::: "memory"); __builtin_amdgcn_s_barrier(); asm volatile("" ::: "memory"); }
DI unsigned pack2(float a, float b) { f32x2 v = {a, b}; return __builtin_bit_cast(unsigned, __builtin_convertvector(v, bf2_t)); }
DI u16 tobf(float a) { return (u16)(pack2(a, 0.f) & 0xffffu); }
DI float bflo(unsigned u) { return __uint_as_float(u << 16); }
DI float bfhi(unsigned u) { return __uint_as_float(u & 0xffff0000u); }
DI float silu(float x) { return x / (1.f + __expf(-x)); }
DI float ex2(float x) { return __builtin_amdgcn_exp2f(x); }
DI f32x16 zero16() { f32x16 z; for (int i = 0; i < 16; ++i) z[i] = 0.f; return z; }

DI int lane_now() { int l; asm volatile("v_mbcnt_lo_u32_b32 %0, -1, 0\n\tv_mbcnt_hi_u32_b32 %0, -1, %0" : "=v"(l)); return l; }
DI int tid_of(int wv) { return wv * 64 + lane_now(); }
DI float shx(float v, int mask) { return __int_as_float(__builtin_amdgcn_ds_bpermute((lane_now() ^ mask) << 2, __float_as_int(v))); }
#define XB_TMO      128
#define XB_XCNT(j)  (256  + 64 * (j))
#define XB_XSUB(j)  (1280 + 64 * (j))
#define XB_XGEN(j)  (2304 + 64 * (j))
#define XB_TOP      3328
#define XB_TOPGEN   3392
#define XCD_BAR_WORDS 3456
#define XB_SPIN_CAP (1u << 18)
#define LAS __attribute__((address_space(3)))

__device__ __forceinline__ unsigned xb_ld(unsigned* p)              { return __hip_atomic_load(p, __ATOMIC_RELAXED, __HIP_MEMORY_SCOPE_AGENT); }
__device__ __forceinline__ unsigned xb_add(unsigned* p, unsigned v) { return __hip_atomic_fetch_add(p, v, __ATOMIC_RELAXED, __HIP_MEMORY_SCOPE_AGENT); }
__device__ __forceinline__ unsigned xb_xcc_id() { return (unsigned)__builtin_amdgcn_s_getreg((3 << 11) | 20) & 0xFu; }
#define XB_SPIN(cond, bar) do { unsigned _sp = 0; while (cond) { __builtin_amdgcn_s_sleep(1); \
    if ((++_sp & 255u) == 0u) { if (xb_ld(&(bar)[XB_TMO])) break; if (_sp > XB_SPIN_CAP) { atomicAdd(&(bar)[XB_TMO], 1u); break; } } } } while (0)

struct XcdBarrier {
    unsigned* bar; unsigned x; int wv;
    volatile LAS unsigned* st;
};

__device__ __forceinline__ XcdBarrier xcd_barrier_post(unsigned* bar, volatile LAS unsigned* st) {
    XcdBarrier b; b.bar = bar; b.x = xb_xcc_id(); b.st = st;
    if (threadIdx.x == 0) (void)xb_add(&bar[XB_XCNT(b.x)], 1u);
    return b;
}
__device__ __forceinline__ void xcd_barrier_complete(unsigned* bar, unsigned x, unsigned& nloc, unsigned& nx) {
    const unsigned G = gridDim.x * gridDim.y * gridDim.z;
    unsigned sum, cnt, mine, sp = 0u;
    for (;;) {
        sum = 0u; cnt = 0u; mine = 0u;
#pragma unroll
        for (unsigned j = 0; j < 16; ++j) { const unsigned c = xb_ld(&bar[XB_XCNT(j)]); sum += c; cnt += (c > 0u) ? 1u : 0u; mine = (j == x) ? c : mine; }
        if (sum == G) break;
        __builtin_amdgcn_s_sleep(1);
        if ((++sp & 255u) == 0u) { if (xb_ld(&bar[XB_TMO])) break; if (sp > XB_SPIN_CAP) { atomicAdd(&bar[XB_TMO], 1u); break; } }
    }
    nloc = mine > 0u ? mine : 1u; nx = cnt > 0u ? cnt : 1u;
}

__device__ __forceinline__ void xcd_barrier(const XcdBarrier& b) {
    asm volatile("s_waitcnt vmcnt(0)" ::: "memory");
    __syncthreads();
    if (b.wv == 0 && lane_now() == 0) {
        unsigned* bar = b.bar;
        __builtin_amdgcn_s_waitcnt(0);
        unsigned nloc = b.st[0], nx = b.st[1];
        if (nloc == 0u) { xcd_barrier_complete(bar, b.x, nloc, nx); b.st[0] = nloc; b.st[1] = nx; }
        const unsigned old = xb_add(&bar[XB_XSUB(b.x)], 1u);
        const unsigned gen = old / nloc;
        if (old + 1u == (gen + 1u) * nloc) {
            __builtin_amdgcn_fence(__ATOMIC_RELEASE, "agent");
            asm volatile("s_waitcnt vmcnt(0)" ::: "memory");
            const unsigned og = xb_add(&bar[XB_TOP], 1u);
            const unsigned tg = og / nx;
            if (og + 1u == (tg + 1u) * nx) xb_add(&bar[XB_TOPGEN], 1u);
            else XB_SPIN(xb_ld(&bar[XB_TOPGEN]) == tg, bar);
            __builtin_amdgcn_fence(__ATOMIC_ACQUIRE, "agent");
            xb_add(&bar[XB_XGEN(b.x)], 1u);
            asm volatile("s_waitcnt vmcnt(0)" ::: "memory");
        } else {
            XB_SPIN(xb_ld(&bar[XB_XGEN(b.x)]) == gen, bar);
            __builtin_amdgcn_fence(__ATOMIC_ACQUIRE, "agent");
            asm volatile("s_waitcnt vmcnt(0)" ::: "memory");
        }
    }
    __syncthreads();
}


namespace pg8 {
#define PG8_LAS __attribute__((address_space(3)))
typedef unsigned short bf16_t;
typedef short bf16x8 __attribute__((ext_vector_type(8)));
typedef float f32x4 __attribute__((ext_vector_type(4)));
typedef unsigned u32x4 __attribute__((ext_vector_type(4)));
constexpr int BM = 256, BK = 64, HALF = 128, HTB = HALF * BK * 2  , STAGE_BYTES = 8 * HTB, NXCD = 8, WGM = 8;

__host__ __device__ __forceinline__ int lds_byte(int r, int c) { const int st = (r >> 4) * 2 + (c >> 5), rr = r & 15, cc = c & 31, ob = rr * 64 + cc * 2; return st * 1024 + (ob ^ (((ob >> 9) & 1) << 5)); }
__host__ __device__ __forceinline__ void stage_rc(int b, int& R, int& C) { const int st = b / 1024, sb = b % 1024, swz = sb ^ (((sb >> 9) & 1) << 5); R = (st >> 1) * 16 + swz / 64; C = (st & 1) * 32 + (swz % 64) / 2; }
__host__ __device__ __forceinline__ int perm32(int rho) { const int n = rho >> 4, i = rho & 15; return 8 * (i >> 2) + 4 * n + (i & 3); }

struct Unit { int pm, pn; };
struct Gemm { const bf16_t* A; const bf16_t* Bt; int M, N, K, lda; };

struct StaticOrder {
    int nM, nN, nwg, G, c;
    __host__ __device__ __forceinline__ void init(int M, int N, int G_, int c_) { nM = M / BM; nN = N / BM; nwg = nM * nN; G = G_; c = c_; }
    __host__ __device__ __forceinline__ bool next(int i, Unit& u) const {
        const long L = (long)i * G + c; if (L >= nwg) return false;
        int wgid = (int)L; { const int q = nwg / NXCD, r = nwg % NXCD, xcd = wgid % NXCD, off = wgid / NXCD; wgid = (xcd < r ? xcd * (q + 1) : r * (q + 1) + (xcd - r) * q) + off; }
        const int nig = WGM * nN, gid = wgid / nig, fm = gid * WGM, gsz = (nM - fm) < WGM ? (nM - fm) : WGM;
        u.pm = fm + ((wgid % nig) % gsz); u.pn = (wgid % nig) / gsz; return true;
    }
    __device__ __forceinline__ void a_ready(const Unit&) const {}
    __device__ __forceinline__ void done(const Unit&) const {}
};
__device__ __forceinline__ unsigned cvt_pk_bf16(float lo, float hi) { unsigned r; asm volatile("v_cvt_pk_bf16_f32 %0, %1, %2" : "=v"(r) : "v"(lo), "v"(hi)); return r; }
typedef float f32x2 __attribute__((ext_vector_type(2)));
__device__ __forceinline__ f32x2 gelu_pk(f32x2 v) {
    const f32x2 av = __builtin_elementwise_abs(v), d = av * 0.2316418882f + 1.0f;
    f32x2 t; t.x = __builtin_amdgcn_rcpf(d.x); t.y = __builtin_amdgcn_rcpf(d.y);
    f32x2 q = t * 0.5307027145f + (-0.7265760135f); q = q * t + 0.7107068705f; q = q * t + (-0.142248368f); q = q * t + 0.127414796f; q = q * t;
    const f32x2 s = (v * v) * (-0.72134752044f);
    f32x2 e; e.x = __builtin_amdgcn_exp2f(s.x); e.y = __builtin_amdgcn_exp2f(s.y);
    const f32x2 m = v * (q * e), r = v - m;
    f32x2 o; o.x = v.x < 0.f ? m.x : r.x; o.y = v.y < 0.f ? m.y : r.y; return o;
}

template <int ACT  > struct EpiBf16 {
    static constexpr bool PERM = true, AFTER_DRAIN = false;
    bf16_t* O; int ldc; const float* bias; int split_cols; size_t split_stride;
    __device__ __forceinline__ void operator()(const f32x4 (&acc)[2][2][4][2], const Unit& u, int wr, int wc, int fr, int fq) const {
        const int row0 = u.pm * BM + wr * 64 + fr; int colt = u.pn * BM; bf16_t* base = O;
        if (split_cols) { const int t = colt / split_cols; base += (size_t)t * split_stride; colt -= t * split_cols; }
        const int col0 = colt + wc * 32 + 8 * fq, bcol0 = u.pn * BM + wc * 32 + 8 * fq;
        f32x4 bv[2][2];
#pragma unroll
        for (int bj = 0; bj < 2; ++bj)
#pragma unroll
            for (int n = 0; n < 2; ++n) bv[bj][n] = bias ? *(const f32x4*)(bias + bcol0 + bj * HALF + 4 * n) : (f32x4){0.f, 0.f, 0.f, 0.f};
#pragma unroll
        for (int ai = 0; ai < 2; ++ai)
#pragma unroll
            for (int m = 0; m < 4; ++m) { bf16_t* rowp = base + (size_t)(row0 + ai * HALF + m * 16) * ldc + col0;
#pragma unroll
                for (int bj = 0; bj < 2; ++bj) { f32x4 v0 = acc[ai][bj][m][0] + bv[bj][0], v1 = acc[ai][bj][m][1] + bv[bj][1];
                    if (ACT == 1) { f32x2 a = gelu_pk((f32x2){v0[0], v0[1]}), b = gelu_pk((f32x2){v0[2], v0[3]}), c = gelu_pk((f32x2){v1[0], v1[1]}), d = gelu_pk((f32x2){v1[2], v1[3]});
                        v0 = (f32x4){a.x, a.y, b.x, b.y}; v1 = (f32x4){c.x, c.y, d.x, d.y}; }
                    if (ACT == 2) {
#pragma unroll
                        for (int j = 0; j < 4; ++j) { v0[j] = 0.5f * v0[j] * (1.0f + erff(v0[j] * 0.70710678f)); v1[j] = 0.5f * v1[j] * (1.0f + erff(v1[j] * 0.70710678f)); } }
                    u32x4 w; w.x = cvt_pk_bf16(v0[0], v0[1]); w.y = cvt_pk_bf16(v0[2], v0[3]); w.z = cvt_pk_bf16(v1[0], v1[1]); w.w = cvt_pk_bf16(v1[2], v1[3]);
                    *(u32x4*)(rowp + bj * HALF) = w; } }
    }
};

template <class Epi, class Sched, bool STAMP = false>
__device__ __forceinline__ void gemm_phase(PG8_LAS unsigned char* lds, const Gemm g, const Sched& S, const Epi& E, unsigned long long* stamps, int wv) {
    const int tid = tid_of(wv), wid = __builtin_amdgcn_readfirstlane(tid >> 6), lane = tid & 63, wr = wid >> 2, wc = wid & 3, fr = lane & 15, fq = lane >> 4;
    const int K = g.K, nt = K / BK;
    int ts_lo = 0, ts_hi = 0, nts = 0; const unsigned long long rt_entry = STAMP ? (unsigned long long)wall_clock64() : 0ull;
#define PG8_STAMP() do { if (STAMP && wid == 0 && nts < 64) { const unsigned long long _c = (unsigned long long)clock64(); \
        ts_lo = (lane == nts) ? (int)(unsigned)_c : ts_lo; ts_hi = (lane == nts) ? (int)(unsigned)(_c >> 32) : ts_hi; ++nts; } } while (0)
    PG8_STAMP();
    unsigned voffA[2], voffB[2];
#pragma unroll
    for (int i = 0; i < 2; ++i) { int R, C; stage_rc(tid * 16 + i * 8192, R, C); const int Rb = Epi::PERM ? ((R & ~31) + perm32(R & 31)) : R;
        voffA[i] = (unsigned)(R * g.lda + C) * 2u; voffB[i] = (unsigned)(Rb * K + C) * 2u; }
    const size_t kstep = (size_t)(BK * 2);
    const size_t hstep = (size_t)HALF * K * 2;
    const size_t tstep = 2 * hstep;
    const size_t hstepA = (size_t)HALF * g.lda * 2, tstepA = 2 * hstepA;
    const unsigned ldsw = (unsigned)wid * 1024u;
    const int aoff = lds_byte(wr * 64 + fr, fq * 8), boff = lds_byte(wc * 32 + fr, fq * 8);
#define PG8_SA(b, h) (((b) * 2 + (h)) * HTB)
#define PG8_SB(b, h) ((4 + (b) * 2 + (h)) * HTB)
#define PG8_STAGE(bufoff, gbase, voff) do { _Pragma("unroll") for (int _i = 0; _i < 2; ++_i) \
        __builtin_amdgcn_global_load_lds((const unsigned*)((const char*)(gbase) + (voff)[_i]), (PG8_LAS unsigned*)(lds + (bufoff) + ldsw + _i * 8192), 16, 0, 0); } while (0)
#define PG8_LDA(dst, b, h) do { _Pragma("unroll") for (int m = 0; m < 4; ++m) _Pragma("unroll") for (int k = 0; k < 2; ++k) dst[m][k] = *(const PG8_LAS bf16x8*)(lds + PG8_SA(b, h) + aoff + m * 2048 + k * 1024); } while (0)
#define PG8_LDB(dst, b, h) do { _Pragma("unroll") for (int n = 0; n < 2; ++n) _Pragma("unroll") for (int k = 0; k < 2; ++k) dst[n][k] = *(const PG8_LAS bf16x8*)(lds + PG8_SB(b, h) + boff + n * 2048 + k * 1024); } while (0)
#define PG8_MMA(ai, bj, At, Bt) do { __builtin_amdgcn_s_setprio(1); _Pragma("unroll") for (int m = 0; m < 4; ++m) _Pragma("unroll") for (int n = 0; n < 2; ++n) _Pragma("unroll") for (int k = 0; k < 2; ++k) \
        acc[ai][bj][m][n] = __builtin_amdgcn_mfma_f32_16x16x32_bf16(Bt[n][k], At[m][k], acc[ai][bj][m][n], 0, 0, 0); __builtin_amdgcn_s_setprio(0); } while (0)
#define PG8_WAIT_V(n) asm volatile("s_waitcnt vmcnt(" #n ")" ::: "memory")
#define PG8_WAIT_L(n) asm volatile("s_waitcnt lgkmcnt(" #n ")" ::: "memory")
#define PG8_BAR __builtin_amdgcn_s_barrier()
#define PG8_SCHED __builtin_amdgcn_sched_barrier(0)
    Unit cur, nxt; int ui = 0;
    if (!S.next(0, cur)) return;
    f32x4 acc[2][2][4][2];
#pragma unroll
    for (int a = 0; a < 2; ++a)
#pragma unroll
        for (int b = 0; b < 2; ++b)
#pragma unroll
            for (int m = 0; m < 4; ++m)
#pragma unroll
                for (int n = 0; n < 2; ++n) acc[a][b][m][n] = (f32x4){0.f, 0.f, 0.f, 0.f};
    bf16x8 At[4][2], B0[2][2], B1[2][2];
    const char* cA = (const char*)g.A + (size_t)cur.pm * tstepA; const char* cB = (const char*)g.Bt + (size_t)cur.pn * tstep;
    S.a_ready(cur);
    PG8_STAGE(PG8_SB(0, 0), cB, voffB); PG8_STAGE(PG8_SA(0, 0), cA, voffA); PG8_STAGE(PG8_SB(0, 1), cB + hstep, voffB); PG8_STAGE(PG8_SA(0, 1), cA + hstepA, voffA);
    if (wr == 1) PG8_BAR;
    PG8_WAIT_V(4); PG8_BAR;
    PG8_STAGE(PG8_SB(1, 0), cB + kstep, voffB); PG8_STAGE(PG8_SA(1, 0), cA + kstep, voffA); PG8_STAGE(PG8_SB(1, 1), cB + hstep + kstep, voffB);
    PG8_WAIT_V(6); PG8_BAR;
    PG8_STAMP();
    for (;;) {
        const bool has_next = S.next(ui + 1, nxt);
        const char* nA = has_next ? (const char*)g.A + (size_t)nxt.pm * tstepA : cA; const char* nB = has_next ? (const char*)g.Bt + (size_t)nxt.pn * tstep : cB;
        for (int t = 0; t < nt; t += 2) {
            const bool last = (t == nt - 2);
            const char* a1 = cA + (size_t)(t + 1) * kstep;
            const char* a2 = last ? nA : cA + (size_t)(t + 2) * kstep; const char* b2 = last ? nB : cB + (size_t)(t + 2) * kstep;
            const char* a3 = a2 + kstep; const char* b3 = b2 + kstep;
            if (last && has_next) S.a_ready(nxt);
            PG8_LDB(B0, 0, 0); PG8_SCHED; PG8_LDA(At, 0, 0); PG8_STAGE(PG8_SA(1, 1), a1 + hstepA, voffA);
            PG8_WAIT_L(8); PG8_BAR; PG8_WAIT_L(0); PG8_MMA(0, 0, At, B0); PG8_BAR; PG8_SCHED;
            PG8_LDB(B1, 0, 1); PG8_STAGE(PG8_SB(0, 0), b2, voffB);
            PG8_BAR; PG8_WAIT_L(0); PG8_MMA(0, 1, At, B1); PG8_BAR;
            PG8_LDA(At, 0, 1); PG8_STAGE(PG8_SA(0, 0), a2, voffA);
            PG8_BAR; PG8_WAIT_L(0); PG8_MMA(1, 0, At, B0); PG8_BAR; PG8_SCHED;
            PG8_STAGE(PG8_SB(0, 1), b2 + hstep, voffB);
            PG8_WAIT_V(6); PG8_BAR; PG8_MMA(1, 1, At, B1); PG8_BAR;
            PG8_LDB(B0, 1, 0); PG8_SCHED; PG8_LDA(At, 1, 0); PG8_STAGE(PG8_SA(0, 1), a2 + hstepA, voffA);
            PG8_WAIT_L(8); PG8_BAR; PG8_WAIT_L(0); PG8_MMA(0, 0, At, B0); PG8_BAR; PG8_SCHED;
            PG8_LDB(B1, 1, 1); PG8_STAGE(PG8_SB(1, 0), b3, voffB);
            PG8_BAR; PG8_WAIT_L(0); PG8_MMA(0, 1, At, B1); PG8_BAR;
            PG8_LDA(At, 1, 1); PG8_STAGE(PG8_SA(1, 0), a3, voffA);
            PG8_BAR; PG8_WAIT_L(0); PG8_MMA(1, 0, At, B0); PG8_BAR; PG8_SCHED;
            PG8_STAGE(PG8_SB(1, 1), b3 + hstep, voffB);
            PG8_WAIT_V(6); PG8_BAR; PG8_MMA(1, 1, At, B1); PG8_BAR;
        }
        PG8_STAMP();
        if constexpr (!Epi::AFTER_DRAIN) { E(acc, cur, wr, wc, fr, fq); S.done(cur); }
        PG8_STAMP();
        if (!has_next) break;
#pragma unroll
        for (int a = 0; a < 2; ++a)
#pragma unroll
            for (int b = 0; b < 2; ++b)
#pragma unroll
                for (int m = 0; m < 4; ++m)
#pragma unroll
                    for (int n = 0; n < 2; ++n) acc[a][b][m][n] = (f32x4){0.f, 0.f, 0.f, 0.f};
        cur = nxt; cA = nA; cB = nB; ++ui;
    }
    PG8_WAIT_V(0);
    if (wr == 0) PG8_BAR;
    PG8_BAR;
    if constexpr (Epi::AFTER_DRAIN) { E.fused(acc, cur, wr, wc, fr, fq, lds, wid, lane); S.done(cur); }
    PG8_STAMP();
    if (STAMP && wid == 0) { stamps[lane] = lane < nts ? (((unsigned long long)(unsigned)ts_hi << 32) | (unsigned)ts_lo) : 0ull;
        if (lane == 62) stamps[62] = rt_entry; if (lane == 63) stamps[63] = (unsigned long long)wall_clock64(); }
#undef PG8_STAMP
#undef PG8_SA
#undef PG8_SB
#undef PG8_STAGE
#undef PG8_LDA
#undef PG8_LDB
#undef PG8_MMA
#undef PG8_WAIT_V
#undef PG8_WAIT_L
#undef PG8_BAR
#undef PG8_SCHED
}
}
template <int NTW, class Epi>
DI void gemm_tile(unsigned char* lds, const u16* __restrict__ A, const u16* __restrict__ X, int ldx, int K, int m0, int n0, Epi& epi) {
  const int tid = otid(), lane = tid & 63, wave = wave_of(tid);
  const int wm = wave & 3, wn = wave >> 2, l32 = lane & 31, h = lane >> 5;
  f32x16 acc[2][NTW];
#pragma unroll
  for (int i = 0; i < 2; ++i)
#pragma unroll
    for (int j = 0; j < NTW; ++j) acc[i][j] = zero16();
  const int nk = K >> 6;
  const int lrow = tid >> 3, lcol = tid & 7;
  const u16* ga = A + (size_t)lrow * K + lcol * 8;
  const u16* gx = X + (size_t)lrow * ldx + lcol * 8;
  u32x4 ra[4], rb[NTW];
#pragma unroll
  for (int i = 0; i < 4; ++i) ra[i] = *(const u32x4*)(ga + (size_t)i * 64 * K);
#pragma unroll
  for (int i = 0; i < NTW; ++i) rb[i] = *(const u32x4*)(gx + (size_t)i * 64 * ldx);
  {
    unsigned char* as = lds; unsigned char* bs = lds + 256 * 144;
#pragma unroll
    for (int i = 0; i < 4; ++i) *(u32x4*)(as + (lrow + i * 64) * 144 + lcol * 16) = ra[i];
#pragma unroll
    for (int i = 0; i < NTW; ++i) *(u32x4*)(bs + (lrow + i * 64) * 144 + lcol * 16) = rb[i];
  }
  __syncthreads();
#pragma unroll 1
  for (int ks = 0; ks < nk; ++ks) {
    const bool more = ks + 1 < nk;
    if (more) {
#pragma unroll
      for (int i = 0; i < 4; ++i) ra[i] = *(const u32x4*)(ga + (size_t)i * 64 * K + (ks + 1) * 64);
#pragma unroll
      for (int i = 0; i < NTW; ++i) rb[i] = *(const u32x4*)(gx + (size_t)i * 64 * ldx + (ks + 1) * 64);
    }
    const unsigned char* as = lds + (ks & 1) * GEMM_STAGE + (wm * 64 + l32) * 144 + h * 16;
    const unsigned char* bs = lds + (ks & 1) * GEMM_STAGE + 256 * 144 + (wn * NTW * 32 + l32) * 144 + h * 16;
#pragma unroll
    for (int kk = 0; kk < 4; ++kk) {
      bf16x8 a0 = *(const bf16x8*)(as + kk * 32), a1 = *(const bf16x8*)(as + 32 * 144 + kk * 32);
      bf16x8 b[NTW];
#pragma unroll
      for (int j = 0; j < NTW; ++j) b[j] = *(const bf16x8*)(bs + j * 32 * 144 + kk * 32);
#pragma unroll
      for (int j = 0; j < NTW; ++j) { acc[0][j] = MFMA(a0, b[j], acc[0][j]); acc[1][j] = MFMA(a1, b[j], acc[1][j]); }
    }
    if (more) {
      unsigned char* as2 = lds + ((ks + 1) & 1) * GEMM_STAGE; unsigned char* bs2 = as2 + 256 * 144;
#pragma unroll
      for (int i = 0; i < 4; ++i) *(u32x4*)(as2 + (lrow + i * 64) * 144 + lcol * 16) = ra[i];
#pragma unroll
      for (int i = 0; i < NTW; ++i) *(u32x4*)(bs2 + (lrow + i * 64) * 144 + lcol * 16) = rb[i];
    }
    __syncthreads();
  }
  epi(acc, m0 + wm * 64, n0 + wn * NTW * 32, l32, h);
}

struct EpiZ {
  u16* z;
  template <int NTW> DI void operator()(f32x16 (&acc)[2][NTW], int chb, int tokb, int l32, int h) {
#pragma unroll
    for (int nt = 0; nt < NTW; ++nt) { const int t = tokb + nt * 32 + l32;
#pragma unroll
      for (int mt = 0; mt < 2; ++mt)
#pragma unroll
        for (int q = 0; q < 4; ++q) {
          u32x2 v = {pack2(acc[mt][nt][q * 4], acc[mt][nt][q * 4 + 1]), pack2(acc[mt][nt][q * 4 + 2], acc[mt][nt][q * 4 + 3])};
          *(u32x2*)(z + (size_t)t * ZLD + chb + mt * 32 + q * 8 + h * 4) = v;
        }
    }
  }
};
struct EpiOut {
  u16* y;
  template <int NTW> DI void operator()(f32x16 (&acc)[2][NTW], int chb, int tokb, int l32, int h) {
#pragma unroll
    for (int nt = 0; nt < NTW; ++nt) { const int t = tokb + nt * 32 + l32;
#pragma unroll
      for (int mt = 0; mt < 2; ++mt)
#pragma unroll
        for (int q = 0; q < 4; ++q) {
          u32x2 v = {pack2(acc[mt][nt][q * 4], acc[mt][nt][q * 4 + 1]), pack2(acc[mt][nt][q * 4 + 2], acc[mt][nt][q * 4 + 3])};
          *(u32x2*)(y + (size_t)t * DM + chb + mt * 32 + q * 8 + h * 4) = v;
        }
    }
  }
};
struct EpiQ {
  u16* Q; const float* cosT; const float* sinT; const float* rs; int n0;
  template <int NTW> DI void operator()(f32x16 (&acc)[2][NTW], int chb, int tokb, int l32, int h) {
    const int seg = chb >> 6, head = seg / 3, part = seg - head * 3;
#pragma unroll
    for (int nt = 0; nt < NTW; ++nt) {
      const int t = tokb + nt * 32 + l32; const float r = rs[tokb - n0 + nt * 32 + l32] * QSCALE;
      u16* dst = Q + ((size_t)head * S + t) * 192;
      if (part < 2) {
#pragma unroll
        for (int mt = 0; mt < 2; ++mt)
#pragma unroll
          for (int q = 0; q < 4; ++q) {
            u32x2 v = {pack2(acc[mt][nt][q * 4] * r, acc[mt][nt][q * 4 + 1] * r), pack2(acc[mt][nt][q * 4 + 2] * r, acc[mt][nt][q * 4 + 3] * r)};
            *(u32x2*)(dst + part * 64 + mt * 32 + q * 8 + h * 4) = v;
          }
      } else {
#pragma unroll
        for (int q = 0; q < 4; ++q) {
          const int d = q * 8 + h * 4;
          const f32x4 c = *(const f32x4*)(cosT + (size_t)t * 32 + d), s = *(const f32x4*)(sinT + (size_t)t * 32 + d);
          float o1[4], o2[4];
#pragma unroll
          for (int j = 0; j < 4; ++j) { const float x1 = acc[0][nt][q * 4 + j], x2 = acc[1][nt][q * 4 + j]; o1[j] = (x1 * c[j] - x2 * s[j]) * r; o2[j] = (x2 * c[j] + x1 * s[j]) * r; }
          u32x2 v1 = {pack2(o1[0], o1[1]), pack2(o1[2], o1[3])}, v2 = {pack2(o2[0], o2[1]), pack2(o2[2], o2[3])};
          *(u32x2*)(dst + 128 + d) = v1; *(u32x2*)(dst + 160 + d) = v2;
        }
      }
    }
  }
};
DI int permpos(int k64) { const int kk = k64 & 15; return (k64 & 48) | (((kk >> 2) & 1) * 8 + (kk >> 3) * 4 + (kk & 3)); }
struct EpiKV {
  u16* K; u16* Vt; const float* rs; int n0;
  template <int NTW> DI void operator()(f32x16 (&acc)[2][NTW], int chb, int tokb, int l32, int h) {
    const int seg = chb >> 6, head = seg >> 2, part = seg & 3;
#pragma unroll
    for (int nt = 0; nt < NTW; ++nt) {
      const int t = tokb + nt * 32 + l32; const float r = rs[tokb - n0 + nt * 32 + l32];
      if (part < 2) {
        u16* dst = K + ((size_t)head * S + t) * 192 + part * 64;
#pragma unroll
        for (int mt = 0; mt < 2; ++mt)
#pragma unroll
          for (int q = 0; q < 4; ++q) {
            u32x2 v = {pack2(acc[mt][nt][q * 4] * r, acc[mt][nt][q * 4 + 1] * r), pack2(acc[mt][nt][q * 4 + 2] * r, acc[mt][nt][q * 4 + 3] * r)};
            *(u32x2*)(dst + mt * 32 + q * 8 + h * 4) = v;
          }
      } else {
        u16* dst = Vt + (((size_t)head * (S / 64) + (t >> 6)) * 128 + (part - 2) * 64) * 64 + permpos(t & 63);
#pragma unroll
        for (int mt = 0; mt < 2; ++mt)
#pragma unroll
          for (int i = 0; i < 16; ++i) { const int dv = mt * 32 + (i & 3) + 8 * (i >> 2) + 4 * h; dst[dv * 64] = tobf(acc[mt][nt][i] * r); }
      }
    }
  }
};

struct EpiQ2 {
  static constexpr bool PERM = true, AFTER_DRAIN = false;
  u16* Q; const PG8_LAS float* rs;
  DI void operator()(const pg8::f32x4 (&acc)[2][2][4][2], const pg8::Unit& u, int wr, int wc, int fr, int fq) const {
    asm volatile("" : "+v"(fr), "+v"(fq));
    int cb[2];
#pragma unroll
    for (int bj = 0; bj < 2; ++bj) { const int c0 = u.pn * 256 + bj * 128 + wc * 32 + 8 * fq, head = c0 / 192; cb[bj] = head * (S * 192) + (c0 - head * 192); }
    const int rl0 = wr * 64 + fr; u16* q0 = Q + (size_t)(u.pm * 256 + rl0) * 192; const PG8_LAS float* rs0 = rs + rl0;
#pragma unroll
    for (int ai = 0; ai < 2; ++ai)
#pragma unroll
      for (int m = 0; m < 4; ++m) { const float sc = rs0[ai * 128 + m * 16] * QSCALE; u16* qr = q0 + (ai * 128 + m * 16) * 192;
#pragma unroll
        for (int bj = 0; bj < 2; ++bj) { const pg8::f32x4 v0 = acc[ai][bj][m][0] * sc, v1 = acc[ai][bj][m][1] * sc;
          u32x4 w = {pack2(v0[0], v0[1]), pack2(v0[2], v0[3]), pack2(v1[0], v1[1]), pack2(v1[2], v1[3])};
          *(u32x4*)(qr + cb[bj]) = w; }
        asm volatile("" ::: "memory"); }
  }
};
struct EpiKV2 {
  static constexpr bool PERM = true, AFTER_DRAIN = false;
  u16* K; u16* Vt; const PG8_LAS float* rs;
  DI void operator()(const pg8::f32x4 (&acc)[2][2][4][2], const pg8::Unit& u, int wr, int wc, int fr, int fq) const {
    asm volatile("" : "+v"(fr), "+v"(fq));
    const int head = u.pn, d0 = wc * 32 + 8 * fq, rl0 = wr * 64 + fr;
    u16* k0 = K + ((size_t)head * S + u.pm * 256 + rl0) * 192 + d0; const PG8_LAS float* rs0 = rs + rl0;
    u16* v0p = Vt + (((size_t)head * (S / 64) + u.pm * 4 + wr) * 128 + d0) * 64 + permpos(fr);
#pragma unroll
    for (int ai = 0; ai < 2; ++ai)
#pragma unroll
      for (int m = 0; m < 4; ++m) { const float sc = rs0[ai * 128 + m * 16];
        { const pg8::f32x4 v0 = acc[ai][0][m][0] * sc, v1 = acc[ai][0][m][1] * sc;
          u32x4 w = {pack2(v0[0], v0[1]), pack2(v0[2], v0[3]), pack2(v1[0], v1[1]), pack2(v1[2], v1[3])};
          *(u32x4*)(k0 + (ai * 128 + m * 16) * 192) = w; }
        { const pg8::f32x4 v0 = acc[ai][1][m][0] * sc, v1 = acc[ai][1][m][1] * sc;
          u16* dst = v0p + ai * (2 * 128 * 64) + m * 16;
#pragma unroll
          for (int j = 0; j < 4; ++j) { dst[j * 64] = tobf(v0[j]); dst[(4 + j) * 64] = tobf(v1[j]); } }
        asm volatile("" ::: "memory"); }
  }
};
DI void row_rstd256(float* rs, const u16* X, int ldx, int K, int wv) {
  const int tid = tid_of(wv), tl = tid >> 1, sub = tid & 1;
  const u16* src = X + (size_t)tl * ldx; float ss = 0.f;
  for (int c = sub; c < (K >> 3); c += 2) {
    u32x4 v = *(const u32x4*)(src + c * 8);
#pragma unroll
    for (int j = 0; j < 4; ++j) { const float a = bflo(v[j]), b = bfhi(v[j]); ss += a * a + b * b; }
  }
  ss += shx(ss, 1);
  if (sub == 0) rs[tl] = rsqrtf(ss / (float)K + EPS);
}
DI void row_rstd(float* rs, const u16* X, int ldx, int K) {
  const int tid = otid(), tl = tid >> 2, sub = tid & 3;
  const u16* src = X + (size_t)tl * ldx; float ss = 0.f;
  for (int c = sub; c < (K >> 3); c += 4) {
    u32x4 v = *(const u32x4*)(src + c * 8);
#pragma unroll
    for (int j = 0; j < 4; ++j) { const float a = bflo(v[j]), b = bfhi(v[j]); ss += a * a + b * b; }
  }
  ss += shx(ss, 1); ss += shx(ss, 2);
  if (sub == 0) rs[tl] = rsqrtf(ss / (float)K + EPS);
}

DI void krope_tile(const P& p, int n0) {
  const int tid = tid_of(p.ph_lo), t = n0 + (tid >> 2), i0 = (tid & 3) * 8;
  const u16* z = (const u16*)(p.ws + WS_Z) + (size_t)t * ZLD + Z_KR;
  const float* cosT = (const float*)(p.ws + WS_COS) + (size_t)t * 32 + i0; const float* sinT = (const float*)(p.ws + WS_SIN) + (size_t)t * 32 + i0;
  u32x4 a = *(const u32x4*)(z + i0), b = *(const u32x4*)(z + 32 + i0);
  f32x4 c0 = *(const f32x4*)cosT, c1 = *(const f32x4*)(cosT + 4), s0 = *(const f32x4*)sinT, s1 = *(const f32x4*)(sinT + 4);
  float x1[8], x2[8], c[8], s[8];
#pragma unroll
  for (int j = 0; j < 4; ++j) { x1[2 * j] = bflo(a[j]); x1[2 * j + 1] = bfhi(a[j]); x2[2 * j] = bflo(b[j]); x2[2 * j + 1] = bfhi(b[j]); c[j] = c0[j]; c[4 + j] = c1[j]; s[j] = s0[j]; s[4 + j] = s1[j]; }
  u32x4 o1, o2;
#pragma unroll
  for (int j = 0; j < 4; ++j) {
    o1[j] = pack2(x1[2 * j] * c[2 * j] - x2[2 * j] * s[2 * j], x1[2 * j + 1] * c[2 * j + 1] - x2[2 * j + 1] * s[2 * j + 1]);
    o2[j] = pack2(x2[2 * j] * c[2 * j] + x1[2 * j] * s[2 * j], x2[2 * j + 1] * c[2 * j + 1] + x1[2 * j + 1] * s[2 * j + 1]);
  }
  u16* K = (u16*)(p.ws + WS_K);
#pragma unroll
  for (int hd = 0; hd < 4; ++hd) { u16* dst = K + ((size_t)hd * S + t) * 192 + 128 + i0; *(u32x4*)dst = o1; *(u32x4*)(dst + 32) = o2; }
}

DI void sgu_job(unsigned char* lds, const P& p, int layer, int nb) {
  const int tid = tid_of(p.ph_lo), lane = tid & 63, wave = wave_of(tid);
  const int n0 = nb * 128;
  const u16* z = (const u16*)(p.ws + WS_Z);
  u16* vT = (u16*)lds;
  {
    const int j = tid >> 2, sub = tid & 3; const u16* src = z + (size_t)(n0 + j) * ZLD + Z_V + sub * 64;
    float v[64]; float s = 0.f;
#pragma unroll
    for (int c = 0; c < 8; ++c) { u32x4 u = *(const u32x4*)(src + c * 8);
#pragma unroll
      for (int k = 0; k < 4; ++k) { v[c * 8 + 2 * k] = bflo(u[k]); v[c * 8 + 2 * k + 1] = bfhi(u[k]); s += v[c * 8 + 2 * k] + v[c * 8 + 2 * k + 1]; } }
    s += shx(s, 1); s += shx(s, 2);
    const float mu = s * (1.f / 256.f); float q = 0.f;
#pragma unroll
    for (int c = 0; c < 64; ++c) { const float d = v[c] - mu; q += d * d; }
    q += shx(q, 1); q += shx(q, 2);
    const float rstd = rsqrtf(q * (1.f / 256.f) + EPS);
    const float* g = p.sgu_ln_g + layer * 256 + sub * 64; const float* b = p.sgu_ln_b + layer * 256 + sub * 64;
#pragma unroll
    for (int c4 = 0; c4 < 16; ++c4) { const f32x4 gg = *(const f32x4*)(g + c4 * 4), bb = *(const f32x4*)(b + c4 * 4);
#pragma unroll
      for (int k = 0; k < 4; ++k) vT[(sub * 64 + c4 * 4 + k) * 136 + j] = tobf((v[c4 * 4 + k] - mu) * rstd * gg[k] + bb[k]); }
  }
  __syncthreads();
  const int wm = wave & 3, wn = wave >> 2, l32 = lane & 31, h = lane >> 5;
  f32x16 acc[2][2]; acc[0][0] = zero16(); acc[0][1] = zero16(); acc[1][0] = zero16(); acc[1][1] = zero16();
  const u16* W = (const u16*)(p.ws + WS_SGUW) + (size_t)(layer * 4 + wm) * 128 * 128;
#pragma unroll
  for (int kk = 0; kk < 8; ++kk) {
    bf16x8 a0 = *(const bf16x8*)(vT + (wm * 64 + l32) * 136 + kk * 16 + h * 8);
    bf16x8 a1 = *(const bf16x8*)(vT + (wm * 64 + 32 + l32) * 136 + kk * 16 + h * 8);
    bf16x8 b0 = *(const bf16x8*)(W + (wn * 64 + l32) * 128 + kk * 16 + h * 8);
    bf16x8 b1 = *(const bf16x8*)(W + (wn * 64 + 32 + l32) * 128 + kk * 16 + h * 8);
    acc[0][0] = MFMA(a0, b0, acc[0][0]); acc[0][1] = MFMA(a0, b1, acc[0][1]);
    acc[1][0] = MFMA(a1, b0, acc[1][0]); acc[1][1] = MFMA(a1, b1, acc[1][1]);
  }
  u16* Y = (u16*)(p.ws + WS_HY);
#pragma unroll
  for (int nt = 0; nt < 2; ++nt) {
    const int i = wn * 64 + nt * 32 + l32, t = n0 + i; const float bias = p.sgu_b[(layer * 4 + wm) * 128 + i];
#pragma unroll
    for (int mt = 0; mt < 2; ++mt)
#pragma unroll
      for (int q = 0; q < 4; ++q) {
        const int c = wm * 64 + mt * 32 + q * 8 + h * 4;
        const u32x2 u = *(const u32x2*)(z + (size_t)t * ZLD + Z_U + c), g = *(const u32x2*)(z + (size_t)t * ZLD + Z_SG + c);
        const float o0 = bflo(u[0]) * (acc[mt][nt][q * 4] + bias) * silu(bflo(g[0])), o1 = bfhi(u[0]) * (acc[mt][nt][q * 4 + 1] + bias) * silu(bfhi(g[0]));
        const float o2 = bflo(u[1]) * (acc[mt][nt][q * 4 + 2] + bias) * silu(bflo(g[1])), o3 = bfhi(u[1]) * (acc[mt][nt][q * 4 + 3] + bias) * silu(bfhi(g[1]));
        u32x2 v = {pack2(o0, o1), pack2(o2, o3)};
        *(u32x2*)(Y + (size_t)t * DM + c) = v;
      }
  }
}

template <int W>
DI void pool_win(const u16* zp, int t0, u16* prow) {
  unsigned v[32 + W];
#pragma unroll
  for (int i = 0; i < 32 + W; ++i) { const int t = t0 - W + i; v[i] = (t >= 0) ? *(const unsigned*)(zp + (size_t)max(t, 0) * ZLD) : 0u; }
  float s0 = 0.f, s1 = 0.f;
#pragma unroll
  for (int i = 0; i < W; ++i) { s0 += bflo(v[i]); s1 += bfhi(v[i]); }
#pragma unroll
  for (int tt = 0; tt < 32; ++tt) {
    const float p0 = bflo(v[W + tt]), p1 = bfhi(v[W + tt]);
    s0 += p0 - bflo(v[tt]); s1 += p1 - bfhi(v[tt]);
    const float inv = 1.f / (float)min(t0 + tt + 1, W);
    *(unsigned*)(prow + tt * 264) = pack2(s0 * inv - p0, s1 * inv - p1);
  }
}
DI void pool_job(unsigned char* lds, const P& p, int layer, int nb) {
  const int tid = tid_of(p.ph_lo), lane = tid & 63, wave = wave_of(tid);
  const int n0 = nb * 128;
  const u16* z = (const u16*)(p.ws + WS_Z);
  u16* pl = (u16*)lds;
  {
    const int g = wave & 3, c = g * 64 + (lane & 31) * 2, tq = (wave >> 2) * 2 + (lane >> 5);
    const u16* zp = z + Z_PI + c; const int t0 = n0 + tq * 32; u16* prow = pl + (tq * 32) * 264 + c;
    switch (g) { case 0: pool_win<2>(zp, t0, prow); break; case 1: pool_win<4>(zp, t0, prow); break; case 2: pool_win<8>(zp, t0, prow); break; default: pool_win<16>(zp, t0, prow); break; }
  }
  __syncthreads();
  const int wm = wave & 3, wn = wave >> 2, l32 = lane & 31, h = lane >> 5;
  f32x16 acc[2][2]; acc[0][0] = zero16(); acc[0][1] = zero16(); acc[1][0] = zero16(); acc[1][1] = zero16();
  const u16* W = (const u16*)(p.ws + WS_PWT) + (size_t)(layer * 4 + wm) * 64 * 64;
#pragma unroll
  for (int kk = 0; kk < 4; ++kk) {
    bf16x8 a0 = *(const bf16x8*)(W + (l32) * 64 + kk * 16 + h * 8);
    bf16x8 a1 = *(const bf16x8*)(W + (32 + l32) * 64 + kk * 16 + h * 8);
    bf16x8 b0 = *(const bf16x8*)(pl + (wn * 64 + l32) * 264 + wm * 64 + kk * 16 + h * 8);
    bf16x8 b1 = *(const bf16x8*)(pl + (wn * 64 + 32 + l32) * 264 + wm * 64 + kk * 16 + h * 8);
    acc[0][0] = MFMA(a0, b0, acc[0][0]); acc[0][1] = MFMA(a0, b1, acc[0][1]);
    acc[1][0] = MFMA(a1, b0, acc[1][0]); acc[1][1] = MFMA(a1, b1, acc[1][1]);
  }
  u16* Y = (u16*)(p.ws + WS_HY);
#pragma unroll
  for (int nt = 0; nt < 2; ++nt) {
    const int t = n0 + wn * 64 + nt * 32 + l32;
#pragma unroll
    for (int mt = 0; mt < 2; ++mt)
#pragma unroll
      for (int q = 0; q < 4; ++q) {
        const int c = wm * 64 + mt * 32 + q * 8 + h * 4;
        const f32x4 sc = *(const f32x4*)(p.pool_scale + layer * 256 + c);
        const u32x2 g = *(const u32x2*)(z + (size_t)t * ZLD + Z_PG + c);
        const float o0 = acc[mt][nt][q * 4] * sc[0] * silu(bflo(g[0])), o1 = acc[mt][nt][q * 4 + 1] * sc[1] * silu(bfhi(g[0]));
        const float o2 = acc[mt][nt][q * 4 + 2] * sc[2] * silu(bflo(g[1])), o3 = acc[mt][nt][q * 4 + 3] * sc[3] * silu(bfhi(g[1]));
        u32x2 v = {pack2(o0, o1), pack2(o2, o3)};
        *(u32x2*)(Y + (size_t)t * DM + 256 + c) = v;
      }
  }
}

DI void att2_qk(f32x16& s0, f32x16& s1, const unsigned char* krow, const bf16x8 (&qf)[12], float m) {
  const float nm = -m;
#pragma unroll
  for (int i = 0; i < 16; ++i) { s0[i] = nm; s1[i] = nm; }
  bf16x8 ka[4], kb[4];
#define ATT2_LDK(F, B_) do { F[0] = *(const bf16x8*)(krow + (2 * (B_)) * 32); F[1] = *(const bf16x8*)(krow + 32 * 400 + (2 * (B_)) * 32); \
                             F[2] = *(const bf16x8*)(krow + (2 * (B_) + 1) * 32); F[3] = *(const bf16x8*)(krow + 32 * 400 + (2 * (B_) + 1) * 32); } while (0)
#define ATT2_MMK(F, B_) do { s0 = MFMA(F[0], qf[2 * (B_)], s0); s1 = MFMA(F[1], qf[2 * (B_)], s1); s0 = MFMA(F[2], qf[2 * (B_) + 1], s0); s1 = MFMA(F[3], qf[2 * (B_) + 1], s1); } while (0)
  ATT2_LDK(ka, 0); ATT2_LDK(kb, 1); __builtin_amdgcn_sched_barrier(0);
  ATT2_MMK(ka, 0); __builtin_amdgcn_sched_barrier(0); ATT2_LDK(ka, 2); __builtin_amdgcn_sched_barrier(0);
  ATT2_MMK(kb, 1); __builtin_amdgcn_sched_barrier(0); ATT2_LDK(kb, 3); __builtin_amdgcn_sched_barrier(0);
  ATT2_MMK(ka, 2); __builtin_amdgcn_sched_barrier(0); ATT2_LDK(ka, 4); __builtin_amdgcn_sched_barrier(0);
  ATT2_MMK(kb, 3); __builtin_amdgcn_sched_barrier(0); ATT2_LDK(kb, 5); __builtin_amdgcn_sched_barrier(0);
  ATT2_MMK(ka, 4); __builtin_amdgcn_sched_barrier(0);
  ATT2_MMK(kb, 5); __builtin_amdgcn_sched_barrier(0);
#undef ATT2_LDK
#undef ATT2_MMK
}
DI void att2_sm_pv(f32x16& s0, f32x16& s1, const unsigned char* vrow, f32x16 (&O)[4], float& m, float& l, bool first) {
  bf16x8 vf[8];
#pragma unroll
  for (int mt = 0; mt < 4; ++mt) { vf[2 * mt] = *(const bf16x8*)(vrow + mt * 32 * 144); vf[2 * mt + 1] = *(const bf16x8*)(vrow + mt * 32 * 144 + 32); }
  __builtin_amdgcn_sched_barrier(0);
  float mx = fmaxf(fmaxf(s0[0], s1[0]), fmaxf(s0[1], s1[1]));
#pragma unroll
  for (int i = 2; i < 16; ++i) mx = fmaxf(fmaxf(mx, s0[i]), s1[i]);
  if (first || __builtin_amdgcn_ballot_w64(mx > 8.f) != 0) {
    const float mxx = fmaxf(mx, shx(mx, 32));
    const float d = first ? mxx : fmaxf(mxx, 0.f);
    const float alpha = first ? 1.f : ex2(-d);
    m += d; l *= alpha;
#pragma unroll
    for (int i = 0; i < 16; ++i) { s0[i] -= d; s1[i] -= d; }
#pragma unroll
    for (int mt = 0; mt < 4; ++mt)
#pragma unroll
      for (int i = 0; i < 16; ++i) O[mt][i] *= alpha;
  }
  float ps0 = 0.f, ps1 = 0.f;
#pragma unroll
  for (int i = 0; i < 16; ++i) { s0[i] = ex2(s0[i]); s1[i] = ex2(s1[i]); ps0 += s0[i]; ps1 += s1[i]; }
  l += ps0 + ps1;
  u32x4 p0 = {pack2(s0[0], s0[1]), pack2(s0[2], s0[3]), pack2(s0[4], s0[5]), pack2(s0[6], s0[7])};
  u32x4 p1 = {pack2(s0[8], s0[9]), pack2(s0[10], s0[11]), pack2(s0[12], s0[13]), pack2(s0[14], s0[15])};
  u32x4 p2 = {pack2(s1[0], s1[1]), pack2(s1[2], s1[3]), pack2(s1[4], s1[5]), pack2(s1[6], s1[7])};
  u32x4 p3 = {pack2(s1[8], s1[9]), pack2(s1[10], s1[11]), pack2(s1[12], s1[13]), pack2(s1[14], s1[15])};
  const bf16x8 pf0 = __builtin_bit_cast(bf16x8, p0), pf1 = __builtin_bit_cast(bf16x8, p1), pf2 = __builtin_bit_cast(bf16x8, p2), pf3 = __builtin_bit_cast(bf16x8, p3);
#pragma unroll
  for (int mt = 0; mt < 4; ++mt) { O[mt] = MFMA(vf[2 * mt], pf0, O[mt]); O[mt] = MFMA(vf[2 * mt + 1], pf1, O[mt]); }
  __builtin_amdgcn_sched_barrier(0);
#pragma unroll
  for (int mt = 0; mt < 4; ++mt) { vf[2 * mt] = *(const bf16x8*)(vrow + mt * 32 * 144 + 64); vf[2 * mt + 1] = *(const bf16x8*)(vrow + mt * 32 * 144 + 96); }
  __builtin_amdgcn_sched_barrier(0);
#pragma unroll
  for (int mt = 0; mt < 4; ++mt) { O[mt] = MFMA(vf[2 * mt], pf2, O[mt]); O[mt] = MFMA(vf[2 * mt + 1], pf3, O[mt]); }
}
DI void attn2_item(unsigned char* lds, const P& p, int hd, int QB, int t0, int t1, unsigned char* part) {
  const int tid = tid_of(p.ph_lo), lane = tid & 63, wave = wave_of(tid);
  const int l32 = lane & 31, h = lane >> 5;
  const int trow = QB * 256 + wave * 32 + l32;
  const u16* Qg = (const u16*)(p.ws + WS_Q) + ((size_t)hd * S + trow) * 192 + h * 8;
  bf16x8 qf[12];
#pragma unroll
  for (int ks = 0; ks < 12; ++ks) qf[ks] = *(const bf16x8*)(Qg + ks * 16);
  {
    const float* ct = (const float*)(p.ws + WS_COS) + (size_t)trow * 32 + h * 8; const float* st = (const float*)(p.ws + WS_SIN) + (size_t)trow * 32 + h * 8;
#pragma unroll
    for (int pr = 0; pr < 2; ++pr) {
      const f32x4 c0 = *(const f32x4*)(ct + pr * 16), c1 = *(const f32x4*)(ct + pr * 16 + 4), s0 = *(const f32x4*)(st + pr * 16), s1 = *(const f32x4*)(st + pr * 16 + 4);
      const u32x4 xa = __builtin_bit_cast(u32x4, qf[8 + pr]), xb = __builtin_bit_cast(u32x4, qf[10 + pr]);
      u32x4 oa, ob;
#pragma unroll
      for (int j = 0; j < 4; ++j) {
        const float cl = (j < 2) ? c0[2 * j] : c1[2 * j - 4], ch = (j < 2) ? c0[2 * j + 1] : c1[2 * j - 3], sl = (j < 2) ? s0[2 * j] : s1[2 * j - 4], sh = (j < 2) ? s0[2 * j + 1] : s1[2 * j - 3];
        const float a0 = bflo(xa[j]), a1 = bfhi(xa[j]), b0 = bflo(xb[j]), b1 = bfhi(xb[j]);
        oa[j] = pack2(a0 * cl - b0 * sl, a1 * ch - b1 * sh); ob[j] = pack2(b0 * cl + a0 * sl, b1 * ch + a1 * sh);
      }
      qf[8 + pr] = __builtin_bit_cast(bf16x8, oa); qf[10 + pr] = __builtin_bit_cast(bf16x8, ob);
    }
  }
  const int mychunk = 4 * QB + (wave >> 1);
  const u16* Kg = (const u16*)(p.ws + WS_K) + (size_t)hd * S * 192 + tid * 8;
  const u16* Vg = (const u16*)(p.ws + WS_VT) + (size_t)hd * S * 128 + tid * 8;
  int kdst[3], vdst[2];
#pragma unroll
  for (int i = 0; i < 3; ++i) { const int c = tid + i * NT; kdst[i] = (c / 24) * 400 + (c % 24) * 16; }
#pragma unroll
  for (int i = 0; i < 2; ++i) { const int c = tid + i * NT; vdst[i] = 64 * 400 + (c >> 3) * 144 + (c & 7) * 16; }
  const int koff = l32 * 400 + h * 16;
  const int voff = 64 * 400 + l32 * 144 + h * 16;
  f32x16 O[4]; O[0] = zero16(); O[1] = zero16(); O[2] = zero16(); O[3] = zero16();
  float m = 0.f, l = 0.f;
  u32x4 rk[3], rv[2];
#pragma unroll
  for (int i = 0; i < 3; ++i) rk[i] = *(const u32x4*)(Kg + (size_t)t0 * 64 * 192 + i * NT * 8);
#pragma unroll
  for (int i = 0; i < 2; ++i) rv[i] = *(const u32x4*)(Vg + (size_t)t0 * 128 * 64 + i * NT * 8);
#pragma unroll
  for (int i = 0; i < 3; ++i) *(u32x4*)(lds + kdst[i]) = rk[i];
#pragma unroll
  for (int i = 0; i < 2; ++i) *(u32x4*)(lds + vdst[i]) = rv[i];
  __syncthreads();
#pragma unroll 1
  for (int kt = t0; kt < t1; ++kt) {
    const int stg = ((kt - t0) & 1) * ATT_STAGE, nxt = min(kt + 1, t1 - 1);
#pragma unroll
    for (int i = 0; i < 3; ++i) rk[i] = *(const u32x4*)(Kg + (size_t)nxt * 64 * 192 + i * NT * 8);
#pragma unroll
    for (int i = 0; i < 2; ++i) rv[i] = *(const u32x4*)(Vg + (size_t)nxt * 128 * 64 + i * NT * 8);
    if (kt <= mychunk) { f32x16 s0, s1; att2_qk(s0, s1, lds + stg + koff, qf, m); att2_sm_pv(s0, s1, lds + stg + voff, O, m, l, kt == t0); }
    {
      unsigned char* st = lds + (ATT_STAGE - stg);
#pragma unroll
      for (int i = 0; i < 3; ++i) *(u32x4*)(st + kdst[i]) = rk[i];
#pragma unroll
      for (int i = 0; i < 2; ++i) *(u32x4*)(st + vdst[i]) = rv[i];
    }
    lds_barrier();
  }
  const float lt = l + shx(l, 32);
  if (part) {
    float* po = (float*)part; float* pm = (float*)(part + 8 * 64 * 64 * 4);
#pragma unroll
    for (int mt = 0; mt < 4; ++mt)
#pragma unroll
      for (int i = 0; i < 16; ++i) po[((wave * 64) + mt * 16 + i) * 64 + lane] = O[mt][i];
    pm[wave * 64 + lane] = m; pm[512 + wave * 64 + lane] = lt;
  } else {
    const float inv = 1.f / lt;
    const u16* zg = (const u16*)(p.ws + WS_Z) + (size_t)trow * ZLD + Z_MG + hd * 128;
    u16* Y = (u16*)(p.ws + WS_HY) + (size_t)trow * DM + 512 + hd * 128;
#pragma unroll
    for (int mt = 0; mt < 4; ++mt)
#pragma unroll
      for (int q = 0; q < 4; ++q) {
        const int dv = mt * 32 + q * 8 + h * 4;
        const u32x2 g = *(const u32x2*)(zg + dv);
        float o[4];
#pragma unroll
        for (int j = 0; j < 4; ++j) o[j] = O[mt][q * 4 + j] * inv;
        u32x2 v = {pack2(o[0] * silu(bflo(g[0])), o[1] * silu(bfhi(g[0]))), pack2(o[2] * silu(bflo(g[1])), o[3] * silu(bfhi(g[1])))};
        *(u32x2*)(Y + dv) = v;
      }
  }
  __syncthreads();
}
DI void attn2_combine(const P& p, int vid) {
  const int tid = tid_of(p.ph_lo), lane = tid & 63, wave = wave_of(tid), l32 = lane & 31, h = lane >> 5;
  const int hd = (vid & 7) >> 1, role = vid & 1, QL = 63 - (vid >> 3), sw = 4 * role + (wave & 3), mt0 = 2 * (wave >> 2);
  const unsigned char* pa = p.ws + WS_PART + (size_t)(vid & ~1) * PART_BYTES; const unsigned char* pb = pa + PART_BYTES;
  const float* oa = (const float*)pa; const float* ob = (const float*)pb; const float* ma = (const float*)(pa + 8 * 64 * 64 * 4); const float* mb = (const float*)(pb + 8 * 64 * 64 * 4);
  const float m0 = ma[sw * 64 + lane], l0 = ma[512 + sw * 64 + lane], m1 = mb[sw * 64 + lane], l1 = mb[512 + sw * 64 + lane];
  const float mm = fmaxf(m0, m1); float a0 = ex2(m0 - mm), a1 = ex2(m1 - mm);
  const float inv = 1.f / (l0 * a0 + l1 * a1); a0 *= inv; a1 *= inv;
  const int trow = QL * 256 + sw * 32 + l32;
  const u16* zg = (const u16*)(p.ws + WS_Z) + (size_t)trow * ZLD + Z_MG + hd * 128;
  u16* Y = (u16*)(p.ws + WS_HY) + (size_t)trow * DM + 512 + hd * 128;
#pragma unroll
  for (int mi = 0; mi < 2; ++mi)
#pragma unroll
    for (int q = 0; q < 4; ++q) {
      const int mt = mt0 + mi, dv = mt * 32 + q * 8 + h * 4;
      const u32x2 g = *(const u32x2*)(zg + dv);
      float o[4];
#pragma unroll
      for (int j = 0; j < 4; ++j) { const int idx = ((sw * 64) + mt * 16 + q * 4 + j) * 64 + lane; o[j] = oa[idx] * a0 + ob[idx] * a1; }
      u32x2 v = {pack2(o[0] * silu(bflo(g[0])), o[1] * silu(bfhi(g[0]))), pack2(o[2] * silu(bflo(g[1])), o[3] * silu(bfhi(g[1])))};
      *(u32x2*)(Y + dv) = v;
    }
}

DI void transpose_tile(unsigned char* lds, const float* __restrict__ src, int ldsrc, u16* __restrict__ dst, int ldd, int k0, int n0, int nvalid, const float* gain) {
  float* tile = (float*)lds;
  const int tid = otid();
#pragma unroll
  for (int i = 0; i < 8; ++i) { const int idx = tid + i * NT, r = idx >> 6, cc = idx & 63, n = n0 + cc;
    float v = (n < nvalid) ? src[(size_t)(k0 + r) * ldsrc + n] : 0.f; if (gain) v *= gain[k0 + r]; tile[r * 65 + cc] = v; }
  __syncthreads();
#pragma unroll
  for (int i = 0; i < 8; ++i) { const int idx = tid + i * NT, r = idx >> 6, cc = idx & 63; dst[(size_t)(n0 + r) * ldd + k0 + cc] = tobf(tile[cc * 65 + r]); }
  __syncthreads();
}
DI float wave_sum(float v) { v += shx(v, 32); v += shx(v, 16); v += shx(v, 8); v += shx(v, 4); v += shx(v, 2); v += shx(v, 1); return v; }
DI void prenorm_row(const f32x4 (&v)[4], const float* g, u16* hrow, int lane) {
  float ss = 0.f;
#pragma unroll
  for (int i = 0; i < 4; ++i) ss += v[i][0] * v[i][0] + v[i][1] * v[i][1] + v[i][2] * v[i][2] + v[i][3] * v[i][3];
  ss = wave_sum(ss);
  const float r = rsqrtf(ss * (1.f / 1024.f) + EPS);
#pragma unroll
  for (int i = 0; i < 4; ++i) { const f32x4 gg = *(const f32x4*)(g + (lane + 64 * i) * 4);
    u32x2 o = {pack2(v[i][0] * r * gg[0], v[i][1] * r * gg[1]), pack2(v[i][2] * r * gg[2], v[i][3] * r * gg[3])};
    *(u32x2*)(hrow + (lane + 64 * i) * 4) = o; }
}

DI void phase_prep(unsigned char* lds, const P& p) {
  const int nb = gridDim.x, bid = blockIdx.x, tid = otid();
  u16* win = (u16*)(p.ws + WS_WIN); u16* wuq = (u16*)(p.ws + WS_WUQ); u16* wukv = (u16*)(p.ws + WS_WUKV); u16* wout = (u16*)(p.ws + WS_WOUT);
  for (int job = bid; job < 2 * 1032; job += nb) {
    const int layer = job / 1032; int r = job - layer * 1032;
    if (r < 640) { const int kt = r / 40, nt = r - kt * 40; transpose_tile(lds, p.w_in + (size_t)layer * 1024 * DIN, DIN, win + (size_t)layer * 2560 * 1024, 1024, kt * 64, nt * 64, DIN, nullptr); }
    else if (r < 712) { r -= 640; const int kt = r / 12, nt = r - kt * 12; transpose_tile(lds, p.w_uq + (size_t)layer * 384 * 768, 768, wuq + (size_t)layer * 768 * 384, 384, kt * 64, nt * 64, 768, p.q_norm_g + layer * 384); }
    else if (r < 776) { r -= 712; const int kt = r / 16, nt = r - kt * 16; transpose_tile(lds, p.w_ukv + (size_t)layer * 256 * 1024, 1024, wukv + (size_t)layer * 1024 * 256, 256, kt * 64, nt * 64, 1024, p.kv_norm_g + layer * 256); }
    else { r -= 776; const int kt = r / 16, nt = r - kt * 16; transpose_tile(lds, p.w_out + (size_t)layer * 1024 * 1024, 1024, wout + (size_t)layer * 1024 * 1024, 1024, kt * 64, nt * 64, 1024, nullptr); }
  }
  const int gtid = bid * NT + tid, gn = nb * NT;
  u16* sguw = (u16*)(p.ws + WS_SGUW);
  for (int idx = gtid; idx < 2 * 4 * 128 * 128; idx += gn) { const int i = (idx >> 7) & 127, j = idx & 127; sguw[idx] = ((j >> 6) <= (i >> 6)) ? tobf(p.sgu_w[idx]) : (u16)0; }
  u16* pwt = (u16*)(p.ws + WS_PWT);
  for (int idx = gtid; idx < 2 * 4 * 64 * 64; idx += gn) { const int lg = idx >> 12, d = (idx >> 6) & 63, c = idx & 63; pwt[idx] = tobf(p.pool_w[(lg * 64 + c) * 64 + d]); }
  float* cosT = (float*)(p.ws + WS_COS); float* sinT = (float*)(p.ws + WS_SIN);
  for (int idx = gtid; idx < S * 32; idx += gn) {
    const int t = idx >> 5, i = idx & 31; const float angf = (float)p.pos[t] * p.invfreq[i];
    const double a = (double)angf; const double k = rint(a * 0.15915494309189535); const double r = a - k * 6.283185307179586; const double r2 = r * r;
    double ts = r, ss = r, tc = 1.0, sc = 1.0;
#pragma unroll
    for (int n = 1; n <= 13; ++n) { ts *= -r2 * (1.0 / (double)((2 * n) * (2 * n + 1))); ss += ts; tc *= -r2 * (1.0 / (double)((2 * n - 1) * (2 * n))); sc += tc; }
    cosT[idx] = (float)sc; sinT[idx] = (float)ss;
  }
  u16* hb = (u16*)(p.ws + WS_HY);
  const int lane = tid & 63, wave = wave_of(tid);
  for (int row = bid * 8 + wave; row < S; row += nb * 16) {
    const int row2 = row + nb * 8; const bool has2 = row2 < S;
    f32x4 v[4], v2[4];
#pragma unroll
    for (int i = 0; i < 4; ++i) v[i] = *(const f32x4*)(p.x + (size_t)row * DM + (lane + 64 * i) * 4);
    if (has2) {
#pragma unroll
      for (int i = 0; i < 4; ++i) v2[i] = *(const f32x4*)(p.x + (size_t)row2 * DM + (lane + 64 * i) * 4);
    }
    prenorm_row(v, p.pre_g, hb + (size_t)row * DM, lane);
    if (has2) prenorm_row(v2, p.pre_g, hb + (size_t)row2 * DM, lane);
  }
}

DI void post_load(const u16* yout, const float* xold, int row, int lane, f32x4 (&y)[4], f32x4 (&xo)[4]) {
#pragma unroll
  for (int i = 0; i < 4; ++i) { const u32x2 yb = *(const u32x2*)(yout + (size_t)row * DM + (lane + 64 * i) * 4); y[i] = (f32x4){bflo(yb[0]), bfhi(yb[0]), bflo(yb[1]), bfhi(yb[1])};
    xo[i] = *(const f32x4*)(xold + (size_t)row * DM + (lane + 64 * i) * 4); }
}
DI void post_finish(const P& p, int layer, int row, int lane, f32x4 (&y)[4], const f32x4 (&xo)[4], u16* hb) {
  float ss = 0.f;
#pragma unroll
  for (int i = 0; i < 4; ++i) ss += y[i][0] * y[i][0] + y[i][1] * y[i][1] + y[i][2] * y[i][2] + y[i][3] * y[i][3];
  ss = wave_sum(ss);
  const float r = rsqrtf(ss * (1.f / 1024.f) + EPS);
#pragma unroll
  for (int i = 0; i < 4; ++i) {
    const f32x4 g = *(const f32x4*)(p.post_g + layer * DM + (lane + 64 * i) * 4);
    y[i] = xo[i] + y[i] * r * g;
    *(f32x4*)(p.out + (size_t)row * DM + (lane + 64 * i) * 4) = y[i];
  }
  if (layer + 1 < DEPTH) prenorm_row(y, p.pre_g + (layer + 1) * DM, hb + (size_t)row * DM, lane);
}
DI void phase_post(const P& p, int layer) {
  const int nb = gridDim.x, bid = blockIdx.x, tid = tid_of(p.ph_lo), lane = tid & 63, wave = wave_of(tid);
  const u16* yout = (const u16*)(p.ws + WS_Z); const float* xold = layer == 0 ? p.x : p.out;
  u16* hb = (u16*)(p.ws + WS_HY);
  for (int row = bid * 8 + wave; row < S; row += nb * 16) {
    const int row2 = row + nb * 8; const bool has2 = row2 < S;
    f32x4 y0[4], x0[4], y1[4], x1[4];
    post_load(yout, xold, row, lane, y0, x0);
    if (has2) post_load(yout, xold, row2, lane, y1, x1);
    post_finish(p, layer, row, lane, y0, x0, hb);
    if (has2) post_finish(p, layer, row2, lane, y1, x1, hb);
  }
}

__global__ void __launch_bounds__(NT) mega(P p0) {
  const P& p = p0;
  extern __shared__ __attribute__((aligned(16))) unsigned char lds[];
  cg::grid_group grid = cg::this_grid();
  const int nb = gridDim.x, bid = blockIdx.x;
  const int wv0 = __builtin_amdgcn_readfirstlane((int)(threadIdx.x >> 6));
  if (threadIdx.x < 4) ((unsigned*)(lds + XB_LDS_OFF))[threadIdx.x] = 0u;
  __syncthreads();
  XcdBarrier xbar = xcd_barrier_post((unsigned*)(p.ws + WS_BAR), (volatile LAS unsigned*)(lds + XB_LDS_OFF)); xbar.wv = wv0;
  unsigned* xcnt = (unsigned*)(p.ws + WS_BAR + 14336);
  unsigned myslot = 0;
  if (threadIdx.x == 0) myslot = xb_add(&xcnt[16 * xbar.x], 1u);
  int vid = bid;
#define RUN(ph_) true
#define SEAM(ph_) do { if (p.ph_hi < 0) grid.sync(); else xcd_barrier(xbar); } while (0)
  if (RUN(ph)) phase_prep(lds, p);
  SEAM(0);
  {
    if (threadIdx.x == 0) { bool even = (nb & 7) == 0; for (int j = 0; j < 8; ++j) even = even && (xb_ld(&xcnt[16 * j]) == (unsigned)(nb >> 3));
      ((volatile LAS unsigned*)(lds + XB_LDS_OFF))[2] = even ? (myslot * 8u + xbar.x) : (unsigned)bid; }
    __syncthreads();
    vid = __builtin_amdgcn_readfirstlane((int)((volatile LAS unsigned*)(lds + XB_LDS_OFF))[2]);
  }
#pragma unroll 1
  for (int layer = 0; layer < DEPTH; ++layer) {
    P pl = p0; pl.ph_lo = wv0;
    u16* hy = (u16*)(pl.ws + WS_HY); u16* z = (u16*)(pl.ws + WS_Z);
    float* rs = (float*)(lds + RS_OFF);
    if (RUN(ph)) {
      const u16* W = (const u16*)(pl.ws + WS_WIN) + (size_t)layer * 2560 * 1024;
      { pg8::Gemm g{hy, W, S, 2560, 1024, 1024}; pg8::StaticOrder so; so.init(S, 2560, nb, vid);
        pg8::EpiBf16<0> E{z, ZLD, nullptr, 0, 0};
        pg8::gemm_phase<pg8::EpiBf16<0>, pg8::StaticOrder, false>((PG8_LAS unsigned char*)lds, g, so, E, nullptr, pl.ph_lo); }
    }
    SEAM(0);
    if (RUN(ph)) {
      const float* cosT = (const float*)(pl.ws + WS_COS); const float* sinT = (const float*)(pl.ws + WS_SIN);
      {
        pg8::StaticOrder so; pg8::Unit u;
        so.init(S, 768, nb, vid);
        if (so.next(0, u)) row_rstd256(rs, z + (size_t)u.pm * 256 * ZLD + Z_CQ, ZLD, 384, pl.ph_lo);
        __syncthreads();
        { pg8::Gemm g{z + Z_CQ, (const u16*)(pl.ws + WS_WUQ) + (size_t)layer * 768 * 384, S, 768, 384, ZLD}; EpiQ2 E{(u16*)(pl.ws + WS_Q), (const PG8_LAS float*)(lds + RS_OFF)};
          pg8::gemm_phase<EpiQ2, pg8::StaticOrder, false>((PG8_LAS unsigned char*)lds, g, so, E, nullptr, pl.ph_lo); }
        __syncthreads();
        so.init(S, 1024, nb, vid);
        if (so.next(0, u)) row_rstd256(rs, z + (size_t)u.pm * 256 * ZLD + Z_CKV, ZLD, 256, pl.ph_lo);
        __syncthreads();
        { pg8::Gemm g{z + Z_CKV, (const u16*)(pl.ws + WS_WUKV) + (size_t)layer * 1024 * 256, S, 1024, 256, ZLD}; EpiKV2 E{(u16*)(pl.ws + WS_K), (u16*)(pl.ws + WS_VT), (const PG8_LAS float*)(lds + RS_OFF)};
          pg8::gemm_phase<EpiKV2, pg8::StaticOrder, false>((PG8_LAS unsigned char*)lds, g, so, E, nullptr, pl.ph_lo); }
        if (vid < 128) krope_tile(pl, vid * 128);
        __syncthreads();
        if (vid < 128) sgu_job(lds, pl, layer, vid); else pool_job(lds, pl, layer, vid - 128);
      }
    }
    SEAM(0);
    if (RUN(ph)) {
      const int hd = (vid & 7) >> 1, role = vid & 1, B = vid >> 3, QL = 63 - B, ntL = 4 * QL + 4;
      unsigned char* part = pl.ws + WS_PART + (size_t)vid * PART_BYTES;
      if (role == 0) attn2_item(lds, pl, hd, QL, 0, 130, part);
      else { attn2_item(lds, pl, hd, QL, 130, ntL, part); attn2_item(lds, pl, hd, B, 0, 4 * B + 4, nullptr); }
    }
    SEAM(0);
    attn2_combine(pl, vid);
    SEAM(0);
    if (RUN(ph)) {
      const u16* W = (const u16*)(pl.ws + WS_WOUT) + (size_t)layer * 1024 * 1024;
      { pg8::Gemm g{hy, W, S, 1024, 1024, 1024}; pg8::StaticOrder so; so.init(S, 1024, nb, vid);
        pg8::EpiBf16<0> E{(u16*)(pl.ws + WS_Z), 1024, nullptr, 0, 0};
        pg8::gemm_phase<pg8::EpiBf16<0>, pg8::StaticOrder, false>((PG8_LAS unsigned char*)lds, g, so, E, nullptr, pl.ph_lo); }
    }
    SEAM(0);
    if (RUN(ph)) phase_post(pl, layer);
    SEAM(0);
  }
  xcd_barrier(xbar);
}
constexpr int NPHASE = 1 + 5 * DEPTH;

extern "C" void kernel_launch(void* const* d_in, const int* in_sizes, int n_in, void* d_out, int out_size, void* d_ws, size_t ws_size, hipStream_t stream) {
  static int grid_blocks = 0;
  if (!grid_blocks) {
    int dev = 0, cus = 0, per_cu = 0;
    hipGetDevice(&dev);
    hipDeviceGetAttribute(&cus, hipDeviceAttributeMultiprocessorCount, dev);
    hipFuncSetAttribute((const void*)mega, hipFuncAttributeMaxDynamicSharedMemorySize, LDS_BYTES);
    hipOccupancyMaxActiveBlocksPerMultiprocessor(&per_cu, (const void*)mega, NT, LDS_BYTES);
    if (per_cu < 1) { fprintf(stderr, "occupancy query returned %d\n", per_cu); per_cu = 1; }
    if (per_cu > 1) per_cu = 1;
    grid_blocks = 256;
    if (cus * per_cu < 256) fprintf(stderr, "device offers %d co-resident workgroups, 256 needed\n", cus * per_cu);
    if (ws_size < WS_END) fprintf(stderr, "workspace too small: %zu < %zu\n", ws_size, (size_t)WS_END);
  }
  P p{};
  p.x = (const float*)d_in[0]; p.pos = (const int*)d_in[1]; p.pre_g = (const float*)d_in[2]; p.post_g = (const float*)d_in[3];
  p.w_in = (const float*)d_in[4]; p.sgu_w = (const float*)d_in[5]; p.sgu_b = (const float*)d_in[6]; p.sgu_ln_g = (const float*)d_in[7];
  p.sgu_ln_b = (const float*)d_in[8]; p.pool_w = (const float*)d_in[9]; p.pool_scale = (const float*)d_in[10]; p.q_norm_g = (const float*)d_in[11];
  p.w_uq = (const float*)d_in[12]; p.kv_norm_g = (const float*)d_in[13]; p.w_ukv = (const float*)d_in[14]; p.w_out = (const float*)d_in[15];
  p.out = (float*)d_out; p.ws = (unsigned char*)d_ws;
  for (int i = 0; i < 32; ++i) p.invfreq[i] = powf(10000.0f, -(float)(2 * i) / 64.0f);
  hipMemsetAsync((char*)d_ws + WS_BAR, 0, 16384, stream);
  p.ph_lo = 0; p.ph_hi = NPHASE;
  void* args[] = {&p};
  hipError_t e = hipLaunchCooperativeKernel((void*)mega, dim3(grid_blocks), dim3(NT), args, LDS_BYTES, stream);
  if (e != hipSuccess) fprintf(stderr, "cooperative launch failed: %s (grid %d)\n", hipGetErrorString(e), grid_blocks);

}
```

```cpp
#include <hip/hip_runtime.h>
#include <hip/hip_cooperative_groups.h>
#include <cstdio>
#include <cmath>
namespace cg = cooperative_groups;

#define DI __device__ __forceinline__
typedef unsigned short u16;
using bf16x8 = __attribute__((ext_vector_type(8))) short;
using f32x16 = __attribute__((ext_vector_type(16))) float;
using f32x4  = __attribute__((ext_vector_type(4))) float;
using f32x2  = __attribute__((ext_vector_type(2))) float;
using u32x4  = __attribute__((ext_vector_type(4))) unsigned;
using u32x2  = __attribute__((ext_vector_type(2))) unsigned;
typedef __bf16 bf2_t __attribute__((ext_vector_type(2)));
#define MFMA(a, b, c) __builtin_amdgcn_mfma_f32_32x32x16_bf16((a), (b), (c), 0, 0, 0)

#ifndef COOP
#define COOP 1
#endif
#ifndef DUP
#define DUP 7
#endif

constexpr int S = 16384, DM = 1024, DIN = 2496, ZLD = 2560, NT = 512, DEPTH = 2;
constexpr float EPS = 1e-6f;
constexpr float QSCALE = 0.07216878364870322f * 1.4426950408889634f;
constexpr int Z_U = 0, Z_V = 256, Z_SG = 512, Z_PI = 768, Z_PG = 1024, Z_CQ = 1280, Z_CKV = 1664, Z_KR = 1920, Z_MG = 1984;

constexpr size_t WS_HY   = 0;
constexpr size_t WS_Z    = WS_HY + (size_t)S * 1024 * 2;
constexpr size_t WS_Q    = WS_Z + (size_t)S * ZLD * 2;
constexpr size_t WS_K    = WS_Q + (size_t)4 * S * 192 * 2;
constexpr size_t WS_VT   = WS_K + (size_t)4 * S * 192 * 2;
constexpr size_t WS_WIN  = WS_VT + (size_t)4 * S * 128 * 2;
constexpr size_t WS_WUQ  = WS_WIN + (size_t)2 * 2560 * 1024 * 2;
constexpr size_t WS_WUKV = WS_WUQ + (size_t)2 * 768 * 384 * 2;
constexpr size_t WS_WOUT = WS_WUKV + (size_t)2 * 1024 * 256 * 2;
constexpr size_t WS_SGUW = WS_WOUT + (size_t)2 * 1024 * 1024 * 2;
constexpr size_t WS_PWT  = WS_SGUW + (size_t)2 * 4 * 128 * 128 * 2;
constexpr size_t WS_COS  = WS_PWT + (size_t)2 * 4 * 64 * 64 * 2;
constexpr size_t WS_SIN  = WS_COS + (size_t)S * 32 * 4;
constexpr size_t WS_BAR  = WS_SIN + (size_t)S * 32 * 4;
constexpr size_t WS_PART = WS_BAR + 16384;
constexpr size_t PART_BYTES = 8 * 64 * 64 * 4 + 2 * 8 * 64 * 4;
constexpr size_t WS_END  = WS_PART + 256 * PART_BYTES;

constexpr int GEMM_STAGE = 512 * 144;
constexpr int RS_OFF = 2 * GEMM_STAGE;
constexpr int XB_LDS_OFF = RS_OFF + 1024;
constexpr int LDS_BYTES = XB_LDS_OFF + 16;
constexpr int ATT_STAGE = 64 * 400 + 128 * 144;

struct P {
  const float* x; const int* pos; const float* pre_g; const float* post_g; const float* w_in; const float* sgu_w; const float* sgu_b;
  const float* sgu_ln_g; const float* sgu_ln_b; const float* pool_w; const float* pool_scale; const float* q_norm_g; const float* w_uq;
  const float* kv_norm_g; const float* w_ukv; const float* w_out;
  float* out; unsigned char* ws;
  float invfreq[32];
  int ph_lo, ph_hi;
};

DI int otid() { int t = threadIdx.x; asm volatile("" : "+v"(t)); return t; }
DI int wave_of(int tid) { return __builtin_amdgcn_readfirstlane(tid >> 6); }
DI void lds_barrier() { asm volatile("s_waitcnt lgkmcnt(0)" ::: "memory"); __builtin_amdgcn_s_barrier(); asm volatile("" ::: "memory"); }
DI unsigned pack2(float a, float b) { f32x2 v = {a, b}; return __builtin_bit_cast(unsigned, __builtin_convertvector(v, bf2_t)); }
DI u16 tobf(float a) { return (u16)(pack2(a, 0.f) & 0xffffu); }
DI float bflo(unsigned u) { return __uint_as_float(u << 16); }
DI float bfhi(unsigned u) { return __uint_as_float(u & 0xffff0000u); }
DI float silu(float x) { return x / (1.f + __expf(-x)); }
DI float ex2(float x) { return __builtin_amdgcn_exp2f(x); }
DI f32x16 zero16() { f32x16 z; for (int i = 0; i < 16; ++i) z[i] = 0.f; return z; }

DI int lane_now() { int l; asm volatile("v_mbcnt_lo_u32_b32 %0, -1, 0\n\tv_mbcnt_hi_u32_b32 %0, -1, %0" : "=v"(l)); return l; }
DI int tid_of(int wv) { return wv * 64 + lane_now(); }
DI float shx(float v, int mask) { return __int_as_float(__builtin_amdgcn_ds_bpermute((lane_now() ^ mask) << 2, __float_as_int(v))); }
#define XB_TMO      128
#define XB_XCNT(j)  (256  + 64 * (j))
#define XB_XSUB(j)  (1280 + 64 * (j))
#define XB_XGEN(j)  (2304 + 64 * (j))
#define XB_TOP      3328
#define XB_TOPGEN   3392
#define XCD_BAR_WORDS 3456
#define XB_SPIN_CAP (1u << 18)
#define LAS __attribute__((address_space(3)))

__device__ __forceinline__ unsigned xb_ld(unsigned* p)              { return __hip_atomic_load(p, __ATOMIC_RELAXED, __HIP_MEMORY_SCOPE_AGENT); }
__device__ __forceinline__ unsigned xb_add(unsigned* p, unsigned v) { return __hip_atomic_fetch_add(p, v, __ATOMIC_RELAXED, __HIP_MEMORY_SCOPE_AGENT); }
__device__ __forceinline__ unsigned xb_xcc_id() { return (unsigned)__builtin_amdgcn_s_getreg((3 << 11) | 20) & 0xFu; }
#define XB_SPIN(cond, bar) do { unsigned _sp = 0; while (cond) { __builtin_amdgcn_s_sleep(1); \
    if ((++_sp & 255u) == 0u) { if (xb_ld(&(bar)[XB_TMO])) break; if (_sp > XB_SPIN_CAP) { atomicAdd(&(bar)[XB_TMO], 1u); break; } } } } while (0)

struct XcdBarrier {
    unsigned* bar; unsigned x; int wv;
    volatile LAS unsigned* st;
};

__device__ __forceinline__ XcdBarrier xcd_barrier_post(unsigned* bar, volatile LAS unsigned* st) {
    XcdBarrier b; b.bar = bar; b.x = xb_xcc_id(); b.st = st;
    if (threadIdx.x == 0) (void)xb_add(&bar[XB_XCNT(b.x)], 1u);
    return b;
}
__device__ __forceinline__ void xcd_barrier_complete(unsigned* bar, unsigned x, unsigned& nloc, unsigned& nx) {
    const unsigned G = gridDim.x * gridDim.y * gridDim.z;
    unsigned sum, cnt, mine, sp = 0u;
    for (;;) {
        sum = 0u; cnt = 0u; mine = 0u;
#pragma unroll
        for (unsigned j = 0; j < 16; ++j) { const unsigned c = xb_ld(&bar[XB_XCNT(j)]); sum += c; cnt += (c > 0u) ? 1u : 0u; mine = (j == x) ? c : mine; }
        if (sum == G) break;
        __builtin_amdgcn_s_sleep(1);
        if ((++sp & 255u) == 0u) { if (xb_ld(&bar[XB_TMO])) break; if (sp > XB_SPIN_CAP) { atomicAdd(&bar[XB_TMO], 1u); break; } }
    }
    nloc = mine > 0u ? mine : 1u; nx = cnt > 0u ? cnt : 1u;
}

__device__ __forceinline__ void xcd_barrier(const XcdBarrier& b) {
    asm volatile("s_waitcnt vmcnt(0)" ::: "memory");
    __syncthreads();
    if (b.wv == 0 && lane_now() == 0) {
        unsigned* bar = b.bar;
        __builtin_amdgcn_s_waitcnt(0);
        unsigned nloc = b.st[0], nx = b.st[1];
        if (nloc == 0u) { xcd_barrier_complete(bar, b.x, nloc, nx); b.st[0] = nloc; b.st[1] = nx; }
        const unsigned old = xb_add(&bar[XB_XSUB(b.x)], 1u);
        const unsigned gen = old / nloc;
        if (old + 1u == (gen + 1u) * nloc) {
            __builtin_amdgcn_fence(__ATOMIC_RELEASE, "agent");
            asm volatile("s_waitcnt vmcnt(0)" ::: "memory");
            const unsigned og = xb_add(&bar[XB_TOP], 1u);
            const unsigned tg = og / nx;
            if (og + 1u == (tg + 1u) * nx) xb_add(&bar[XB_TOPGEN], 1u);
            else XB_SPIN(xb_ld(&bar[XB_TOPGEN]) == tg, bar);
            __builtin_amdgcn_fence(__ATOMIC_ACQUIRE, "agent");
            xb_add(&bar[XB_XGEN(b.x)], 1u);
            asm volatile("s_waitcnt vmcnt(0)" ::: "memory");
        } else {
            XB_SPIN(xb_ld(&bar[XB_XGEN(b.x)]) == gen, bar);
            __builtin_amdgcn_fence(__ATOMIC_ACQUIRE, "agent");
            asm volatile("s_waitcnt vmcnt(0)" ::: "memory");
        }
    }
    __syncthreads();
}


namespace pg8 {
#define PG8_LAS __attribute__((address_space(3)))
typedef unsigned short bf16_t;
typedef short bf16x8 __attribute__((ext_vector_type(8)));
typedef float f32x4 __attribute__((ext_vector_type(4)));
typedef unsigned u32x4 __attribute__((ext_vector_type(4)));
constexpr int BM = 256, BK = 64, HALF = 128, HTB = HALF * BK * 2  , STAGE_BYTES = 8 * HTB, NXCD = 8, WGM = 8;

__host__ __device__ __forceinline__ int lds_byte(int r, int c) { const int st = (r >> 4) * 2 + (c >> 5), rr = r & 15, cc = c & 31, ob = rr * 64 + cc * 2; return st * 1024 + (ob ^ (((ob >> 9) & 1) << 5)); }
__host__ __device__ __forceinline__ void stage_rc(int b, int& R, int& C) { const int st = b / 1024, sb = b % 1024, swz = sb ^ (((sb >> 9) & 1) << 5); R = (st >> 1) * 16 + swz / 64; C = (st & 1) * 32 + (swz % 64) / 2; }
__host__ __device__ __forceinline__ int perm32(int rho) { const int n = rho >> 4, i = rho & 15; return 8 * (i >> 2) + 4 * n + (i & 3); }

struct Unit { int pm, pn; };
struct Gemm { const bf16_t* A; const bf16_t* Bt; int M, N, K, lda; };

struct StaticOrder {
    int nM, nN, nwg, G, c;
    __host__ __device__ __forceinline__ void init(int M, int N, int G_, int c_) { nM = M / BM; nN = N / BM; nwg = nM * nN; G = G_; c = c_; }
    __host__ __device__ __forceinline__ bool next(int i, Unit& u) const {
        const long L = (long)i * G + c; if (L >= nwg) return false;
        int wgid = (int)L; { const int q = nwg / NXCD, r = nwg % NXCD, xcd = wgid % NXCD, off = wgid / NXCD; wgid = (xcd < r ? xcd * (q + 1) : r * (q + 1) + (xcd - r) * q) + off; }
        const int nig = WGM * nN, gid = wgid / nig, fm = gid * WGM, gsz = (nM - fm) < WGM ? (nM - fm) : WGM;
        u.pm = fm + ((wgid % nig) % gsz); u.pn = (wgid % nig) / gsz; return true;
    }
    __device__ __forceinline__ void a_ready(const Unit&) const {}
    __device__ __forceinline__ void done(const Unit&) const {}
};
__device__ __forceinline__ unsigned cvt_pk_bf16(float lo, float hi) { unsigned r; asm volatile("v_cvt_pk_bf16_f32 %0, %1, %2" : "=v"(r) : "v"(lo), "v"(hi)); return r; }
typedef float f32x2 __attribute__((ext_vector_type(2)));
__device__ __forceinline__ f32x2 gelu_pk(f32x2 v) {
    const f32x2 av = __builtin_elementwise_abs(v), d = av * 0.2316418882f + 1.0f;
    f32x2 t; t.x = __builtin_amdgcn_rcpf(d.x); t.y = __builtin_amdgcn_rcpf(d.y);
    f32x2 q = t * 0.5307027145f + (-0.7265760135f); q = q * t + 0.7107068705f; q = q * t + (-0.142248368f); q = q * t + 0.127414796f; q = q * t;
    const f32x2 s = (v * v) * (-0.72134752044f);
    f32x2 e; e.x = __builtin_amdgcn_exp2f(s.x); e.y = __builtin_amdgcn_exp2f(s.y);
    const f32x2 m = v * (q * e), r = v - m;
    f32x2 o; o.x = v.x < 0.f ? m.x : r.x; o.y = v.y < 0.f ? m.y : r.y; return o;
}

template <int ACT  > struct EpiBf16 {
    static constexpr bool PERM = true, AFTER_DRAIN = false;
    bf16_t* O; int ldc; const float* bias; int split_cols; size_t split_stride;
    __device__ __forceinline__ void operator()(const f32x4 (&acc)[2][2][4][2], const Unit& u, int wr, int wc, int fr, int fq) const {
        const int row0 = u.pm * BM + wr * 64 + fr; int colt = u.pn * BM; bf16_t* base = O;
        if (split_cols) { const int t = colt / split_cols; base += (size_t)t * split_stride; colt -= t * split_cols; }
        const int col0 = colt + wc * 32 + 8 * fq, bcol0 = u.pn * BM + wc * 32 + 8 * fq;
        f32x4 bv[2][2];
#pragma unroll
        for (int bj = 0; bj < 2; ++bj)
#pragma unroll
            for (int n = 0; n < 2; ++n) bv[bj][n] = bias ? *(const f32x4*)(bias + bcol0 + bj * HALF + 4 * n) : (f32x4){0.f, 0.f, 0.f, 0.f};
#pragma unroll
        for (int ai = 0; ai < 2; ++ai)
#pragma unroll
            for (int m = 0; m < 4; ++m) { bf16_t* rowp = base + (size_t)(row0 + ai * HALF + m * 16) * ldc + col0;
#pragma unroll
                for (int bj = 0; bj < 2; ++bj) { f32x4 v0 = acc[ai][bj][m][0] + bv[bj][0], v1 = acc[ai][bj][m][1] + bv[bj][1];
                    if (ACT == 1) { f32x2 a = gelu_pk((f32x2){v0[0], v0[1]}), b = gelu_pk((f32x2){v0[2], v0[3]}), c = gelu_pk((f32x2){v1[0], v1[1]}), d = gelu_pk((f32x2){v1[2], v1[3]});
                        v0 = (f32x4){a.x, a.y, b.x, b.y}; v1 = (f32x4){c.x, c.y, d.x, d.y}; }
                    if (ACT == 2) {
#pragma unroll
                        for (int j = 0; j < 4; ++j) { v0[j] = 0.5f * v0[j] * (1.0f + erff(v0[j] * 0.70710678f)); v1[j] = 0.5f * v1[j] * (1.0f + erff(v1[j] * 0.70710678f)); } }
                    u32x4 w; w.x = cvt_pk_bf16(v0[0], v0[1]); w.y = cvt_pk_bf16(v0[2], v0[3]); w.z = cvt_pk_bf16(v1[0], v1[1]); w.w = cvt_pk_bf16(v1[2], v1[3]);
                    *(u32x4*)(rowp + bj * HALF) = w; } }
    }
};

template <class Epi, class Sched, bool STAMP = false>
__device__ __forceinline__ void gemm_phase(PG8_LAS unsigned char* lds, const Gemm g, const Sched& S, const Epi& E, unsigned long long* stamps, int wv) {
    const int tid = tid_of(wv), wid = __builtin_amdgcn_readfirstlane(tid >> 6), lane = tid & 63, wr = wid >> 2, wc = wid & 3, fr = lane & 15, fq = lane >> 4;
    const int K = g.K, nt = K / BK;
    int ts_lo = 0, ts_hi = 0, nts = 0; const unsigned long long rt_entry = STAMP ? (unsigned long long)wall_clock64() : 0ull;
#define PG8_STAMP() do { if (STAMP && wid == 0 && nts < 64) { const unsigned long long _c = (unsigned long long)clock64(); \
        ts_lo = (lane == nts) ? (int)(unsigned)_c : ts_lo; ts_hi = (lane == nts) ? (int)(unsigned)(_c >> 32) : ts_hi; ++nts; } } while (0)
    PG8_STAMP();
    unsigned voffA[2], voffB[2];
#pragma unroll
    for (int i = 0; i < 2; ++i) { int R, C; stage_rc(tid * 16 + i * 8192, R, C); const int Rb = Epi::PERM ? ((R & ~31) + perm32(R & 31)) : R;
        voffA[i] = (unsigned)(R * g.lda + C) * 2u; voffB[i] = (unsigned)(Rb * K + C) * 2u; }
    const size_t kstep = (size_t)(BK * 2);
    const size_t hstep = (size_t)HALF * K * 2;
    const size_t tstep = 2 * hstep;
    const size_t hstepA = (size_t)HALF * g.lda * 2, tstepA = 2 * hstepA;
    const unsigned ldsw = (unsigned)wid * 1024u;
    const int aoff = lds_byte(wr * 64 + fr, fq * 8), boff = lds_byte(wc * 32 + fr, fq * 8);
#define PG8_SA(b, h) (((b) * 2 + (h)) * HTB)
#define PG8_SB(b, h) ((4 + (b) * 2 + (h)) * HTB)
#define PG8_STAGE(bufoff, gbase, voff) do { _Pragma("unroll") for (int _i = 0; _i < 2; ++_i) \
        __builtin_amdgcn_global_load_lds((const unsigned*)((const char*)(gbase) + (voff)[_i]), (PG8_LAS unsigned*)(lds + (bufoff) + ldsw + _i * 8192), 16, 0, 0); } while (0)
#define PG8_LDA(dst, b, h) do { _Pragma("unroll") for (int m = 0; m < 4; ++m) _Pragma("unroll") for (int k = 0; k < 2; ++k) dst[m][k] = *(const PG8_LAS bf16x8*)(lds + PG8_SA(b, h) + aoff + m * 2048 + k * 1024); } while (0)
#define PG8_LDB(dst, b, h) do { _Pragma("unroll") for (int n = 0; n < 2; ++n) _Pragma("unroll") for (int k = 0; k < 2; ++k) dst[n][k] = *(const PG8_LAS bf16x8*)(lds + PG8_SB(b, h) + boff + n * 2048 + k * 1024); } while (0)
#define PG8_MMA(ai, bj, At, Bt) do { __builtin_amdgcn_s_setprio(1); _Pragma("unroll") for (int m = 0; m < 4; ++m) _Pragma("unroll") for (int n = 0; n < 2; ++n) _Pragma("unroll") for (int k = 0; k < 2; ++k) \
        acc[ai][bj][m][n] = __builtin_amdgcn_mfma_f32_16x16x32_bf16(Bt[n][k], At[m][k], acc[ai][bj][m][n], 0, 0, 0); __builtin_amdgcn_s_setprio(0); } while (0)
#define PG8_WAIT_V(n) asm volatile("s_waitcnt vmcnt(" #n ")" ::: "memory")
#define PG8_WAIT_L(n) asm volatile("s_waitcnt lgkmcnt(" #n ")" ::: "memory")
#define PG8_BAR __builtin_amdgcn_s_barrier()
#define PG8_SCHED __builtin_amdgcn_sched_barrier(0)
    Unit cur, nxt; int ui = 0;
    if (!S.next(0, cur)) return;
    f32x4 acc[2][2][4][2];
#pragma unroll
    for (int a = 0; a < 2; ++a)
#pragma unroll
        for (int b = 0; b < 2; ++b)
#pragma unroll
            for (int m = 0; m < 4; ++m)
#pragma unroll
                for (int n = 0; n < 2; ++n) acc[a][b][m][n] = (f32x4){0.f, 0.f, 0.f, 0.f};
    bf16x8 At[4][2], B0[2][2], B1[2][2];
    const char* cA = (const char*)g.A + (size_t)cur.pm * tstepA; const char* cB = (const char*)g.Bt + (size_t)cur.pn * tstep;
    S.a_ready(cur);
    PG8_STAGE(PG8_SB(0, 0), cB, voffB); PG8_STAGE(PG8_SA(0, 0), cA, voffA); PG8_STAGE(PG8_SB(0, 1), cB + hstep, voffB); PG8_STAGE(PG8_SA(0, 1), cA + hstepA, voffA);
    if (wr == 1) PG8_BAR;
    PG8_WAIT_V(4); PG8_BAR;
    PG8_STAGE(PG8_SB(1, 0), cB + kstep, voffB); PG8_STAGE(PG8_SA(1, 0), cA + kstep, voffA); PG8_STAGE(PG8_SB(1, 1), cB + hstep + kstep, voffB);
    PG8_WAIT_V(6); PG8_BAR;
    PG8_STAMP();
    for (;;) {
        const bool has_next = S.next(ui + 1, nxt);
        const char* nA = has_next ? (const char*)g.A + (size_t)nxt.pm * tstepA : cA; const char* nB = has_next ? (const char*)g.Bt + (size_t)nxt.pn * tstep : cB;
        for (int t = 0; t < nt; t += 2) {
            const bool last = (t == nt - 2);
            const char* a1 = cA + (size_t)(t + 1) * kstep;
            const char* a2 = last ? nA : cA + (size_t)(t + 2) * kstep; const char* b2 = last ? nB : cB + (size_t)(t + 2) * kstep;
            const char* a3 = a2 + kstep; const char* b3 = b2 + kstep;
            if (last && has_next) S.a_ready(nxt);
            PG8_LDB(B0, 0, 0); PG8_SCHED; PG8_LDA(At, 0, 0); PG8_STAGE(PG8_SA(1, 1), a1 + hstepA, voffA);
            PG8_WAIT_L(8); PG8_BAR; PG8_WAIT_L(0); PG8_MMA(0, 0, At, B0); PG8_BAR; PG8_SCHED;
            PG8_LDB(B1, 0, 1); PG8_STAGE(PG8_SB(0, 0), b2, voffB);
            PG8_BAR; PG8_WAIT_L(0); PG8_MMA(0, 1, At, B1); PG8_BAR;
            PG8_LDA(At, 0, 1); PG8_STAGE(PG8_SA(0, 0), a2, voffA);
            PG8_BAR; PG8_WAIT_L(0); PG8_MMA(1, 0, At, B0); PG8_BAR; PG8_SCHED;
            PG8_STAGE(PG8_SB(0, 1), b2 + hstep, voffB);
            PG8_WAIT_V(6); PG8_BAR; PG8_MMA(1, 1, At, B1); PG8_BAR;
            PG8_LDB(B0, 1, 0); PG8_SCHED; PG8_LDA(At, 1, 0); PG8_STAGE(PG8_SA(0, 1), a2 + hstepA, voffA);
            PG8_WAIT_L(8); PG8_BAR; PG8_WAIT_L(0); PG8_MMA(0, 0, At, B0); PG8_BAR; PG8_SCHED;
            PG8_LDB(B1, 1, 1); PG8_STAGE(PG8_SB(1, 0), b3, voffB);
            PG8_BAR; PG8_WAIT_L(0); PG8_MMA(0, 1, At, B1); PG8_BAR;
            PG8_LDA(At, 1, 1); PG8_STAGE(PG8_SA(1, 0), a3, voffA);
            PG8_BAR; PG8_WAIT_L(0); PG8_MMA(1, 0, At, B0); PG8_BAR; PG8_SCHED;
            PG8_STAGE(PG8_SB(1, 1), b3 + hstep, voffB);
            PG8_WAIT_V(6); PG8_BAR; PG8_MMA(1, 1, At, B1); PG8_BAR;
        }
        PG8_STAMP();
        if constexpr (!Epi::AFTER_DRAIN) { E(acc, cur, wr, wc, fr, fq); S.done(cur); }
        PG8_STAMP();
        if (!has_next) break;
#pragma unroll
        for (int a = 0; a < 2; ++a)
#pragma unroll
            for (int b = 0; b < 2; ++b)
#pragma unroll
                for (int m = 0; m < 4; ++m)
#pragma unroll
                    for (int n = 0; n < 2; ++n) acc[a][b][m][n] = (f32x4){0.f, 0.f, 0.f, 0.f};
        cur = nxt; cA = nA; cB = nB; ++ui;
    }
    PG8_WAIT_V(0);
    if (wr == 0) PG8_BAR;
    PG8_BAR;
    if constexpr (Epi::AFTER_DRAIN) { E.fused(acc, cur, wr, wc, fr, fq, lds, wid, lane); S.done(cur); }
    PG8_STAMP();
    if (STAMP && wid == 0) { stamps[lane] = lane < nts ? (((unsigned long long)(unsigned)ts_hi << 32) | (unsigned)ts_lo) : 0ull;
        if (lane == 62) stamps[62] = rt_entry; if (lane == 63) stamps[63] = (unsigned long long)wall_clock64(); }
#undef PG8_STAMP
#undef PG8_SA
#undef PG8_SB
#undef PG8_STAGE
#undef PG8_LDA
#undef PG8_LDB
#undef PG8_MMA
#undef PG8_WAIT_V
#undef PG8_WAIT_L
#undef PG8_BAR
#undef PG8_SCHED
}
}
template <int NTW, class Epi>
DI void gemm_tile(unsigned char* lds, const u16* __restrict__ A, const u16* __restrict__ X, int ldx, int K, int m0, int n0, Epi& epi) {
  const int tid = otid(), lane = tid & 63, wave = wave_of(tid);
  const int wm = wave & 3, wn = wave >> 2, l32 = lane & 31, h = lane >> 5;
  f32x16 acc[2][NTW];
#pragma unroll
  for (int i = 0; i < 2; ++i)
#pragma unroll
    for (int j = 0; j < NTW; ++j) acc[i][j] = zero16();
  const int nk = K >> 6;
  const int lrow = tid >> 3, lcol = tid & 7;
  const u16* ga = A + (size_t)lrow * K + lcol * 8;
  const u16* gx = X + (size_t)lrow * ldx + lcol * 8;
  u32x4 ra[4], rb[NTW];
#pragma unroll
  for (int i = 0; i < 4; ++i) ra[i] = *(const u32x4*)(ga + (size_t)i * 64 * K);
#pragma unroll
  for (int i = 0; i < NTW; ++i) rb[i] = *(const u32x4*)(gx + (size_t)i * 64 * ldx);
  {
    unsigned char* as = lds; unsigned char* bs = lds + 256 * 144;
#pragma unroll
    for (int i = 0; i < 4; ++i) *(u32x4*)(as + (lrow + i * 64) * 144 + lcol * 16) = ra[i];
#pragma unroll
    for (int i = 0; i < NTW; ++i) *(u32x4*)(bs + (lrow + i * 64) * 144 + lcol * 16) = rb[i];
  }
  __syncthreads();
#pragma unroll 1
  for (int ks = 0; ks < nk; ++ks) {
    const bool more = ks + 1 < nk;
    if (more) {
#pragma unroll
      for (int i = 0; i < 4; ++i) ra[i] = *(const u32x4*)(ga + (size_t)i * 64 * K + (ks + 1) * 64);
#pragma unroll
      for (int i = 0; i < NTW; ++i) rb[i] = *(const u32x4*)(gx + (size_t)i * 64 * ldx + (ks + 1) * 64);
    }
    const unsigned char* as = lds + (ks & 1) * GEMM_STAGE + (wm * 64 + l32) * 144 + h * 16;
    const unsigned char* bs = lds + (ks & 1) * GEMM_STAGE + 256 * 144 + (wn * NTW * 32 + l32) * 144 + h * 16;
#pragma unroll
    for (int kk = 0; kk < 4; ++kk) {
      bf16x8 a0 = *(const bf16x8*)(as + kk * 32), a1 = *(const bf16x8*)(as + 32 * 144 + kk * 32);
      bf16x8 b[NTW];
#pragma unroll
      for (int j = 0; j < NTW; ++j) b[j] = *(const bf16x8*)(bs + j * 32 * 144 + kk * 32);
#pragma unroll
      for (int j = 0; j < NTW; ++j) { acc[0][j] = MFMA(a0, b[j], acc[0][j]); acc[1][j] = MFMA(a1, b[j], acc[1][j]); }
    }
    if (more) {
      unsigned char* as2 = lds + ((ks + 1) & 1) * GEMM_STAGE; unsigned char* bs2 = as2 + 256 * 144;
#pragma unroll
      for (int i = 0; i < 4; ++i) *(u32x4*)(as2 + (lrow + i * 64) * 144 + lcol * 16) = ra[i];
#pragma unroll
      for (int i = 0; i < NTW; ++i) *(u32x4*)(bs2 + (lrow + i * 64) * 144 + lcol * 16) = rb[i];
    }
    __syncthreads();
  }
  epi(acc, m0 + wm * 64, n0 + wn * NTW * 32, l32, h);
}

struct EpiZ {
  u16* z;
  template <int NTW> DI void operator()(f32x16 (&acc)[2][NTW], int chb, int tokb, int l32, int h) {
#pragma unroll
    for (int nt = 0; nt < NTW; ++nt) { const int t = tokb + nt * 32 + l32;
#pragma unroll
      for (int mt = 0; mt < 2; ++mt)
#pragma unroll
        for (int q = 0; q < 4; ++q) {
          u32x2 v = {pack2(acc[mt][nt][q * 4], acc[mt][nt][q * 4 + 1]), pack2(acc[mt][nt][q * 4 + 2], acc[mt][nt][q * 4 + 3])};
          *(u32x2*)(z + (size_t)t * ZLD + chb + mt * 32 + q * 8 + h * 4) = v;
        }
    }
  }
};
struct EpiOut {
  u16* y;
  template <int NTW> DI void operator()(f32x16 (&acc)[2][NTW], int chb, int tokb, int l32, int h) {
#pragma unroll
    for (int nt = 0; nt < NTW; ++nt) { const int t = tokb + nt * 32 + l32;
#pragma unroll
      for (int mt = 0; mt < 2; ++mt)
#pragma unroll
        for (int q = 0; q < 4; ++q) {
          u32x2 v = {pack2(acc[mt][nt][q * 4], acc[mt][nt][q * 4 + 1]), pack2(acc[mt][nt][q * 4 + 2], acc[mt][nt][q * 4 + 3])};
          *(u32x2*)(y + (size_t)t * DM + chb + mt * 32 + q * 8 + h * 4) = v;
        }
    }
  }
};
struct EpiQ {
  u16* Q; const float* cosT; const float* sinT; const float* rs; int n0;
  template <int NTW> DI void operator()(f32x16 (&acc)[2][NTW], int chb, int tokb, int l32, int h) {
    const int seg = chb >> 6, head = seg / 3, part = seg - head * 3;
#pragma unroll
    for (int nt = 0; nt < NTW; ++nt) {
      const int t = tokb + nt * 32 + l32; const float r = rs[tokb - n0 + nt * 32 + l32] * QSCALE;
      u16* dst = Q + ((size_t)head * S + t) * 192;
      if (part < 2) {
#pragma unroll
        for (int mt = 0; mt < 2; ++mt)
#pragma unroll
          for (int q = 0; q < 4; ++q) {
            u32x2 v = {pack2(acc[mt][nt][q * 4] * r, acc[mt][nt][q * 4 + 1] * r), pack2(acc[mt][nt][q * 4 + 2] * r, acc[mt][nt][q * 4 + 3] * r)};
            *(u32x2*)(dst + part * 64 + mt * 32 + q * 8 + h * 4) = v;
          }
      } else {
#pragma unroll
        for (int q = 0; q < 4; ++q) {
          const int d = q * 8 + h * 4;
          const f32x4 c = *(const f32x4*)(cosT + (size_t)t * 32 + d), s = *(const f32x4*)(sinT + (size_t)t * 32 + d);
          float o1[4], o2[4];
#pragma unroll
          for (int j = 0; j < 4; ++j) { const float x1 = acc[0][nt][q * 4 + j], x2 = acc[1][nt][q * 4 + j]; o1[j] = (x1 * c[j] - x2 * s[j]) * r; o2[j] = (x2 * c[j] + x1 * s[j]) * r; }
          u32x2 v1 = {pack2(o1[0], o1[1]), pack2(o1[2], o1[3])}, v2 = {pack2(o2[0], o2[1]), pack2(o2[2], o2[3])};
          *(u32x2*)(dst + 128 + d) = v1; *(u32x2*)(dst + 160 + d) = v2;
        }
      }
    }
  }
};
DI int permpos(int k64) { const int kk = k64 & 15; return (k64 & 48) | (((kk >> 2) & 1) * 8 + (kk >> 3) * 4 + (kk & 3)); }
struct EpiKV {
  u16* K; u16* Vt; const float* rs; int n0;
  template <int NTW> DI void operator()(f32x16 (&acc)[2][NTW], int chb, int tokb, int l32, int h) {
    const int seg = chb >> 6, head = seg >> 2, part = seg & 3;
#pragma unroll
    for (int nt = 0; nt < NTW; ++nt) {
      const int t = tokb + nt * 32 + l32; const float r = rs[tokb - n0 + nt * 32 + l32];
      if (part < 2) {
        u16* dst = K + ((size_t)head * S + t) * 192 + part * 64;
#pragma unroll
        for (int mt = 0; mt < 2; ++mt)
#pragma unroll
          for (int q = 0; q < 4; ++q) {
            u32x2 v = {pack2(acc[mt][nt][q * 4] * r, acc[mt][nt][q * 4 + 1] * r), pack2(acc[mt][nt][q * 4 + 2] * r, acc[mt][nt][q * 4 + 3] * r)};
            *(u32x2*)(dst + mt * 32 + q * 8 + h * 4) = v;
          }
      } else {
        u16* dst = Vt + (((size_t)head * (S / 64) + (t >> 6)) * 128 + (part - 2) * 64) * 64 + permpos(t & 63);
#pragma unroll
        for (int mt = 0; mt < 2; ++mt)
#pragma unroll
          for (int i = 0; i < 16; ++i) { const int dv = mt * 32 + (i & 3) + 8 * (i >> 2) + 4 * h; dst[dv * 64] = tobf(acc[mt][nt][i] * r); }
      }
    }
  }
};

struct EpiQ2 {
  static constexpr bool PERM = true, AFTER_DRAIN = false;
  u16* Q; const PG8_LAS float* rs;
  DI void operator()(const pg8::f32x4 (&acc)[2][2][4][2], const pg8::Unit& u, int wr, int wc, int fr, int fq) const {
    asm volatile("" : "+v"(fr), "+v"(fq));
    int cb[2];
#pragma unroll
    for (int bj = 0; bj < 2; ++bj) { const int c0 = u.pn * 256 + bj * 128 + wc * 32 + 8 * fq, head = c0 / 192; cb[bj] = head * (S * 192) + (c0 - head * 192); }
    const int rl0 = wr * 64 + fr; u16* q0 = Q + (size_t)(u.pm * 256 + rl0) * 192; const PG8_LAS float* rs0 = rs + rl0;
#pragma unroll
    for (int ai = 0; ai < 2; ++ai)
#pragma unroll
      for (int m = 0; m < 4; ++m) { const float sc = rs0[ai * 128 + m * 16] * QSCALE; u16* qr = q0 + (ai * 128 + m * 16) * 192;
#pragma unroll
        for (int bj = 0; bj < 2; ++bj) { const pg8::f32x4 v0 = acc[ai][bj][m][0] * sc, v1 = acc[ai][bj][m][1] * sc;
          u32x4 w = {pack2(v0[0], v0[1]), pack2(v0[2], v0[3]), pack2(v1[0], v1[1]), pack2(v1[2], v1[3])};
          *(u32x4*)(qr + cb[bj]) = w; }
        asm volatile("" ::: "memory"); }
  }
};
struct EpiKV2 {
  static constexpr bool PERM = true, AFTER_DRAIN = false;
  u16* K; u16* Vt; const PG8_LAS float* rs;
  DI void operator()(const pg8::f32x4 (&acc)[2][2][4][2], const pg8::Unit& u, int wr, int wc, int fr, int fq) const {
    asm volatile("" : "+v"(fr), "+v"(fq));
    const int head = u.pn, d0 = wc * 32 + 8 * fq, rl0 = wr * 64 + fr;
    u16* k0 = K + ((size_t)head * S + u.pm * 256 + rl0) * 192 + d0; const PG8_LAS float* rs0 = rs + rl0;
    u16* v0p = Vt + (((size_t)head * (S / 64) + u.pm * 4 + wr) * 128 + d0) * 64 + permpos(fr);
#pragma unroll
    for (int ai = 0; ai < 2; ++ai)
#pragma unroll
      for (int m = 0; m < 4; ++m) { const float sc = rs0[ai * 128 + m * 16];
        { const pg8::f32x4 v0 = acc[ai][0][m][0] * sc, v1 = acc[ai][0][m][1] * sc;
          u32x4 w = {pack2(v0[0], v0[1]), pack2(v0[2], v0[3]), pack2(v1[0], v1[1]), pack2(v1[2], v1[3])};
          *(u32x4*)(k0 + (ai * 128 + m * 16) * 192) = w; }
        { const pg8::f32x4 v0 = acc[ai][1][m][0] * sc, v1 = acc[ai][1][m][1] * sc;
          u16* dst = v0p + ai * (2 * 128 * 64) + m * 16;
#pragma unroll
          for (int j = 0; j < 4; ++j) { dst[j * 64] = tobf(v0[j]); dst[(4 + j) * 64] = tobf(v1[j]); } }
        asm volatile("" ::: "memory"); }
  }
};
DI void row_rstd256(float* rs, const u16* X, int ldx, int K, int wv) {
  const int tid = tid_of(wv), tl = tid >> 1, sub = tid & 1;
  const u16* src = X + (size_t)tl * ldx; float ss = 0.f;
  for (int c = sub; c < (K >> 3); c += 2) {
    u32x4 v = *(const u32x4*)(src + c * 8);
#pragma unroll
    for (int j = 0; j < 4; ++j) { const float a = bflo(v[j]), b = bfhi(v[j]); ss += a * a + b * b; }
  }
  ss += shx(ss, 1);
  if (sub == 0) rs[tl] = rsqrtf(ss / (float)K + EPS);
}
DI void row_rstd(float* rs, const u16* X, int ldx, int K) {
  const int tid = otid(), tl = tid >> 2, sub = tid & 3;
  const u16* src = X + (size_t)tl * ldx; float ss = 0.f;
  for (int c = sub; c < (K >> 3); c += 4) {
    u32x4 v = *(const u32x4*)(src + c * 8);
#pragma unroll
    for (int j = 0; j < 4; ++j) { const float a = bflo(v[j]), b = bfhi(v[j]); ss += a * a + b * b; }
  }
  ss += shx(ss, 1); ss += shx(ss, 2);
  if (sub == 0) rs[tl] = rsqrtf(ss / (float)K + EPS);
}

DI void krope_tile(const P& p, int n0) {
  const int tid = tid_of(p.ph_lo), t = n0 + (tid >> 2), i0 = (tid & 3) * 8;
  const u16* z = (const u16*)(p.ws + WS_Z) + (size_t)t * ZLD + Z_KR;
  const float* cosT = (const float*)(p.ws + WS_COS) + (size_t)t * 32 + i0; const float* sinT = (const float*)(p.ws + WS_SIN) + (size_t)t * 32 + i0;
  u32x4 a = *(const u32x4*)(z + i0), b = *(const u32x4*)(z + 32 + i0);
  f32x4 c0 = *(const f32x4*)cosT, c1 = *(const f32x4*)(cosT + 4), s0 = *(const f32x4*)sinT, s1 = *(const f32x4*)(sinT + 4);
  float x1[8], x2[8], c[8], s[8];
#pragma unroll
  for (int j = 0; j < 4; ++j) { x1[2 * j] = bflo(a[j]); x1[2 * j + 1] = bfhi(a[j]); x2[2 * j] = bflo(b[j]); x2[2 * j + 1] = bfhi(b[j]); c[j] = c0[j]; c[4 + j] = c1[j]; s[j] = s0[j]; s[4 + j] = s1[j]; }
  u32x4 o1, o2;
#pragma unroll
  for (int j = 0; j < 4; ++j) {
    o1[j] = pack2(x1[2 * j] * c[2 * j] - x2[2 * j] * s[2 * j], x1[2 * j + 1] * c[2 * j + 1] - x2[2 * j + 1] * s[2 * j + 1]);
    o2[j] = pack2(x2[2 * j] * c[2 * j] + x1[2 * j] * s[2 * j], x2[2 * j + 1] * c[2 * j + 1] + x1[2 * j + 1] * s[2 * j + 1]);
  }
  u16* K = (u16*)(p.ws + WS_K);
#pragma unroll
  for (int hd = 0; hd < 4; ++hd) { u16* dst = K + ((size_t)hd * S + t) * 192 + 128 + i0; *(u32x4*)dst = o1; *(u32x4*)(dst + 32) = o2; }
}

DI void sgu_job(unsigned char* lds, const P& p, int layer, int nb) {
  const int tid = tid_of(p.ph_lo), lane = tid & 63, wave = wave_of(tid);
  const int n0 = nb * 128;
  const u16* z = (const u16*)(p.ws + WS_Z);
  u16* vT = (u16*)lds;
  {
    const int j = tid >> 2, sub = tid & 3; const u16* src = z + (size_t)(n0 + j) * ZLD + Z_V + sub * 64;
    float v[64]; float s = 0.f;
#pragma unroll
    for (int c = 0; c < 8; ++c) { u32x4 u = *(const u32x4*)(src + c * 8);
#pragma unroll
      for (int k = 0; k < 4; ++k) { v[c * 8 + 2 * k] = bflo(u[k]); v[c * 8 + 2 * k + 1] = bfhi(u[k]); s += v[c * 8 + 2 * k] + v[c * 8 + 2 * k + 1]; } }
    s += shx(s, 1); s += shx(s, 2);
    const float mu = s * (1.f / 256.f); float q = 0.f;
#pragma unroll
    for (int c = 0; c < 64; ++c) { const float d = v[c] - mu; q += d * d; }
    q += shx(q, 1); q += shx(q, 2);
    const float rstd = rsqrtf(q * (1.f / 256.f) + EPS);
    const float* g = p.sgu_ln_g + layer * 256 + sub * 64; const float* b = p.sgu_ln_b + layer * 256 + sub * 64;
#pragma unroll
    for (int c4 = 0; c4 < 16; ++c4) { const f32x4 gg = *(const f32x4*)(g + c4 * 4), bb = *(const f32x4*)(b + c4 * 4);
#pragma unroll
      for (int k = 0; k < 4; ++k) vT[(sub * 64 + c4 * 4 + k) * 136 + j] = tobf((v[c4 * 4 + k] - mu) * rstd * gg[k] + bb[k]); }
  }
  __syncthreads();
  const int wm = wave & 3, wn = wave >> 2, l32 = lane & 31, h = lane >> 5;
  f32x16 acc[2][2]; acc[0][0] = zero16(); acc[0][1] = zero16(); acc[1][0] = zero16(); acc[1][1] = zero16();
  const u16* W = (const u16*)(p.ws + WS_SGUW) + (size_t)(layer * 4 + wm) * 128 * 128;
#pragma unroll
  for (int kk = 0; kk < 8; ++kk) {
    bf16x8 a0 = *(const bf16x8*)(vT + (wm * 64 + l32) * 136 + kk * 16 + h * 8);
    bf16x8 a1 = *(const bf16x8*)(vT + (wm * 64 + 32 + l32) * 136 + kk * 16 + h * 8);
    bf16x8 b0 = *(const bf16x8*)(W + (wn * 64 + l32) * 128 + kk * 16 + h * 8);
    bf16x8 b1 = *(const bf16x8*)(W + (wn * 64 + 32 + l32) * 128 + kk * 16 + h * 8);
    acc[0][0] = MFMA(a0, b0, acc[0][0]); acc[0][1] = MFMA(a0, b1, acc[0][1]);
    acc[1][0] = MFMA(a1, b0, acc[1][0]); acc[1][1] = MFMA(a1, b1, acc[1][1]);
  }
  u16* Y = (u16*)(p.ws + WS_HY);
#pragma unroll
  for (int nt = 0; nt < 2; ++nt) {
    const int i = wn * 64 + nt * 32 + l32, t = n0 + i; const float bias = p.sgu_b[(layer * 4 + wm) * 128 + i];
#pragma unroll
    for (int mt = 0; mt < 2; ++mt)
#pragma unroll
      for (int q = 0; q < 4; ++q) {
        const int c = wm * 64 + mt * 32 + q * 8 + h * 4;
        const u32x2 u = *(const u32x2*)(z + (size_t)t * ZLD + Z_U + c), g = *(const u32x2*)(z + (size_t)t * ZLD + Z_SG + c);
        const float o0 = bflo(u[0]) * (acc[mt][nt][q * 4] + bias) * silu(bflo(g[0])), o1 = bfhi(u[0]) * (acc[mt][nt][q * 4 + 1] + bias) * silu(bfhi(g[0]));
        const float o2 = bflo(u[1]) * (acc[mt][nt][q * 4 + 2] + bias) * silu(bflo(g[1])), o3 = bfhi(u[1]) * (acc[mt][nt][q * 4 + 3] + bias) * silu(bfhi(g[1]));
        u32x2 v = {pack2(o0, o1), pack2(o2, o3)};
        *(u32x2*)(Y + (size_t)t * DM + c) = v;
      }
  }
}

template <int W>
DI void pool_win(const u16* zp, int t0, u16* prow) {
  unsigned v[32 + W];
#pragma unroll
  for (int i = 0; i < 32 + W; ++i) { const int t = t0 - W + i; v[i] = (t >= 0) ? *(const unsigned*)(zp + (size_t)max(t, 0) * ZLD) : 0u; }
  float s0 = 0.f, s1 = 0.f;
#pragma unroll
  for (int i = 0; i < W; ++i) { s0 += bflo(v[i]); s1 += bfhi(v[i]); }
#pragma unroll
  for (int tt = 0; tt < 32; ++tt) {
    const float p0 = bflo(v[W + tt]), p1 = bfhi(v[W + tt]);
    s0 += p0 - bflo(v[tt]); s1 += p1 - bfhi(v[tt]);
    const float inv = 1.f / (float)min(t0 + tt + 1, W);
    *(unsigned*)(prow + tt * 264) = pack2(s0 * inv - p0, s1 * inv - p1);
  }
}
DI void pool_job(unsigned char* lds, const P& p, int layer, int nb) {
  const int tid = tid_of(p.ph_lo), lane = tid & 63, wave = wave_of(tid);
  const int n0 = nb * 128;
  const u16* z = (const u16*)(p.ws + WS_Z);
  u16* pl = (u16*)lds;
  {
    const int g = wave & 3, c = g * 64 + (lane & 31) * 2, tq = (wave >> 2) * 2 + (lane >> 5);
    const u16* zp = z + Z_PI + c; const int t0 = n0 + tq * 32; u16* prow = pl + (tq * 32) * 264 + c;
    switch (g) { case 0: pool_win<2>(zp, t0, prow); break; case 1: pool_win<4>(zp, t0, prow); break; case 2: pool_win<8>(zp, t0, prow); break; default: pool_win<16>(zp, t0, prow); break; }
  }
  __syncthreads();
  const int wm = wave & 3, wn = wave >> 2, l32 = lane & 31, h = lane >> 5;
  f32x16 acc[2][2]; acc[0][0] = zero16(); acc[0][1] = zero16(); acc[1][0] = zero16(); acc[1][1] = zero16();
  const u16* W = (const u16*)(p.ws + WS_PWT) + (size_t)(layer * 4 + wm) * 64 * 64;
#pragma unroll
  for (int kk = 0; kk < 4; ++kk) {
    bf16x8 a0 = *(const bf16x8*)(W + (l32) * 64 + kk * 16 + h * 8);
    bf16x8 a1 = *(const bf16x8*)(W + (32 + l32) * 64 + kk * 16 + h * 8);
    bf16x8 b0 = *(const bf16x8*)(pl + (wn * 64 + l32) * 264 + wm * 64 + kk * 16 + h * 8);
    bf16x8 b1 = *(const bf16x8*)(pl + (wn * 64 + 32 + l32) * 264 + wm * 64 + kk * 16 + h * 8);
    acc[0][0] = MFMA(a0, b0, acc[0][0]); acc[0][1] = MFMA(a0, b1, acc[0][1]);
    acc[1][0] = MFMA(a1, b0, acc[1][0]); acc[1][1] = MFMA(a1, b1, acc[1][1]);
  }
  u16* Y = (u16*)(p.ws + WS_HY);
#pragma unroll
  for (int nt = 0; nt < 2; ++nt) {
    const int t = n0 + wn * 64 + nt * 32 + l32;
#pragma unroll
    for (int mt = 0; mt < 2; ++mt)
#pragma unroll
      for (int q = 0; q < 4; ++q) {
        const int c = wm * 64 + mt * 32 + q * 8 + h * 4;
        const f32x4 sc = *(const f32x4*)(p.pool_scale + layer * 256 + c);
        const u32x2 g = *(const u32x2*)(z + (size_t)t * ZLD + Z_PG + c);
        const float o0 = acc[mt][nt][q * 4] * sc[0] * silu(bflo(g[0])), o1 = acc[mt][nt][q * 4 + 1] * sc[1] * silu(bfhi(g[0]));
        const float o2 = acc[mt][nt][q * 4 + 2] * sc[2] * silu(bflo(g[1])), o3 = acc[mt][nt][q * 4 + 3] * sc[3] * silu(bfhi(g[1]));
        u32x2 v = {pack2(o0, o1), pack2(o2, o3)};
        *(u32x2*)(Y + (size_t)t * DM + 256 + c) = v;
      }
  }
}

DI void att2_qk(f32x16& s0, f32x16& s1, const unsigned char* krow, const bf16x8 (&qf)[12], float m) {
  const float nm = -m;
#pragma unroll
  for (int i = 0; i < 16; ++i) { s0[i] = nm; s1[i] = nm; }
  bf16x8 ka[4], kb[4];
#define ATT2_LDK(F, B_) do { F[0] = *(const bf16x8*)(krow + (2 * (B_)) * 32); F[1] = *(const bf16x8*)(krow + 32 * 400 + (2 * (B_)) * 32); \
                             F[2] = *(const bf16x8*)(krow + (2 * (B_) + 1) * 32); F[3] = *(const bf16x8*)(krow + 32 * 400 + (2 * (B_) + 1) * 32); } while (0)
#define ATT2_MMK(F, B_) do { s0 = MFMA(F[0], qf[2 * (B_)], s0); s1 = MFMA(F[1], qf[2 * (B_)], s1); s0 = MFMA(F[2], qf[2 * (B_) + 1], s0); s1 = MFMA(F[3], qf[2 * (B_) + 1], s1); } while (0)
  ATT2_LDK(ka, 0); ATT2_LDK(kb, 1); __builtin_amdgcn_sched_barrier(0);
  ATT2_MMK(ka, 0); __builtin_amdgcn_sched_barrier(0); ATT2_LDK(ka, 2); __builtin_amdgcn_sched_barrier(0);
  ATT2_MMK(kb, 1); __builtin_amdgcn_sched_barrier(0); ATT2_LDK(kb, 3); __builtin_amdgcn_sched_barrier(0);
  ATT2_MMK(ka, 2); __builtin_amdgcn_sched_barrier(0); ATT2_LDK(ka, 4); __builtin_amdgcn_sched_barrier(0);
  ATT2_MMK(kb, 3); __builtin_amdgcn_sched_barrier(0); ATT2_LDK(kb, 5); __builtin_amdgcn_sched_barrier(0);
  ATT2_MMK(ka, 4); __builtin_amdgcn_sched_barrier(0);
  ATT2_MMK(kb, 5); __builtin_amdgcn_sched_barrier(0);
#undef ATT2_LDK
#undef ATT2_MMK
}
DI void att2_sm_pv(f32x16& s0, f32x16& s1, const unsigned char* vrow, f32x16 (&O)[4], float& m, float& l, bool first) {
  bf16x8 vf[8];
#pragma unroll
  for (int mt = 0; mt < 4; ++mt) { vf[2 * mt] = *(const bf16x8*)(vrow + mt * 32 * 144); vf[2 * mt + 1] = *(const bf16x8*)(vrow + mt * 32 * 144 + 32); }
  __builtin_amdgcn_sched_barrier(0);
  float mx = fmaxf(fmaxf(s0[0], s1[0]), fmaxf(s0[1], s1[1]));
#pragma unroll
  for (int i = 2; i < 16; ++i) mx = fmaxf(fmaxf(mx, s0[i]), s1[i]);
  if (first || __builtin_amdgcn_ballot_w64(mx > 8.f) != 0) {
    const float mxx = fmaxf(mx, shx(mx, 32));
    const float d = first ? mxx : fmaxf(mxx, 0.f);
    const float alpha = first ? 1.f : ex2(-d);
    m += d; l *= alpha;
#pragma unroll
    for (int i = 0; i < 16; ++i) { s0[i] -= d; s1[i] -= d; }
#pragma unroll
    for (int mt = 0; mt < 4; ++mt)
#pragma unroll
      for (int i = 0; i < 16; ++i) O[mt][i] *= alpha;
  }
  float ps0 = 0.f, ps1 = 0.f;
#pragma unroll
  for (int i = 0; i < 16; ++i) { s0[i] = ex2(s0[i]); s1[i] = ex2(s1[i]); ps0 += s0[i]; ps1 += s1[i]; }
  l += ps0 + ps1;
  u32x4 p0 = {pack2(s0[0], s0[1]), pack2(s0[2], s0[3]), pack2(s0[4], s0[5]), pack2(s0[6], s0[7])};
  u32x4 p1 = {pack2(s0[8], s0[9]), pack2(s0[10], s0[11]), pack2(s0[12], s0[13]), pack2(s0[14], s0[15])};
  u32x4 p2 = {pack2(s1[0], s1[1]), pack2(s1[2], s1[3]), pack2(s1[4], s1[5]), pack2(s1[6], s1[7])};
  u32x4 p3 = {pack2(s1[8], s1[9]), pack2(s1[10], s1[11]), pack2(s1[12], s1[13]), pack2(s1[14], s1[15])};
  const bf16x8 pf0 = __builtin_bit_cast(bf16x8, p0), pf1 = __builtin_bit_cast(bf16x8, p1), pf2 = __builtin_bit_cast(bf16x8, p2), pf3 = __builtin_bit_cast(bf16x8, p3);
#pragma unroll
  for (int mt = 0; mt < 4; ++mt) { O[mt] = MFMA(vf[2 * mt], pf0, O[mt]); O[mt] = MFMA(vf[2 * mt + 1], pf1, O[mt]); }
  __builtin_amdgcn_sched_barrier(0);
#pragma unroll
  for (int mt = 0; mt < 4; ++mt) { vf[2 * mt] = *(const bf16x8*)(vrow + mt * 32 * 144 + 64); vf[2 * mt + 1] = *(const bf16x8*)(vrow + mt * 32 * 144 + 96); }
  __builtin_amdgcn_sched_barrier(0);
#pragma unroll
  for (int mt = 0; mt < 4; ++mt) { O[mt] = MFMA(vf[2 * mt], pf2, O[mt]); O[mt] = MFMA(vf[2 * mt + 1], pf3, O[mt]); }
}
DI void attn2_item(unsigned char* lds, const P& p, int hd, int QB, int t0, int t1, unsigned char* part) {
  const int tid = tid_of(p.ph_lo), lane = tid & 63, wave = wave_of(tid);
  const int l32 = lane & 31, h = lane >> 5;
  const int trow = QB * 256 + wave * 32 + l32;
  const u16* Qg = (const u16*)(p.ws + WS_Q) + ((size_t)hd * S + trow) * 192 + h * 8;
  bf16x8 qf[12];
#pragma unroll
  for (int ks = 0; ks < 12; ++ks) qf[ks] = *(const bf16x8*)(Qg + ks * 16);
  {
    const float* ct = (const float*)(p.ws + WS_COS) + (size_t)trow * 32 + h * 8; const float* st = (const float*)(p.ws + WS_SIN) + (size_t)trow * 32 + h * 8;
#pragma unroll
    for (int pr = 0; pr < 2; ++pr) {
      const f32x4 c0 = *(const f32x4*)(ct + pr * 16), c1 = *(const f32x4*)(ct + pr * 16 + 4), s0 = *(const f32x4*)(st + pr * 16), s1 = *(const f32x4*)(st + pr * 16 + 4);
      const u32x4 xa = __builtin_bit_cast(u32x4, qf[8 + pr]), xb = __builtin_bit_cast(u32x4, qf[10 + pr]);
      u32x4 oa, ob;
#pragma unroll
      for (int j = 0; j < 4; ++j) {
        const float cl = (j < 2) ? c0[2 * j] : c1[2 * j - 4], ch = (j < 2) ? c0[2 * j + 1] : c1[2 * j - 3], sl = (j < 2) ? s0[2 * j] : s1[2 * j - 4], sh = (j < 2) ? s0[2 * j + 1] : s1[2 * j - 3];
        const float a0 = bflo(xa[j]), a1 = bfhi(xa[j]), b0 = bflo(xb[j]), b1 = bfhi(xb[j]);
        oa[j] = pack2(a0 * cl - b0 * sl, a1 * ch - b1 * sh); ob[j] = pack2(b0 * cl + a0 * sl, b1 * ch + a1 * sh);
      }
      qf[8 + pr] = __builtin_bit_cast(bf16x8, oa); qf[10 + pr] = __builtin_bit_cast(bf16x8, ob);
    }
  }
  const int mychunk = 4 * QB + (wave >> 1);
  const u16* Kg = (const u16*)(p.ws + WS_K) + (size_t)hd * S * 192 + tid * 8;
  const u16* Vg = (const u16*)(p.ws + WS_VT) + (size_t)hd * S * 128 + tid * 8;
  int kdst[3], vdst[2];
#pragma unroll
  for (int i = 0; i < 3; ++i) { const int c = tid + i * NT; kdst[i] = (c / 24) * 400 + (c % 24) * 16; }
#pragma unroll
  for (int i = 0; i < 2; ++i) { const int c = tid + i * NT; vdst[i] = 64 * 400 + (c >> 3) * 144 + (c & 7) * 16; }
  const int koff = l32 * 400 + h * 16;
  const int voff = 64 * 400 + l32 * 144 + h * 16;
  f32x16 O[4]; O[0] = zero16(); O[1] = zero16(); O[2] = zero16(); O[3] = zero16();
  float m = 0.f, l = 0.f;
  u32x4 rk[3], rv[2];
#pragma unroll
  for (int i = 0; i < 3; ++i) rk[i] = *(const u32x4*)(Kg + (size_t)t0 * 64 * 192 + i * NT * 8);
#pragma unroll
  for (int i = 0; i < 2; ++i) rv[i] = *(const u32x4*)(Vg + (size_t)t0 * 128 * 64 + i * NT * 8);
#pragma unroll
  for (int i = 0; i < 3; ++i) *(u32x4*)(lds + kdst[i]) = rk[i];
#pragma unroll
  for (int i = 0; i < 2; ++i) *(u32x4*)(lds + vdst[i]) = rv[i];
  __syncthreads();
#pragma unroll 1
  for (int kt = t0; kt < t1; ++kt) {
    const int stg = ((kt - t0) & 1) * ATT_STAGE, nxt = min(kt + 1, t1 - 1);
#pragma unroll
    for (int i = 0; i < 3; ++i) rk[i] = *(const u32x4*)(Kg + (size_t)nxt * 64 * 192 + i * NT * 8);
#pragma unroll
    for (int i = 0; i < 2; ++i) rv[i] = *(const u32x4*)(Vg + (size_t)nxt * 128 * 64 + i * NT * 8);
    if (kt <= mychunk) { f32x16 s0, s1; att2_qk(s0, s1, lds + stg + koff, qf, m); att2_sm_pv(s0, s1, lds + stg + voff, O, m, l, kt == t0); }
    {
      unsigned char* st = lds + (ATT_STAGE - stg);
#pragma unroll
      for (int i = 0; i < 3; ++i) *(u32x4*)(st + kdst[i]) = rk[i];
#pragma unroll
      for (int i = 0; i < 2; ++i) *(u32x4*)(st + vdst[i]) = rv[i];
    }
    lds_barrier();
  }
  const float lt = l + shx(l, 32);
  if (part) {
    float* po = (float*)part; float* pm = (float*)(part + 8 * 64 * 64 * 4);
#pragma unroll
    for (int mt = 0; mt < 4; ++mt)
#pragma unroll
      for (int i = 0; i < 16; ++i) po[((wave * 64) + mt * 16 + i) * 64 + lane] = O[mt][i];
    pm[wave * 64 + lane] = m; pm[512 + wave * 64 + lane] = lt;
  } else {
    const float inv = 1.f / lt;
    const u16* zg = (const u16*)(p.ws + WS_Z) + (size_t)trow * ZLD + Z_MG + hd * 128;
    u16* Y = (u16*)(p.ws + WS_HY) + (size_t)trow * DM + 512 + hd * 128;
#pragma unroll
    for (int mt = 0; mt < 4; ++mt)
#pragma unroll
      for (int q = 0; q < 4; ++q) {
        const int dv = mt * 32 + q * 8 + h * 4;
        const u32x2 g = *(const u32x2*)(zg + dv);
        float o[4];
#pragma unroll
        for (int j = 0; j < 4; ++j) o[j] = O[mt][q * 4 + j] * inv;
        u32x2 v = {pack2(o[0] * silu(bflo(g[0])), o[1] * silu(bfhi(g[0]))), pack2(o[2] * silu(bflo(g[1])), o[3] * silu(bfhi(g[1])))};
        *(u32x2*)(Y + dv) = v;
      }
  }
  __syncthreads();
}
DI void attn2_combine(const P& p, int vid) {
  const int tid = tid_of(p.ph_lo), lane = tid & 63, wave = wave_of(tid), l32 = lane & 31, h = lane >> 5;
  const int hd = (vid & 7) >> 1, role = vid & 1, QL = 63 - (vid >> 3), sw = 4 * role + (wave & 3), mt0 = 2 * (wave >> 2);
  const unsigned char* pa = p.ws + WS_PART + (size_t)(vid & ~1) * PART_BYTES; const unsigned char* pb = pa + PART_BYTES;
  const float* oa = (const float*)pa; const float* ob = (const float*)pb; const float* ma = (const float*)(pa + 8 * 64 * 64 * 4); const float* mb = (const float*)(pb + 8 * 64 * 64 * 4);
  const float m0 = ma[sw * 64 + lane], l0 = ma[512 + sw * 64 + lane], m1 = mb[sw * 64 + lane], l1 = mb[512 + sw * 64 + lane];
  const float mm = fmaxf(m0, m1); float a0 = ex2(m0 - mm), a1 = ex2(m1 - mm);
  const float inv = 1.f / (l0 * a0 + l1 * a1); a0 *= inv; a1 *= inv;
  const int trow = QL * 256 + sw * 32 + l32;
  const u16* zg = (const u16*)(p.ws + WS_Z) + (size_t)trow * ZLD + Z_MG + hd * 128;
  u16* Y = (u16*)(p.ws + WS_HY) + (size_t)trow * DM + 512 + hd * 128;
#pragma unroll
  for (int mi = 0; mi < 2; ++mi)
#pragma unroll
    for (int q = 0; q < 4; ++q) {
      const int mt = mt0 + mi, dv = mt * 32 + q * 8 + h * 4;
      const u32x2 g = *(const u32x2*)(zg + dv);
      float o[4];
#pragma unroll
      for (int j = 0; j < 4; ++j) { const int idx = ((sw * 64) + mt * 16 + q * 4 + j) * 64 + lane; o[j] = oa[idx] * a0 + ob[idx] * a1; }
      u32x2 v = {pack2(o[0] * silu(bflo(g[0])), o[1] * silu(bfhi(g[0]))), pack2(o[2] * silu(bflo(g[1])), o[3] * silu(bfhi(g[1])))};
      *(u32x2*)(Y + dv) = v;
    }
}

DI void transpose_tile(unsigned char* lds, const float* __restrict__ src, int ldsrc, u16* __restrict__ dst, int ldd, int k0, int n0, int nvalid, const float* gain, int tid) {
  float* tile = (float*)lds;
#pragma unroll
  for (int i = 0; i < 8; ++i) { const int idx = tid + i * NT, r = idx >> 6, cc = idx & 63, n = n0 + cc;
    float v = (n < nvalid) ? src[(size_t)(k0 + r) * ldsrc + n] : 0.f; if (gain) v *= gain[k0 + r]; tile[r * 65 + cc] = v; }
  __syncthreads();
#pragma unroll
  for (int i = 0; i < 8; ++i) { const int idx = tid + i * NT, r = idx >> 6, cc = idx & 63; dst[(size_t)(n0 + r) * ldd + k0 + cc] = tobf(tile[cc * 65 + r]); }
  __syncthreads();
}
DI float wave_sum(float v) { v += shx(v, 32); v += shx(v, 16); v += shx(v, 8); v += shx(v, 4); v += shx(v, 2); v += shx(v, 1); return v; }
DI void prenorm_row(const f32x4 (&v)[4], const float* g, u16* hrow, int lane) {
  float ss = 0.f;
#pragma unroll
  for (int i = 0; i < 4; ++i) ss += v[i][0] * v[i][0] + v[i][1] * v[i][1] + v[i][2] * v[i][2] + v[i][3] * v[i][3];
  ss = wave_sum(ss);
  const float r = rsqrtf(ss * (1.f / 1024.f) + EPS);
#pragma unroll
  for (int i = 0; i < 4; ++i) { const f32x4 gg = *(const f32x4*)(g + (lane + 64 * i) * 4);
    u32x2 o = {pack2(v[i][0] * r * gg[0], v[i][1] * r * gg[1]), pack2(v[i][2] * r * gg[2], v[i][3] * r * gg[3])};
    *(u32x2*)(hrow + (lane + 64 * i) * 4) = o; }
}

DI void prep_weights(unsigned char* lds, const P& p, int layer, int first, int stride, int wv) {
  const int tid = tid_of(wv);
  u16* win = (u16*)(p.ws + WS_WIN); u16* wuq = (u16*)(p.ws + WS_WUQ); u16* wukv = (u16*)(p.ws + WS_WUKV); u16* wout = (u16*)(p.ws + WS_WOUT);
  for (int job = first; job < 1032; job += stride) {
    int r = job;
    if (r < 640) { const int kt = r / 40, nt = r - kt * 40; transpose_tile(lds, p.w_in + (size_t)layer * 1024 * DIN, DIN, win + (size_t)layer * 2560 * 1024, 1024, kt * 64, nt * 64, DIN, nullptr, tid); }
    else if (r < 712) { r -= 640; const int kt = r / 12, nt = r - kt * 12; transpose_tile(lds, p.w_uq + (size_t)layer * 384 * 768, 768, wuq + (size_t)layer * 768 * 384, 384, kt * 64, nt * 64, 768, p.q_norm_g + layer * 384, tid); }
    else if (r < 776) { r -= 712; const int kt = r / 16, nt = r - kt * 16; transpose_tile(lds, p.w_ukv + (size_t)layer * 256 * 1024, 1024, wukv + (size_t)layer * 1024 * 256, 256, kt * 64, nt * 64, 1024, p.kv_norm_g + layer * 256, tid); }
    else { r -= 776; const int kt = r / 16, nt = r - kt * 16; transpose_tile(lds, p.w_out + (size_t)layer * 1024 * 1024, 1024, wout + (size_t)layer * 1024 * 1024, 1024, kt * 64, nt * 64, 1024, nullptr, tid); }
  }
}
DI void phase_prep(unsigned char* lds, const P& p, int wv) {
  const int nb = gridDim.x, bid = blockIdx.x, tid = tid_of(wv);
  u16* win = (u16*)(p.ws + WS_WIN); u16* wuq = (u16*)(p.ws + WS_WUQ); u16* wukv = (u16*)(p.ws + WS_WUKV); u16* wout = (u16*)(p.ws + WS_WOUT);
  prep_weights(lds, p, 0, bid, nb, wv);
  const int gtid = bid * NT + tid, gn = nb * NT;
  u16* sguw = (u16*)(p.ws + WS_SGUW);
  for (int idx = gtid; idx < 2 * 4 * 128 * 128; idx += gn) { const int i = (idx >> 7) & 127, j = idx & 127; sguw[idx] = ((j >> 6) <= (i >> 6)) ? tobf(p.sgu_w[idx]) : (u16)0; }
  u16* pwt = (u16*)(p.ws + WS_PWT);
  for (int idx = gtid; idx < 2 * 4 * 64 * 64; idx += gn) { const int lg = idx >> 12, d = (idx >> 6) & 63, c = idx & 63; pwt[idx] = tobf(p.pool_w[(lg * 64 + c) * 64 + d]); }
  float* cosT = (float*)(p.ws + WS_COS); float* sinT = (float*)(p.ws + WS_SIN);
  for (int idx = gtid; idx < S * 32; idx += gn) {
    const int t = idx >> 5, i = idx & 31; const float angf = (float)p.pos[t] * p.invfreq[i];
    const double a = (double)angf; const double k = rint(a * 0.15915494309189535); const double r = a - k * 6.283185307179586; const double r2 = r * r;
    double ts = r, ss = r, tc = 1.0, sc = 1.0;
#pragma unroll
    for (int n = 1; n <= 13; ++n) { ts *= -r2 * (1.0 / (double)((2 * n) * (2 * n + 1))); ss += ts; tc *= -r2 * (1.0 / (double)((2 * n - 1) * (2 * n))); sc += tc; }
    cosT[idx] = (float)sc; sinT[idx] = (float)ss;
  }
  u16* hb = (u16*)(p.ws + WS_HY);
  const int lane = tid & 63, wave = wave_of(tid);
  for (int row = bid * 8 + wave; row < S; row += nb * 16) {
    const int row2 = row + nb * 8; const bool has2 = row2 < S;
    f32x4 v[4], v2[4];
#pragma unroll
    for (int i = 0; i < 4; ++i) v[i] = *(const f32x4*)(p.x + (size_t)row * DM + (lane + 64 * i) * 4);
    if (has2) {
#pragma unroll
      for (int i = 0; i < 4; ++i) v2[i] = *(const f32x4*)(p.x + (size_t)row2 * DM + (lane + 64 * i) * 4);
    }
    prenorm_row(v, p.pre_g, hb + (size_t)row * DM, lane);
    if (has2) prenorm_row(v2, p.pre_g, hb + (size_t)row2 * DM, lane);
  }
}

DI void post_load(const u16* yout, const float* xold, int row, int lane, f32x4 (&y)[4], f32x4 (&xo)[4]) {
#pragma unroll
  for (int i = 0; i < 4; ++i) { const u32x2 yb = *(const u32x2*)(yout + (size_t)row * DM + (lane + 64 * i) * 4); y[i] = (f32x4){bflo(yb[0]), bfhi(yb[0]), bflo(yb[1]), bfhi(yb[1])};
    xo[i] = *(const f32x4*)(xold + (size_t)row * DM + (lane + 64 * i) * 4); }
}
DI void post_finish(const P& p, int layer, int row, int lane, f32x4 (&y)[4], const f32x4 (&xo)[4], u16* hb) {
  float ss = 0.f;
#pragma unroll
  for (int i = 0; i < 4; ++i) ss += y[i][0] * y[i][0] + y[i][1] * y[i][1] + y[i][2] * y[i][2] + y[i][3] * y[i][3];
  ss = wave_sum(ss);
  const float r = rsqrtf(ss * (1.f / 1024.f) + EPS);
#pragma unroll
  for (int i = 0; i < 4; ++i) {
    const f32x4 g = *(const f32x4*)(p.post_g + layer * DM + (lane + 64 * i) * 4);
    y[i] = xo[i] + y[i] * r * g;
    *(f32x4*)(p.out + (size_t)row * DM + (lane + 64 * i) * 4) = y[i];
  }
  if (layer + 1 < DEPTH) prenorm_row(y, p.pre_g + (layer + 1) * DM, hb + (size_t)row * DM, lane);
}
DI void phase_post(const P& p, int layer) {
  const int nb = gridDim.x, bid = blockIdx.x, tid = tid_of(p.ph_lo), lane = tid & 63, wave = wave_of(tid);
  const u16* yout = (const u16*)(p.ws + WS_Z); const float* xold = layer == 0 ? p.x : p.out;
  u16* hb = (u16*)(p.ws + WS_HY);
  for (int row = bid * 8 + wave; row < S; row += nb * 16) {
    const int row2 = row + nb * 8; const bool has2 = row2 < S;
    f32x4 y0[4], x0[4], y1[4], x1[4];
    post_load(yout, xold, row, lane, y0, x0);
    if (has2) post_load(yout, xold, row2, lane, y1, x1);
    post_finish(p, layer, row, lane, y0, x0, hb);
    if (has2) post_finish(p, layer, row2, lane, y1, x1, hb);
  }
}

__global__ void __launch_bounds__(NT) mega(P p0) {
  const P& p = p0;
  extern __shared__ __attribute__((aligned(16))) unsigned char lds[];
  cg::grid_group grid = cg::this_grid();
  const int nb = gridDim.x, bid = blockIdx.x;
  const int wv0 = __builtin_amdgcn_readfirstlane((int)(threadIdx.x >> 6));
  if (threadIdx.x < 4) ((unsigned*)(lds + XB_LDS_OFF))[threadIdx.x] = 0u;
  __syncthreads();
  XcdBarrier xbar = xcd_barrier_post((unsigned*)(p.ws + WS_BAR), (volatile LAS unsigned*)(lds + XB_LDS_OFF)); xbar.wv = wv0;
  unsigned* xcnt = (unsigned*)(p.ws + WS_BAR + 14336);
  unsigned myslot = 0;
  if (threadIdx.x == 0) myslot = xb_add(&xcnt[16 * xbar.x], 1u);
  int vid = bid;
#define RUN(ph_) true
#define SEAM(ph_) do { if (p.ph_hi < 0) grid.sync(); else xcd_barrier(xbar); } while (0)
  if (RUN(ph)) phase_prep(lds, p, wv0);
  SEAM(0);
  {
    if (threadIdx.x == 0) { bool even = (nb & 7) == 0; for (int j = 0; j < 8; ++j) even = even && (xb_ld(&xcnt[16 * j]) == (unsigned)(nb >> 3));
      ((volatile LAS unsigned*)(lds + XB_LDS_OFF))[2] = even ? (myslot * 8u + xbar.x) : (unsigned)bid; }
    __syncthreads();
    vid = __builtin_amdgcn_readfirstlane((int)((volatile LAS unsigned*)(lds + XB_LDS_OFF))[2]);
  }
#pragma unroll 1
  for (int layer = 0; layer < DEPTH; ++layer) {
    P pl = p0; pl.ph_lo = wv0;
    u16* hy = (u16*)(pl.ws + WS_HY); u16* z = (u16*)(pl.ws + WS_Z);
    float* rs = (float*)(lds + RS_OFF);
    if (RUN(ph)) {
      const u16* W = (const u16*)(pl.ws + WS_WIN) + (size_t)layer * 2560 * 1024;
      { pg8::Gemm g{hy, W, S, 2560, 1024, 1024}; pg8::StaticOrder so; so.init(S, 2560, nb, vid);
        pg8::EpiBf16<0> E{z, ZLD, nullptr, 0, 0};
        pg8::gemm_phase<pg8::EpiBf16<0>, pg8::StaticOrder, false>((PG8_LAS unsigned char*)lds, g, so, E, nullptr, pl.ph_lo); }
      if (layer == 0 && vid >= 128) { __syncthreads(); prep_weights(lds, pl, 1, vid - 128, 128, pl.ph_lo); }
    }
    SEAM(0);
    if (RUN(ph)) {
      const float* cosT = (const float*)(pl.ws + WS_COS); const float* sinT = (const float*)(pl.ws + WS_SIN);
      {
        pg8::StaticOrder so; pg8::Unit u;
        so.init(S, 768, nb, vid);
        if (so.next(0, u)) row_rstd256(rs, z + (size_t)u.pm * 256 * ZLD + Z_CQ, ZLD, 384, pl.ph_lo);
        __syncthreads();
        { pg8::Gemm g{z + Z_CQ, (const u16*)(pl.ws + WS_WUQ) + (size_t)layer * 768 * 384, S, 768, 384, ZLD}; EpiQ2 E{(u16*)(pl.ws + WS_Q), (const PG8_LAS float*)(lds + RS_OFF)};
          pg8::gemm_phase<EpiQ2, pg8::StaticOrder, false>((PG8_LAS unsigned char*)lds, g, so, E, nullptr, pl.ph_lo); }
        __syncthreads();
        so.init(S, 1024, nb, vid);
        if (so.next(0, u)) row_rstd256(rs, z + (size_t)u.pm * 256 * ZLD + Z_CKV, ZLD, 256, pl.ph_lo);
        __syncthreads();
        { pg8::Gemm g{z + Z_CKV, (const u16*)(pl.ws + WS_WUKV) + (size_t)layer * 1024 * 256, S, 1024, 256, ZLD}; EpiKV2 E{(u16*)(pl.ws + WS_K), (u16*)(pl.ws + WS_VT), (const PG8_LAS float*)(lds + RS_OFF)};
          pg8::gemm_phase<EpiKV2, pg8::StaticOrder, false>((PG8_LAS unsigned char*)lds, g, so, E, nullptr, pl.ph_lo); }
        if (vid < 128) krope_tile(pl, vid * 128);
        __syncthreads();
        if (vid < 128) sgu_job(lds, pl, layer, vid); else pool_job(lds, pl, layer, vid - 128);
      }
    }
    SEAM(0);
    if (RUN(ph)) {
      const int hd = (vid & 7) >> 1, role = vid & 1, B = vid >> 3, QL = 63 - B, ntL = 4 * QL + 4;
      unsigned char* part = pl.ws + WS_PART + (size_t)vid * PART_BYTES;
      if (role == 0) attn2_item(lds, pl, hd, QL, 0, 130, part);
      else { attn2_item(lds, pl, hd, QL, 130, ntL, part); attn2_item(lds, pl, hd, B, 0, 4 * B + 4, nullptr); }
    }
    SEAM(0);
    attn2_combine(pl, vid);
    SEAM(0);
    if (RUN(ph)) {
      const u16* W = (const u16*)(pl.ws + WS_WOUT) + (size_t)layer * 1024 * 1024;
      { pg8::Gemm g{hy, W, S, 1024, 1024, 1024}; pg8::StaticOrder so; so.init(S, 1024, nb, vid);
        pg8::EpiBf16<0> E{(u16*)(pl.ws + WS_Z), 1024, nullptr, 0, 0};
        pg8::gemm_phase<pg8::EpiBf16<0>, pg8::StaticOrder, false>((PG8_LAS unsigned char*)lds, g, so, E, nullptr, pl.ph_lo); }
    }
    SEAM(0);
    if (RUN(ph)) phase_post(pl, layer);
    SEAM(0);
  }
  xcd_barrier(xbar);
}
constexpr int NPHASE = 1 + 5 * DEPTH;

extern "C" void kernel_launch(void* const* d_in, const int* in_sizes, int n_in, void* d_out, int out_size, void* d_ws, size_t ws_size, hipStream_t stream) {
  static int grid_blocks = 0;
  if (!grid_blocks) {
    int dev = 0, cus = 0, per_cu = 0;
    hipGetDevice(&dev);
    hipDeviceGetAttribute(&cus, hipDeviceAttributeMultiprocessorCount, dev);
    hipFuncSetAttribute((const void*)mega, hipFuncAttributeMaxDynamicSharedMemorySize, LDS_BYTES);
    hipOccupancyMaxActiveBlocksPerMultiprocessor(&per_cu, (const void*)mega, NT, LDS_BYTES);
    if (per_cu < 1) { fprintf(stderr, "occupancy query returned %d\n", per_cu); per_cu = 1; }
    if (per_cu > 1) per_cu = 1;
    grid_blocks = 256;
    if (cus * per_cu < 256) fprintf(stderr, "device offers %d co-resident workgroups, 256 needed\n", cus * per_cu);
    if (ws_size < WS_END) fprintf(stderr, "workspace too small: %zu < %zu\n", ws_size, (size_t)WS_END);
  }
  P p{};
  p.x = (const float*)d_in[0]; p.pos = (const int*)d_in[1]; p.pre_g = (const float*)d_in[2]; p.post_g = (const float*)d_in[3];
  p.w_in = (const float*)d_in[4]; p.sgu_w = (const float*)d_in[5]; p.sgu_b = (const float*)d_in[6]; p.sgu_ln_g = (const float*)d_in[7];
  p.sgu_ln_b = (const float*)d_in[8]; p.pool_w = (const float*)d_in[9]; p.pool_scale = (const float*)d_in[10]; p.q_norm_g = (const float*)d_in[11];
  p.w_uq = (const float*)d_in[12]; p.kv_norm_g = (const float*)d_in[13]; p.w_ukv = (const float*)d_in[14]; p.w_out = (const float*)d_in[15];
  p.out = (float*)d_out; p.ws = (unsigned char*)d_ws;
  for (int i = 0; i < 32; ++i) p.invfreq[i] = powf(10000.0f, -(float)(2 * i) / 64.0f);
  hipMemsetAsync((char*)d_ws + WS_BAR, 0, 16384, stream);
  p.ph_lo = 0; p.ph_hi = NPHASE;
  void* args[] = {&p};
  hipError_t e = hipLaunchCooperativeKernel((void*)mega, dim3(grid_blocks), dim3(NT), args, LDS_BYTES, stream);
  if (e != hipSuccess) fprintf(stderr, "cooperative launch failed: %s (grid %d)\n", hipGetErrorString(e), grid_blocks);

}
```

```cpp
#include <hip/hip_runtime.h>
#include <hip/hip_cooperative_groups.h>
#include <cstdio>
#include <cmath>
namespace cg = cooperative_groups;

#define DI __device__ __forceinline__
typedef unsigned short u16;
using bf16x8 = __attribute__((ext_vector_type(8))) short;
using f32x16 = __attribute__((ext_vector_type(16))) float;
using f32x4  = __attribute__((ext_vector_type(4))) float;
using f32x2  = __attribute__((ext_vector_type(2))) float;
using u32x4  = __attribute__((ext_vector_type(4))) unsigned;
using u32x2  = __attribute__((ext_vector_type(2))) unsigned;
typedef __bf16 bf2_t __attribute__((ext_vector_type(2)));
#define MFMA(a, b, c) __builtin_amdgcn_mfma_f32_32x32x16_bf16((a), (b), (c), 0, 0, 0)

#ifndef COOP
#define COOP 1
#endif
#ifndef DUP
#define DUP 7
#endif

constexpr int S = 16384, DM = 1024, DIN = 2496, ZLD = 2560, NT = 512, DEPTH = 2;
constexpr float EPS = 1e-6f;
constexpr float QSCALE = 0.07216878364870322f * 1.4426950408889634f;
constexpr int Z_U = 0, Z_V = 256, Z_SG = 512, Z_PI = 768, Z_PG = 1024, Z_CQ = 1280, Z_CKV = 1664, Z_KR = 1920, Z_MG = 1984;

constexpr size_t WS_HY   = 0;
constexpr size_t WS_Z    = WS_HY + (size_t)S * 1024 * 2;
constexpr size_t WS_Q    = WS_Z + (size_t)S * ZLD * 2;
constexpr size_t WS_K    = WS_Q + (size_t)4 * S * 192 * 2;
constexpr size_t WS_VT   = WS_K + (size_t)4 * S * 192 * 2;
constexpr size_t WS_WIN  = WS_VT + (size_t)4 * S * 128 * 2;
constexpr size_t WS_WUQ  = WS_WIN + (size_t)2 * 2560 * 1024 * 2;
constexpr size_t WS_WUKV = WS_WUQ + (size_t)2 * 768 * 384 * 2;
constexpr size_t WS_WOUT = WS_WUKV + (size_t)2 * 1024 * 256 * 2;
constexpr size_t WS_SGUW = WS_WOUT + (size_t)2 * 1024 * 1024 * 2;
constexpr size_t WS_PWT  = WS_SGUW + (size_t)2 * 4 * 128 * 128 * 2;
constexpr size_t WS_COS  = WS_PWT + (size_t)2 * 4 * 64 * 64 * 2;
constexpr size_t WS_SIN  = WS_COS + (size_t)S * 32 * 4;
constexpr size_t WS_BAR  = WS_SIN + (size_t)S * 32 * 4;
constexpr size_t WS_PART = WS_BAR + 16384;
constexpr size_t PART_BYTES = 8 * 64 * 64 * 4 + 2 * 8 * 64 * 4;
constexpr size_t WS_END  = WS_PART + 256 * PART_BYTES;

constexpr int GEMM_STAGE = 512 * 144;
constexpr int RS_OFF = 2 * GEMM_STAGE;
constexpr int XB_LDS_OFF = RS_OFF + 1024;
constexpr int LDS_BYTES = XB_LDS_OFF + 16;
constexpr int ATT_STAGE = 64 * 400 + 128 * 144;

struct P {
  const float* x; const int* pos; const float* pre_g; const float* post_g; const float* w_in; const float* sgu_w; const float* sgu_b;
  const float* sgu_ln_g; const float* sgu_ln_b; const float* pool_w; const float* pool_scale; const float* q_norm_g; const float* w_uq;
  const float* kv_norm_g; const float* w_ukv; const float* w_out;
  float* out; unsigned char* ws;
  float invfreq[32];
  int ph_lo, ph_hi;
};

DI int otid() { int t = threadIdx.x; asm volatile("" : "+v"(t)); return t; }
DI int wave_of(int tid) { return __builtin_amdgcn_readfirstlane(tid >> 6); }
DI void lds_barrier() { asm volatile("s_waitcnt lgkmcnt(0)" ::: "memory"); __builtin_amdgcn_s_barrier(); asm volatile("" ::: "memory"); }
DI unsigned pack2(float a, float b) { f32x2 v = {a, b}; return __builtin_bit_cast(unsigned, __builtin_convertvector(v, bf2_t)); }
DI u16 tobf(float a) { return (u16)(pack2(a, 0.f) & 0xffffu); }
DI float bflo(unsigned u) { return __uint_as_float(u << 16); }
DI float bfhi(unsigned u) { return __uint_as_float(u & 0xffff0000u); }
DI float silu(float x) { return x / (1.f + __expf(-x)); }
DI float ex2(float x) { return __builtin_amdgcn_exp2f(x); }
DI f32x16 zero16() { f32x16 z; for (int i = 0; i < 16; ++i) z[i] = 0.f; return z; }

DI int lane_now() { int l; asm volatile("v_mbcnt_lo_u32_b32 %0, -1, 0\n\tv_mbcnt_hi_u32_b32 %0, -1, %0" : "=v"(l)); return l; }
DI int tid_of(int wv) { return wv * 64 + lane_now(); }
DI float shx(float v, int mask) { return __int_as_float(__builtin_amdgcn_ds_bpermute((lane_now() ^ mask) << 2, __float_as_int(v))); }
#define XB_TMO      128
#define XB_XCNT(j)  (256  + 64 * (j))
#define XB_XSUB(j)  (1280 + 64 * (j))
#define XB_XGEN(j)  (2304 + 64 * (j))
#define XB_TOP      3328
#define XB_TOPGEN   3392
#define XCD_BAR_WORDS 3456
#define XB_SPIN_CAP (1u << 18)
#define LAS __attribute__((address_space(3)))

__device__ __forceinline__ unsigned xb_ld(unsigned* p)              { return __hip_atomic_load(p, __ATOMIC_RELAXED, __HIP_MEMORY_SCOPE_AGENT); }
__device__ __forceinline__ unsigned xb_add(unsigned* p, unsigned v) { return __hip_atomic_fetch_add(p, v, __ATOMIC_RELAXED, __HIP_MEMORY_SCOPE_AGENT); }
__device__ __forceinline__ unsigned xb_xcc_id() { return (unsigned)__builtin_amdgcn_s_getreg((3 << 11) | 20) & 0xFu; }
#define XB_SPIN(cond, bar) do { unsigned _sp = 0; while (cond) { __builtin_amdgcn_s_sleep(1); \
    if ((++_sp & 255u) == 0u) { if (xb_ld(&(bar)[XB_TMO])) break; if (_sp > XB_SPIN_CAP) { atomicAdd(&(bar)[XB_TMO], 1u); break; } } } } while (0)

struct XcdBarrier {
    unsigned* bar; unsigned x; int wv;
    volatile LAS unsigned* st;
};

__device__ __forceinline__ XcdBarrier xcd_barrier_post(unsigned* bar, volatile LAS unsigned* st) {
    XcdBarrier b; b.bar = bar; b.x = xb_xcc_id(); b.st = st;
    if (threadIdx.x == 0) (void)xb_add(&bar[XB_XCNT(b.x)], 1u);
    return b;
}
__device__ __forceinline__ void xcd_barrier_complete(unsigned* bar, unsigned x, unsigned& nloc, unsigned& nx) {
    const unsigned G = gridDim.x * gridDim.y * gridDim.z;
    unsigned sum, cnt, mine, sp = 0u;
    for (;;) {
        sum = 0u; cnt = 0u; mine = 0u;
#pragma unroll
        for (unsigned j = 0; j < 16; ++j) { const unsigned c = xb_ld(&bar[XB_XCNT(j)]); sum += c; cnt += (c > 0u) ? 1u : 0u; mine = (j == x) ? c : mine; }
        if (sum == G) break;
        __builtin_amdgcn_s_sleep(1);
        if ((++sp & 255u) == 0u) { if (xb_ld(&bar[XB_TMO])) break; if (sp > XB_SPIN_CAP) { atomicAdd(&bar[XB_TMO], 1u); break; } }
    }
    nloc = mine > 0u ? mine : 1u; nx = cnt > 0u ? cnt : 1u;
}

__device__ __forceinline__ void xcd_barrier(const XcdBarrier& b) {
    asm volatile("s_waitcnt vmcnt(0)" ::: "memory");
    __syncthreads();
    if (b.wv == 0 && lane_now() == 0) {
        unsigned* bar = b.bar;
        __builtin_amdgcn_s_waitcnt(0);
        unsigned nloc = b.st[0], nx = b.st[1];
        if (nloc == 0u) { xcd_barrier_complete(bar, b.x, nloc, nx); b.st[0] = nloc; b.st[1] = nx; }
        const unsigned old = xb_add(&bar[XB_XSUB(b.x)], 1u);
        const unsigned gen = old / nloc;
        if (old + 1u == (gen + 1u) * nloc) {
            __builtin_amdgcn_fence(__ATOMIC_RELEASE, "agent");
            asm volatile("s_waitcnt vmcnt(0)" ::: "memory");
            const unsigned og = xb_add(&bar[XB_TOP], 1u);
            const unsigned tg = og / nx;
            if (og + 1u == (tg + 1u) * nx) xb_add(&bar[XB_TOPGEN], 1u);
            else XB_SPIN(xb_ld(&bar[XB_TOPGEN]) == tg, bar);
            __builtin_amdgcn_fence(__ATOMIC_ACQUIRE, "agent");
            xb_add(&bar[XB_XGEN(b.x)], 1u);
            asm volatile("s_waitcnt vmcnt(0)" ::: "memory");
        } else {
            XB_SPIN(xb_ld(&bar[XB_XGEN(b.x)]) == gen, bar);
            __builtin_amdgcn_fence(__ATOMIC_ACQUIRE, "agent");
            asm volatile("s_waitcnt vmcnt(0)" ::: "memory");
        }
    }
    __syncthreads();
}


namespace pg8 {
#define PG8_LAS __attribute__((address_space(3)))
typedef unsigned short bf16_t;
typedef short bf16x8 __attribute__((ext_vector_type(8)));
typedef float f32x4 __attribute__((ext_vector_type(4)));
typedef unsigned u32x4 __attribute__((ext_vector_type(4)));
constexpr int BM = 256, BK = 64, HALF = 128, HTB = HALF * BK * 2  , STAGE_BYTES = 8 * HTB, NXCD = 8, WGM = 8;

__host__ __device__ __forceinline__ int lds_byte(int r, int c) { const int st = (r >> 4) * 2 + (c >> 5), rr = r & 15, cc = c & 31, ob = rr * 64 + cc * 2; return st * 1024 + (ob ^ (((ob >> 9) & 1) << 5)); }
__host__ __device__ __forceinline__ void stage_rc(int b, int& R, int& C) { const int st = b / 1024, sb = b % 1024, swz = sb ^ (((sb >> 9) & 1) << 5); R = (st >> 1) * 16 + swz / 64; C = (st & 1) * 32 + (swz % 64) / 2; }
__host__ __device__ __forceinline__ int perm32(int rho) { const int n = rho >> 4, i = rho & 15; return 8 * (i >> 2) + 4 * n + (i & 3); }

struct Unit { int pm, pn; };
struct Gemm { const bf16_t* A; const bf16_t* Bt; int M, N, K, lda; };

struct StaticOrder {
    int nM, nN, nwg, G, c;
    __host__ __device__ __forceinline__ void init(int M, int N, int G_, int c_) { nM = M / BM; nN = N / BM; nwg = nM * nN; G = G_; c = c_; }
    __host__ __device__ __forceinline__ bool next(int i, Unit& u) const {
        const long L = (long)i * G + c; if (L >= nwg) return false;
        int wgid = (int)L; { const int q = nwg / NXCD, r = nwg % NXCD, xcd = wgid % NXCD, off = wgid / NXCD; wgid = (xcd < r ? xcd * (q + 1) : r * (q + 1) + (xcd - r) * q) + off; }
        const int nig = WGM * nN, gid = wgid / nig, fm = gid * WGM, gsz = (nM - fm) < WGM ? (nM - fm) : WGM;
        u.pm = fm + ((wgid % nig) % gsz); u.pn = (wgid % nig) / gsz; return true;
    }
    __device__ __forceinline__ void a_ready(const Unit&) const {}
    __device__ __forceinline__ void done(const Unit&) const {}
};
__device__ __forceinline__ unsigned cvt_pk_bf16(float lo, float hi) { unsigned r; asm volatile("v_cvt_pk_bf16_f32 %0, %1, %2" : "=v"(r) : "v"(lo), "v"(hi)); return r; }
typedef float f32x2 __attribute__((ext_vector_type(2)));
__device__ __forceinline__ f32x2 gelu_pk(f32x2 v) {
    const f32x2 av = __builtin_elementwise_abs(v), d = av * 0.2316418882f + 1.0f;
    f32x2 t; t.x = __builtin_amdgcn_rcpf(d.x); t.y = __builtin_amdgcn_rcpf(d.y);
    f32x2 q = t * 0.5307027145f + (-0.7265760135f); q = q * t + 0.7107068705f; q = q * t + (-0.142248368f); q = q * t + 0.127414796f; q = q * t;
    const f32x2 s = (v * v) * (-0.72134752044f);
    f32x2 e; e.x = __builtin_amdgcn_exp2f(s.x); e.y = __builtin_amdgcn_exp2f(s.y);
    const f32x2 m = v * (q * e), r = v - m;
    f32x2 o; o.x = v.x < 0.f ? m.x : r.x; o.y = v.y < 0.f ? m.y : r.y; return o;
}

template <int ACT  > struct EpiBf16 {
    static constexpr bool PERM = true, AFTER_DRAIN = false;
    bf16_t* O; int ldc; const float* bias; int split_cols; size_t split_stride;
    __device__ __forceinline__ void operator()(const f32x4 (&acc)[2][2][4][2], const Unit& u, int wr, int wc, int fr, int fq) const {
        const int row0 = u.pm * BM + wr * 64 + fr; int colt = u.pn * BM; bf16_t* base = O;
        if (split_cols) { const int t = colt / split_cols; base += (size_t)t * split_stride; colt -= t * split_cols; }
        const int col0 = colt + wc * 32 + 8 * fq, bcol0 = u.pn * BM + wc * 32 + 8 * fq;
        f32x4 bv[2][2];
#pragma unroll
        for (int bj = 0; bj < 2; ++bj)
#pragma unroll
            for (int n = 0; n < 2; ++n) bv[bj][n] = bias ? *(const f32x4*)(bias + bcol0 + bj * HALF + 4 * n) : (f32x4){0.f, 0.f, 0.f, 0.f};
#pragma unroll
        for (int ai = 0; ai < 2; ++ai)
#pragma unroll
            for (int m = 0; m < 4; ++m) { bf16_t* rowp = base + (size_t)(row0 + ai * HALF + m * 16) * ldc + col0;
#pragma unroll
                for (int bj = 0; bj < 2; ++bj) { f32x4 v0 = acc[ai][bj][m][0] + bv[bj][0], v1 = acc[ai][bj][m][1] + bv[bj][1];
                    if (ACT == 1) { f32x2 a = gelu_pk((f32x2){v0[0], v0[1]}), b = gelu_pk((f32x2){v0[2], v0[3]}), c = gelu_pk((f32x2){v1[0], v1[1]}), d = gelu_pk((f32x2){v1[2], v1[3]});
                        v0 = (f32x4){a.x, a.y, b.x, b.y}; v1 = (f32x4){c.x, c.y, d.x, d.y}; }
                    if (ACT == 2) {
#pragma unroll
                        for (int j = 0; j < 4; ++j) { v0[j] = 0.5f * v0[j] * (1.0f + erff(v0[j] * 0.70710678f)); v1[j] = 0.5f * v1[j] * (1.0f + erff(v1[j] * 0.70710678f)); } }
                    u32x4 w; w.x = cvt_pk_bf16(v0[0], v0[1]); w.y = cvt_pk_bf16(v0[2], v0[3]); w.z = cvt_pk_bf16(v1[0], v1[1]); w.w = cvt_pk_bf16(v1[2], v1[3]);
                    *(u32x4*)(rowp + bj * HALF) = w; } }
    }
};

template <class Epi, class Sched, bool STAMP = false>
__device__ __forceinline__ void gemm_phase(PG8_LAS unsigned char* lds, const Gemm g, const Sched& S, const Epi& E, unsigned long long* stamps, int wv) {
    const int tid = tid_of(wv), wid = __builtin_amdgcn_readfirstlane(tid >> 6), lane = tid & 63, wr = wid >> 2, wc = wid & 3, fr = lane & 15, fq = lane >> 4;
    const int K = g.K, nt = K / BK;
    int ts_lo = 0, ts_hi = 0, nts = 0; const unsigned long long rt_entry = STAMP ? (unsigned long long)wall_clock64() : 0ull;
#define PG8_STAMP() do { if (STAMP && wid == 0 && nts < 64) { const unsigned long long _c = (unsigned long long)clock64(); \
        ts_lo = (lane == nts) ? (int)(unsigned)_c : ts_lo; ts_hi = (lane == nts) ? (int)(unsigned)(_c >> 32) : ts_hi; ++nts; } } while (0)
    PG8_STAMP();
    unsigned voffA[2], voffB[2];
#pragma unroll
    for (int i = 0; i < 2; ++i) { int R, C; stage_rc(tid * 16 + i * 8192, R, C); const int Rb = Epi::PERM ? ((R & ~31) + perm32(R & 31)) : R;
        voffA[i] = (unsigned)(R * g.lda + C) * 2u; voffB[i] = (unsigned)(Rb * K + C) * 2u; }
    const size_t kstep = (size_t)(BK * 2);
    const size_t hstep = (size_t)HALF * K * 2;
    const size_t tstep = 2 * hstep;
    const size_t hstepA = (size_t)HALF * g.lda * 2, tstepA = 2 * hstepA;
    const unsigned ldsw = (unsigned)wid * 1024u;
    const int aoff = lds_byte(wr * 64 + fr, fq * 8), boff = lds_byte(wc * 32 + fr, fq * 8);
#define PG8_SA(b, h) (((b) * 2 + (h)) * HTB)
#define PG8_SB(b, h) ((4 + (b) * 2 + (h)) * HTB)
#define PG8_STAGE(bufoff, gbase, voff) do { _Pragma("unroll") for (int _i = 0; _i < 2; ++_i) \
        __builtin_amdgcn_global_load_lds((const unsigned*)((const char*)(gbase) + (voff)[_i]), (PG8_LAS unsigned*)(lds + (bufoff) + ldsw + _i * 8192), 16, 0, 0); } while (0)
#define PG8_LDA(dst, b, h) do { _Pragma("unroll") for (int m = 0; m < 4; ++m) _Pragma("unroll") for (int k = 0; k < 2; ++k) dst[m][k] = *(const PG8_LAS bf16x8*)(lds + PG8_SA(b, h) + aoff + m * 2048 + k * 1024); } while (0)
#define PG8_LDB(dst, b, h) do { _Pragma("unroll") for (int n = 0; n < 2; ++n) _Pragma("unroll") for (int k = 0; k < 2; ++k) dst[n][k] = *(const PG8_LAS bf16x8*)(lds + PG8_SB(b, h) + boff + n * 2048 + k * 1024); } while (0)
#define PG8_MMA(ai, bj, At, Bt) do { __builtin_amdgcn_s_setprio(1); _Pragma("unroll") for (int m = 0; m < 4; ++m) _Pragma("unroll") for (int n = 0; n < 2; ++n) _Pragma("unroll") for (int k = 0; k < 2; ++k) \
        acc[ai][bj][m][n] = __builtin_amdgcn_mfma_f32_16x16x32_bf16(Bt[n][k], At[m][k], acc[ai][bj][m][n], 0, 0, 0); __builtin_amdgcn_s_setprio(0); } while (0)
#define PG8_WAIT_V(n) asm volatile("s_waitcnt vmcnt(" #n ")" ::: "memory")
#define PG8_WAIT_L(n) asm volatile("s_waitcnt lgkmcnt(" #n ")" ::: "memory")
#define PG8_BAR __builtin_amdgcn_s_barrier()
#define PG8_SCHED __builtin_amdgcn_sched_barrier(0)
    Unit cur, nxt; int ui = 0;
    if (!S.next(0, cur)) return;
    f32x4 acc[2][2][4][2];
#pragma unroll
    for (int a = 0; a < 2; ++a)
#pragma unroll
        for (int b = 0; b < 2; ++b)
#pragma unroll
            for (int m = 0; m < 4; ++m)
#pragma unroll
                for (int n = 0; n < 2; ++n) acc[a][b][m][n] = (f32x4){0.f, 0.f, 0.f, 0.f};
    bf16x8 At[4][2], B0[2][2], B1[2][2];
    const char* cA = (const char*)g.A + (size_t)cur.pm * tstepA; const char* cB = (const char*)g.Bt + (size_t)cur.pn * tstep;
    S.a_ready(cur);
    PG8_STAGE(PG8_SB(0, 0), cB, voffB); PG8_STAGE(PG8_SA(0, 0), cA, voffA); PG8_STAGE(PG8_SB(0, 1), cB + hstep, voffB); PG8_STAGE(PG8_SA(0, 1), cA + hstepA, voffA);
    if (wr == 1) PG8_BAR;
    PG8_WAIT_V(4); PG8_BAR;
    PG8_STAGE(PG8_SB(1, 0), cB + kstep, voffB); PG8_STAGE(PG8_SA(1, 0), cA + kstep, voffA); PG8_STAGE(PG8_SB(1, 1), cB + hstep + kstep, voffB);
    PG8_WAIT_V(6); PG8_BAR;
    PG8_STAMP();
    for (;;) {
        const bool has_next = S.next(ui + 1, nxt);
        const char* nA = has_next ? (const char*)g.A + (size_t)nxt.pm * tstepA : cA; const char* nB = has_next ? (const char*)g.Bt + (size_t)nxt.pn * tstep : cB;
        for (int t = 0; t < nt; t += 2) {
            const bool last = (t == nt - 2);
            const char* a1 = cA + (size_t)(t + 1) * kstep;
            const char* a2 = last ? nA : cA + (size_t)(t + 2) * kstep; const char* b2 = last ? nB : cB + (size_t)(t + 2) * kstep;
            const char* a3 = a2 + kstep; const char* b3 = b2 + kstep;
            if (last && has_next) S.a_ready(nxt);
            PG8_LDB(B0, 0, 0); PG8_SCHED; PG8_LDA(At, 0, 0); PG8_STAGE(PG8_SA(1, 1), a1 + hstepA, voffA);
            PG8_WAIT_L(8); PG8_BAR; PG8_WAIT_L(0); PG8_MMA(0, 0, At, B0); PG8_BAR; PG8_SCHED;
            PG8_LDB(B1, 0, 1); PG8_STAGE(PG8_SB(0, 0), b2, voffB);
            PG8_BAR; PG8_WAIT_L(0); PG8_MMA(0, 1, At, B1); PG8_BAR;
            PG8_LDA(At, 0, 1); PG8_STAGE(PG8_SA(0, 0), a2, voffA);
            PG8_BAR; PG8_WAIT_L(0); PG8_MMA(1, 0, At, B0); PG8_BAR; PG8_SCHED;
            PG8_STAGE(PG8_SB(0, 1), b2 + hstep, voffB);
            PG8_WAIT_V(6); PG8_BAR; PG8_MMA(1, 1, At, B1); PG8_BAR;
            PG8_LDB(B0, 1, 0); PG8_SCHED; PG8_LDA(At, 1, 0); PG8_STAGE(PG8_SA(0, 1), a2 + hstepA, voffA);
            PG8_WAIT_L(8); PG8_BAR; PG8_WAIT_L(0); PG8_MMA(0, 0, At, B0); PG8_BAR; PG8_SCHED;
            PG8_LDB(B1, 1, 1); PG8_STAGE(PG8_SB(1, 0), b3, voffB);
            PG8_BAR; PG8_WAIT_L(0); PG8_MMA(0, 1, At, B1); PG8_BAR;
            PG8_LDA(At, 1, 1); PG8_STAGE(PG8_SA(1, 0), a3, voffA);
            PG8_BAR; PG8_WAIT_L(0); PG8_MMA(1, 0, At, B0); PG8_BAR; PG8_SCHED;
            PG8_STAGE(PG8_SB(1, 1), b3 + hstep, voffB);
            PG8_WAIT_V(6); PG8_BAR; PG8_MMA(1, 1, At, B1); PG8_BAR;
        }
        PG8_STAMP();
        if constexpr (!Epi::AFTER_DRAIN) { E(acc, cur, wr, wc, fr, fq); S.done(cur); }
        PG8_STAMP();
        if (!has_next) break;
#pragma unroll
        for (int a = 0; a < 2; ++a)
#pragma unroll
            for (int b = 0; b < 2; ++b)
#pragma unroll
                for (int m = 0; m < 4; ++m)
#pragma unroll
                    for (int n = 0; n < 2; ++n) acc[a][b][m][n] = (f32x4){0.f, 0.f, 0.f, 0.f};
        cur = nxt; cA = nA; cB = nB; ++ui;
    }
    PG8_WAIT_V(0);
    if (wr == 0) PG8_BAR;
    PG8_BAR;
    if constexpr (Epi::AFTER_DRAIN) { E.fused(acc, cur, wr, wc, fr, fq, lds, wid, lane); S.done(cur); }
    PG8_STAMP();
    if (STAMP && wid == 0) { stamps[lane] = lane < nts ? (((unsigned long long)(unsigned)ts_hi << 32) | (unsigned)ts_lo) : 0ull;
        if (lane == 62) stamps[62] = rt_entry; if (lane == 63) stamps[63] = (unsigned long long)wall_clock64(); }
#undef PG8_STAMP
#undef PG8_SA
#undef PG8_SB
#undef PG8_STAGE
#undef PG8_LDA
#undef PG8_LDB
#undef PG8_MMA
#undef PG8_WAIT_V
#undef PG8_WAIT_L
#undef PG8_BAR
#undef PG8_SCHED
}
}
template <int NTW, class Epi>
DI void gemm_tile(unsigned char* lds, const u16* __restrict__ A, const u16* __restrict__ X, int ldx, int K, int m0, int n0, Epi& epi) {
  const int tid = otid(), lane = tid & 63, wave = wave_of(tid);
  const int wm = wave & 3, wn = wave >> 2, l32 = lane & 31, h = lane >> 5;
  f32x16 acc[2][NTW];
#pragma unroll
  for (int i = 0; i < 2; ++i)
#pragma unroll
    for (int j = 0; j < NTW; ++j) acc[i][j] = zero16();
  const int nk = K >> 6;
  const int lrow = tid >> 3, lcol = tid & 7;
  const u16* ga = A + (size_t)lrow * K + lcol * 8;
  const u16* gx = X + (size_t)lrow * ldx + lcol * 8;
  u32x4 ra[4], rb[NTW];
#pragma unroll
  for (int i = 0; i < 4; ++i) ra[i] = *(const u32x4*)(ga + (size_t)i * 64 * K);
#pragma unroll
  for (int i = 0; i < NTW; ++i) rb[i] = *(const u32x4*)(gx + (size_t)i * 64 * ldx);
  {
    unsigned char* as = lds; unsigned char* bs = lds + 256 * 144;
#pragma unroll
    for (int i = 0; i < 4; ++i) *(u32x4*)(as + (lrow + i * 64) * 144 + lcol * 16) = ra[i];
#pragma unroll
    for (int i = 0; i < NTW; ++i) *(u32x4*)(bs + (lrow + i * 64) * 144 + lcol * 16) = rb[i];
  }
  __syncthreads();
#pragma unroll 1
  for (int ks = 0; ks < nk; ++ks) {
    const bool more = ks + 1 < nk;
    if (more) {
#pragma unroll
      for (int i = 0; i < 4; ++i) ra[i] = *(const u32x4*)(ga + (size_t)i * 64 * K + (ks + 1) * 64);
#pragma unroll
      for (int i = 0; i < NTW; ++i) rb[i] = *(const u32x4*)(gx + (size_t)i * 64 * ldx + (ks + 1) * 64);
    }
    const unsigned char* as = lds + (ks & 1) * GEMM_STAGE + (wm * 64 + l32) * 144 + h * 16;
    const unsigned char* bs = lds + (ks & 1) * GEMM_STAGE + 256 * 144 + (wn * NTW * 32 + l32) * 144 + h * 16;
#pragma unroll
    for (int kk = 0; kk < 4; ++kk) {
      bf16x8 a0 = *(const bf16x8*)(as + kk * 32), a1 = *(const bf16x8*)(as + 32 * 144 + kk * 32);
      bf16x8 b[NTW];
#pragma unroll
      for (int j = 0; j < NTW; ++j) b[j] = *(const bf16x8*)(bs + j * 32 * 144 + kk * 32);
#pragma unroll
      for (int j = 0; j < NTW; ++j) { acc[0][j] = MFMA(a0, b[j], acc[0][j]); acc[1][j] = MFMA(a1, b[j], acc[1][j]); }
    }
    if (more) {
      unsigned char* as2 = lds + ((ks + 1) & 1) * GEMM_STAGE; unsigned char* bs2 = as2 + 256 * 144;
#pragma unroll
      for (int i = 0; i < 4; ++i) *(u32x4*)(as2 + (lrow + i * 64) * 144 + lcol * 16) = ra[i];
#pragma unroll
      for (int i = 0; i < NTW; ++i) *(u32x4*)(bs2 + (lrow + i * 64) * 144 + lcol * 16) = rb[i];
    }
    __syncthreads();
  }
  epi(acc, m0 + wm * 64, n0 + wn * NTW * 32, l32, h);
}

struct EpiZ {
  u16* z;
  template <int NTW> DI void operator()(f32x16 (&acc)[2][NTW], int chb, int tokb, int l32, int h) {
#pragma unroll
    for (int nt = 0; nt < NTW; ++nt) { const int t = tokb + nt * 32 + l32;
#pragma unroll
      for (int mt = 0; mt < 2; ++mt)
#pragma unroll
        for (int q = 0; q < 4; ++q) {
          u32x2 v = {pack2(acc[mt][nt][q * 4], acc[mt][nt][q * 4 + 1]), pack2(acc[mt][nt][q * 4 + 2], acc[mt][nt][q * 4 + 3])};
          *(u32x2*)(z + (size_t)t * ZLD + chb + mt * 32 + q * 8 + h * 4) = v;
        }
    }
  }
};
struct EpiOut {
  u16* y;
  template <int NTW> DI void operator()(f32x16 (&acc)[2][NTW], int chb, int tokb, int l32, int h) {
#pragma unroll
    for (int nt = 0; nt < NTW; ++nt) { const int t = tokb + nt * 32 + l32;
#pragma unroll
      for (int mt = 0; mt < 2; ++mt)
#pragma unroll
        for (int q = 0; q < 4; ++q) {
          u32x2 v = {pack2(acc[mt][nt][q * 4], acc[mt][nt][q * 4 + 1]), pack2(acc[mt][nt][q * 4 + 2], acc[mt][nt][q * 4 + 3])};
          *(u32x2*)(y + (size_t)t * DM + chb + mt * 32 + q * 8 + h * 4) = v;
        }
    }
  }
};
struct EpiQ {
  u16* Q; const float* cosT; const float* sinT; const float* rs; int n0;
  template <int NTW> DI void operator()(f32x16 (&acc)[2][NTW], int chb, int tokb, int l32, int h) {
    const int seg = chb >> 6, head = seg / 3, part = seg - head * 3;
#pragma unroll
    for (int nt = 0; nt < NTW; ++nt) {
      const int t = tokb + nt * 32 + l32; const float r = rs[tokb - n0 + nt * 32 + l32] * QSCALE;
      u16* dst = Q + ((size_t)head * S + t) * 192;
      if (part < 2) {
#pragma unroll
        for (int mt = 0; mt < 2; ++mt)
#pragma unroll
          for (int q = 0; q < 4; ++q) {
            u32x2 v = {pack2(acc[mt][nt][q * 4] * r, acc[mt][nt][q * 4 + 1] * r), pack2(acc[mt][nt][q * 4 + 2] * r, acc[mt][nt][q * 4 + 3] * r)};
            *(u32x2*)(dst + part * 64 + mt * 32 + q * 8 + h * 4) = v;
          }
      } else {
#pragma unroll
        for (int q = 0; q < 4; ++q) {
          const int d = q * 8 + h * 4;
          const f32x4 c = *(const f32x4*)(cosT + (size_t)t * 32 + d), s = *(const f32x4*)(sinT + (size_t)t * 32 + d);
          float o1[4], o2[4];
#pragma unroll
          for (int j = 0; j < 4; ++j) { const float x1 = acc[0][nt][q * 4 + j], x2 = acc[1][nt][q * 4 + j]; o1[j] = (x1 * c[j] - x2 * s[j]) * r; o2[j] = (x2 * c[j] + x1 * s[j]) * r; }
          u32x2 v1 = {pack2(o1[0], o1[1]), pack2(o1[2], o1[3])}, v2 = {pack2(o2[0], o2[1]), pack2(o2[2], o2[3])};
          *(u32x2*)(dst + 128 + d) = v1; *(u32x2*)(dst + 160 + d) = v2;
        }
      }
    }
  }
};
DI int permpos(int k64) { const int kk = k64 & 15; return (k64 & 48) | (((kk >> 2) & 1) * 8 + (kk >> 3) * 4 + (kk & 3)); }
struct EpiKV {
  u16* K; u16* Vt; const float* rs; int n0;
  template <int NTW> DI void operator()(f32x16 (&acc)[2][NTW], int chb, int tokb, int l32, int h) {
    const int seg = chb >> 6, head = seg >> 2, part = seg & 3;
#pragma unroll
    for (int nt = 0; nt < NTW; ++nt) {
      const int t = tokb + nt * 32 + l32; const float r = rs[tokb - n0 + nt * 32 + l32];
      if (part < 2) {
        u16* dst = K + ((size_t)head * S + t) * 192 + part * 64;
#pragma unroll
        for (int mt = 0; mt < 2; ++mt)
#pragma unroll
          for (int q = 0; q < 4; ++q) {
            u32x2 v = {pack2(acc[mt][nt][q * 4] * r, acc[mt][nt][q * 4 + 1] * r), pack2(acc[mt][nt][q * 4 + 2] * r, acc[mt][nt][q * 4 + 3] * r)};
            *(u32x2*)(dst + mt * 32 + q * 8 + h * 4) = v;
          }
      } else {
        u16* dst = Vt + (((size_t)head * (S / 64) + (t >> 6)) * 128 + (part - 2) * 64) * 64 + permpos(t & 63);
#pragma unroll
        for (int mt = 0; mt < 2; ++mt)
#pragma unroll
          for (int i = 0; i < 16; ++i) { const int dv = mt * 32 + (i & 3) + 8 * (i >> 2) + 4 * h; dst[dv * 64] = tobf(acc[mt][nt][i] * r); }
      }
    }
  }
};

struct EpiQ2 {
  static constexpr bool PERM = true, AFTER_DRAIN = false;
  u16* Q; const PG8_LAS float* rs;
  DI void operator()(const pg8::f32x4 (&acc)[2][2][4][2], const pg8::Unit& u, int wr, int wc, int fr, int fq) const {
    asm volatile("" : "+v"(fr), "+v"(fq));
    int cb[2];
#pragma unroll
    for (int bj = 0; bj < 2; ++bj) { const int c0 = u.pn * 256 + bj * 128 + wc * 32 + 8 * fq, head = c0 / 192; cb[bj] = head * (S * 192) + (c0 - head * 192); }
    const int rl0 = wr * 64 + fr; u16* q0 = Q + (size_t)(u.pm * 256 + rl0) * 192; const PG8_LAS float* rs0 = rs + rl0;
#pragma unroll
    for (int ai = 0; ai < 2; ++ai)
#pragma unroll
      for (int m = 0; m < 4; ++m) { const float sc = rs0[ai * 128 + m * 16] * QSCALE; u16* qr = q0 + (ai * 128 + m * 16) * 192;
#pragma unroll
        for (int bj = 0; bj < 2; ++bj) { const pg8::f32x4 v0 = acc[ai][bj][m][0] * sc, v1 = acc[ai][bj][m][1] * sc;
          u32x4 w = {pack2(v0[0], v0[1]), pack2(v0[2], v0[3]), pack2(v1[0], v1[1]), pack2(v1[2], v1[3])};
          *(u32x4*)(qr + cb[bj]) = w; }
        asm volatile("" ::: "memory"); }
  }
};
struct EpiKV2 {
  static constexpr bool PERM = true, AFTER_DRAIN = false;
  u16* K; u16* Vt; const PG8_LAS float* rs;
  DI void operator()(const pg8::f32x4 (&acc)[2][2][4][2], const pg8::Unit& u, int wr, int wc, int fr, int fq) const {
    asm volatile("" : "+v"(fr), "+v"(fq));
    const int head = u.pn, d0 = wc * 32 + 8 * fq, rl0 = wr * 64 + fr;
    u16* k0 = K + ((size_t)head * S + u.pm * 256 + rl0) * 192 + d0; const PG8_LAS float* rs0 = rs + rl0;
    u16* v0p = Vt + (((size_t)head * (S / 64) + u.pm * 4 + wr) * 128 + d0) * 64 + permpos(fr);
#pragma unroll
    for (int ai = 0; ai < 2; ++ai)
#pragma unroll
      for (int m = 0; m < 4; ++m) { const float sc = rs0[ai * 128 + m * 16];
        { const pg8::f32x4 v0 = acc[ai][0][m][0] * sc, v1 = acc[ai][0][m][1] * sc;
          u32x4 w = {pack2(v0[0], v0[1]), pack2(v0[2], v0[3]), pack2(v1[0], v1[1]), pack2(v1[2], v1[3])};
          *(u32x4*)(k0 + (ai * 128 + m * 16) * 192) = w; }
        { const pg8::f32x4 v0 = acc[ai][1][m][0] * sc, v1 = acc[ai][1][m][1] * sc;
          u16* dst = v0p + ai * (2 * 128 * 64) + m * 16;
#pragma unroll
          for (int j = 0; j < 4; ++j) { dst[j * 64] = tobf(v0[j]); dst[(4 + j) * 64] = tobf(v1[j]); } }
        asm volatile("" ::: "memory"); }
  }
};
DI void row_rstd256(float* rs, const u16* X, int ldx, int K, int wv) {
  const int tid = tid_of(wv), tl = tid >> 1, sub = tid & 1;
  const u16* src = X + (size_t)tl * ldx; float ss = 0.f;
  for (int c = sub; c < (K >> 3); c += 2) {
    u32x4 v = *(const u32x4*)(src + c * 8);
#pragma unroll
    for (int j = 0; j < 4; ++j) { const float a = bflo(v[j]), b = bfhi(v[j]); ss += a * a + b * b; }
  }
  ss += shx(ss, 1);
  if (sub == 0) rs[tl] = rsqrtf(ss / (float)K + EPS);
}
DI void row_rstd(float* rs, const u16* X, int ldx, int K) {
  const int tid = otid(), tl = tid >> 2, sub = tid & 3;
  const u16* src = X + (size_t)tl * ldx; float ss = 0.f;
  for (int c = sub; c < (K >> 3); c += 4) {
    u32x4 v = *(const u32x4*)(src + c * 8);
#pragma unroll
    for (int j = 0; j < 4; ++j) { const float a = bflo(v[j]), b = bfhi(v[j]); ss += a * a + b * b; }
  }
  ss += shx(ss, 1); ss += shx(ss, 2);
  if (sub == 0) rs[tl] = rsqrtf(ss / (float)K + EPS);
}

DI void krope_tile(const P& p, int n0) {
  const int tid = tid_of(p.ph_lo), t = n0 + (tid >> 2), i0 = (tid & 3) * 8;
  const u16* z = (const u16*)(p.ws + WS_Z) + (size_t)t * ZLD + Z_KR;
  const float* cosT = (const float*)(p.ws + WS_COS) + (size_t)t * 32 + i0; const float* sinT = (const float*)(p.ws + WS_SIN) + (size_t)t * 32 + i0;
  u32x4 a = *(const u32x4*)(z + i0), b = *(const u32x4*)(z + 32 + i0);
  f32x4 c0 = *(const f32x4*)cosT, c1 = *(const f32x4*)(cosT + 4), s0 = *(const f32x4*)sinT, s1 = *(const f32x4*)(sinT + 4);
  float x1[8], x2[8], c[8], s[8];
#pragma unroll
  for (int j = 0; j < 4; ++j) { x1[2 * j] = bflo(a[j]); x1[2 * j + 1] = bfhi(a[j]); x2[2 * j] = bflo(b[j]); x2[2 * j + 1] = bfhi(b[j]); c[j] = c0[j]; c[4 + j] = c1[j]; s[j] = s0[j]; s[4 + j] = s1[j]; }
  u32x4 o1, o2;
#pragma unroll
  for (int j = 0; j < 4; ++j) {
    o1[j] = pack2(x1[2 * j] * c[2 * j] - x2[2 * j] * s[2 * j], x1[2 * j + 1] * c[2 * j + 1] - x2[2 * j + 1] * s[2 * j + 1]);
    o2[j] = pack2(x2[2 * j] * c[2 * j] + x1[2 * j] * s[2 * j], x2[2 * j + 1] * c[2 * j + 1] + x1[2 * j + 1] * s[2 * j + 1]);
  }
  u16* K = (u16*)(p.ws + WS_K);
#pragma unroll
  for (int hd = 0; hd < 4; ++hd) { u16* dst = K + ((size_t)hd * S + t) * 192 + 128 + i0; *(u32x4*)dst = o1; *(u32x4*)(dst + 32) = o2; }
}

DI void gate_rows(const u16* oT, const u16* z, u16* Y, int n0, int ucol, int gcol, int ycol, const float* scale, int tid) {
  const int cl = (tid & 31) * 8, tk = tid >> 5;
  f32x4 s0 = {1.f, 1.f, 1.f, 1.f}, s1 = s0;
  if (scale) { s0 = *(const f32x4*)(scale + cl); s1 = *(const f32x4*)(scale + cl + 4); }
#pragma unroll
  for (int k = 0; k < 8; ++k) {
    const int i = tk + 16 * k, t = n0 + i;
    const u32x4 mx = *(const u32x4*)(oT + i * 264 + cl), gg = *(const u32x4*)(z + (size_t)t * ZLD + gcol + cl);
    u32x4 uu = {0x3f803f80u, 0x3f803f80u, 0x3f803f80u, 0x3f803f80u};
    if (ucol >= 0) uu = *(const u32x4*)(z + (size_t)t * ZLD + ucol + cl);
    u32x4 o;
#pragma unroll
    for (int j = 0; j < 4; ++j) { const float sa = (j < 2) ? s0[2 * j] : s1[2 * j - 4], sb = (j < 2) ? s0[2 * j + 1] : s1[2 * j - 3];
      o[j] = pack2(bflo(uu[j]) * bflo(mx[j]) * sa * silu(bflo(gg[j])), bfhi(uu[j]) * bfhi(mx[j]) * sb * silu(bfhi(gg[j]))); }
    *(u32x4*)(Y + (size_t)t * DM + ycol + cl) = o;
  }
}
DI void sgu_job(unsigned char* lds, const P& p, int layer, int nb) {
  const int tid = tid_of(p.ph_lo), lane = tid & 63, wave = wave_of(tid);
  const int n0 = nb * 128;
  const u16* z = (const u16*)(p.ws + WS_Z);
  u16* vT = (u16*)lds;
  float* stats = (float*)(lds + 256 * 272);
  const int wm = wave & 3, wn = wave >> 2, l32 = lane & 31, h = lane >> 5;
  const int cp = tid & 127, tg = tid >> 7, c = 2 * cp;
  u32x4 u1[8];
  { const u16* src = z + (size_t)(n0 + (tid >> 2)) * ZLD + Z_V + (tid & 3) * 64;
#pragma unroll
    for (int k = 0; k < 8; ++k) u1[k] = *(const u32x4*)(src + k * 8); }
  unsigned x[32];
  { const u16* src = z + (size_t)(n0 + tg * 32) * ZLD + Z_V + c;
#pragma unroll
    for (int k = 0; k < 32; ++k) x[k] = *(const unsigned*)(src + (size_t)k * ZLD); }
  bf16x8 wb[8][2];
  { const u16* W = (const u16*)(p.ws + WS_SGUW) + (size_t)(layer * 4 + wm) * 128 * 128 + (wn * 64 + l32) * 128 + h * 8;
#pragma unroll
    for (int kk = 0; kk < 8; ++kk) { wb[kk][0] = *(const bf16x8*)(W + kk * 16); wb[kk][1] = *(const bf16x8*)(W + 32 * 128 + kk * 16); } }
  const float g0 = p.sgu_ln_g[layer * 256 + c], g1 = p.sgu_ln_g[layer * 256 + c + 1], b0 = p.sgu_ln_b[layer * 256 + c], b1 = p.sgu_ln_b[layer * 256 + c + 1];
  {
    const int j = tid >> 2, sub = tid & 3;
    float sm = 0.f, sq = 0.f;
#pragma unroll
    for (int k8 = 0; k8 < 8; ++k8)
#pragma unroll
      for (int k = 0; k < 4; ++k) { const float a = bflo(u1[k8][k]), b2 = bfhi(u1[k8][k]); sm += a + b2; sq += a * a + b2 * b2; }
    sm += shx(sm, 1); sm += shx(sm, 2); sq += shx(sq, 1); sq += shx(sq, 2);
    const float mu = sm * (1.f / 256.f), var = fmaxf(sq * (1.f / 256.f) - mu * mu, 0.f);
    if (sub == 0) { stats[2 * j] = mu; stats[2 * j + 1] = rsqrtf(var + EPS); }
  }
  __syncthreads();
  {
#pragma unroll
    for (int o = 0; o < 4; ++o) {
      float y0[8], y1[8];
#pragma unroll
      for (int jj = 0; jj < 8; ++jj) { const f32x2 st = *(const f32x2*)(stats + 2 * (tg * 32 + o * 8 + jj));
        y0[jj] = (bflo(x[o * 8 + jj]) - st[0]) * st[1] * g0 + b0; y1[jj] = (bfhi(x[o * 8 + jj]) - st[0]) * st[1] * g1 + b1; }
      u32x4 w0 = {pack2(y0[0], y0[1]), pack2(y0[2], y0[3]), pack2(y0[4], y0[5]), pack2(y0[6], y0[7])};
      u32x4 w1 = {pack2(y1[0], y1[1]), pack2(y1[2], y1[3]), pack2(y1[4], y1[5]), pack2(y1[6], y1[7])};
      *(u32x4*)(vT + c * 136 + tg * 32 + o * 8) = w0; *(u32x4*)(vT + (c + 1) * 136 + tg * 32 + o * 8) = w1;
    }
  }
  __syncthreads();
  f32x16 acc[2][2]; acc[0][0] = zero16(); acc[0][1] = zero16(); acc[1][0] = zero16(); acc[1][1] = zero16();
#pragma unroll
  for (int kk = 0; kk < 8; ++kk) {
    bf16x8 a0 = *(const bf16x8*)(vT + (wm * 64 + l32) * 136 + kk * 16 + h * 8);
    bf16x8 a1 = *(const bf16x8*)(vT + (wm * 64 + 32 + l32) * 136 + kk * 16 + h * 8);
    acc[0][0] = MFMA(a0, wb[kk][0], acc[0][0]); acc[0][1] = MFMA(a0, wb[kk][1], acc[0][1]);
    acc[1][0] = MFMA(a1, wb[kk][0], acc[1][0]); acc[1][1] = MFMA(a1, wb[kk][1], acc[1][1]);
  }
  __syncthreads();
  u16* oT = (u16*)lds;
#pragma unroll
  for (int nt = 0; nt < 2; ++nt) {
    const int i = wn * 64 + nt * 32 + l32; const float bias = p.sgu_b[(layer * 4 + wm) * 128 + i];
#pragma unroll
    for (int mt = 0; mt < 2; ++mt)
#pragma unroll
      for (int q = 0; q < 4; ++q) {
        const int cc = wm * 64 + mt * 32 + q * 8 + h * 4;
        u32x2 v = {pack2(acc[mt][nt][q * 4] + bias, acc[mt][nt][q * 4 + 1] + bias), pack2(acc[mt][nt][q * 4 + 2] + bias, acc[mt][nt][q * 4 + 3] + bias)};
        *(u32x2*)(oT + i * 264 + cc) = v;
      }
  }
  __syncthreads();
  gate_rows(oT, z, (u16*)(p.ws + WS_HY), n0, Z_U, Z_SG, 0, nullptr, tid);
}

template <int W>
DI void pool_win(const u16* zp, int t0, u16* prow) {
  unsigned v[32 + W];
#pragma unroll
  for (int i = 0; i < 32 + W; ++i) { const int t = t0 - W + i; v[i] = (t >= 0) ? *(const unsigned*)(zp + (size_t)max(t, 0) * ZLD) : 0u; }
  float s0 = 0.f, s1 = 0.f;
#pragma unroll
  for (int i = 0; i < W; ++i) { s0 += bflo(v[i]); s1 += bfhi(v[i]); }
#pragma unroll
  for (int tt = 0; tt < 32; ++tt) {
    const float p0 = bflo(v[W + tt]), p1 = bfhi(v[W + tt]);
    s0 += p0 - bflo(v[tt]); s1 += p1 - bfhi(v[tt]);
    const float inv = 1.f / (float)min(t0 + tt + 1, W);
    *(unsigned*)(prow + tt * 264) = pack2(s0 * inv - p0, s1 * inv - p1);
  }
}
DI void pool_job(unsigned char* lds, const P& p, int layer, int nb) {
  const int tid = tid_of(p.ph_lo), lane = tid & 63, wave = wave_of(tid);
  const int n0 = nb * 128;
  const u16* z = (const u16*)(p.ws + WS_Z);
  u16* pl = (u16*)lds;
  {
    const int g = wave & 3, c = g * 64 + (lane & 31) * 2, tq = (wave >> 2) * 2 + (lane >> 5);
    const u16* zp = z + Z_PI + c; const int t0 = n0 + tq * 32; u16* prow = pl + (tq * 32) * 264 + c;
    switch (g) { case 0: pool_win<2>(zp, t0, prow); break; case 1: pool_win<4>(zp, t0, prow); break; case 2: pool_win<8>(zp, t0, prow); break; default: pool_win<16>(zp, t0, prow); break; }
  }
  __syncthreads();
  const int wm = wave & 3, wn = wave >> 2, l32 = lane & 31, h = lane >> 5;
  f32x16 acc[2][2]; acc[0][0] = zero16(); acc[0][1] = zero16(); acc[1][0] = zero16(); acc[1][1] = zero16();
  const u16* W = (const u16*)(p.ws + WS_PWT) + (size_t)(layer * 4 + wm) * 64 * 64;
#pragma unroll
  for (int kk = 0; kk < 4; ++kk) {
    bf16x8 a0 = *(const bf16x8*)(W + (l32) * 64 + kk * 16 + h * 8);
    bf16x8 a1 = *(const bf16x8*)(W + (32 + l32) * 64 + kk * 16 + h * 8);
    bf16x8 b0 = *(const bf16x8*)(pl + (wn * 64 + l32) * 264 + wm * 64 + kk * 16 + h * 8);
    bf16x8 b1 = *(const bf16x8*)(pl + (wn * 64 + 32 + l32) * 264 + wm * 64 + kk * 16 + h * 8);
    acc[0][0] = MFMA(a0, b0, acc[0][0]); acc[0][1] = MFMA(a0, b1, acc[0][1]);
    acc[1][0] = MFMA(a1, b0, acc[1][0]); acc[1][1] = MFMA(a1, b1, acc[1][1]);
  }
  __syncthreads();
  u16* oT = (u16*)lds;
#pragma unroll
  for (int nt = 0; nt < 2; ++nt) {
    const int i = wn * 64 + nt * 32 + l32;
#pragma unroll
    for (int mt = 0; mt < 2; ++mt)
#pragma unroll
      for (int q = 0; q < 4; ++q) {
        const int cc = wm * 64 + mt * 32 + q * 8 + h * 4;
        u32x2 v = {pack2(acc[mt][nt][q * 4], acc[mt][nt][q * 4 + 1]), pack2(acc[mt][nt][q * 4 + 2], acc[mt][nt][q * 4 + 3])};
        *(u32x2*)(oT + i * 264 + cc) = v;
      }
  }
  __syncthreads();
  gate_rows(oT, z, (u16*)(p.ws + WS_HY), n0, -1, Z_PG, 256, p.pool_scale + layer * 256, tid);
}

DI void att2_qk(f32x16& s0, f32x16& s1, const unsigned char* krow, const bf16x8 (&qf)[12], float m) {
  const float nm = -m;
#pragma unroll
  for (int i = 0; i < 16; ++i) { s0[i] = nm; s1[i] = nm; }
  bf16x8 ka[4], kb[4];
#define ATT2_LDK(F, B_) do { F[0] = *(const bf16x8*)(krow + (2 * (B_)) * 32); F[1] = *(const bf16x8*)(krow + 32 * 400 + (2 * (B_)) * 32); \
                             F[2] = *(const bf16x8*)(krow + (2 * (B_) + 1) * 32); F[3] = *(const bf16x8*)(krow + 32 * 400 + (2 * (B_) + 1) * 32); } while (0)
#define ATT2_MMK(F, B_) do { s0 = MFMA(F[0], qf[2 * (B_)], s0); s1 = MFMA(F[1], qf[2 * (B_)], s1); s0 = MFMA(F[2], qf[2 * (B_) + 1], s0); s1 = MFMA(F[3], qf[2 * (B_) + 1], s1); } while (0)
  ATT2_LDK(ka, 0); ATT2_LDK(kb, 1); __builtin_amdgcn_sched_barrier(0);
  ATT2_MMK(ka, 0); __builtin_amdgcn_sched_barrier(0); ATT2_LDK(ka, 2); __builtin_amdgcn_sched_barrier(0);
  ATT2_MMK(kb, 1); __builtin_amdgcn_sched_barrier(0); ATT2_LDK(kb, 3); __builtin_amdgcn_sched_barrier(0);
  ATT2_MMK(ka, 2); __builtin_amdgcn_sched_barrier(0); ATT2_LDK(ka, 4); __builtin_amdgcn_sched_barrier(0);
  ATT2_MMK(kb, 3); __builtin_amdgcn_sched_barrier(0); ATT2_LDK(kb, 5); __builtin_amdgcn_sched_barrier(0);
  ATT2_MMK(ka, 4); __builtin_amdgcn_sched_barrier(0);
  ATT2_MMK(kb, 5); __builtin_amdgcn_sched_barrier(0);
#undef ATT2_LDK
#undef ATT2_MMK
}
DI void att2_sm_pv(f32x16& s0, f32x16& s1, const unsigned char* vrow, f32x16 (&O)[4], float& m, float& l, bool first) {
  bf16x8 vf[8];
#pragma unroll
  for (int mt = 0; mt < 4; ++mt) { vf[2 * mt] = *(const bf16x8*)(vrow + mt * 32 * 144); vf[2 * mt + 1] = *(const bf16x8*)(vrow + mt * 32 * 144 + 32); }
  __builtin_amdgcn_sched_barrier(0);
  float mx = fmaxf(fmaxf(s0[0], s1[0]), fmaxf(s0[1], s1[1]));
#pragma unroll
  for (int i = 2; i < 16; ++i) mx = fmaxf(fmaxf(mx, s0[i]), s1[i]);
  if (first || __builtin_amdgcn_ballot_w64(mx > 8.f) != 0) {
    const float mxx = fmaxf(mx, shx(mx, 32));
    const float d = first ? mxx : fmaxf(mxx, 0.f);
    const float alpha = first ? 1.f : ex2(-d);
    m += d; l *= alpha;
#pragma unroll
    for (int i = 0; i < 16; ++i) { s0[i] -= d; s1[i] -= d; }
#pragma unroll
    for (int mt = 0; mt < 4; ++mt)
#pragma unroll
      for (int i = 0; i < 16; ++i) O[mt][i] *= alpha;
  }
  float ps0 = 0.f, ps1 = 0.f;
#pragma unroll
  for (int i = 0; i < 16; ++i) { s0[i] = ex2(s0[i]); s1[i] = ex2(s1[i]); ps0 += s0[i]; ps1 += s1[i]; }
  l += ps0 + ps1;
  u32x4 p0 = {pack2(s0[0], s0[1]), pack2(s0[2], s0[3]), pack2(s0[4], s0[5]), pack2(s0[6], s0[7])};
  u32x4 p1 = {pack2(s0[8], s0[9]), pack2(s0[10], s0[11]), pack2(s0[12], s0[13]), pack2(s0[14], s0[15])};
  u32x4 p2 = {pack2(s1[0], s1[1]), pack2(s1[2], s1[3]), pack2(s1[4], s1[5]), pack2(s1[6], s1[7])};
  u32x4 p3 = {pack2(s1[8], s1[9]), pack2(s1[10], s1[11]), pack2(s1[12], s1[13]), pack2(s1[14], s1[15])};
  const bf16x8 pf0 = __builtin_bit_cast(bf16x8, p0), pf1 = __builtin_bit_cast(bf16x8, p1), pf2 = __builtin_bit_cast(bf16x8, p2), pf3 = __builtin_bit_cast(bf16x8, p3);
#pragma unroll
  for (int mt = 0; mt < 4; ++mt) { O[mt] = MFMA(vf[2 * mt], pf0, O[mt]); O[mt] = MFMA(vf[2 * mt + 1], pf1, O[mt]); }
  __builtin_amdgcn_sched_barrier(0);
#pragma unroll
  for (int mt = 0; mt < 4; ++mt) { vf[2 * mt] = *(const bf16x8*)(vrow + mt * 32 * 144 + 64); vf[2 * mt + 1] = *(const bf16x8*)(vrow + mt * 32 * 144 + 96); }
  __builtin_amdgcn_sched_barrier(0);
#pragma unroll
  for (int mt = 0; mt < 4; ++mt) { O[mt] = MFMA(vf[2 * mt], pf2, O[mt]); O[mt] = MFMA(vf[2 * mt + 1], pf3, O[mt]); }
}
DI void attn2_item(unsigned char* lds, const P& p, int hd, int QB, int t0, int t1, unsigned char* part) {
  const int tid = tid_of(p.ph_lo), lane = tid & 63, wave = wave_of(tid);
  const int l32 = lane & 31, h = lane >> 5;
  const int trow = QB * 256 + wave * 32 + l32;
  const u16* Qg = (const u16*)(p.ws + WS_Q) + ((size_t)hd * S + trow) * 192 + h * 8;
  bf16x8 qf[12];
#pragma unroll
  for (int ks = 0; ks < 12; ++ks) qf[ks] = *(const bf16x8*)(Qg + ks * 16);
  {
    const float* ct = (const float*)(p.ws + WS_COS) + (size_t)trow * 32 + h * 8; const float* st = (const float*)(p.ws + WS_SIN) + (size_t)trow * 32 + h * 8;
#pragma unroll
    for (int pr = 0; pr < 2; ++pr) {
      const f32x4 c0 = *(const f32x4*)(ct + pr * 16), c1 = *(const f32x4*)(ct + pr * 16 + 4), s0 = *(const f32x4*)(st + pr * 16), s1 = *(const f32x4*)(st + pr * 16 + 4);
      const u32x4 xa = __builtin_bit_cast(u32x4, qf[8 + pr]), xb = __builtin_bit_cast(u32x4, qf[10 + pr]);
      u32x4 oa, ob;
#pragma unroll
      for (int j = 0; j < 4; ++j) {
        const float cl = (j < 2) ? c0[2 * j] : c1[2 * j - 4], ch = (j < 2) ? c0[2 * j + 1] : c1[2 * j - 3], sl = (j < 2) ? s0[2 * j] : s1[2 * j - 4], sh = (j < 2) ? s0[2 * j + 1] : s1[2 * j - 3];
        const float a0 = bflo(xa[j]), a1 = bfhi(xa[j]), b0 = bflo(xb[j]), b1 = bfhi(xb[j]);
        oa[j] = pack2(a0 * cl - b0 * sl, a1 * ch - b1 * sh); ob[j] = pack2(b0 * cl + a0 * sl, b1 * ch + a1 * sh);
      }
      qf[8 + pr] = __builtin_bit_cast(bf16x8, oa); qf[10 + pr] = __builtin_bit_cast(bf16x8, ob);
    }
  }
  const int mychunk = 4 * QB + (wave >> 1);
  const u16* Kg = (const u16*)(p.ws + WS_K) + (size_t)hd * S * 192 + tid * 8;
  const u16* Vg = (const u16*)(p.ws + WS_VT) + (size_t)hd * S * 128 + tid * 8;
  int kdst[3], vdst[2];
#pragma unroll
  for (int i = 0; i < 3; ++i) { const int c = tid + i * NT; kdst[i] = (c / 24) * 400 + (c % 24) * 16; }
#pragma unroll
  for (int i = 0; i < 2; ++i) { const int c = tid + i * NT; vdst[i] = 64 * 400 + (c >> 3) * 144 + (c & 7) * 16; }
  const int koff = l32 * 400 + h * 16;
  const int voff = 64 * 400 + l32 * 144 + h * 16;
  f32x16 O[4]; O[0] = zero16(); O[1] = zero16(); O[2] = zero16(); O[3] = zero16();
  float m = 0.f, l = 0.f;
  u32x4 rk[3], rv[2];
#pragma unroll
  for (int i = 0; i < 3; ++i) rk[i] = *(const u32x4*)(Kg + (size_t)t0 * 64 * 192 + i * NT * 8);
#pragma unroll
  for (int i = 0; i < 2; ++i) rv[i] = *(const u32x4*)(Vg + (size_t)t0 * 128 * 64 + i * NT * 8);
#pragma unroll
  for (int i = 0; i < 3; ++i) *(u32x4*)(lds + kdst[i]) = rk[i];
#pragma unroll
  for (int i = 0; i < 2; ++i) *(u32x4*)(lds + vdst[i]) = rv[i];
  __syncthreads();
#pragma unroll 1
  for (int kt = t0; kt < t1; ++kt) {
    const int stg = ((kt - t0) & 1) * ATT_STAGE, nxt = min(kt + 1, t1 - 1);
#pragma unroll
    for (int i = 0; i < 3; ++i) rk[i] = *(const u32x4*)(Kg + (size_t)nxt * 64 * 192 + i * NT * 8);
#pragma unroll
    for (int i = 0; i < 2; ++i) rv[i] = *(const u32x4*)(Vg + (size_t)nxt * 128 * 64 + i * NT * 8);
    if (kt <= mychunk) { f32x16 s0, s1; att2_qk(s0, s1, lds + stg + koff, qf, m); att2_sm_pv(s0, s1, lds + stg + voff, O, m, l, kt == t0); }
    {
      unsigned char* st = lds + (ATT_STAGE - stg);
#pragma unroll
      for (int i = 0; i < 3; ++i) *(u32x4*)(st + kdst[i]) = rk[i];
#pragma unroll
      for (int i = 0; i < 2; ++i) *(u32x4*)(st + vdst[i]) = rv[i];
    }
    lds_barrier();
  }
  const float lt = l + shx(l, 32);
  if (part) {
    float* po = (float*)part; float* pm = (float*)(part + 8 * 64 * 64 * 4);
#pragma unroll
    for (int mt = 0; mt < 4; ++mt)
#pragma unroll
      for (int i = 0; i < 16; ++i) po[((wave * 64) + mt * 16 + i) * 64 + lane] = O[mt][i];
    pm[wave * 64 + lane] = m; pm[512 + wave * 64 + lane] = lt;
  } else {
    const float inv = 1.f / lt;
    const u16* zg = (const u16*)(p.ws + WS_Z) + (size_t)trow * ZLD + Z_MG + hd * 128;
    u16* Y = (u16*)(p.ws + WS_HY) + (size_t)trow * DM + 512 + hd * 128;
#pragma unroll
    for (int mt = 0; mt < 4; ++mt)
#pragma unroll
      for (int q = 0; q < 4; ++q) {
        const int dv = mt * 32 + q * 8 + h * 4;
        const u32x2 g = *(const u32x2*)(zg + dv);
        float o[4];
#pragma unroll
        for (int j = 0; j < 4; ++j) o[j] = O[mt][q * 4 + j] * inv;
        u32x2 v = {pack2(o[0] * silu(bflo(g[0])), o[1] * silu(bfhi(g[0]))), pack2(o[2] * silu(bflo(g[1])), o[3] * silu(bfhi(g[1])))};
        *(u32x2*)(Y + dv) = v;
      }
  }
  __syncthreads();
}
DI void attn2_combine(const P& p, int vid) {
  const int tid = tid_of(p.ph_lo), lane = tid & 63, wave = wave_of(tid), l32 = lane & 31, h = lane >> 5;
  const int hd = (vid & 7) >> 1, role = vid & 1, QL = 63 - (vid >> 3), sw = 4 * role + (wave & 3), mt0 = 2 * (wave >> 2);
  const unsigned char* pa = p.ws + WS_PART + (size_t)(vid & ~1) * PART_BYTES; const unsigned char* pb = pa + PART_BYTES;
  const float* oa = (const float*)pa; const float* ob = (const float*)pb; const float* ma = (const float*)(pa + 8 * 64 * 64 * 4); const float* mb = (const float*)(pb + 8 * 64 * 64 * 4);
  const float m0 = ma[sw * 64 + lane], l0 = ma[512 + sw * 64 + lane], m1 = mb[sw * 64 + lane], l1 = mb[512 + sw * 64 + lane];
  const float mm = fmaxf(m0, m1); float a0 = ex2(m0 - mm), a1 = ex2(m1 - mm);
  const float inv = 1.f / (l0 * a0 + l1 * a1); a0 *= inv; a1 *= inv;
  const int trow = QL * 256 + sw * 32 + l32;
  const u16* zg = (const u16*)(p.ws + WS_Z) + (size_t)trow * ZLD + Z_MG + hd * 128;
  u16* Y = (u16*)(p.ws + WS_HY) + (size_t)trow * DM + 512 + hd * 128;
#pragma unroll
  for (int mi = 0; mi < 2; ++mi)
#pragma unroll
    for (int q = 0; q < 4; ++q) {
      const int mt = mt0 + mi, dv = mt * 32 + q * 8 + h * 4;
      const u32x2 g = *(const u32x2*)(zg + dv);
      float o[4];
#pragma unroll
      for (int j = 0; j < 4; ++j) { const int idx = ((sw * 64) + mt * 16 + q * 4 + j) * 64 + lane; o[j] = oa[idx] * a0 + ob[idx] * a1; }
      u32x2 v = {pack2(o[0] * silu(bflo(g[0])), o[1] * silu(bfhi(g[0]))), pack2(o[2] * silu(bflo(g[1])), o[3] * silu(bfhi(g[1])))};
      *(u32x2*)(Y + dv) = v;
    }
}

DI void transpose_tile(unsigned char* lds, const float* __restrict__ src, int ldsrc, u16* __restrict__ dst, int ldd, int k0, int n0, int nvalid, const float* gain, int tid) {
  float* tile = (float*)lds;
#pragma unroll
  for (int i = 0; i < 8; ++i) { const int idx = tid + i * NT, r = idx >> 6, cc = idx & 63, n = n0 + cc;
    float v = (n < nvalid) ? src[(size_t)(k0 + r) * ldsrc + n] : 0.f; if (gain) v *= gain[k0 + r]; tile[r * 65 + cc] = v; }
  __syncthreads();
#pragma unroll
  for (int i = 0; i < 8; ++i) { const int idx = tid + i * NT, r = idx >> 6, cc = idx & 63; dst[(size_t)(n0 + r) * ldd + k0 + cc] = tobf(tile[cc * 65 + r]); }
  __syncthreads();
}
DI float wave_sum(float v) { v += shx(v, 32); v += shx(v, 16); v += shx(v, 8); v += shx(v, 4); v += shx(v, 2); v += shx(v, 1); return v; }
DI void prenorm_row(const f32x4 (&v)[4], const float* g, u16* hrow, int lane) {
  float ss = 0.f;
#pragma unroll
  for (int i = 0; i < 4; ++i) ss += v[i][0] * v[i][0] + v[i][1] * v[i][1] + v[i][2] * v[i][2] + v[i][3] * v[i][3];
  ss = wave_sum(ss);
  const float r = rsqrtf(ss * (1.f / 1024.f) + EPS);
#pragma unroll
  for (int i = 0; i < 4; ++i) { const f32x4 gg = *(const f32x4*)(g + (lane + 64 * i) * 4);
    u32x2 o = {pack2(v[i][0] * r * gg[0], v[i][1] * r * gg[1]), pack2(v[i][2] * r * gg[2], v[i][3] * r * gg[3])};
    *(u32x2*)(hrow + (lane + 64 * i) * 4) = o; }
}

DI void prep_weights(unsigned char* lds, const P& p, int layer, int first, int stride, int wv) {
  const int tid = tid_of(wv);
  u16* win = (u16*)(p.ws + WS_WIN); u16* wuq = (u16*)(p.ws + WS_WUQ); u16* wukv = (u16*)(p.ws + WS_WUKV); u16* wout = (u16*)(p.ws + WS_WOUT);
  for (int job = first; job < 1032; job += stride) {
    int r = job;
    if (r < 640) { const int kt = r / 40, nt = r - kt * 40; transpose_tile(lds, p.w_in + (size_t)layer * 1024 * DIN, DIN, win + (size_t)layer * 2560 * 1024, 1024, kt * 64, nt * 64, DIN, nullptr, tid); }
    else if (r < 712) { r -= 640; const int kt = r / 12, nt = r - kt * 12; transpose_tile(lds, p.w_uq + (size_t)layer * 384 * 768, 768, wuq + (size_t)layer * 768 * 384, 384, kt * 64, nt * 64, 768, p.q_norm_g + layer * 384, tid); }
    else if (r < 776) { r -= 712; const int kt = r / 16, nt = r - kt * 16; transpose_tile(lds, p.w_ukv + (size_t)layer * 256 * 1024, 1024, wukv + (size_t)layer * 1024 * 256, 256, kt * 64, nt * 64, 1024, p.kv_norm_g + layer * 256, tid); }
    else { r -= 776; const int kt = r / 16, nt = r - kt * 16; transpose_tile(lds, p.w_out + (size_t)layer * 1024 * 1024, 1024, wout + (size_t)layer * 1024 * 1024, 1024, kt * 64, nt * 64, 1024, nullptr, tid); }
  }
}
DI void phase_prep(unsigned char* lds, const P& p, int wv) {
  const int nb = gridDim.x, bid = blockIdx.x, tid = tid_of(wv);
  u16* win = (u16*)(p.ws + WS_WIN); u16* wuq = (u16*)(p.ws + WS_WUQ); u16* wukv = (u16*)(p.ws + WS_WUKV); u16* wout = (u16*)(p.ws + WS_WOUT);
  prep_weights(lds, p, 0, bid, nb, wv);
  const int gtid = bid * NT + tid, gn = nb * NT;
  u16* sguw = (u16*)(p.ws + WS_SGUW);
  for (int idx = gtid; idx < 2 * 4 * 128 * 128; idx += gn) { const int i = (idx >> 7) & 127, j = idx & 127; sguw[idx] = ((j >> 6) <= (i >> 6)) ? tobf(p.sgu_w[idx]) : (u16)0; }
  u16* pwt = (u16*)(p.ws + WS_PWT);
  for (int idx = gtid; idx < 2 * 4 * 64 * 64; idx += gn) { const int lg = idx >> 12, d = (idx >> 6) & 63, c = idx & 63; pwt[idx] = tobf(p.pool_w[(lg * 64 + c) * 64 + d]); }
  float* cosT = (float*)(p.ws + WS_COS); float* sinT = (float*)(p.ws + WS_SIN);
  for (int idx = gtid; idx < S * 32; idx += gn) {
    const int t = idx >> 5, i = idx & 31; const float angf = (float)p.pos[t] * p.invfreq[i];
    const double a = (double)angf; const double k = rint(a * 0.15915494309189535); const double r = a - k * 6.283185307179586; const double r2 = r * r;
    double ts = r, ss = r, tc = 1.0, sc = 1.0;
#pragma unroll
    for (int n = 1; n <= 13; ++n) { ts *= -r2 * (1.0 / (double)((2 * n) * (2 * n + 1))); ss += ts; tc *= -r2 * (1.0 / (double)((2 * n - 1) * (2 * n))); sc += tc; }
    cosT[idx] = (float)sc; sinT[idx] = (float)ss;
  }
  u16* hb = (u16*)(p.ws + WS_HY);
  const int lane = tid & 63, wave = wave_of(tid);
  for (int row = bid * 8 + wave; row < S; row += nb * 16) {
    const int row2 = row + nb * 8; const bool has2 = row2 < S;
    f32x4 v[4], v2[4];
#pragma unroll
    for (int i = 0; i < 4; ++i) v[i] = *(const f32x4*)(p.x + (size_t)row * DM + (lane + 64 * i) * 4);
    if (has2) {
#pragma unroll
      for (int i = 0; i < 4; ++i) v2[i] = *(const f32x4*)(p.x + (size_t)row2 * DM + (lane + 64 * i) * 4);
    }
    prenorm_row(v, p.pre_g, hb + (size_t)row * DM, lane);
    if (has2) prenorm_row(v2, p.pre_g, hb + (size_t)row2 * DM, lane);
  }
}

DI void post_load(const u16* yout, const float* xold, int row, int lane, f32x4 (&y)[4], f32x4 (&xo)[4]) {
#pragma unroll
  for (int i = 0; i < 4; ++i) { const u32x2 yb = *(const u32x2*)(yout + (size_t)row * DM + (lane + 64 * i) * 4); y[i] = (f32x4){bflo(yb[0]), bfhi(yb[0]), bflo(yb[1]), bfhi(yb[1])};
    xo[i] = *(const f32x4*)(xold + (size_t)row * DM + (lane + 64 * i) * 4); }
}
DI void post_finish(const P& p, int layer, int row, int lane, f32x4 (&y)[4], const f32x4 (&xo)[4], u16* hb) {
  float ss = 0.f;
#pragma unroll
  for (int i = 0; i < 4; ++i) ss += y[i][0] * y[i][0] + y[i][1] * y[i][1] + y[i][2] * y[i][2] + y[i][3] * y[i][3];
  ss = wave_sum(ss);
  const float r = rsqrtf(ss * (1.f / 1024.f) + EPS);
#pragma unroll
  for (int i = 0; i < 4; ++i) {
    const f32x4 g = *(const f32x4*)(p.post_g + layer * DM + (lane + 64 * i) * 4);
    y[i] = xo[i] + y[i] * r * g;
    *(f32x4*)(p.out + (size_t)row * DM + (lane + 64 * i) * 4) = y[i];
  }
  if (layer + 1 < DEPTH) prenorm_row(y, p.pre_g + (layer + 1) * DM, hb + (size_t)row * DM, lane);
}
DI void phase_post(const P& p, int layer) {
  const int nb = gridDim.x, bid = blockIdx.x, tid = tid_of(p.ph_lo), lane = tid & 63, wave = wave_of(tid);
  const u16* yout = (const u16*)(p.ws + WS_Z); const float* xold = layer == 0 ? p.x : p.out;
  u16* hb = (u16*)(p.ws + WS_HY);
  for (int row = bid * 8 + wave; row < S; row += nb * 16) {
    const int row2 = row + nb * 8; const bool has2 = row2 < S;
    f32x4 y0[4], x0[4], y1[4], x1[4];
    post_load(yout, xold, row, lane, y0, x0);
    if (has2) post_load(yout, xold, row2, lane, y1, x1);
    post_finish(p, layer, row, lane, y0, x0, hb);
    if (has2) post_finish(p, layer, row2, lane, y1, x1, hb);
  }
}

__global__ void __launch_bounds__(NT) mega(P p0) {
  const P& p = p0;
  extern __shared__ __attribute__((aligned(16))) unsigned char lds[];
  cg::grid_group grid = cg::this_grid();
  const int nb = gridDim.x, bid = blockIdx.x;
  const int wv0 = __builtin_amdgcn_readfirstlane((int)(threadIdx.x >> 6));
  if (threadIdx.x < 4) ((unsigned*)(lds + XB_LDS_OFF))[threadIdx.x] = 0u;
  __syncthreads();
  XcdBarrier xbar = xcd_barrier_post((unsigned*)(p.ws + WS_BAR), (volatile LAS unsigned*)(lds + XB_LDS_OFF)); xbar.wv = wv0;
  unsigned* xcnt = (unsigned*)(p.ws + WS_BAR + 14336);
  unsigned myslot = 0;
  if (threadIdx.x == 0) myslot = xb_add(&xcnt[16 * xbar.x], 1u);
  int vid = bid;
#define RUN(ph_) true
#define SEAM(ph_) do { if (p.ph_hi < 0) grid.sync(); else xcd_barrier(xbar); } while (0)
  if (RUN(ph)) phase_prep(lds, p, wv0);
  SEAM(0);
  {
    if (threadIdx.x == 0) { bool even = (nb & 7) == 0; for (int j = 0; j < 8; ++j) even = even && (xb_ld(&xcnt[16 * j]) == (unsigned)(nb >> 3));
      ((volatile LAS unsigned*)(lds + XB_LDS_OFF))[2] = even ? (myslot * 8u + xbar.x) : (unsigned)bid; }
    __syncthreads();
    vid = __builtin_amdgcn_readfirstlane((int)((volatile LAS unsigned*)(lds + XB_LDS_OFF))[2]);
  }
#pragma unroll 1
  for (int layer = 0; layer < DEPTH; ++layer) {
    P pl = p0; pl.ph_lo = wv0;
    u16* hy = (u16*)(pl.ws + WS_HY); u16* z = (u16*)(pl.ws + WS_Z);
    float* rs = (float*)(lds + RS_OFF);
    if (RUN(ph)) {
      const u16* W = (const u16*)(pl.ws + WS_WIN) + (size_t)layer * 2560 * 1024;
      { pg8::Gemm g{hy, W, S, 2560, 1024, 1024}; pg8::StaticOrder so; so.init(S, 2560, nb, vid);
        pg8::EpiBf16<0> E{z, ZLD, nullptr, 0, 0};
        pg8::gemm_phase<pg8::EpiBf16<0>, pg8::StaticOrder, false>((PG8_LAS unsigned char*)lds, g, so, E, nullptr, pl.ph_lo); }
      if (layer == 0 && vid >= 128) { __syncthreads(); prep_weights(lds, pl, 1, vid - 128, 128, pl.ph_lo); }
    }
    SEAM(0);
    if (RUN(ph)) {
      const float* cosT = (const float*)(pl.ws + WS_COS); const float* sinT = (const float*)(pl.ws + WS_SIN);
      {
        pg8::StaticOrder so; pg8::Unit u;
        so.init(S, 768, nb, vid);
        if (so.next(0, u)) row_rstd256(rs, z + (size_t)u.pm * 256 * ZLD + Z_CQ, ZLD, 384, pl.ph_lo);
        __syncthreads();
        { pg8::Gemm g{z + Z_CQ, (const u16*)(pl.ws + WS_WUQ) + (size_t)layer * 768 * 384, S, 768, 384, ZLD}; EpiQ2 E{(u16*)(pl.ws + WS_Q), (const PG8_LAS float*)(lds + RS_OFF)};
          pg8::gemm_phase<EpiQ2, pg8::StaticOrder, false>((PG8_LAS unsigned char*)lds, g, so, E, nullptr, pl.ph_lo); }
        __syncthreads();
        so.init(S, 1024, nb, vid);
        if (so.next(0, u)) row_rstd256(rs, z + (size_t)u.pm * 256 * ZLD + Z_CKV, ZLD, 256, pl.ph_lo);
        __syncthreads();
        { pg8::Gemm g{z + Z_CKV, (const u16*)(pl.ws + WS_WUKV) + (size_t)layer * 1024 * 256, S, 1024, 256, ZLD}; EpiKV2 E{(u16*)(pl.ws + WS_K), (u16*)(pl.ws + WS_VT), (const PG8_LAS float*)(lds + RS_OFF)};
          pg8::gemm_phase<EpiKV2, pg8::StaticOrder, false>((PG8_LAS unsigned char*)lds, g, so, E, nullptr, pl.ph_lo); }
        if (vid < 128) krope_tile(pl, vid * 128);
        __syncthreads();
        if (vid < 128) sgu_job(lds, pl, layer, vid); else pool_job(lds, pl, layer, vid - 128);
      }
    }
    SEAM(0);
    if (RUN(ph)) {
      const int hd = (vid & 7) >> 1, role = vid & 1, B = vid >> 3, QL = 63 - B, ntL = 4 * QL + 4;
      unsigned char* part = pl.ws + WS_PART + (size_t)vid * PART_BYTES;
      if (role == 0) attn2_item(lds, pl, hd, QL, 0, 130, part);
      else { attn2_item(lds, pl, hd, QL, 130, ntL, part); attn2_item(lds, pl, hd, B, 0, 4 * B + 4, nullptr); }
    }
    SEAM(0);
    attn2_combine(pl, vid);
    SEAM(0);
    if (RUN(ph)) {
      const u16* W = (const u16*)(pl.ws + WS_WOUT) + (size_t)layer * 1024 * 1024;
      { pg8::Gemm g{hy, W, S, 1024, 1024, 1024}; pg8::StaticOrder so; so.init(S, 1024, nb, vid);
        pg8::EpiBf16<0> E{(u16*)(pl.ws + WS_Z), 1024, nullptr, 0, 0};
        pg8::gemm_phase<pg8::EpiBf16<0>, pg8::StaticOrder, false>((PG8_LAS unsigned char*)lds, g, so, E, nullptr, pl.ph_lo); }
    }
    SEAM(0);
    if (RUN(ph)) phase_post(pl, layer);
    SEAM(0);
  }
  xcd_barrier(xbar);
}
constexpr int NPHASE = 1 + 5 * DEPTH;

extern "C" void kernel_launch(void* const* d_in, const int* in_sizes, int n_in, void* d_out, int out_size, void* d_ws, size_t ws_size, hipStream_t stream) {
  static int grid_blocks = 0;
  if (!grid_blocks) {
    int dev = 0, cus = 0, per_cu = 0;
    hipGetDevice(&dev);
    hipDeviceGetAttribute(&cus, hipDeviceAttributeMultiprocessorCount, dev);
    hipFuncSetAttribute((const void*)mega, hipFuncAttributeMaxDynamicSharedMemorySize, LDS_BYTES);
    hipOccupancyMaxActiveBlocksPerMultiprocessor(&per_cu, (const void*)mega, NT, LDS_BYTES);
    if (per_cu < 1) { fprintf(stderr, "occupancy query returned %d\n", per_cu); per_cu = 1; }
    if (per_cu > 1) per_cu = 1;
    grid_blocks = 256;
    if (cus * per_cu < 256) fprintf(stderr, "device offers %d co-resident workgroups, 256 needed\n", cus * per_cu);
    if (ws_size < WS_END) fprintf(stderr, "workspace too small: %zu < %zu\n", ws_size, (size_t)WS_END);
  }
  P p{};
  p.x = (const float*)d_in[0]; p.pos = (const int*)d_in[1]; p.pre_g = (const float*)d_in[2]; p.post_g = (const float*)d_in[3];
  p.w_in = (const float*)d_in[4]; p.sgu_w = (const float*)d_in[5]; p.sgu_b = (const float*)d_in[6]; p.sgu_ln_g = (const float*)d_in[7];
  p.sgu_ln_b = (const float*)d_in[8]; p.pool_w = (const float*)d_in[9]; p.pool_scale = (const float*)d_in[10]; p.q_norm_g = (const float*)d_in[11];
  p.w_uq = (const float*)d_in[12]; p.kv_norm_g = (const float*)d_in[13]; p.w_ukv = (const float*)d_in[14]; p.w_out = (const float*)d_in[15];
  p.out = (float*)d_out; p.ws = (unsigned char*)d_ws;
  for (int i = 0; i < 32; ++i) p.invfreq[i] = powf(10000.0f, -(float)(2 * i) / 64.0f);
  hipMemsetAsync((char*)d_ws + WS_BAR, 0, 16384, stream);
  p.ph_lo = 0; p.ph_hi = NPHASE;
  void* args[] = {&p};
  hipError_t e = hipLaunchCooperativeKernel((void*)mega, dim3(grid_blocks), dim3(NT), args, LDS_BYTES, stream);
  if (e != hipSuccess) fprintf(stderr, "cooperative launch failed: %s (grid %d)\n", hipGetErrorString(e), grid_blocks);

}
```
